# Optimizing an MI355X kernel written in HIP

```python
import math
import jax, jax.numpy as jnp
from jax import lax
import numpy as np

D_MODEL = 1024
BATCH = 2
SEQ = 8192
DEPTH = 4

N_MIXERS = 3
NORM_EPS = 1e-6
D_FF = ((-(-8 * D_MODEL // 3) + 255) // 256) * 256

D_RNN = 5 * D_MODEL // 4
LRU_HEADS = 10
LRU_HEAD_DIM = D_RNN // LRU_HEADS
CONV_WIDTH = 4
LRU_C = 8.0

NSA_HEADS = 16
NSA_KV_GROUPS = 4
NSA_HEAD_DIM = 64
CMP_LEN = 32
CMP_STRIDE = 16
SEL_LEN = 64
SEL_TOPN = 16
WINDOW = 512
Q_BLOCK = 128
FORCE_SCORE = 1e4
NSA_PROJ = NSA_HEADS * NSA_HEAD_DIM + 6 * NSA_KV_GROUPS * NSA_HEAD_DIM + 3 * NSA_HEADS

REL_BUCKETS = 32
REL_MAX_DIST = 128

GLA_HEADS = 4
GLA_DK = D_MODEL // 2
GLA_DV = D_MODEL
GLA_GATE_RANK = 16
GLA_TAU = 16.0
GLA_CHUNK = 64
GLA_PROJ = 2 * GLA_DK + 2 * GLA_DV + GLA_GATE_RANK

N_A = (DEPTH + 2) // 3
N_B = (DEPTH + 1) // 3
N_C = DEPTH // 3

kernel_name = 'hybrid_rglru_nsa_gla_interleaved'


def rmsnorm(x, g):
    xf = x.astype(jnp.float32)
    y = xf * lax.rsqrt(jnp.mean(xf * xf, axis=-1, keepdims=True) + NORM_EPS) * g.astype(jnp.float32)
    return y.astype(x.dtype)


def swiglu(h, w_gate, w_up, w_down):
    return (jax.nn.silu(h @ w_gate) * (h @ w_up)) @ w_down


def masked_softmax(logits, mask):
    lg = jnp.where(mask, logits.astype(jnp.float32), -jnp.inf)
    m = jnp.max(lg, axis=-1, keepdims=True)
    m = jnp.where(jnp.isfinite(m), m, 0.0)
    e = jnp.exp(lg - m)
    s = jnp.sum(e, axis=-1, keepdims=True)
    return e / jnp.where(s > 0, s, 1.0)


def rel_bucket(dist):
    n = jnp.maximum(dist, 0)
    max_exact = REL_BUCKETS // 2
    nf = jnp.maximum(n, 1).astype(jnp.float32)
    large = max_exact + (jnp.log(nf / max_exact) / math.log(REL_MAX_DIST / max_exact)
                         * (REL_BUCKETS - max_exact)).astype(jnp.int32)
    large = jnp.minimum(large, REL_BUCKETS - 1)
    return jnp.where(n < max_exact, n, large)


def causal_depthwise_conv(x, w, b):
    S = x.shape[1]
    xp = jnp.pad(x, ((0, 0), (CONV_WIDTH - 1, 0), (0, 0)))
    y = b
    for k in range(CONV_WIDTH):
        y = y + xp[:, k:k + S] * w[k]
    return y


def _linear_combine(left, right):
    a_l, b_l = left
    a_r, b_r = right
    return a_l * a_r, a_r * b_l + b_r


def rglru_mixer(h, w_in, conv_w, conv_b, w_a, b_a, w_x, b_x, lam, w_out):
    B, S, _ = h.shape
    gate_in, x_in = jnp.split(h @ w_in, 2, axis=-1)
    xc = causal_depthwise_conv(x_in, conv_w, conv_b)
    xh = xc.reshape(B, S, LRU_HEADS, LRU_HEAD_DIM)
    r = jax.nn.sigmoid((jnp.einsum('bshi,hij->bshj', xh, w_a).reshape(B, S, D_RNN) + b_a).astype(jnp.float32))
    i = jax.nn.sigmoid((jnp.einsum('bshi,hij->bshj', xh, w_x).reshape(B, S, D_RNN) + b_x).astype(jnp.float32))
    log_a = -LRU_C * r * jax.nn.softplus(-lam.astype(jnp.float32))
    a = jnp.exp(log_a)
    u = jnp.sqrt(-jnp.expm1(2.0 * log_a)) * (i * xc.astype(jnp.float32))
    _, hs = lax.associative_scan(_linear_combine, (a, u), axis=1)
    y = jax.nn.gelu(gate_in, approximate=True) * hs.astype(h.dtype)
    return y @ w_out


def nsa_compress(kv, pos, w1, b1, w2, b2):
    B, S, G, dh = kv.shape
    nb = (S - CMP_LEN) // CMP_STRIDE + 1
    idx = jnp.arange(nb)[:, None] * CMP_STRIDE + jnp.arange(CMP_LEN)[None, :]
    blocks = kv[:, idx] + pos[None, None, :, None, :]
    flat = jnp.moveaxis(blocks, 3, 2).reshape(B, nb, G, CMP_LEN * dh)
    return jax.nn.gelu(flat @ w1 + b1) @ w2 + b2


def cmp_to_sel_map(nb_cmp, nb_sel):
    start = jnp.arange(nb_cmp)[:, None] * CMP_STRIDE
    sel_start = jnp.arange(nb_sel)[None, :] * SEL_LEN
    return ((start < sel_start + SEL_LEN) & (start + CMP_LEN > sel_start)).astype(jnp.float32)


def nsa_mixer(h, w_in, cmp_pos, cmp_w1, cmp_b1, cmp_w2, cmp_b2, w_out, rel_bias):
    B, S, _ = h.shape
    G, HG, DH = NSA_KV_GROUPS, NSA_HEADS // NSA_KV_GROUPS, NSA_HEAD_DIM
    qw, kvw = NSA_HEADS * DH, NSA_KV_GROUPS * DH
    proj = h @ w_in
    q = proj[..., :qw].reshape(B, S, G, HG, DH) * DH ** -0.5
    kv = proj[..., qw:qw + 6 * kvw].reshape(B, S, 6, G, DH)
    k_c, v_c, k_s, v_s, k_w, v_w = [kv[:, :, j] for j in range(6)]
    gates = jax.nn.sigmoid(proj[..., qw + 6 * kvw:].reshape(B, S, G, HG, 3))

    kc = nsa_compress(k_c, cmp_pos[0], cmp_w1[0], cmp_b1[0], cmp_w2[0], cmp_b2[0])
    vc = nsa_compress(v_c, cmp_pos[1], cmp_w1[1], cmp_b1[1], cmp_w2[1], cmp_b2[1])
    nb_cmp = kc.shape[1]
    nb_sel = S // SEL_LEN
    n_sel = min(SEL_TOPN, nb_sel)
    sel_map = cmp_to_sel_map(nb_cmp, nb_sel)
    cmp_end = jnp.arange(nb_cmp) * CMP_STRIDE + CMP_LEN - 1

    def to_blocks(t):
        return jnp.moveaxis(t.reshape(B, nb_sel, SEL_LEN, G, DH), 3, 1).reshape(B, G, nb_sel, SEL_LEN * DH)

    ks_blk, vs_blk = to_blocks(k_s), to_blocks(v_s)
    kw_pad = jnp.pad(k_w, ((0, 0), (WINDOW, 0), (0, 0), (0, 0)))
    vw_pad = jnp.pad(v_w, ((0, 0), (WINDOW, 0), (0, 0), (0, 0)))
    table_g = jnp.transpose(rel_bias.reshape(REL_BUCKETS, G, HG), (1, 0, 2))
    blk_ids = jnp.arange(nb_sel)
    g_ids = jnp.arange(G)[None, :, None, None]

    def head_bias(dist):
        return jnp.transpose(rel_bias[rel_bucket(dist)].reshape(*dist.shape, G, HG), (2, 3, 0, 1))

    def query_block(qb):
        t0 = qb * Q_BLOCK
        tpos = t0 + jnp.arange(Q_BLOCK)
        qi = lax.dynamic_slice_in_dim(q, t0, Q_BLOCK, axis=1)
        gi = lax.dynamic_slice_in_dim(gates, t0, Q_BLOCK, axis=1)
        dist_c = tpos[:, None] - cmp_end[None, :]
        lg_c = jnp.einsum('bqghd,bngd->bghqn', qi, kc) + head_bias(dist_c)
        p_c = masked_softmax(lg_c, dist_c >= 0)
        o_c = jnp.einsum('bghqn,bngd->bqghd', p_c.astype(vc.dtype), vc)
        imp = jnp.einsum('bghqn,nm->bgqm', p_c, sel_map)
        cur = tpos // SEL_LEN
        valid = blk_ids[None, :] * SEL_LEN <= tpos[:, None]
        forced = (blk_ids[None, :] == 0) | (blk_ids[None, :] == cur[:, None]) | (blk_ids[None, :] == cur[:, None] - 1)
        score = jnp.where(valid, imp + jnp.where(forced, FORCE_SCORE, 0.0), -jnp.inf)
        _, idx = lax.top_k(score, n_sel)
        flat_idx = idx.reshape(B, G, Q_BLOCK * n_sel, 1)
        k_sel = jnp.take_along_axis(ks_blk, flat_idx, axis=2).reshape(B, G, Q_BLOCK, n_sel * SEL_LEN, DH)
        v_sel = jnp.take_along_axis(vs_blk, flat_idx, axis=2).reshape(B, G, Q_BLOCK, n_sel * SEL_LEN, DH)
        key_pos = (idx[..., None] * SEL_LEN + jnp.arange(SEL_LEN)).reshape(B, G, Q_BLOCK, n_sel * SEL_LEN)
        dist_s = tpos[None, None, :, None] - key_pos
        bias_s = jnp.moveaxis(table_g[g_ids, rel_bucket(dist_s)], -1, 3)
        lg_s = jnp.einsum('bqghd,bgqkd->bgqhk', qi, k_sel) + bias_s
        p_s = masked_softmax(lg_s, (dist_s >= 0)[:, :, :, None, :])
        o_s = jnp.einsum('bgqhk,bgqkd->bqghd', p_s.astype(v_sel.dtype), v_sel)
        kw = lax.dynamic_slice_in_dim(kw_pad, t0, Q_BLOCK + WINDOW, axis=1)
        vw = lax.dynamic_slice_in_dim(vw_pad, t0, Q_BLOCK + WINDOW, axis=1)
        key_pos_w = t0 - WINDOW + jnp.arange(Q_BLOCK + WINDOW)
        dist_w = tpos[:, None] - key_pos_w[None, :]
        mask_w = (dist_w >= 0) & (dist_w < WINDOW) & (key_pos_w[None, :] >= 0)
        lg_w = jnp.einsum('bqghd,bkgd->bghqk', qi, kw) + head_bias(dist_w)
        p_w = masked_softmax(lg_w, mask_w)
        o_w = jnp.einsum('bghqk,bkgd->bqghd', p_w.astype(vw.dtype), vw)
        return gi[..., 0:1] * o_c + gi[..., 1:2] * o_s + gi[..., 2:3] * o_w

    o = lax.map(query_block, jnp.arange(S // Q_BLOCK))
    o = jnp.moveaxis(o, 0, 1).reshape(B, S, NSA_HEADS * DH)
    return o @ w_out


def gla_mixer(h, w_in, w_g2, b_g2, norm_g, w_out):
    B, S, _ = h.shape
    H, C = GLA_HEADS, GLA_CHUNK
    dk, dv = GLA_DK // H, GLA_DV // H
    N = S // C
    proj = h @ w_in
    q, k, v, r, g_low = jnp.split(proj, [GLA_DK, 2 * GLA_DK, 2 * GLA_DK + GLA_DV, 2 * GLA_DK + 2 * GLA_DV], axis=-1)
    log_alpha = jax.nn.log_sigmoid((g_low @ w_g2 + b_g2).astype(jnp.float32)) / GLA_TAU

    def chunks(t, d):
        return jnp.transpose(t.astype(jnp.float32).reshape(B, N, C, H, d), (0, 3, 1, 2, 4))

    q = chunks(q, dk) * dk ** -0.5
    k, v, la = chunks(k, dk), chunks(v, dv), chunks(log_alpha, dk)
    b = jnp.cumsum(la, axis=3)
    b_last = b[:, :, :, -1:, :]
    q_dec = q * jnp.exp(b)
    k_inv = k * jnp.exp(-b)
    k_end = k * jnp.exp(b_last - b)
    causal = jnp.tril(jnp.ones((C, C), dtype=bool))
    att = jnp.where(causal, jnp.einsum('bhncd,bhnjd->bhncj', q_dec, k_inv), 0.0)
    o_intra = jnp.einsum('bhncj,bhnje->bhnce', att, v)

    def step(state, inp):
        q_c, k_c, v_c, dec = inp
        o = jnp.einsum('bhcd,bhde->bhce', q_c, state)
        state = state * dec[..., None] + jnp.einsum('bhcd,bhce->bhde', k_c, v_c)
        return state, o

    xs = (jnp.moveaxis(q_dec, 2, 0), jnp.moveaxis(k_end, 2, 0), jnp.moveaxis(v, 2, 0),
          jnp.moveaxis(jnp.exp(b_last[:, :, :, 0, :]), 2, 0))
    _, o_inter = lax.scan(step, jnp.zeros((B, H, dk, dv), jnp.float32), xs)
    o = o_intra + jnp.moveaxis(o_inter, 0, 2)
    o = jnp.transpose(o, (0, 2, 3, 1, 4)).reshape(B, S, H, dv)
    o = o * lax.rsqrt(jnp.mean(o * o, axis=-1, keepdims=True) + NORM_EPS) * norm_g.astype(jnp.float32)
    o = o.reshape(B, S, GLA_DV).astype(h.dtype) * jax.nn.silu(r)
    return o @ w_out


def setup_inputs(seed: int = 0) -> dict:
    key = jax.random.key(seed)
    keys = iter(jax.random.split(key, 40))
    f32 = jnp.float32

    def nrm(shape, fan_in, scale=1.0):
        return jax.random.normal(next(keys), shape, f32) * (scale * fan_in ** -0.5)

    def gain(shape):
        return 1.0 + 0.02 * jax.random.normal(next(keys), shape, f32)

    def small(shape, s=0.01):
        return s * jax.random.normal(next(keys), shape, f32)

    D = D_MODEL
    x = jax.random.normal(next(keys), (BATCH, SEQ, D), f32)
    rel_bias = small((REL_BUCKETS, NSA_HEADS), 0.2)
    final_norm = gain((D,))
    mix_norm = gain((DEPTH, D))
    ffn_norm = gain((DEPTH, D))
    ffn_w_gate = nrm((DEPTH, D, D_FF), D)
    ffn_w_up = nrm((DEPTH, D, D_FF), D)
    ffn_w_down = nrm((DEPTH, D_FF, D), D_FF)
    lru_w_in = nrm((N_A, D, 2 * D_RNN), D)
    lru_conv_w = nrm((N_A, CONV_WIDTH, D_RNN), CONV_WIDTH)
    lru_conv_b = small((N_A, D_RNN))
    lru_w_a = nrm((N_A, LRU_HEADS, LRU_HEAD_DIM, LRU_HEAD_DIM), LRU_HEAD_DIM)
    lru_b_a = small((N_A, D_RNN))
    lru_w_x = nrm((N_A, LRU_HEADS, LRU_HEAD_DIM, LRU_HEAD_DIM), LRU_HEAD_DIM)
    lru_b_x = small((N_A, D_RNN))
    u = jax.random.uniform(next(keys), (N_A, D_RNN), f32, 0.9, 0.999)
    p = u ** (1.0 / LRU_C)
    lru_lam = jnp.log(p) - jnp.log1p(-p)
    lru_w_out = nrm((N_A, D_RNN, D), D_RNN)
    nsa_w_in = nrm((N_B, D, NSA_PROJ), D)
    nsa_cmp_pos = small((N_B, 2, CMP_LEN, NSA_HEAD_DIM), 0.1)
    nsa_cmp_w1 = nrm((N_B, 2, CMP_LEN * NSA_HEAD_DIM, NSA_HEAD_DIM), CMP_LEN * NSA_HEAD_DIM)
    nsa_cmp_b1 = small((N_B, 2, NSA_HEAD_DIM))
    nsa_cmp_w2 = nrm((N_B, 2, NSA_HEAD_DIM, NSA_HEAD_DIM), NSA_HEAD_DIM)
    nsa_cmp_b2 = small((N_B, 2, NSA_HEAD_DIM))
    nsa_w_out = nrm((N_B, NSA_HEADS * NSA_HEAD_DIM, D), NSA_HEADS * NSA_HEAD_DIM)
    gla_w_in = nrm((N_C, D, GLA_PROJ), D)
    gla_w_g2 = nrm((N_C, GLA_GATE_RANK, GLA_DK), GLA_GATE_RANK)
    gla_b_g2 = small((N_C, GLA_DK), 0.1)
    gla_norm = gain((N_C, GLA_DV // GLA_HEADS))
    gla_w_out = nrm((N_C, GLA_DV, D), GLA_DV)
    return {
        'x': x, 'rel_bias': rel_bias, 'final_norm': final_norm, 'mix_norm': mix_norm, 'ffn_norm': ffn_norm,
        'ffn_w_gate': ffn_w_gate, 'ffn_w_up': ffn_w_up, 'ffn_w_down': ffn_w_down,
        'lru_w_in': lru_w_in, 'lru_conv_w': lru_conv_w, 'lru_conv_b': lru_conv_b, 'lru_w_a': lru_w_a,
        'lru_b_a': lru_b_a, 'lru_w_x': lru_w_x, 'lru_b_x': lru_b_x, 'lru_lam': lru_lam, 'lru_w_out': lru_w_out,
        'nsa_w_in': nsa_w_in, 'nsa_cmp_pos': nsa_cmp_pos, 'nsa_cmp_w1': nsa_cmp_w1, 'nsa_cmp_b1': nsa_cmp_b1,
        'nsa_cmp_w2': nsa_cmp_w2, 'nsa_cmp_b2': nsa_cmp_b2, 'nsa_w_out': nsa_w_out,
        'gla_w_in': gla_w_in, 'gla_w_g2': gla_w_g2, 'gla_b_g2': gla_b_g2, 'gla_norm': gla_norm, 'gla_w_out': gla_w_out,
    }


def reference(x, rel_bias, final_norm, mix_norm, ffn_norm, ffn_w_gate, ffn_w_up, ffn_w_down,
              lru_w_in, lru_conv_w, lru_conv_b, lru_w_a, lru_b_a, lru_w_x, lru_b_x, lru_lam, lru_w_out,
              nsa_w_in, nsa_cmp_pos, nsa_cmp_w1, nsa_cmp_b1, nsa_cmp_w2, nsa_cmp_b2, nsa_w_out,
              gla_w_in, gla_w_g2, gla_b_g2, gla_norm, gla_w_out):
    h = x
    for layer in range(DEPTH):
        kind = layer % N_MIXERS
        j = layer // N_MIXERS
        hn = rmsnorm(h, mix_norm[layer])
        if kind == 0:
            y = rglru_mixer(hn, lru_w_in[j], lru_conv_w[j], lru_conv_b[j], lru_w_a[j], lru_b_a[j],
                            lru_w_x[j], lru_b_x[j], lru_lam[j], lru_w_out[j])
        elif kind == 1:
            y = nsa_mixer(hn, nsa_w_in[j], nsa_cmp_pos[j], nsa_cmp_w1[j], nsa_cmp_b1[j], nsa_cmp_w2[j],
                          nsa_cmp_b2[j], nsa_w_out[j], rel_bias)
        else:
            y = gla_mixer(hn, gla_w_in[j], gla_w_g2[j], gla_b_g2[j], gla_norm[j], gla_w_out[j])
        h = h + y
        h = h + swiglu(rmsnorm(h, ffn_norm[layer]), ffn_w_gate[layer], ffn_w_up[layer], ffn_w_down[layer])
    return rmsnorm(h, final_norm)
```

```cpp
#include <hip/hip_runtime.h>
#include <hip/hip_cooperative_groups.h>
#include <cstdio>
#include <cstdint>
namespace cg = cooperative_groups;

#define LAS __attribute__((address_space(3)))
typedef unsigned short bf16_t;
typedef short bf16x8 __attribute__((ext_vector_type(8)));
typedef short s16x4 __attribute__((ext_vector_type(4)));
typedef float f32x4 __attribute__((ext_vector_type(4)));
typedef float f32x2 __attribute__((ext_vector_type(2)));
typedef unsigned u32x4 __attribute__((ext_vector_type(4)));
typedef unsigned u32x2 __attribute__((ext_vector_type(2)));
typedef __bf16 bf16x2_t __attribute__((ext_vector_type(2)));

constexpr int T_ = 16384, SEQ = 8192, D_ = 1024, FF = 2816, RNN = 1280;
constexpr int NSA_NPAD = 2816, GLA_NPAD = 3328;
constexpr float EPS = 1e-6f;
constexpr float LOG2E = 1.4426950408889634f;

constexpr size_t MiB = 1u << 20;
constexpr size_t WS_W_GU = 0, WS_W_DN = 11 * MiB, WS_W_MIN = 17 * MiB, WS_W_MOUT = 24 * MiB, WS_W_SMALL = 27 * MiB;
constexpr size_t WS_HN = 28 * MiB;
constexpr size_t WS_ACT = 60 * MiB;
constexpr size_t WS_LG = 60 * MiB, WS_LX = 100 * MiB, WS_LHL = 140 * MiB, WS_LAC = 180 * MiB, WS_LAGGA = 220 * MiB, WS_LAGGH = 221 * MiB;
constexpr size_t WS_NQ = 60 * MiB, WS_NKV = 92 * MiB, WS_NGT = 140 * MiB, WS_NKC = 143 * MiB, WS_NVC = 144 * MiB;
constexpr size_t WS_GQ = 60 * MiB, WS_GK = 76 * MiB, WS_GV = 92 * MiB, WS_GR = 124 * MiB, WS_GGL = 156 * MiB, WS_GDEC = 157 * MiB, WS_GKVT = 158 * MiB;
constexpr size_t WS_END = 224 * MiB;

constexpr int LDS_BYTES = 147456;

__device__ __forceinline__ unsigned pk2(float lo, float hi) { f32x2 v = {lo, hi}; bf16x2_t b = __builtin_convertvector(v, bf16x2_t); return __builtin_bit_cast(unsigned, b); }
__device__ __forceinline__ float bf2f(unsigned short h) { return __uint_as_float(((unsigned)h) << 16); }
__device__ __forceinline__ float bflo(unsigned w) { return __uint_as_float(w << 16); }
__device__ __forceinline__ float bfhi(unsigned w) { return __uint_as_float(w & 0xffff0000u); }
__device__ __forceinline__ float fast_rcp(float x) { return __builtin_amdgcn_rcpf(x); }
__device__ __forceinline__ float fast_exp2(float x) { return __builtin_amdgcn_exp2f(x); }
__device__ __forceinline__ float sigmoidf_(float x) { return fast_rcp(1.f + fast_exp2(-x * LOG2E)); }
__device__ __forceinline__ float siluf_(float x) { return x * sigmoidf_(x); }
__device__ __forceinline__ float gelu_tanh_(float x) { const float z = 0.7978845608028654f * (x + 0.044715f * x * x * x); return x * fast_rcp(1.f + fast_exp2(-2.f * LOG2E * z)); }
__device__ __forceinline__ float wave_sum(float v) {
#pragma unroll
    for (int o = 1; o < 64; o <<= 1) v += __shfl_xor(v, o);
    return v;
}
namespace pg8 {
#define PG8_LAS __attribute__((address_space(3)))
typedef unsigned short bf16_t;
typedef short bf16x8 __attribute__((ext_vector_type(8)));
typedef float f32x4 __attribute__((ext_vector_type(4)));
typedef unsigned u32x4 __attribute__((ext_vector_type(4)));
constexpr int BM = 256, BK = 64, HALF = 128, HTB = HALF * BK * 2  , STAGE_BYTES = 8 * HTB, NXCD = 8, WGM = 8;

__host__ __device__ __forceinline__ int lds_byte(int r, int c) { const int st = (r >> 4) * 2 + (c >> 5), rr = r & 15, cc = c & 31, ob = rr * 64 + cc * 2; return st * 1024 + (ob ^ (((ob >> 9) & 1) << 5)); }
__host__ __device__ __forceinline__ void stage_rc(int b, int& R, int& C) { const int st = b / 1024, sb = b % 1024, swz = sb ^ (((sb >> 9) & 1) << 5); R = (st >> 1) * 16 + swz / 64; C = (st & 1) * 32 + (swz % 64) / 2; }
__host__ __device__ __forceinline__ int perm32(int rho) { const int n = rho >> 4, i = rho & 15; return 8 * (i >> 2) + 4 * n + (i & 3); }

struct Unit { int pm, pn; };
struct Gemm { const bf16_t* A; const bf16_t* Bt; int M, N, K; };

struct StaticOrder {
    int nM, nN, nwg, G, c;
    __host__ __device__ void init(int M, int N, int G_, int c_) { nM = M / BM; nN = N / BM; nwg = nM * nN; G = G_; c = c_; }
    __host__ __device__ bool next(int i, Unit& u) const {
        const long L = (long)i * G + c; if (L >= nwg) return false;
        int wgid = (int)L; { const int q = nwg / NXCD, r = nwg % NXCD, xcd = wgid % NXCD, off = wgid / NXCD; wgid = (xcd < r ? xcd * (q + 1) : r * (q + 1) + (xcd - r) * q) + off; }
        const int nig = WGM * nN, gid = wgid / nig, fm = gid * WGM, gsz = (nM - fm) < WGM ? (nM - fm) : WGM;
        u.pm = fm + ((wgid % nig) % gsz); u.pn = (wgid % nig) / gsz; return true;
    }
    __device__ __forceinline__ void a_ready(const Unit&) const {}
    __device__ __forceinline__ void done(const Unit&) const {}
};

struct EpiResid {
    static constexpr bool PERM = false, AFTER_DRAIN = false;
    const float* base; float* out;
    __device__ __forceinline__ void operator()(const f32x4 (&acc)[2][2][4][2], const Unit& u, int wr, int wc, int fr, int fq) const {
        const int row0 = u.pm * BM + wr * 64 + fr, col0 = u.pn * BM + wc * 32 + 4 * fq;
#pragma unroll
        for (int ai = 0; ai < 2; ++ai)
#pragma unroll
            for (int m = 0; m < 4; ++m) { const size_t off = (size_t)(row0 + ai * HALF + m * 16) * 1024 + col0;
#pragma unroll
                for (int bj = 0; bj < 2; ++bj)
#pragma unroll
                    for (int n = 0; n < 2; ++n) { const f32x4 b = *(const f32x4*)(base + off + bj * HALF + n * 16); *(f32x4*)(out + off + bj * HALF + n * 16) = b + acc[ai][bj][m][n]; } }
    }
};
__device__ __forceinline__ u32x4 pack8(const f32x4 a, const f32x4 b) { u32x4 w; w.x = ::pk2(a[0], a[1]); w.y = ::pk2(a[2], a[3]); w.z = ::pk2(b[0], b[1]); w.w = ::pk2(b[2], b[3]); return w; }
struct EpiSwiglu {
    static constexpr bool PERM = true, AFTER_DRAIN = false;
    bf16_t* O;
    __device__ __forceinline__ void operator()(const f32x4 (&acc)[2][2][4][2], const Unit& u, int wr, int wc, int fr, int fq) const {
        const int row0 = u.pm * BM + wr * 64 + fr, col0 = u.pn * HALF + wc * 32 + 8 * fq;
#pragma unroll
        for (int ai = 0; ai < 2; ++ai)
#pragma unroll
            for (int m = 0; m < 4; ++m) { f32x4 v[2];
#pragma unroll
                for (int n = 0; n < 2; ++n) { const f32x4 g = acc[ai][0][m][n], up = acc[ai][1][m][n];
#pragma unroll
                    for (int j = 0; j < 4; ++j) v[n][j] = ::siluf_(g[j]) * up[j]; }
                *(u32x4*)(O + (size_t)(row0 + ai * HALF + m * 16) * FF + col0) = pack8(v[0], v[1]); }
    }
};
template <int ACT> __device__ __forceinline__ void store_tile_bf16(const f32x4 (&acc)[2][2][4][2], bf16_t* dst, int ldc, int cbase, float scale, int pm, int wr, int wc, int fr, int fq) {
    const int row0 = pm * BM + wr * 64 + fr, col0 = cbase + wc * 32 + 8 * fq;
#pragma unroll
    for (int ai = 0; ai < 2; ++ai)
#pragma unroll
        for (int m = 0; m < 4; ++m)
#pragma unroll
            for (int bj = 0; bj < 2; ++bj) { f32x4 v[2];
#pragma unroll
                for (int n = 0; n < 2; ++n)
#pragma unroll
                    for (int j = 0; j < 4; ++j) { const float x = acc[ai][bj][m][n][j]; v[n][j] = ACT == 1 ? ::gelu_tanh_(x) : ACT == 2 ? ::siluf_(x) : x * scale; }
                *(u32x4*)(dst + (size_t)(row0 + ai * HALF + m * 16) * ldc + col0 + bj * HALF) = pack8(v[0], v[1]); }
}
template <int ACT> __device__ __forceinline__ void store_tile_f32_narrow(const f32x4 (&acc)[2][2][4][2], float* dst, int ldc, int ncols, int pm, int wr, int wc, int fr, int fq) {
    const int row0 = pm * BM + wr * 64 + fr;
#pragma unroll
    for (int ai = 0; ai < 2; ++ai)
#pragma unroll
        for (int m = 0; m < 4; ++m)
#pragma unroll
            for (int n = 0; n < 2; ++n) { const int c = wc * 32 + 8 * fq + 4 * n;
                if (c < ncols) { f32x4 v = acc[ai][0][m][n];
                    if (ACT == 3) { v[0] = ::sigmoidf_(v[0]); v[1] = ::sigmoidf_(v[1]); v[2] = ::sigmoidf_(v[2]); v[3] = ::sigmoidf_(v[3]); }
                    *(f32x4*)(dst + (size_t)(row0 + ai * HALF + m * 16) * ldc + c) = v; } }
}
struct EpiLruIn {
    static constexpr bool PERM = true, AFTER_DRAIN = false;
    bf16_t* G; bf16_t* X;
    __device__ __forceinline__ void operator()(const f32x4 (&acc)[2][2][4][2], const Unit& u, int wr, int wc, int fr, int fq) const {
        if (u.pn < 5) store_tile_bf16<1>(acc, G, RNN, u.pn * BM, 1.f, u.pm, wr, wc, fr, fq);
        else store_tile_bf16<0>(acc, X, RNN, (u.pn - 5) * BM, 1.f, u.pm, wr, wc, fr, fq);
    }
};
struct EpiNsaIn {
    static constexpr bool PERM = true, AFTER_DRAIN = false;
    bf16_t* Q; bf16_t* KV; float* GT;
    __device__ __forceinline__ void operator()(const f32x4 (&acc)[2][2][4][2], const Unit& u, int wr, int wc, int fr, int fq) const {
        if (u.pn < 4) store_tile_bf16<0>(acc, Q, 1024, u.pn * BM, 0.125f, u.pm, wr, wc, fr, fq);
        else if (u.pn < 10) store_tile_bf16<0>(acc, KV + (size_t)(u.pn - 4) * T_ * 256, 256, 0, 1.f, u.pm, wr, wc, fr, fq);
        else store_tile_f32_narrow<3>(acc, GT, 48, 48, u.pm, wr, wc, fr, fq);
    }
};
struct EpiGlaIn {
    static constexpr bool PERM = true, AFTER_DRAIN = false;
    bf16_t* Q; bf16_t* K; bf16_t* V; bf16_t* R; float* GL;
    __device__ __forceinline__ void operator()(const f32x4 (&acc)[2][2][4][2], const Unit& u, int wr, int wc, int fr, int fq) const {
        if (u.pn < 2) store_tile_bf16<0>(acc, Q, 512, u.pn * BM, 0.08838834764831845f, u.pm, wr, wc, fr, fq);
        else if (u.pn < 4) store_tile_bf16<0>(acc, K, 512, (u.pn - 2) * BM, 1.f, u.pm, wr, wc, fr, fq);
        else if (u.pn < 8) store_tile_bf16<0>(acc, V, 1024, (u.pn - 4) * BM, 1.f, u.pm, wr, wc, fr, fq);
        else if (u.pn < 12) store_tile_bf16<2>(acc, R, 1024, (u.pn - 8) * BM, 1.f, u.pm, wr, wc, fr, fq);
        else store_tile_f32_narrow<0>(acc, GL, 16, 16, u.pm, wr, wc, fr, fq);
    }
};
template <class Epi, class Sched, bool ALIGN_EPI = false, bool SP2 = false>
__device__ __forceinline__ void gemm_phase(PG8_LAS unsigned char* lds, const Gemm g, const Sched& S, const Epi& E, const int tid) {
    const int wid = __builtin_amdgcn_readfirstlane(tid >> 6), lane = tid & 63, wr = wid >> 2, wc = wid & 3, fr = lane & 15, fq = lane >> 4;
    const int K = g.K, nt = K / BK;
    unsigned voffA[2], voffB[2];
#pragma unroll
    for (int i = 0; i < 2; ++i) { int R, C; stage_rc(tid * 16 + i * 8192, R, C); const int Rb = Epi::PERM ? ((R & ~31) + perm32(R & 31)) : R;
        voffA[i] = (unsigned)(R * K + C) * 2u; voffB[i] = (unsigned)(Rb * K + C) * 2u; }
    const size_t kstep = (size_t)(BK * 2);
    const size_t hstep = (size_t)HALF * K * 2;
    const size_t tstep = 2 * hstep;
    const unsigned ldsw = (unsigned)wid * 1024u;
    const int aoff = lds_byte(wr * 64 + fr, fq * 8), boff = lds_byte(wc * 32 + fr, fq * 8);
#define PG8_SA(b, h) (((b) * 2 + (h)) * HTB)
#define PG8_SB(b, h) ((4 + (b) * 2 + (h)) * HTB)
#define PG8_STAGE(bufoff, gbase, voff) do { _Pragma("unroll") for (int _i = 0; _i < 2; ++_i) \
        __builtin_amdgcn_global_load_lds((const unsigned*)((const char*)(gbase) + (voff)[_i]), (PG8_LAS unsigned*)(lds + (bufoff) + ldsw + _i * 8192), 16, 0, 0); } while (0)
#define PG8_LDA(dst, b, h) do { _Pragma("unroll") for (int m = 0; m < 4; ++m) _Pragma("unroll") for (int k = 0; k < 2; ++k) dst[m][k] = *(const PG8_LAS bf16x8*)(lds + PG8_SA(b, h) + aoff + m * 2048 + k * 1024); } while (0)
#define PG8_LDB(dst, b, h) do { _Pragma("unroll") for (int n = 0; n < 2; ++n) _Pragma("unroll") for (int k = 0; k < 2; ++k) dst[n][k] = *(const PG8_LAS bf16x8*)(lds + PG8_SB(b, h) + boff + n * 2048 + k * 1024); } while (0)
#define PG8_MMA(ai, bj, At, Bt) do { __builtin_amdgcn_s_setprio(1); _Pragma("unroll") for (int m = 0; m < 4; ++m) _Pragma("unroll") for (int n = 0; n < 2; ++n) _Pragma("unroll") for (int k = 0; k < 2; ++k) \
        acc[ai][bj][m][n] = __builtin_amdgcn_mfma_f32_16x16x32_bf16(Bt[n][k], At[m][k], acc[ai][bj][m][n], 0, 0, 0); __builtin_amdgcn_s_setprio(0); } while (0)
#define PG8_WAIT_V(n) asm volatile("s_waitcnt vmcnt(" #n ")" ::: "memory")
#define PG8_WAIT_L(n) asm volatile("s_waitcnt lgkmcnt(" #n ")" ::: "memory")
#define PG8_BAR __builtin_amdgcn_s_barrier()
#define PG8_SCHED __builtin_amdgcn_sched_barrier(0)
    Unit cur, nxt; int ui = 0;
    if (!S.next(0, cur)) return;
    f32x4 acc[2][2][4][2];
#pragma unroll
    for (int a = 0; a < 2; ++a)
#pragma unroll
        for (int b = 0; b < 2; ++b)
#pragma unroll
            for (int m = 0; m < 4; ++m)
#pragma unroll
                for (int n = 0; n < 2; ++n) acc[a][b][m][n] = (f32x4){0.f, 0.f, 0.f, 0.f};
    bf16x8 At[4][2], B0[2][2], B1[2][2];
    const char* cA = (const char*)g.A + (size_t)cur.pm * tstep; const char* cB = (const char*)g.Bt + (size_t)cur.pn * tstep;
    S.a_ready(cur);
    if constexpr (SP2) {
        PG8_STAGE(PG8_SB(0, 0), cB, voffB); PG8_STAGE(PG8_SB(0, 1), cB + hstep, voffB); PG8_STAGE(PG8_SA(0, 0), cA, voffA); PG8_STAGE(PG8_SA(0, 1), cA + hstep, voffA);
        if (wr == 1) PG8_BAR;
        PG8_WAIT_V(2); PG8_BAR;
        PG8_STAGE(PG8_SB(1, 0), cB + kstep, voffB); PG8_STAGE(PG8_SA(1, 0), cA + kstep, voffA); PG8_STAGE(PG8_SB(1, 1), cB + hstep + kstep, voffB);
        PG8_WAIT_V(6); PG8_BAR;
    } else {
        PG8_STAGE(PG8_SB(0, 0), cB, voffB); PG8_STAGE(PG8_SA(0, 0), cA, voffA); PG8_STAGE(PG8_SB(0, 1), cB + hstep, voffB); PG8_STAGE(PG8_SA(0, 1), cA + hstep, voffA);
        if (wr == 1) PG8_BAR;
        PG8_WAIT_V(4); PG8_BAR;
        PG8_STAGE(PG8_SB(1, 0), cB + kstep, voffB); PG8_STAGE(PG8_SA(1, 0), cA + kstep, voffA); PG8_STAGE(PG8_SB(1, 1), cB + hstep + kstep, voffB);
        PG8_WAIT_V(6); PG8_BAR;
    }
    for (;;) {
        const bool has_next = S.next(ui + 1, nxt);
        const char* nA = has_next ? (const char*)g.A + (size_t)nxt.pm * tstep : cA; const char* nB = has_next ? (const char*)g.Bt + (size_t)nxt.pn * tstep : cB;
        for (int t = 0; t < nt; t += 2) {
            const bool last = (t == nt - 2);
            const char* a1 = cA + (size_t)(t + 1) * kstep;
            const char* a2 = last ? nA : cA + (size_t)(t + 2) * kstep; const char* b2 = last ? nB : cB + (size_t)(t + 2) * kstep;
            const char* a3 = a2 + kstep; const char* b3 = b2 + kstep;
            if (last && has_next) S.a_ready(nxt);
            if constexpr (SP2) {
            PG8_LDB(B0, 0, 0); PG8_LDB(B1, 0, 1); PG8_SCHED; PG8_LDA(At, 0, 0); PG8_STAGE(PG8_SA(1, 1), a1 + hstep, voffA);
            PG8_WAIT_V(8); PG8_WAIT_L(0); PG8_BAR; PG8_MMA(0, 0, At, B0); PG8_MMA(0, 1, At, B1); PG8_BAR; PG8_SCHED;
            PG8_LDA(At, 0, 1); PG8_STAGE(PG8_SB(0, 0), b2, voffB); PG8_STAGE(PG8_SB(0, 1), b2 + hstep, voffB); PG8_STAGE(PG8_SA(0, 0), a2, voffA);
            PG8_WAIT_V(8); PG8_WAIT_L(0); PG8_BAR; PG8_MMA(1, 0, At, B0); PG8_MMA(1, 1, At, B1); PG8_BAR; PG8_SCHED;
            PG8_LDB(B0, 1, 0); PG8_LDB(B1, 1, 1); PG8_SCHED; PG8_LDA(At, 1, 0); PG8_STAGE(PG8_SA(0, 1), a2 + hstep, voffA);
            PG8_WAIT_V(8); PG8_WAIT_L(0); PG8_BAR; PG8_MMA(0, 0, At, B0); PG8_MMA(0, 1, At, B1); PG8_BAR; PG8_SCHED;
            PG8_LDA(At, 1, 1); PG8_STAGE(PG8_SB(1, 0), b3, voffB); PG8_STAGE(PG8_SB(1, 1), b3 + hstep, voffB); PG8_STAGE(PG8_SA(1, 0), a3, voffA);
            PG8_WAIT_V(8); PG8_WAIT_L(0); PG8_BAR; PG8_MMA(1, 0, At, B0); PG8_MMA(1, 1, At, B1); PG8_BAR; PG8_SCHED;
            } else {
            PG8_LDB(B0, 0, 0); PG8_SCHED; PG8_LDA(At, 0, 0); PG8_STAGE(PG8_SA(1, 1), a1 + hstep, voffA);
            PG8_WAIT_L(8); PG8_BAR; PG8_WAIT_L(0); PG8_MMA(0, 0, At, B0); PG8_BAR; PG8_SCHED;
            PG8_LDB(B1, 0, 1); PG8_STAGE(PG8_SB(0, 0), b2, voffB);
            PG8_BAR; PG8_WAIT_L(0); PG8_MMA(0, 1, At, B1); PG8_BAR;
            PG8_LDA(At, 0, 1); PG8_STAGE(PG8_SA(0, 0), a2, voffA);
            PG8_BAR; PG8_WAIT_L(0); PG8_MMA(1, 0, At, B0); PG8_BAR; PG8_SCHED;
            PG8_STAGE(PG8_SB(0, 1), b2 + hstep, voffB);
            PG8_WAIT_V(6); PG8_BAR; PG8_MMA(1, 1, At, B1); PG8_BAR;
            PG8_LDB(B0, 1, 0); PG8_SCHED; PG8_LDA(At, 1, 0); PG8_STAGE(PG8_SA(0, 1), a2 + hstep, voffA);
            PG8_WAIT_L(8); PG8_BAR; PG8_WAIT_L(0); PG8_MMA(0, 0, At, B0); PG8_BAR; PG8_SCHED;
            PG8_LDB(B1, 1, 1); PG8_STAGE(PG8_SB(1, 0), b3, voffB);
            PG8_BAR; PG8_WAIT_L(0); PG8_MMA(0, 1, At, B1); PG8_BAR;
            PG8_LDA(At, 1, 1); PG8_STAGE(PG8_SA(1, 0), a3, voffA);
            PG8_BAR; PG8_WAIT_L(0); PG8_MMA(1, 0, At, B0); PG8_BAR; PG8_SCHED;
            PG8_STAGE(PG8_SB(1, 1), b3 + hstep, voffB);
            PG8_WAIT_V(6); PG8_BAR; PG8_MMA(1, 1, At, B1); PG8_BAR;
            }
        }
        if constexpr (ALIGN_EPI) { if (wr == 0) PG8_BAR; }
        if constexpr (!Epi::AFTER_DRAIN) { E(acc, cur, wr, wc, fr, fq); S.done(cur); }
        if (!has_next) break;
#pragma unroll
        for (int a = 0; a < 2; ++a)
#pragma unroll
            for (int b = 0; b < 2; ++b)
#pragma unroll
                for (int m = 0; m < 4; ++m)
#pragma unroll
                    for (int n = 0; n < 2; ++n) acc[a][b][m][n] = (f32x4){0.f, 0.f, 0.f, 0.f};
        cur = nxt; cA = nA; cB = nB; ++ui;
        if constexpr (ALIGN_EPI) { if (wr == 1) PG8_BAR; }
    }
    PG8_WAIT_V(0);
    if constexpr (!ALIGN_EPI) { if (wr == 0) PG8_BAR; }
    PG8_BAR;
    if constexpr (Epi::AFTER_DRAIN) { E.fused(acc, cur, wr, wc, fr, fq, lds, wid, lane); S.done(cur); }
#undef PG8_SA
#undef PG8_SB
#undef PG8_STAGE
#undef PG8_LDA
#undef PG8_LDB
#undef PG8_MMA
#undef PG8_WAIT_V
#undef PG8_WAIT_L
#undef PG8_BAR
#undef PG8_SCHED
}
}
__device__ __forceinline__ void transpose_item(const float* __restrict__ W, int ldw, int N, int k0, int n0, bf16_t* WT, int ldt, int dst_row0, LAS float* scr, int lane) {
    const int nn = n0 + (lane & 31); const bool ok = nn < N;
#pragma unroll 8
    for (int i = 0; i < 32; ++i) { const int kk = 2 * i + (lane >> 5); scr[kk * 33 + (lane & 31)] = ok ? W[(size_t)(k0 + kk) * ldw + nn] : 0.f; }
    asm volatile("s_waitcnt lgkmcnt(0)" ::: "memory");
    const int c = lane & 7;
#pragma unroll
    for (int j = 0; j < 4; ++j) { const int n = (lane >> 3) + 8 * j; const LAS float* s = scr + (8 * c) * 33 + n;
        u32x4 o; o.x = pk2(s[0 * 33], s[1 * 33]); o.y = pk2(s[2 * 33], s[3 * 33]); o.z = pk2(s[4 * 33], s[5 * 33]); o.w = pk2(s[6 * 33], s[7 * 33]);
        *(u32x4*)(WT + (size_t)(dst_row0 + n) * ldt + k0 + 8 * c) = o; }
    asm volatile("s_waitcnt lgkmcnt(0)" ::: "memory");
}
__device__ __forceinline__ void transpose_job(const float* W, int K, int N, bf16_t* WT, int ldt, int mode, int& rot, int gw, int NGW, LAS float* scr, int lane) {
    const int nnb = (N + 31) >> 5, nit = (K >> 6) * nnb;
    int start = gw - rot; if (start < 0) start += NGW;
    for (int it = start; it < nit; it += NGW) {
        const int kb = it / nnb, nb = it - kb * nnb, n0 = nb << 5;
        const int dr = mode == 0 ? n0 : ((n0 >> 7) * 256 + (n0 & 127) + (mode == 2 ? 128 : 0));
        transpose_item(W, N, N, kb << 6, n0, WT, ldt, dr, scr, lane);
    }
    rot = (rot + nit) % NGW;
}
__device__ __forceinline__ void norm_rows_bf16(const float* src, const float* __restrict__ g, bf16_t* dst, int gw, int NGW, int lane) {
    f32x4 gv[4];
#pragma unroll
    for (int j = 0; j < 4; ++j) gv[j] = *(const f32x4*)(g + 4 * lane + 256 * j);
    for (int m = gw; m < T_; m += NGW) {
        const f32x4* xr = (const f32x4*)(src + (size_t)m * D_) + lane;
        f32x4 v[4]; float s = 0.f;
#pragma unroll
        for (int j = 0; j < 4; ++j) { v[j] = xr[64 * j]; s += (v[j].x * v[j].x + v[j].y * v[j].y) + (v[j].z * v[j].z + v[j].w * v[j].w); }
        const float rs = 1.0f / sqrtf(wave_sum(s) * (1.f / D_) + EPS);
        u32x2* o8 = (u32x2*)(dst + (size_t)m * D_) + lane;
#pragma unroll
        for (int j = 0; j < 4; ++j) { u32x2 o; o.x = pk2(v[j].x * rs * gv[j].x, v[j].y * rs * gv[j].y); o.y = pk2(v[j].z * rs * gv[j].z, v[j].w * rs * gv[j].w); o8[64 * j] = o; }
    }
}
__device__ __forceinline__ void norm_rows_f32(float* x, const float* __restrict__ g, int gw, int NGW, int lane) {
    f32x4 gv[4];
#pragma unroll
    for (int j = 0; j < 4; ++j) gv[j] = *(const f32x4*)(g + 4 * lane + 256 * j);
    for (int m = gw; m < T_; m += NGW) {
        f32x4* xr = (f32x4*)(x + (size_t)m * D_) + lane;
        f32x4 v[4]; float s = 0.f;
#pragma unroll
        for (int j = 0; j < 4; ++j) { v[j] = xr[64 * j]; s += (v[j].x * v[j].x + v[j].y * v[j].y) + (v[j].z * v[j].z + v[j].w * v[j].w); }
        const float rs = 1.0f / sqrtf(wave_sum(s) * (1.f / D_) + EPS);
#pragma unroll
        for (int j = 0; j < 4; ++j) xr[64 * j] = v[j] * rs * gv[j];
    }
}
__device__ __forceinline__ f32x4 mfma16(bf16x8 a, bf16x8 b, f32x4 c) { return __builtin_amdgcn_mfma_f32_16x16x32_bf16(a, b, c, 0, 0, 0); }
__device__ __forceinline__ void unpack8(const u32x4 w, float (&f)[8]) { f[0] = bflo(w.x); f[1] = bfhi(w.x); f[2] = bflo(w.y); f[3] = bfhi(w.y); f[4] = bflo(w.z); f[5] = bfhi(w.z); f[6] = bflo(w.w); f[7] = bfhi(w.w); }
__device__ __forceinline__ u32x4 pack8f(const float (&f)[8]) { u32x4 w; w.x = pk2(f[0], f[1]); w.y = pk2(f[2], f[3]); w.z = pk2(f[4], f[5]); w.w = pk2(f[6], f[7]); return w; }

__device__ __forceinline__ float neg_expm1(float x) {
    const float p = 1.f + x * (0.5f + x * (0.16666667f + x * (0.041666668f + x * (0.0083333338f + x * 0.0013888889f))));
    const float big = 1.f - fast_exp2(x * LOG2E);
    return x > -0.3f ? -x * p : big;
}
__device__ __forceinline__ void lru_gates_phase(LAS unsigned char* lds, const bf16_t* X, const float* __restrict__ conv_w, const float* __restrict__ conv_b,
        const bf16_t* WAT, const bf16_t* WXT, const float* __restrict__ b_a, const float* __restrict__ b_x, const float* __restrict__ lam,
        bf16_t* HL, bf16_t* AC, float* AGGA, float* AGGH, const int tid, const int bid, const int G) {
    const int lane = tid & 63, wid = __builtin_amdgcn_readfirstlane(tid >> 6), fr = lane & 15, fq = lane >> 4;
    constexpr int SA = 0, SBA = 34816, SBX = 69632, SAF = 0, SUF = 67584, SAGG = 135168, LDA_ = 272, LDF = 528;
    for (int u = bid; u < 1280; u += G) {
        const int tt = u / 10, hd = u - tt * 10, m0 = tt * 128, cbase = hd * 128;
        { const int c8 = tid & 15, r = tid >> 4, ch = cbase + 8 * c8;
          float cw[4][8], cb[8];
#pragma unroll
          for (int k = 0; k < 4; ++k) { const f32x4 w0 = *(const f32x4*)(conv_w + k * RNN + ch), w1 = *(const f32x4*)(conv_w + k * RNN + ch + 4);
              cw[k][0] = w0[0]; cw[k][1] = w0[1]; cw[k][2] = w0[2]; cw[k][3] = w0[3]; cw[k][4] = w1[0]; cw[k][5] = w1[1]; cw[k][6] = w1[2]; cw[k][7] = w1[3]; }
          { const f32x4 w0 = *(const f32x4*)(conv_b + ch), w1 = *(const f32x4*)(conv_b + ch + 4); cb[0] = w0[0]; cb[1] = w0[1]; cb[2] = w0[2]; cb[3] = w0[3]; cb[4] = w1[0]; cb[5] = w1[1]; cb[6] = w1[2]; cb[7] = w1[3]; }
#pragma unroll
          for (int g = 0; g < 4; ++g) { const int row = r + 32 * g, m = m0 + row, ts = m & (SEQ - 1);
              float acc[8];
#pragma unroll
              for (int e = 0; e < 8; ++e) acc[e] = cb[e];
#pragma unroll
              for (int k = 0; k < 4; ++k) if (ts - 3 + k >= 0) { const u32x4 xv = *(const u32x4*)(X + (size_t)(m - 3 + k) * RNN + ch); float xf[8]; unpack8(xv, xf);
#pragma unroll
                  for (int e = 0; e < 8; ++e) acc[e] += cw[k][e] * xf[e]; }
              *(LAS u32x4*)(lds + SA + row * LDA_ + c8 * 16) = pack8f(acc); } }
#pragma unroll
        for (int i = 0; i < 8; ++i) { const int q = tid + 512 * i, mat = q >> 11, j = (q >> 4) & 127, c = q & 15;
            const u32x4 v = *(const u32x4*)((mat ? WXT : WAT) + hd * 16384 + j * 128 + c * 8);
            *(LAS u32x4*)(lds + (mat ? SBX : SBA) + j * LDA_ + c * 16) = v; }
        __syncthreads();
        const int rg = wid >> 1, chh = wid & 1;
        f32x4 acca[2][4], accx[2][4];
#pragma unroll
        for (int mt = 0; mt < 2; ++mt)
#pragma unroll
            for (int nt = 0; nt < 4; ++nt) { acca[mt][nt] = (f32x4){0.f, 0.f, 0.f, 0.f}; accx[mt][nt] = (f32x4){0.f, 0.f, 0.f, 0.f}; }
#pragma unroll
        for (int s = 0; s < 4; ++s) { bf16x8 af[2];
#pragma unroll
            for (int mt = 0; mt < 2; ++mt) af[mt] = *(const LAS bf16x8*)(lds + SA + (32 * rg + 16 * mt + fr) * LDA_ + (32 * s + 8 * fq) * 2);
#pragma unroll
            for (int nt = 0; nt < 4; ++nt) { const bf16x8 ba = *(const LAS bf16x8*)(lds + SBA + (64 * chh + 16 * nt + fr) * LDA_ + (32 * s + 8 * fq) * 2);
                const bf16x8 bx = *(const LAS bf16x8*)(lds + SBX + (64 * chh + 16 * nt + fr) * LDA_ + (32 * s + 8 * fq) * 2);
#pragma unroll
                for (int mt = 0; mt < 2; ++mt) { acca[mt][nt] = mfma16(ba, af[mt], acca[mt][nt]); accx[mt][nt] = mfma16(bx, af[mt], accx[mt][nt]); } } }
        u32x2 xcv[2][4];
#pragma unroll
        for (int mt = 0; mt < 2; ++mt)
#pragma unroll
            for (int nt = 0; nt < 4; ++nt) xcv[mt][nt] = *(const LAS u32x2*)(lds + SA + (32 * rg + 16 * mt + fr) * LDA_ + (64 * chh + 16 * nt + 4 * fq) * 2);
        __syncthreads();
#pragma unroll
        for (int nt = 0; nt < 4; ++nt) { const int cc = cbase + 64 * chh + 16 * nt + 4 * fq;
            const f32x4 ba4 = *(const f32x4*)(b_a + cc), bx4 = *(const f32x4*)(b_x + cc), lm4 = *(const f32x4*)(lam + cc);
            f32x4 nl8;
#pragma unroll
            for (int j = 0; j < 4; ++j) nl8[j] = -8.f * log1pf(expf(-lm4[j]));
#pragma unroll
            for (int mt = 0; mt < 2; ++mt) { const float xc4[4] = {bflo(xcv[mt][nt].x), bfhi(xcv[mt][nt].x), bflo(xcv[mt][nt].y), bfhi(xcv[mt][nt].y)};
                f32x4 a4, u4;
#pragma unroll
                for (int j = 0; j < 4; ++j) { const float r = sigmoidf_(acca[mt][nt][j] + ba4[j]), ig = sigmoidf_(accx[mt][nt][j] + bx4[j]);
                    const float la = nl8[j] * r; a4[j] = fast_exp2(la * LOG2E); u4[j] = sqrtf(neg_expm1(2.f * la)) * ig * xc4[j]; }
                const int off = (32 * rg + 16 * mt + fr) * LDF + (64 * chh + 16 * nt + 4 * fq) * 4;
                *(LAS f32x4*)(lds + SAF + off) = a4; *(LAS f32x4*)(lds + SUF + off) = u4; } }
        __syncthreads();
        { const int ch = tid & 127, seg = tid >> 7;
          LAS float* pa = (LAS float*)(lds + SAF) + ch; LAS float* pu = (LAS float*)(lds + SUF) + ch; LAS float* ag = (LAS float*)(lds + SAGG);
          float A = 1.f, H = 0.f;
#pragma unroll 8
          for (int t = seg * 32; t < seg * 32 + 32; ++t) { const float a = pa[t * (LDF / 4)], uu = pu[t * (LDF / 4)]; H = a * H + uu; A *= a; }
          ag[seg * 128 + ch] = A; ag[512 + seg * 128 + ch] = H;
          __syncthreads();
          float cA = 1.f, cH = 0.f;
          for (int s = 0; s < seg; ++s) { const float As = ag[s * 128 + ch], Hs = ag[512 + s * 128 + ch]; cH = As * cH + Hs; cA *= As; }
#pragma unroll 8
          for (int t = seg * 32; t < seg * 32 + 32; ++t) { const float a = pa[t * (LDF / 4)], uu = pu[t * (LDF / 4)]; cH = a * cH + uu; cA *= a; pa[t * (LDF / 4)] = cA; pu[t * (LDF / 4)] = cH; }
          if (seg == 3) { AGGA[(size_t)tt * RNN + cbase + ch] = cA; AGGH[(size_t)tt * RNN + cbase + ch] = cH; } }
        __syncthreads();
#pragma unroll
        for (int i = 0; i < 4; ++i) { const int q = tid + 512 * i, row = q >> 4, c8 = q & 15;
            const f32x4 a0 = *(const LAS f32x4*)(lds + SAF + row * LDF + c8 * 32), a1 = *(const LAS f32x4*)(lds + SAF + row * LDF + c8 * 32 + 16);
            const f32x4 h0 = *(const LAS f32x4*)(lds + SUF + row * LDF + c8 * 32), h1 = *(const LAS f32x4*)(lds + SUF + row * LDF + c8 * 32 + 16);
            u32x4 wa, wh; wa.x = pk2(a0[0], a0[1]); wa.y = pk2(a0[2], a0[3]); wa.z = pk2(a1[0], a1[1]); wa.w = pk2(a1[2], a1[3]);
            wh.x = pk2(h0[0], h0[1]); wh.y = pk2(h0[2], h0[3]); wh.z = pk2(h1[0], h1[1]); wh.w = pk2(h1[2], h1[3]);
            const size_t go = (size_t)(m0 + row) * RNN + cbase + 8 * c8;
            *(u32x4*)(AC + go) = wa; *(u32x4*)(HL + go) = wh; }
        __syncthreads();
    }
}
__device__ __forceinline__ void lru_apply_phase(bf16_t* GB, const bf16_t* HL, const bf16_t* AC, const float* AGGA, const float* AGGH, const int tid, const int bid, const int G) {
    const int c8 = tid & 31, r = tid >> 5;
    for (int u = bid; u < 640; u += G) {
        const int tt = u / 5, cb = u - tt * 5, m0 = tt * 128, ch = cb * 256 + 8 * c8;
        float carry[8];
#pragma unroll
        for (int e = 0; e < 8; ++e) carry[e] = 0.f;
        for (int p = tt & ~63; p < tt; ++p) { const f32x4 a0 = *(const f32x4*)(AGGA + (size_t)p * RNN + ch), a1 = *(const f32x4*)(AGGA + (size_t)p * RNN + ch + 4);
            const f32x4 h0 = *(const f32x4*)(AGGH + (size_t)p * RNN + ch), h1 = *(const f32x4*)(AGGH + (size_t)p * RNN + ch + 4);
#pragma unroll
            for (int e = 0; e < 4; ++e) { carry[e] = carry[e] * a0[e] + h0[e]; carry[4 + e] = carry[4 + e] * a1[e] + h1[e]; } }
#pragma unroll
        for (int i = 0; i < 8; ++i) { const size_t go = (size_t)(m0 + r + 16 * i) * RNN + ch;
            float g[8], hl[8], ac[8], y[8]; unpack8(*(const u32x4*)(GB + go), g); unpack8(*(const u32x4*)(HL + go), hl); unpack8(*(const u32x4*)(AC + go), ac);
#pragma unroll
            for (int e = 0; e < 8; ++e) y[e] = g[e] * (hl[e] + ac[e] * carry[e]);
            *(u32x4*)(GB + go) = pack8f(y); }
    }
}
__device__ __forceinline__ s16x4 tr_read(const LAS unsigned char* p) { typedef short v4i16_t __attribute__((ext_vector_type(4))); return __builtin_bit_cast(s16x4, __builtin_amdgcn_ds_read_tr16_b64_v4i16((LAS v4i16_t*)p)); }
__device__ __forceinline__ bf16x8 cat44(s16x4 lo, s16x4 hi) { return (bf16x8){lo[0], lo[1], lo[2], lo[3], hi[0], hi[1], hi[2], hi[3]}; }
__device__ __forceinline__ void gla_cum(LAS unsigned char* lds, const float* GL, const float* __restrict__ w_g2, const float* __restrict__ b_g2, int m0, int h, const int tid, const int bid, const int G) {

    LAS float* sGL = (LAS float*)lds; LAS float* sSeg = (LAS float*)(lds + 4096); LAS float* sB = (LAS float*)(lds + 8192);
    if (tid < 256) *(LAS f32x4*)(sGL + tid * 4) = *(const f32x4*)(GL + (size_t)m0 * 16 + tid * 4);
    const int d = tid & 127, tq = tid >> 7, dch = h * 128 + d;
    float w[16];
#pragma unroll
    for (int r = 0; r < 16; ++r) w[r] = w_g2[r * 512 + dch];
    const float bb = b_g2[dch];
    __syncthreads();
    float run = 0.f;
#pragma unroll 4
    for (int i = 0; i < 16; ++i) { const int t = tq * 16 + i; float z = bb;
#pragma unroll
        for (int r4 = 0; r4 < 4; ++r4) { const f32x4 gv = *(const LAS f32x4*)(sGL + t * 16 + r4 * 4); z += gv[0] * w[r4 * 4] + gv[1] * w[r4 * 4 + 1] + gv[2] * w[r4 * 4 + 2] + gv[3] * w[r4 * 4 + 3]; }
        const float la = -(log1pf(expf(-fabsf(z))) + fmaxf(-z, 0.f)) * 0.0625f;
        run += la; sB[t * 128 + d] = run; }
    sSeg[tq * 128 + d] = run;
    __syncthreads();
    float pre = 0.f;
    for (int s = 0; s < tq; ++s) pre += sSeg[s * 128 + d];
#pragma unroll 4
    for (int i = 0; i < 16; ++i) sB[(tq * 16 + i) * 128 + d] += pre;
    __syncthreads();
}
__device__ __forceinline__ void gla_kv_phase(LAS unsigned char* lds, const bf16_t* Kg, const bf16_t* Vg, const float* GL, const float* w_g2, const float* b_g2, bf16_t* KVT, float* DEC, const int tid, const int bid, const int G) {
    const int lane = tid & 63, wid = __builtin_amdgcn_readfirstlane(tid >> 6), fr = lane & 15, fq = lane >> 4, q4 = (lane & 15) >> 2, p4 = lane & 3;
    constexpr int SB_ = 8192, SK = 40960, SV = 58368, LDK = 272, LDV = 528;
    const LAS float* sB = (const LAS float*)(lds + SB_);
    for (int u = bid; u < 1024; u += G) {
        const int b = u >> 9, n = (u >> 2) & 127, h = u & 3, m0 = b * SEQ + 64 * n, bh = b * 4 + h;
        gla_cum(lds, GL, w_g2, b_g2, m0, h, tid, bid, G);
#pragma unroll
        for (int i = 0; i < 2; ++i) { const int q = tid + 512 * i, t = q >> 4, c = q & 15; float kf[8]; unpack8(*(const u32x4*)(Kg + (size_t)(m0 + t) * 512 + h * 128 + 8 * c), kf);
#pragma unroll
            for (int e = 0; e < 8; ++e) kf[e] *= expf(sB[63 * 128 + 8 * c + e] - sB[t * 128 + 8 * c + e]);
            *(LAS u32x4*)(lds + SK + t * LDK + c * 16) = pack8f(kf); }
        if (tid < 128) DEC[((size_t)bh * 128 + n) * 128 + tid] = expf(sB[63 * 128 + tid]);
#pragma unroll
        for (int i = 0; i < 4; ++i) { const int q = tid + 512 * i, t = q >> 5, c = q & 31; *(LAS u32x4*)(lds + SV + t * LDV + c * 16) = *(const u32x4*)(Vg + (size_t)(m0 + t) * 1024 + h * 256 + 8 * c); }
        __syncthreads();
        f32x4 acc[8][2];
#pragma unroll
        for (int mt = 0; mt < 8; ++mt) { acc[mt][0] = (f32x4){0.f, 0.f, 0.f, 0.f}; acc[mt][1] = (f32x4){0.f, 0.f, 0.f, 0.f}; }
#pragma unroll
        for (int s = 0; s < 2; ++s) { bf16x8 bv[2];
#pragma unroll
            for (int nl = 0; nl < 2; ++nl) { const LAS unsigned char* pv = lds + SV + (32 * s + 8 * fq + q4) * LDV + (32 * wid + 16 * nl + 4 * p4) * 2; bv[nl] = cat44(tr_read(pv), tr_read(pv + 4 * LDV)); }
#pragma unroll
            for (int mt = 0; mt < 8; ++mt) { const LAS unsigned char* pk = lds + SK + (32 * s + 8 * fq + q4) * LDK + (16 * mt + 4 * p4) * 2; const bf16x8 ak = cat44(tr_read(pk), tr_read(pk + 4 * LDK));
                acc[mt][0] = mfma16(ak, bv[0], acc[mt][0]); acc[mt][1] = mfma16(ak, bv[1], acc[mt][1]); } }
        bf16_t* dst = KVT + ((size_t)bh * 128 + n) * 32768;
#pragma unroll
        for (int mt = 0; mt < 8; ++mt)
#pragma unroll
            for (int nl = 0; nl < 2; ++nl) { u32x2 w; w.x = pk2(acc[mt][nl][0], acc[mt][nl][1]); w.y = pk2(acc[mt][nl][2], acc[mt][nl][3]);
                *(u32x2*)(dst + (32 * wid + 16 * nl + fr) * 128 + 16 * mt + 4 * fq) = w; }
        __syncthreads();
    }
}
__device__ __forceinline__ void gla_scan_phase(bf16_t* KVT, const float* DEC, const int tid, const int bid, const int G) {
    const int nthr = G * 512;
    for (int e2 = bid * 512 + tid; e2 < 8 * 16384; e2 += nthr) {
        const int bh = e2 >> 14, e = (e2 & 16383) * 2, dk = e & 127;
        unsigned* p = (unsigned*)(KVT + (size_t)bh * 128 * 32768 + e); const float* dp = DEC + (size_t)bh * 128 * 128 + dk;
        float s0 = 0.f, s1 = 0.f;
        for (int n0 = 0; n0 < 128; n0 += 8) { unsigned w[8]; f32x2 d2[8];
#pragma unroll
            for (int i = 0; i < 8; ++i) { w[i] = p[(size_t)(n0 + i) * 16384]; d2[i] = *(const f32x2*)(dp + (n0 + i) * 128); }
#pragma unroll
            for (int i = 0; i < 8; ++i) { p[(size_t)(n0 + i) * 16384] = pk2(s0, s1); s0 = s0 * d2[i].x + bflo(w[i]); s1 = s1 * d2[i].y + bfhi(w[i]); } }
    }
}
__device__ __forceinline__ void gla_out_phase(LAS unsigned char* lds, const bf16_t* Qg, const bf16_t* Kg, const bf16_t* Vg, const bf16_t* Rg, const float* GL, const float* w_g2, const float* b_g2,
        const float* __restrict__ norm_g, const bf16_t* KVT, bf16_t* Y, const int tid, const int bid, const int G) {
    const int lane = tid & 63, wid = __builtin_amdgcn_readfirstlane(tid >> 6), fr = lane & 15, fq = lane >> 4, q4 = (lane & 15) >> 2, p4 = lane & 3;
    constexpr int SB_ = 8192, SQ = 40960, SKI = 58368, SV = 75776, SATT = 109568, SSS = 118784, LDQ = 272, LDV = 528, LDAT = 144;
    const LAS float* sB = (const LAS float*)(lds + SB_);
    for (int u = bid; u < 1024; u += G) {
        const int b = u >> 9, n = (u >> 2) & 127, h = u & 3, m0 = b * SEQ + 64 * n, bh = b * 4 + h;
        gla_cum(lds, GL, w_g2, b_g2, m0, h, tid, bid, G);
#pragma unroll
        for (int i = 0; i < 2; ++i) { const int q = tid + 512 * i, t = q >> 4, c = q & 15; float qf[8], kf[8];
            unpack8(*(const u32x4*)(Qg + (size_t)(m0 + t) * 512 + h * 128 + 8 * c), qf); unpack8(*(const u32x4*)(Kg + (size_t)(m0 + t) * 512 + h * 128 + 8 * c), kf);
#pragma unroll
            for (int e = 0; e < 8; ++e) { const float bb = sB[t * 128 + 8 * c + e]; qf[e] *= expf(bb); kf[e] *= expf(-bb); }
            *(LAS u32x4*)(lds + SQ + t * LDQ + c * 16) = pack8f(qf); *(LAS u32x4*)(lds + SKI + t * LDQ + c * 16) = pack8f(kf); }
#pragma unroll
        for (int i = 0; i < 4; ++i) { const int q = tid + 512 * i, t = q >> 5, c = q & 31; *(LAS u32x4*)(lds + SV + t * LDV + c * 16) = *(const u32x4*)(Vg + (size_t)(m0 + t) * 1024 + h * 256 + 8 * c); }
        __syncthreads();
        { const int mt = wid >> 1; f32x4 at[2] = {(f32x4){0.f, 0.f, 0.f, 0.f}, (f32x4){0.f, 0.f, 0.f, 0.f}};
#pragma unroll
          for (int s = 0; s < 4; ++s) { const bf16x8 a = *(const LAS bf16x8*)(lds + SQ + (16 * mt + fr) * LDQ + (32 * s + 8 * fq) * 2);
#pragma unroll
              for (int nl = 0; nl < 2; ++nl) { const int nt = 2 * (wid & 1) + nl; const bf16x8 bk = *(const LAS bf16x8*)(lds + SKI + (16 * nt + fr) * LDQ + (32 * s + 8 * fq) * 2); at[nl] = mfma16(bk, a, at[nl]); } }
#pragma unroll
          for (int nl = 0; nl < 2; ++nl) { const int nt = 2 * (wid & 1) + nl, c = 16 * mt + fr, j0 = 16 * nt + 4 * fq; float v[4];
#pragma unroll
              for (int j = 0; j < 4; ++j) v[j] = (j0 + j <= c) ? at[nl][j] : 0.f;
              u32x2 w; w.x = pk2(v[0], v[1]); w.y = pk2(v[2], v[3]); *(LAS u32x2*)(lds + SATT + c * LDAT + j0 * 2) = w; } }
        __syncthreads();
        f32x4 o[4][2];
#pragma unroll
        for (int mt = 0; mt < 4; ++mt) { o[mt][0] = (f32x4){0.f, 0.f, 0.f, 0.f}; o[mt][1] = (f32x4){0.f, 0.f, 0.f, 0.f}; }
#pragma unroll
        for (int s = 0; s < 2; ++s) { bf16x8 bv[2];
#pragma unroll
            for (int nl = 0; nl < 2; ++nl) { const LAS unsigned char* pv = lds + SV + (32 * s + 8 * fq + q4) * LDV + (32 * wid + 16 * nl + 4 * p4) * 2; bv[nl] = cat44(tr_read(pv), tr_read(pv + 4 * LDV)); }
#pragma unroll
            for (int mt = 0; mt < 4; ++mt) { const bf16x8 a = *(const LAS bf16x8*)(lds + SATT + (16 * mt + fr) * LDAT + (32 * s + 8 * fq) * 2);
                o[mt][0] = mfma16(bv[0], a, o[mt][0]); o[mt][1] = mfma16(bv[1], a, o[mt][1]); } }
        const bf16_t* Sp = KVT + ((size_t)bh * 128 + n) * 32768;
#pragma unroll
        for (int s = 0; s < 4; ++s) { bf16x8 bs[2];
#pragma unroll
            for (int nl = 0; nl < 2; ++nl) bs[nl] = *(const bf16x8*)(Sp + (32 * wid + 16 * nl + fr) * 128 + 32 * s + 8 * fq);
#pragma unroll
            for (int mt = 0; mt < 4; ++mt) { const bf16x8 a = *(const LAS bf16x8*)(lds + SQ + (16 * mt + fr) * LDQ + (32 * s + 8 * fq) * 2);
                o[mt][0] = mfma16(bs[0], a, o[mt][0]); o[mt][1] = mfma16(bs[1], a, o[mt][1]); } }
        LAS float* sSS = (LAS float*)(lds + SSS);
#pragma unroll
        for (int mt = 0; mt < 4; ++mt) { float ss = 0.f;
#pragma unroll
            for (int nl = 0; nl < 2; ++nl)
#pragma unroll
                for (int j = 0; j < 4; ++j) ss += o[mt][nl][j] * o[mt][nl][j];
            ss += __shfl_xor(ss, 16); ss += __shfl_xor(ss, 32);
            if (fq == 0) sSS[(16 * mt + fr) * 8 + wid] = ss; }
        __syncthreads();
#pragma unroll
        for (int mt = 0; mt < 4; ++mt) { const int tok = 16 * mt + fr; const f32x4 s0 = *(const LAS f32x4*)(sSS + tok * 8), s1 = *(const LAS f32x4*)(sSS + tok * 8 + 4);
            const float tot = ((s0[0] + s0[1]) + (s0[2] + s0[3])) + ((s1[0] + s1[1]) + (s1[2] + s1[3])); const float rs = 1.0f / sqrtf(tot * (1.f / 256.f) + EPS);
#pragma unroll
            for (int nl = 0; nl < 2; ++nl) { const int dv = 32 * wid + 16 * nl + 4 * fq; const f32x4 gn = *(const f32x4*)(norm_g + dv);
                const size_t go = (size_t)(m0 + tok) * 1024 + h * 256 + dv; const u32x2 rv = *(const u32x2*)(Rg + go);
                u32x2 w; w.x = pk2(o[mt][nl][0] * rs * gn[0] * bflo(rv.x), o[mt][nl][1] * rs * gn[1] * bfhi(rv.x)); w.y = pk2(o[mt][nl][2] * rs * gn[2] * bflo(rv.y), o[mt][nl][3] * rs * gn[3] * bfhi(rv.y));
                *(u32x2*)(Y + go) = w; } }
        __syncthreads();
    }
}
__device__ __forceinline__ void nsa_compress_phase(LAS unsigned char* lds, const bf16_t* KV, const float* __restrict__ pos, const float* __restrict__ w1, const float* __restrict__ b1,
        const float* __restrict__ b2, const bf16_t* W1T, const bf16_t* W2T, bf16_t* KC, bf16_t* VC, const int tid, const int bid, const int G) {
    const int lane = tid & 63, wid = __builtin_amdgcn_readfirstlane(tid >> 6), fr = lane & 15, fq = lane >> 4;
    constexpr int SP = 0, SB1 = 2048, SPART = 4096, SH = 36864, LDH = 144;
    for (int u = bid; u < 256; u += G) {
        const int kv = u >> 7, b = (u >> 6) & 1, g = (u >> 4) & 3, n0 = (u & 15) * 32;
        { const int j = tid & 63, part = tid >> 6; float s = 0.f; const float* pw = w1 + (size_t)kv * 2048 * 64 + j; const float* pp = pos + kv * 2048;
          for (int kk = part * 256; kk < part * 256 + 256; ++kk) s += pp[kk] * pw[(size_t)kk * 64];
          ((LAS float*)(lds + SP))[part * 64 + j] = s; }
        __syncthreads();
        if (tid < 64) { float s = b1[kv * 64 + tid];
#pragma unroll
            for (int p = 0; p < 8; ++p) s += ((LAS float*)(lds + SP))[p * 64 + tid];
            ((LAS float*)(lds + SB1))[tid] = s; }
        { const int rt = wid & 1, kq = wid >> 1, n = n0 + 16 * rt + fr; const bool ok = n <= 510;
          const bf16_t* src = KV + (size_t)kv * T_ * 256 + (size_t)(b * SEQ + 16 * (ok ? n : 0)) * 256 + g * 64;
          const bf16_t* wt = W1T + (size_t)kv * 64 * 2048;
          f32x4 acc[4] = {(f32x4){0.f, 0.f, 0.f, 0.f}, (f32x4){0.f, 0.f, 0.f, 0.f}, (f32x4){0.f, 0.f, 0.f, 0.f}, (f32x4){0.f, 0.f, 0.f, 0.f}};
#pragma unroll 4
          for (int s = 0; s < 16; ++s) { const int kk = kq * 512 + 32 * s + 8 * fq, l = kk >> 6, d = kk & 63;
              bf16x8 a = *(const bf16x8*)(src + (size_t)l * 256 + d); if (!ok) a = (bf16x8){0, 0, 0, 0, 0, 0, 0, 0};
#pragma unroll
              for (int nt = 0; nt < 4; ++nt) { const bf16x8 bb = *(const bf16x8*)(wt + (size_t)(16 * nt + fr) * 2048 + kk); acc[nt] = mfma16(bb, a, acc[nt]); } }
#pragma unroll
          for (int nt = 0; nt < 4; ++nt) *(LAS f32x4*)(lds + SPART + ((kq * 2 + rt) * 1024 + fr * 64 + 16 * nt + 4 * fq) * 4) = acc[nt]; }
        __syncthreads();
        { const int row = tid >> 4, c4 = (tid & 15) * 4, rt = row >> 4, rr = row & 15; f32x4 s = *(const LAS f32x4*)(lds + SB1 + c4 * 4);
#pragma unroll
          for (int kq = 0; kq < 4; ++kq) s += *(const LAS f32x4*)(lds + SPART + ((kq * 2 + rt) * 1024 + rr * 64 + c4) * 4);
          u32x2 w; w.x = pk2(gelu_tanh_(s[0]), gelu_tanh_(s[1])); w.y = pk2(gelu_tanh_(s[2]), gelu_tanh_(s[3])); *(LAS u32x2*)(lds + SH + row * LDH + c4 * 2) = w; }
        __syncthreads();
        { const int rt = wid >> 2, nt = wid & 3; f32x4 acc = (f32x4){0.f, 0.f, 0.f, 0.f};
#pragma unroll
          for (int s = 0; s < 2; ++s) { const bf16x8 a = *(const LAS bf16x8*)(lds + SH + (16 * rt + fr) * LDH + (32 * s + 8 * fq) * 2);
              const bf16x8 bb = *(const bf16x8*)(W2T + kv * 4096 + (16 * nt + fr) * 64 + 32 * s + 8 * fq); acc = mfma16(bb, a, acc); }
          const int n = n0 + 16 * rt + fr, d = 16 * nt + 4 * fq; const f32x4 bv = *(const f32x4*)(b2 + kv * 64 + d);
          u32x2 w; w.x = pk2(acc[0] + bv[0], acc[1] + bv[1]); w.y = pk2(acc[2] + bv[2], acc[3] + bv[3]);
          *(u32x2*)((kv ? VC : KC) + ((size_t)(b * 4 + g) * 512 + n) * 64 + d) = w; }
        __syncthreads();
    }
}
struct NsaSt { float m, l; f32x4 o[4]; };
__device__ __forceinline__ float xmax16_32(float v) { v = fmaxf(v, __shfl_xor(v, 16)); v = fmaxf(v, __shfl_xor(v, 32)); return v; }
__device__ __forceinline__ float xsum16_32(float v) { v += __shfl_xor(v, 16); v += __shfl_xor(v, 32); return v; }
template <int MODE, int STEP>
__device__ __forceinline__ void nsa_tile(const LAS unsigned char* sK, const LAS unsigned char* sV, const bf16x8 (&qf)[2][2], NsaSt (&st)[2], const int (&dbase)[2], const bool (&act)[2],
        const bool general, const bool (&colsel)[2], const LAS float* bt, const float bfar, const float (&minv)[2], LAS float* sMain, LAS float* sSpill, const int (&tokl)[2], const int mg0,
        const int fr, const int fq, const int q4, const int p4) {
    constexpr int LDT = 144; const float NEG = -INFINITY;
    f32x4 sacc[2][4];
#pragma unroll
    for (int kt = 0; kt < 4; ++kt) { const bf16x8 k0 = *(const LAS bf16x8*)(sK + (16 * kt + fr) * LDT + (8 * fq) * 2), k1 = *(const LAS bf16x8*)(sK + (16 * kt + fr) * LDT + (32 + 8 * fq) * 2);
#pragma unroll
        for (int ct = 0; ct < 2; ++ct) if (act[ct]) { f32x4 z = (f32x4){0.f, 0.f, 0.f, 0.f}; z = mfma16(k0, qf[ct][0], z); sacc[ct][kt] = mfma16(k1, qf[ct][1], z); } }
#pragma unroll
    for (int ct = 0; ct < 2; ++ct) if (act[ct]) {
        float tmax = NEG;
#pragma unroll
        for (int kt = 0; kt < 4; ++kt)
#pragma unroll
            for (int j = 0; j < 4; ++j) { float x;
                if (general) { const int kk = 16 * kt + 4 * fq + j, dist = dbase[ct] - kk * STEP; bool valid = dist >= 0;
                    if (MODE == 3) valid = valid && dist < 512;
                    if (MODE == 2) valid = valid && colsel[ct];
                    const int idx = dist < 0 ? 0 : (dist > 128 ? 128 : dist);
                    x = valid ? sacc[ct][kt][j] * LOG2E + bt[idx] : NEG; }
                else { x = sacc[ct][kt][j] * LOG2E + bfar; if (MODE == 2 && !colsel[ct]) x = NEG; }
                sacc[ct][kt][j] = x; tmax = fmaxf(tmax, x); }
        if (MODE == 1) {
            const float mm = st[ct].m, li = minv[ct];
#pragma unroll
            for (int kt = 0; kt < 4; ++kt) { float gs = 0.f, p3 = 0.f;
#pragma unroll
                for (int j = 0; j < 4; ++j) { const float p = fast_exp2(sacc[ct][kt][j] - mm) * li; sacc[ct][kt][j] = p; gs += p; if (j == 3) p3 = p; }
                gs += __shfl_xor(gs, 1); gs += __shfl_xor(gs, 2); p3 += __shfl_xor(p3, 1); p3 += __shfl_xor(p3, 2);
                const int mg = mg0 + 4 * kt + fq;
                if ((fr & 3) == 0) { sMain[tokl[ct] * 128 + mg] = gs; if (mg + 1 < 128) sSpill[tokl[ct] * 128 + mg + 1] = p3; } }
        } else {
            tmax = xmax16_32(tmax);
            const float mnew = fmaxf(st[ct].m, tmax), msafe = (mnew == NEG) ? 0.f : mnew, alpha = fast_exp2(st[ct].m - msafe);
            float ps = 0.f;
#pragma unroll
            for (int kt = 0; kt < 4; ++kt)
#pragma unroll
                for (int j = 0; j < 4; ++j) { const float p = fast_exp2(sacc[ct][kt][j] - msafe); sacc[ct][kt][j] = p; ps += p; }
            st[ct].l = st[ct].l * alpha + ps; st[ct].m = mnew;
            if (MODE != 0) {
#pragma unroll
                for (int dt = 0; dt < 4; ++dt) st[ct].o[dt] = st[ct].o[dt] * alpha; }
        }
    }
    if (MODE != 0) {
#pragma unroll
        for (int s = 0; s < 2; ++s) { bf16x8 pf[2];
#pragma unroll
            for (int ct = 0; ct < 2; ++ct) { u32x4 w; w.x = pk2(sacc[ct][2 * s][0], sacc[ct][2 * s][1]); w.y = pk2(sacc[ct][2 * s][2], sacc[ct][2 * s][3]);
                w.z = pk2(sacc[ct][2 * s + 1][0], sacc[ct][2 * s + 1][1]); w.w = pk2(sacc[ct][2 * s + 1][2], sacc[ct][2 * s + 1][3]); pf[ct] = __builtin_bit_cast(bf16x8, w); }
#pragma unroll
            for (int dt = 0; dt < 4; ++dt) { const LAS unsigned char* pv = sV + (32 * s + 4 * fq + q4) * LDT + (16 * dt + 4 * p4) * 2; const bf16x8 vf = cat44(tr_read(pv), tr_read(pv + 16 * LDT));
#pragma unroll
                for (int ct = 0; ct < 2; ++ct) if (act[ct]) st[ct].o[dt] = mfma16(vf, pf[ct], st[ct].o[dt]); } }
    }
}
__device__ __forceinline__ void nsa_ld(const bf16_t* Kp, const bf16_t* Vp, int ld, int tid, u32x4& kr, u32x4& vr) { const int key = tid >> 3, c = tid & 7; kr = *(const u32x4*)(Kp + (size_t)key * ld + 8 * c); vr = *(const u32x4*)(Vp + (size_t)key * ld + 8 * c); }
__device__ __forceinline__ void nsa_st(LAS unsigned char* sK, LAS unsigned char* sV, int tid, const u32x4 kr, const u32x4 vr) { const int key = tid >> 3, c = tid & 7; *(LAS u32x4*)(sK + key * 144 + c * 16) = kr; *(LAS u32x4*)(sV + key * 144 + c * 16) = vr; }

__device__ __forceinline__ void nsa_attn_phase(LAS unsigned char* lds, const bf16_t* Q, const bf16_t* KV, const float* GT, const bf16_t* KC, const bf16_t* VC, const float* __restrict__ rel_bias, bf16_t* Y, const int tid, const int bid, const int G) {
    const int lane = tid & 63, wid = __builtin_amdgcn_readfirstlane(tid >> 6), fr = lane & 15, fq = lane >> 4, q4 = (lane & 15) >> 2, p4 = lane & 3, hg = fr & 3;
    constexpr int SKO = 0, SVO = 18432, SMAIN = 36864, SSPILL = 69632, SBT = 102400, SSEL = 104512, TB = 9216;
    LAS float* sMain = (LAS float*)(lds + SMAIN); LAS float* sSpill = (LAS float*)(lds + SSPILL); LAS float* sBt = (LAS float*)(lds + SBT); LAS unsigned* sSel = (LAS unsigned*)(lds + SSEL);
    const float NEG = -INFINITY;
        for (int ui = 0; ; ++ui) {
        int bg, qb;
        if (G == 256) { if (ui >= 4) break; const int c = bid, s = c & 31; bg = c >> 5; qb = ui == 0 ? s : ui == 1 ? 63 - s : ui == 2 ? 64 + s : 127 - s; }
        else { const int uu = bid + ui * G; if (uu >= 1024) break; bg = uu >> 7; qb = uu & 127; }
        const int b = bg >> 2, g = bg & 3, t0 = 64 * qb, m0 = b * SEQ + t0;
        int tokl[2]; tokl[0] = 8 * wid + (fr >> 2); tokl[1] = tokl[0] + 4;
        bf16x8 qf[2][2];
#pragma unroll
        for (int ct = 0; ct < 2; ++ct)
#pragma unroll
            for (int s = 0; s < 2; ++s) qf[ct][s] = *(const bf16x8*)(Q + (size_t)(m0 + tokl[ct]) * 1024 + (g * 4 + hg) * 64 + 32 * s + 8 * fq);
        for (int i = tid; i < 4 * 129; i += 512) { const int h = i / 129, dist = i - h * 129; int bk;
            if (dist < 16) bk = dist; else { bk = 16 + (int)(logf((float)dist * (1.f / 16.f)) / 2.0794415416798357f * 16.f); bk = bk > 31 ? 31 : bk; }
            sBt[h * 132 + dist] = rel_bias[bk * 16 + g * 4 + h] * LOG2E; }
#pragma unroll
        for (int i = 0; i < 4; ++i) { *(LAS f32x4*)(lds + SMAIN + (tid + 512 * i) * 16) = (f32x4){0.f, 0.f, 0.f, 0.f}; *(LAS f32x4*)(lds + SSPILL + (tid + 512 * i) * 16) = (f32x4){0.f, 0.f, 0.f, 0.f}; }
        __syncthreads();
        const LAS float* bt = sBt + hg * 132; const float bfar = bt[128];
        LAS f32x4* totp = (LAS f32x4*)(lds + SMAIN + wid * 4096) + lane;
        const float* gtp = GT + (size_t)(m0 + tokl[0]) * 48 + (g * 4 + hg) * 3;
        NsaSt st[2]; bool act[2] = {true, true}; bool colsel[2] = {true, true}; int dbase[2]; float minv[2] = {1.f, 1.f};
        u32x4 kr, vr;
#define NSA_RESET() do { _Pragma("unroll") for (int ct = 0; ct < 2; ++ct) { st[ct].m = NEG; st[ct].l = 0.f; _Pragma("unroll") for (int dt = 0; dt < 4; ++dt) st[ct].o[dt] = (f32x4){0.f, 0.f, 0.f, 0.f}; } } while (0)
        const int ncmp = 4 * qb + 3, nct = (ncmp + 63) >> 6;
        const bf16_t* kcb = KC + (size_t)bg * 512 * 64; const bf16_t* vcb = VC + (size_t)bg * 512 * 64;
        NSA_RESET();
#pragma unroll 1
        for (int pass = 0; pass < 2; ++pass) {
            nsa_ld(kcb, vcb, 64, tid, kr, vr); nsa_st(lds + SKO, lds + SVO, tid, kr, vr); __syncthreads();
#pragma unroll 1
            for (int i = 0; i < nct; ++i) { const int buf = i & 1;
                if (i + 1 < nct) nsa_ld(kcb + (size_t)(i + 1) * 4096, vcb + (size_t)(i + 1) * 4096, 64, tid, kr, vr);
                dbase[0] = t0 + tokl[0] - 31 - 1024 * i; dbase[1] = dbase[0] + 4;
                if (pass == 0) nsa_tile<0, 16>(lds + SKO + buf * TB, lds + SVO + buf * TB, qf, st, dbase, act, true, colsel, bt, bfar, minv, sMain, sSpill, tokl, 16 * i, fr, fq, q4, p4);
                else nsa_tile<1, 16>(lds + SKO + buf * TB, lds + SVO + buf * TB, qf, st, dbase, act, true, colsel, bt, bfar, minv, sMain, sSpill, tokl, 16 * i, fr, fq, q4, p4);
                if (i + 1 < nct) nsa_st(lds + SKO + (buf ^ 1) * TB, lds + SVO + (buf ^ 1) * TB, tid, kr, vr);
                __syncthreads(); }
            if (pass == 0) {
#pragma unroll
                for (int ct = 0; ct < 2; ++ct) { const float lt = xsum16_32(st[ct].l); minv[ct] = fast_rcp(lt > 0.f ? lt : 1.f); if (st[ct].m == NEG) st[ct].m = 0.f; } }
        }
        f32x4 oc[2][4];
#pragma unroll
        for (int ct = 0; ct < 2; ++ct) { const float gt0 = gtp[ct * 4 * 48];
#pragma unroll
            for (int dt = 0; dt < 4; ++dt) oc[ct][dt] = st[ct].o[dt] * gt0; }
        unsigned msk[2][4];
        if (qb <= 15) {
#pragma unroll
            for (int ct = 0; ct < 2; ++ct) { msk[ct][0] = (2u << qb) - 1u; msk[ct][1] = 0u; msk[ct][2] = 0u; msk[ct][3] = 0u; }
        } else {
            const int tl = lane >> 3, sub = lane & 7, tok = 8 * wid + tl;
            unsigned key[16];
#pragma unroll
            for (int i = 0; i < 4; ++i) { const f32x4 a = *(const LAS f32x4*)(sMain + tok * 128 + 16 * sub + 4 * i), s4 = *(const LAS f32x4*)(sSpill + tok * 128 + 16 * sub + 4 * i);
#pragma unroll
                for (int j = 0; j < 4; ++j) { const int m = 16 * sub + 4 * i + j; const float imp = a[j] + s4[j];
                    key[4 * i + j] = (m >= 1 && m <= qb - 2) ? ((__float_as_uint(imp) & ~127u) | (unsigned)(127 - m)) : 0u; } }
            unsigned selb = 0u;
#pragma unroll 1
            for (int it = 0; it < 13; ++it) { unsigned mx = key[0];
#pragma unroll
                for (int i = 1; i < 16; ++i) mx = key[i] > mx ? key[i] : mx;
                { unsigned o = (unsigned)__shfl_xor((int)mx, 1); mx = o > mx ? o : mx; o = (unsigned)__shfl_xor((int)mx, 2); mx = o > mx ? o : mx; o = (unsigned)__shfl_xor((int)mx, 4); mx = o > mx ? o : mx; }
#pragma unroll
                for (int i = 0; i < 16; ++i) if (key[i] == mx) { selb |= 1u << i; key[i] = 0u; } }
            { const int f0 = 0, f1 = qb, f2 = qb - 1;
              if ((f0 >> 4) == sub) selb |= 1u << (f0 & 15); if ((f1 >> 4) == sub) selb |= 1u << (f1 & 15); if ((f2 >> 4) == sub) selb |= 1u << (f2 & 15); }
            const unsigned oth = (unsigned)__shfl_xor((int)selb, 1);
            if ((sub & 1) == 0) sSel[tok * 4 + (sub >> 1)] = selb | (oth << 16);
            asm volatile("s_waitcnt lgkmcnt(0)" ::: "memory");
#pragma unroll
            for (int ct = 0; ct < 2; ++ct) { const u32x4 w = *(const LAS u32x4*)(sSel + tokl[ct] * 4); msk[ct][0] = w.x; msk[ct][1] = w.y; msk[ct][2] = w.z; msk[ct][3] = w.w; }
        }
#pragma unroll
        for (int ct = 0; ct < 2; ++ct)
#pragma unroll
            for (int dt = 0; dt < 4; ++dt) totp[ct * (SSPILL - SMAIN) / 16 + 64 * dt] = oc[ct][dt];
        { const bf16_t* ksb = KV + (size_t)2 * T_ * 256 + (size_t)(b * SEQ) * 256 + g * 64; const bf16_t* vsb = KV + (size_t)3 * T_ * 256 + (size_t)(b * SEQ) * 256 + g * 64;
          NSA_RESET();
          nsa_ld(ksb, vsb, 256, tid, kr, vr); nsa_st(lds + SKO, lds + SVO, tid, kr, vr); __syncthreads();
#pragma unroll 1
          for (int m = 0; m <= qb; ++m) { const int buf = m & 1;
              if (m < qb) nsa_ld(ksb + (size_t)(m + 1) * 64 * 256, vsb + (size_t)(m + 1) * 64 * 256, 256, tid, kr, vr);
              const int mw = m >> 5, mb = m & 31;
#pragma unroll
              for (int ct = 0; ct < 2; ++ct) { const unsigned w = mw == 0 ? msk[ct][0] : mw == 1 ? msk[ct][1] : mw == 2 ? msk[ct][2] : msk[ct][3]; colsel[ct] = (w >> mb) & 1u; act[ct] = __any(colsel[ct]); }
              dbase[0] = t0 + tokl[0] - 64 * m; dbase[1] = dbase[0] + 4;
              if (act[0] || act[1]) nsa_tile<2, 1>(lds + SKO + buf * TB, lds + SVO + buf * TB, qf, st, dbase, act, m + 2 >= qb, colsel, bt, bfar, minv, sMain, sSpill, tokl, 0, fr, fq, q4, p4);
              if (m < qb) nsa_st(lds + SKO + (buf ^ 1) * TB, lds + SVO + (buf ^ 1) * TB, tid, kr, vr);
              __syncthreads(); }
#pragma unroll
          for (int ct = 0; ct < 2; ++ct) { const float lt = xsum16_32(st[ct].l), sc = gtp[ct * 4 * 48 + 1] * fast_rcp(lt > 0.f ? lt : 1.f);
#pragma unroll
              for (int dt = 0; dt < 4; ++dt) totp[ct * (SSPILL - SMAIN) / 16 + 64 * dt] += st[ct].o[dt] * sc; } }
        { const bf16_t* kwb = KV + (size_t)4 * T_ * 256 + (size_t)(b * SEQ) * 256 + g * 64; const bf16_t* vwb = KV + (size_t)5 * T_ * 256 + (size_t)(b * SEQ) * 256 + g * 64;
          NSA_RESET(); act[0] = true; act[1] = true; colsel[0] = true; colsel[1] = true;
          const int j0 = qb >= 8 ? 0 : 8 - qb;
          nsa_ld(kwb + (size_t)(t0 - 512 + 64 * j0) * 256, vwb + (size_t)(t0 - 512 + 64 * j0) * 256, 256, tid, kr, vr); nsa_st(lds + SKO, lds + SVO, tid, kr, vr); __syncthreads();
#pragma unroll 1
          for (int j = j0; j <= 8; ++j) { const int buf = (j - j0) & 1;
              if (j < 8) nsa_ld(kwb + (size_t)(t0 - 512 + 64 * (j + 1)) * 256, vwb + (size_t)(t0 - 512 + 64 * (j + 1)) * 256, 256, tid, kr, vr);
              dbase[0] = tokl[0] + 512 - 64 * j; dbase[1] = dbase[0] + 4;
              nsa_tile<3, 1>(lds + SKO + buf * TB, lds + SVO + buf * TB, qf, st, dbase, act, (j == 0) || (j >= 6), colsel, bt, bfar, minv, sMain, sSpill, tokl, 0, fr, fq, q4, p4);
              if (j < 8) nsa_st(lds + SKO + (buf ^ 1) * TB, lds + SVO + (buf ^ 1) * TB, tid, kr, vr);
              __syncthreads(); }
#pragma unroll
          for (int ct = 0; ct < 2; ++ct) { const float lt = xsum16_32(st[ct].l), sc = gtp[ct * 4 * 48 + 2] * fast_rcp(lt > 0.f ? lt : 1.f);
#pragma unroll
              for (int dt = 0; dt < 4; ++dt) st[ct].o[dt] = totp[ct * (SSPILL - SMAIN) / 16 + 64 * dt] + st[ct].o[dt] * sc; } }
#pragma unroll
        for (int ct = 0; ct < 2; ++ct)
#pragma unroll
            for (int dt = 0; dt < 4; ++dt) { u32x2 w; w.x = pk2(st[ct].o[dt][0], st[ct].o[dt][1]); w.y = pk2(st[ct].o[dt][2], st[ct].o[dt][3]);
                *(u32x2*)(Y + (size_t)(m0 + tokl[ct]) * 1024 + (g * 4 + hg) * 64 + 16 * dt + 4 * fq) = w; }
        __syncthreads();
#undef NSA_RESET
    }
}
#ifndef EN_ALL
#define EN_ALL 1
#endif
#ifndef EN_LRUG
#define EN_LRUG EN_ALL
#endif
#ifndef EN_LRUA
#define EN_LRUA EN_ALL
#endif
#ifndef EN_NSAC
#define EN_NSAC EN_ALL
#endif
#ifndef EN_NSAA
#define EN_NSAA EN_ALL
#endif
#ifndef EN_GLAK
#define EN_GLAK EN_ALL
#endif
#ifndef EN_GLAS
#define EN_GLAS EN_ALL
#endif
#ifndef EN_GLAO
#define EN_GLAO EN_ALL
#endif
#ifndef EN_G_LRUIN
#define EN_G_LRUIN EN_ALL
#endif
#ifndef EN_G_RESID
#define EN_G_RESID EN_ALL
#endif
#ifndef EN_G_NSAIN
#define EN_G_NSAIN EN_ALL
#endif
#ifndef EN_G_GLAIN
#define EN_G_GLAIN EN_ALL
#endif
#ifndef EN_G_GU
#define EN_G_GU EN_ALL
#endif
#ifndef EN_PREP
#define EN_PREP EN_ALL
#endif
struct Args {
    const float* x; const float* rel_bias; const float* final_norm; const float* mix_norm; const float* ffn_norm;
    const float* ffn_w_gate; const float* ffn_w_up; const float* ffn_w_down;
    const float* lru_w_in; const float* lru_conv_w; const float* lru_conv_b; const float* lru_w_a; const float* lru_b_a; const float* lru_w_x; const float* lru_b_x; const float* lru_lam; const float* lru_w_out;
    const float* nsa_w_in; const float* nsa_cmp_pos; const float* nsa_cmp_w1; const float* nsa_cmp_b1; const float* nsa_cmp_w2; const float* nsa_cmp_b2; const float* nsa_w_out;
    const float* gla_w_in; const float* gla_w_g2; const float* gla_b_g2; const float* gla_norm; const float* gla_w_out;
    float* out; unsigned char* ws; int ph_lo, ph_hi;
};

__global__ void __launch_bounds__(512, 2) mega_fwd(Args a) {
    extern __shared__ __attribute__((aligned(16))) unsigned char lds_raw[];
    LAS unsigned char* lds = (LAS unsigned char*)lds_raw;
    cg::grid_group grid = cg::this_grid();
    const int tid0 = threadIdx.x;
    constexpr int PTR_OFF = LDS_BYTES - 512;
    if (tid0 == 0) { LAS unsigned long long* tb = (LAS unsigned long long*)(lds + PTR_OFF);
        tb[0] = (unsigned long long)a.x;
        tb[1] = (unsigned long long)a.rel_bias;
        tb[2] = (unsigned long long)a.final_norm;
        tb[3] = (unsigned long long)a.mix_norm;
        tb[4] = (unsigned long long)a.ffn_norm;
        tb[5] = (unsigned long long)a.ffn_w_gate;
        tb[6] = (unsigned long long)a.ffn_w_up;
        tb[7] = (unsigned long long)a.ffn_w_down;
        tb[8] = (unsigned long long)a.lru_w_in;
        tb[9] = (unsigned long long)a.lru_conv_w;
        tb[10] = (unsigned long long)a.lru_conv_b;
        tb[11] = (unsigned long long)a.lru_w_a;
        tb[12] = (unsigned long long)a.lru_b_a;
        tb[13] = (unsigned long long)a.lru_w_x;
        tb[14] = (unsigned long long)a.lru_b_x;
        tb[15] = (unsigned long long)a.lru_lam;
        tb[16] = (unsigned long long)a.lru_w_out;
        tb[17] = (unsigned long long)a.nsa_w_in;
        tb[18] = (unsigned long long)a.nsa_cmp_pos;
        tb[19] = (unsigned long long)a.nsa_cmp_w1;
        tb[20] = (unsigned long long)a.nsa_cmp_b1;
        tb[21] = (unsigned long long)a.nsa_cmp_w2;
        tb[22] = (unsigned long long)a.nsa_cmp_b2;
        tb[23] = (unsigned long long)a.nsa_w_out;
        tb[24] = (unsigned long long)a.gla_w_in;
        tb[25] = (unsigned long long)a.gla_w_g2;
        tb[26] = (unsigned long long)a.gla_b_g2;
        tb[27] = (unsigned long long)a.gla_norm;
        tb[28] = (unsigned long long)a.gla_w_out;
        tb[29] = (unsigned long long)a.out;
        tb[30] = (unsigned long long)a.ws;
    }
    __syncthreads();
#define PRAW(i) ((((unsigned long long)(unsigned)__builtin_amdgcn_readfirstlane((int)((const LAS unsigned*)(lds + PTR_OFF))[2 * (i) + 1])) << 32) | (unsigned long long)(unsigned)__builtin_amdgcn_readfirstlane((int)((const LAS unsigned*)(lds + PTR_OFF))[2 * (i)]))
#define PF(i) ((const float*)PRAW(i))
#define P_OUT ((float*)PRAW(29))
#define WSP(off) ((unsigned char*)PRAW(30) + (off))
#define W_GU ((bf16_t*)WSP(WS_W_GU))
#define W_DN ((bf16_t*)WSP(WS_W_DN))
#define W_MIN ((bf16_t*)WSP(WS_W_MIN))
#define W_MOUT ((bf16_t*)WSP(WS_W_MOUT))
#define W_SM ((bf16_t*)WSP(WS_W_SMALL))
#define HN ((bf16_t*)WSP(WS_HN))
#define ACT ((bf16_t*)WSP(WS_ACT))
#define LG ((bf16_t*)WSP(WS_LG))
#define LX ((bf16_t*)WSP(WS_LX))
#define LHL ((bf16_t*)WSP(WS_LHL))
#define LAC ((bf16_t*)WSP(WS_LAC))
#define AGGA ((float*)WSP(WS_LAGGA))
#define AGGH ((float*)WSP(WS_LAGGH))
#define NQ ((bf16_t*)WSP(WS_NQ))
#define NKV ((bf16_t*)WSP(WS_NKV))
#define NGT ((float*)WSP(WS_NGT))
#define NKC ((bf16_t*)WSP(WS_NKC))
#define NVC ((bf16_t*)WSP(WS_NVC))
#define GQ ((bf16_t*)WSP(WS_GQ))
#define GK ((bf16_t*)WSP(WS_GK))
#define GV ((bf16_t*)WSP(WS_GV))
#define GR ((bf16_t*)WSP(WS_GR))
#define GGL ((float*)WSP(WS_GGL))
#define GDEC ((float*)WSP(WS_GDEC))
#define GKVT ((bf16_t*)WSP(WS_GKVT))

    enum { OP_PREP, OP_G_LRUIN, OP_LRU_GATES, OP_LRU_APPLY, OP_G_RESID, OP_G_NSAIN, OP_NSA_CMP, OP_NSA_ATTN, OP_G_GLAIN, OP_GLA_KV, OP_GLA_SCAN, OP_GLA_OUT, OP_NORM2, OP_G_GU, OP_FINAL };
#pragma unroll 1
    for (int ph = a.ph_lo; ph < a.ph_hi; ++ph) {
        int layer, r;
        if (ph < 8) { layer = 0; r = ph; } else if (ph < 16) { layer = 1; r = ph - 8; } else if (ph < 25) { layer = 2; r = ph - 16; } else if (ph < 33) { layer = 3; r = ph - 25; } else { layer = 4; r = 0; }
        const int kind = layer % 3, jj = layer / 3, nmix = kind == 2 ? 5 : 4;
        int tid = threadIdx.x, bid = blockIdx.x, G = gridDim.x;
        asm volatile("" : "+v"(tid) :: "memory"); asm volatile("" : "+s"(bid)); asm volatile("" : "+s"(G));
        const int lane = tid & 63, wid = __builtin_amdgcn_readfirstlane(tid >> 6), gw = bid * 8 + wid, NGW = G * 8;
        LAS float* scr = (LAS float*)(lds + wid * 8448);
        const float* hsrc = layer == 0 ? PF(0) : P_OUT;
        int op;
        if (layer == 4) op = OP_FINAL;
        else if (r == 0) op = OP_PREP;
        else if (r <= nmix) { const int q = r - 1;
            if (kind == 0) op = q == 0 ? OP_G_LRUIN : q == 1 ? OP_LRU_GATES : q == 2 ? OP_LRU_APPLY : OP_G_RESID;
            else if (kind == 1) op = q == 0 ? OP_G_NSAIN : q == 1 ? OP_NSA_CMP : q == 2 ? OP_NSA_ATTN : OP_G_RESID;
            else op = q == 0 ? OP_G_GLAIN : q == 1 ? OP_GLA_KV : q == 2 ? OP_GLA_SCAN : q == 3 ? OP_GLA_OUT : OP_G_RESID; }
        else { const int q = r - nmix - 1; op = q == 0 ? OP_NORM2 : q == 1 ? OP_G_GU : OP_G_RESID; }
        const bool is_down = (r == nmix + 3);
        switch (op) {
        case OP_PREP: if (EN_PREP) {
            int rot = 0;
            transpose_job(PF(5) + (size_t)layer * D_ * FF, D_, FF, W_GU, D_, 1, rot, gw, NGW, scr, lane);
            transpose_job(PF(6) + (size_t)layer * D_ * FF, D_, FF, W_GU, D_, 2, rot, gw, NGW, scr, lane);
            transpose_job(PF(7) + (size_t)layer * FF * D_, FF, D_, W_DN, FF, 0, rot, gw, NGW, scr, lane);
            if (kind == 0) {
                transpose_job(PF(8) + (size_t)jj * D_ * 2 * RNN, D_, 2 * RNN, W_MIN, D_, 0, rot, gw, NGW, scr, lane);
                transpose_job(PF(16) + (size_t)jj * RNN * D_, RNN, D_, W_MOUT, RNN, 0, rot, gw, NGW, scr, lane);
#pragma unroll 1
                for (int h = 0; h < 20; ++h) {
                    const int hh = h % 10; const float* src = (h < 10 ? PF(11) : PF(13)) + ((size_t)jj * 10 + hh) * 16384;
                    transpose_job(src, 128, 128, W_SM + (h < 10 ? 0 : 163840) + hh * 16384, 128, 0, rot, gw, NGW, scr, lane); }
            } else if (kind == 1) {
                transpose_job(PF(17), D_, 2608, W_MIN, D_, 0, rot, gw, NGW, scr, lane);
                transpose_job(PF(23), D_, D_, W_MOUT, D_, 0, rot, gw, NGW, scr, lane);
#pragma unroll 1
                for (int kv = 0; kv < 2; ++kv) {
                    transpose_job(PF(19) + (size_t)kv * 2048 * 64, 2048, 64, W_SM + (size_t)kv * 64 * 2048, 2048, 0, rot, gw, NGW, scr, lane);
                    transpose_job(PF(21) + (size_t)kv * 4096, 64, 64, W_SM + 262144 + kv * 4096, 64, 0, rot, gw, NGW, scr, lane); }
            } else {
                transpose_job(PF(24), D_, 3088, W_MIN, D_, 0, rot, gw, NGW, scr, lane);
                transpose_job(PF(28), D_, D_, W_MOUT, D_, 0, rot, gw, NGW, scr, lane);
            }
            norm_rows_bf16(hsrc, PF(3) + layer * D_, HN, gw, NGW, lane); }
            break;
        case OP_G_LRUIN: if (EN_G_LRUIN) { pg8::Gemm g{HN, W_MIN, T_, 2 * RNN, D_}; pg8::StaticOrder S; S.init(T_, 2 * RNN, G, bid); pg8::EpiLruIn E{LG, LX};
            pg8::gemm_phase<pg8::EpiLruIn, pg8::StaticOrder, true, true>(lds, g, S, E, tid); }
            break;
        case OP_LRU_GATES: if (EN_LRUG) lru_gates_phase(lds, LX, PF(9) + jj * 4 * RNN, PF(10) + jj * RNN, W_SM, W_SM + 163840, PF(12) + jj * RNN, PF(14) + jj * RNN, PF(15) + jj * RNN, LHL, LAC, AGGA, AGGH, tid, bid, G);
            break;
        case OP_LRU_APPLY: if (EN_LRUA) lru_apply_phase(LG, LHL, LAC, AGGA, AGGH, tid, bid, G);
            break;
        case OP_G_RESID: if (EN_G_RESID) {
            const bf16_t* A = is_down ? ACT : (kind == 0 ? LG : HN); const bf16_t* Bt = is_down ? W_DN : W_MOUT; const int K = is_down ? FF : (kind == 0 ? RNN : D_);
            const float* base = is_down ? P_OUT : hsrc;
            pg8::Gemm g{A, Bt, T_, D_, K}; pg8::StaticOrder S; S.init(T_, D_, G, bid); pg8::EpiResid E{base, P_OUT};
            pg8::gemm_phase<pg8::EpiResid, pg8::StaticOrder, true, true>(lds, g, S, E, tid); }
            break;
        case OP_G_NSAIN: if (EN_G_NSAIN) { pg8::Gemm g{HN, W_MIN, T_, NSA_NPAD, D_}; pg8::StaticOrder S; S.init(T_, NSA_NPAD, G, bid); pg8::EpiNsaIn E{NQ, NKV, NGT};
            pg8::gemm_phase<pg8::EpiNsaIn, pg8::StaticOrder, true, true>(lds, g, S, E, tid); }
            break;
        case OP_NSA_CMP: if (EN_NSAC) nsa_compress_phase(lds, NKV, PF(18), PF(19), PF(20), PF(22), W_SM, W_SM + 262144, NKC, NVC, tid, bid, G);
            break;
        case OP_NSA_ATTN: if (EN_NSAA) nsa_attn_phase(lds, NQ, NKV, NGT, NKC, NVC, PF(1), HN, tid, bid, G);
            break;
        case OP_G_GLAIN: if (EN_G_GLAIN) { pg8::Gemm g{HN, W_MIN, T_, GLA_NPAD, D_}; pg8::StaticOrder S; S.init(T_, GLA_NPAD, G, bid); pg8::EpiGlaIn E{GQ, GK, GV, GR, GGL};
            pg8::gemm_phase<pg8::EpiGlaIn, pg8::StaticOrder, true, true>(lds, g, S, E, tid); }
            break;
        case OP_GLA_KV: if (EN_GLAK) gla_kv_phase(lds, GK, GV, GGL, PF(25), PF(26), GKVT, GDEC, tid, bid, G);
            break;
        case OP_GLA_SCAN: if (EN_GLAS) gla_scan_phase(GKVT, GDEC, tid, bid, G);
            break;
        case OP_GLA_OUT: if (EN_GLAO) gla_out_phase(lds, GQ, GK, GV, GR, GGL, PF(25), PF(26), PF(27), GKVT, HN, tid, bid, G);
            break;
        case OP_NORM2: if (EN_PREP) norm_rows_bf16(P_OUT, PF(4) + layer * D_, HN, gw, NGW, lane);
            break;
        case OP_G_GU: if (EN_G_GU) { pg8::Gemm g{HN, W_GU, T_, 2 * FF, D_}; pg8::StaticOrder S; S.init(T_, 2 * FF, G, bid); pg8::EpiSwiglu E{ACT};
            pg8::gemm_phase<pg8::EpiSwiglu, pg8::StaticOrder, true, true>(lds, g, S, E, tid); }
            break;
        default: if (EN_PREP) norm_rows_f32(P_OUT, PF(2), gw, NGW, lane);
            break;
        }
        if (ph + 1 < a.ph_hi) grid.sync();
    }
}

#ifndef N_LAUNCH_MODE
#define N_LAUNCH_MODE 1
#endif
constexpr int N_PHASES = 34;

extern "C" void kernel_launch(void* const* d_in, const int* in_sizes, int n_in, void* d_out, int out_size, void* d_ws, size_t ws_size, hipStream_t stream) {
    static int grid = 0;
    if (grid == 0) {
        if (n_in != 29 || out_size != T_ * D_ || ws_size < WS_END) { fprintf(stderr, "kernel_launch: unexpected problem: n_in %d out %d ws %zu\n", n_in, out_size, ws_size); grid = -1; return; }
        int dev = 0, cus = 0, per_cu = 0;
        hipGetDevice(&dev); hipDeviceGetAttribute(&cus, hipDeviceAttributeMultiprocessorCount, dev);
        if (hipFuncSetAttribute((const void*)mega_fwd, hipFuncAttributeMaxDynamicSharedMemorySize, LDS_BYTES) != hipSuccess) { fprintf(stderr, "kernel_launch: hipFuncSetAttribute failed\n"); grid = -1; return; }
        if (hipOccupancyMaxActiveBlocksPerMultiprocessor(&per_cu, (const void*)mega_fwd, 512, LDS_BYTES) != hipSuccess || per_cu < 1) { fprintf(stderr, "kernel_launch: occupancy query says %d\n", per_cu); per_cu = 1; }
        (void)hipGetLastError();
        grid = cus * 1;
        fprintf(stderr, "kernel_launch: grid %d (cus %d, occupancy %d)\n", grid, cus, per_cu);
    }
    if (grid < 0) return;
    Args a{};
    const float** p = (const float**)&a;
    for (int i = 0; i < 29; ++i) p[i] = (const float*)d_in[i];
    a.out = (float*)d_out; a.ws = (unsigned char*)d_ws;
#if N_LAUNCH_MODE == 1
    a.ph_lo = 0; a.ph_hi = N_PHASES;
    void* args[] = {&a};
    hipError_t e = hipLaunchCooperativeKernel((const void*)mega_fwd, dim3(grid), dim3(512), args, LDS_BYTES, stream);
    if (e != hipSuccess) fprintf(stderr, "cooperative launch failed: %s (grid %d)\n", hipGetErrorString(e), grid);
#else
#ifndef RUN_UPTO
#define RUN_UPTO (N_PHASES - 1)
#endif
    for (int ph = 0; ph < N_PHASES; ++ph) { if (ph >= RUN_UPTO && ph != N_PHASES - 1) continue; a.ph_lo = ph; a.ph_hi = ph + 1; hipLaunchKernelGGL(mega_fwd, dim3(grid), dim3(512), LDS_BYTES, stream, a); }
#endif
}
```

```cpp
#include <hip/hip_runtime.h>
#include <hip/hip_cooperative_groups.h>
#include <cstdio>
#include <cstdint>
namespace cg = cooperative_groups;

#define LAS __attribute__((address_space(3)))
typedef unsigned short bf16_t;
typedef short bf16x8 __attribute__((ext_vector_type(8)));
typedef short s16x4 __attribute__((ext_vector_type(4)));
typedef float f32x4 __attribute__((ext_vector_type(4)));
typedef float f32x2 __attribute__((ext_vector_type(2)));
typedef unsigned u32x4 __attribute__((ext_vector_type(4)));
typedef unsigned u32x2 __attribute__((ext_vector_type(2)));
typedef __bf16 bf16x2_t __attribute__((ext_vector_type(2)));

constexpr int T_ = 16384, SEQ = 8192, D_ = 1024, FF = 2816, RNN = 1280;
constexpr int NSA_NPAD = 2816, GLA_NPAD = 3328;
constexpr float EPS = 1e-6f;
constexpr float LOG2E = 1.4426950408889634f;

constexpr size_t MiB = 1u << 20;
constexpr size_t WS_W_GU = 0, WS_W_DN = 11 * MiB, WS_W_MIN = 17 * MiB, WS_W_MOUT = 24 * MiB, WS_W_SMALL = 27 * MiB;
constexpr size_t WS_HN = 28 * MiB;
constexpr size_t WS_ACT = 60 * MiB;
constexpr size_t WS_LG = 60 * MiB, WS_LX = 100 * MiB, WS_LHL = 140 * MiB, WS_LAC = 180 * MiB, WS_LAGGA = 220 * MiB, WS_LAGGH = 221 * MiB;
constexpr size_t WS_NQ = 60 * MiB, WS_NKV = 92 * MiB, WS_NGT = 140 * MiB, WS_NKC = 143 * MiB, WS_NVC = 144 * MiB;
constexpr size_t WS_GQ = 60 * MiB, WS_GK = 76 * MiB, WS_GV = 92 * MiB, WS_GR = 124 * MiB, WS_GGL = 156 * MiB, WS_GDEC = 157 * MiB, WS_GKVT = 158 * MiB;
constexpr size_t WS_TQ = 223 * MiB, WS_CTL = 222 * MiB, WS_SSP = 222 * MiB + 65536, WS_NY = 148 * MiB;
constexpr size_t WS_END = 224 * MiB;

constexpr int LDS_BYTES = 147456;

__device__ __forceinline__ unsigned pk2(float lo, float hi) { f32x2 v = {lo, hi}; bf16x2_t b = __builtin_convertvector(v, bf16x2_t); return __builtin_bit_cast(unsigned, b); }
__device__ __forceinline__ float bf2f(unsigned short h) { return __uint_as_float(((unsigned)h) << 16); }
__device__ __forceinline__ float bflo(unsigned w) { return __uint_as_float(w << 16); }
__device__ __forceinline__ float bfhi(unsigned w) { return __uint_as_float(w & 0xffff0000u); }
__device__ __forceinline__ float fast_rcp(float x) { return __builtin_amdgcn_rcpf(x); }
__device__ __forceinline__ float fast_exp2(float x) { return __builtin_amdgcn_exp2f(x); }
__device__ __forceinline__ float sigmoidf_(float x) { return fast_rcp(1.f + fast_exp2(-x * LOG2E)); }
__device__ __forceinline__ float siluf_(float x) { return x * sigmoidf_(x); }
__device__ __forceinline__ float gelu_tanh_(float x) { const float z = 0.7978845608028654f * (x + 0.044715f * x * x * x); return x * fast_rcp(1.f + fast_exp2(-2.f * LOG2E * z)); }
__device__ __forceinline__ float wave_sum(float v) {
#pragma unroll
    for (int o = 1; o < 64; o <<= 1) v += __shfl_xor(v, o);
    return v;
}
__device__ __forceinline__ float xmax16_32(float v) {
    auto r = __builtin_amdgcn_permlane16_swap(__float_as_uint(v), __float_as_uint(v), false, false); v = fmaxf(__uint_as_float(r[0]), __uint_as_float(r[1]));
    auto q = __builtin_amdgcn_permlane32_swap(__float_as_uint(v), __float_as_uint(v), false, false); return fmaxf(__uint_as_float(q[0]), __uint_as_float(q[1]));
}
__device__ __forceinline__ float xsum16_32(float v) {
    auto r = __builtin_amdgcn_permlane16_swap(__float_as_uint(v), __float_as_uint(v), false, false); v = __uint_as_float(r[0]) + __uint_as_float(r[1]);
    auto q = __builtin_amdgcn_permlane32_swap(__float_as_uint(v), __float_as_uint(v), false, false); return __uint_as_float(q[0]) + __uint_as_float(q[1]);
}
__device__ __forceinline__ float dpp_xor1(float v) { return __uint_as_float((unsigned)__builtin_amdgcn_update_dpp(0, (int)__float_as_uint(v), 0xB1, 0xF, 0xF, true)); }
__device__ __forceinline__ float dpp_xor2(float v) { return __uint_as_float((unsigned)__builtin_amdgcn_update_dpp(0, (int)__float_as_uint(v), 0x4E, 0xF, 0xF, true)); }
__device__ __forceinline__ float max3_(float a, float b, float c) { float r; asm("v_max3_f32 %0, %1, %2, %3" : "=v"(r) : "v"(a), "v"(b), "v"(c)); return r; }
namespace pg8 {
#define PG8_LAS __attribute__((address_space(3)))
typedef unsigned short bf16_t;
typedef short bf16x8 __attribute__((ext_vector_type(8)));
typedef float f32x4 __attribute__((ext_vector_type(4)));
typedef unsigned u32x4 __attribute__((ext_vector_type(4)));
constexpr int BM = 256, BK = 64, HALF = 128, HTB = HALF * BK * 2  , STAGE_BYTES = 8 * HTB, NXCD = 8, WGM = 8;

__host__ __device__ __forceinline__ int lds_byte(int r, int c) { const int st = (r >> 4) * 2 + (c >> 5), rr = r & 15, cc = c & 31, ob = rr * 64 + cc * 2; return st * 1024 + (ob ^ (((ob >> 9) & 1) << 5)); }
__host__ __device__ __forceinline__ void stage_rc(int b, int& R, int& C) { const int st = b / 1024, sb = b % 1024, swz = sb ^ (((sb >> 9) & 1) << 5); R = (st >> 1) * 16 + swz / 64; C = (st & 1) * 32 + (swz % 64) / 2; }
__host__ __device__ __forceinline__ int perm32(int rho) { const int n = rho >> 4, i = rho & 15; return 8 * (i >> 2) + 4 * n + (i & 3); }

struct Unit { int pm, pn; };
struct Gemm { const bf16_t* A; const bf16_t* Bt; int M, N, K; };

struct StaticOrder {
    int nM, nN, nwg, G, c;
    __host__ __device__ void init(int M, int N, int G_, int c_) { nM = M / BM; nN = N / BM; nwg = nM * nN; G = G_; c = c_; }
    __host__ __device__ bool next(int i, Unit& u) const {
        const long L = (long)i * G + c; if (L >= nwg) return false;
        int wgid = (int)L; { const int q = nwg / NXCD, r = nwg % NXCD, xcd = wgid % NXCD, off = wgid / NXCD; wgid = (xcd < r ? xcd * (q + 1) : r * (q + 1) + (xcd - r) * q) + off; }
        const int nig = WGM * nN, gid = wgid / nig, fm = gid * WGM, gsz = (nM - fm) < WGM ? (nM - fm) : WGM;
        u.pm = fm + ((wgid % nig) % gsz); u.pn = (wgid % nig) / gsz; return true;
    }
    __device__ __forceinline__ void a_ready(const Unit&) const {}
    __device__ __forceinline__ void done(const Unit&) const {}
};

struct EpiResid {
    static constexpr bool PERM = false, AFTER_DRAIN = false;
    bf16_t* hb; float* ssp; PG8_LAS float* red;
    __device__ __forceinline__ void operator()(const f32x4 (&acc)[2][2][4][2], const Unit& u, int wr, int wc, int fr, int fq) const {
        const int row0 = u.pm * BM + wr * 64 + fr, col0 = u.pn * BM + wc * 32 + 4 * fq;
#pragma unroll
        for (int ai = 0; ai < 2; ++ai)
#pragma unroll
            for (int m = 0; m < 4; ++m) { const size_t off = (size_t)(row0 + ai * HALF + m * 16) * 1024 + col0; float ss = 0.f;
#pragma unroll
                for (int bj = 0; bj < 2; ++bj)
#pragma unroll
                    for (int n = 0; n < 2; ++n) { const u32x2 b = *(const u32x2*)(hb + off + bj * HALF + n * 16); const f32x4 a = acc[ai][bj][m][n];
                        u32x2 w; w.x = ::pk2(::bflo(b.x) + a[0], ::bfhi(b.x) + a[1]); w.y = ::pk2(::bflo(b.y) + a[2], ::bfhi(b.y) + a[3]); *(u32x2*)(hb + off + bj * HALF + n * 16) = w;
                        const float h0 = ::bflo(w.x), h1 = ::bfhi(w.x), h2 = ::bflo(w.y), h3 = ::bfhi(w.y); ss += (h0 * h0 + h1 * h1) + (h2 * h2 + h3 * h3); }
                ss = ::xsum16_32(ss); if (fq == 0) red[(ai * HALF + wr * 64 + m * 16 + fr) * 4 + wc] = ss; }
        asm volatile("s_waitcnt lgkmcnt(0)" ::: "memory"); __builtin_amdgcn_s_barrier(); asm volatile("" ::: "memory");
        const int t = (wr * 4 + wc) * 64 + fq * 16 + fr;
        if (t < 256) { const f32x4 s = *(const PG8_LAS f32x4*)(red + t * 4); ssp[(size_t)(u.pm * BM + t) * 4 + u.pn] = (s[0] + s[1]) + (s[2] + s[3]); }
    }
};
__device__ __forceinline__ void load_rs(const float* ssp, int pm, int wr, int fr, float (&rs)[2][4]) {
#pragma unroll
    for (int ai = 0; ai < 2; ++ai)
#pragma unroll
        for (int m = 0; m < 4; ++m) { const int row = pm * BM + ai * HALF + wr * 64 + m * 16 + fr;
            const f32x4 s4 = *(const f32x4*)(ssp + (size_t)row * 4); const float s = (s4[0] + s4[1]) + (s4[2] + s4[3]); rs[ai][m] = __builtin_amdgcn_rsqf(s * (1.f / 1024.f) + 1e-6f); }
}
__device__ __forceinline__ u32x4 pack8(const f32x4 a, const f32x4 b) { u32x4 w; w.x = ::pk2(a[0], a[1]); w.y = ::pk2(a[2], a[3]); w.z = ::pk2(b[0], b[1]); w.w = ::pk2(b[2], b[3]); return w; }
struct EpiSwiglu {
    static constexpr bool PERM = true, AFTER_DRAIN = false;
    bf16_t* O; const float* ssp;
    __device__ __forceinline__ void operator()(const f32x4 (&acc)[2][2][4][2], const Unit& u, int wr, int wc, int fr, int fq) const {
        float rs[2][4]; load_rs(ssp, u.pm, wr, fr, rs);
        const int row0 = u.pm * BM + wr * 64 + fr, col0 = u.pn * HALF + wc * 32 + 8 * fq;
#pragma unroll
        for (int ai = 0; ai < 2; ++ai)
#pragma unroll
            for (int m = 0; m < 4; ++m) { f32x4 v[2];
#pragma unroll
                for (int n = 0; n < 2; ++n) { const f32x4 g = acc[ai][0][m][n], up = acc[ai][1][m][n];
#pragma unroll
                    for (int j = 0; j < 4; ++j) v[n][j] = ::siluf_(g[j] * rs[ai][m]) * (up[j] * rs[ai][m]); }
                *(u32x4*)(O + (size_t)(row0 + ai * HALF + m * 16) * FF + col0) = pack8(v[0], v[1]); }
    }
};
template <int ACT> __device__ __forceinline__ void store_tile_bf16(const f32x4 (&acc)[2][2][4][2], const float (&rs)[2][4], bf16_t* dst, int ldc, int cbase, float scale, int pm, int wr, int wc, int fr, int fq) {
    const int row0 = pm * BM + wr * 64 + fr, col0 = cbase + wc * 32 + 8 * fq;
#pragma unroll
    for (int ai = 0; ai < 2; ++ai)
#pragma unroll
        for (int m = 0; m < 4; ++m)
#pragma unroll
            for (int bj = 0; bj < 2; ++bj) { f32x4 v[2];
#pragma unroll
                for (int n = 0; n < 2; ++n)
#pragma unroll
                    for (int j = 0; j < 4; ++j) { const float x = acc[ai][bj][m][n][j] * rs[ai][m]; v[n][j] = ACT == 1 ? ::gelu_tanh_(x) : ACT == 2 ? ::siluf_(x) : x * scale; }
                *(u32x4*)(dst + (size_t)(row0 + ai * HALF + m * 16) * ldc + col0 + bj * HALF) = pack8(v[0], v[1]); }
}
template <int ACT> __device__ __forceinline__ void store_tile_f32_narrow(const f32x4 (&acc)[2][2][4][2], const float (&rs)[2][4], float* dst, int ldc, int ncols, int pm, int wr, int wc, int fr, int fq) {
    const int row0 = pm * BM + wr * 64 + fr;
#pragma unroll
    for (int ai = 0; ai < 2; ++ai)
#pragma unroll
        for (int m = 0; m < 4; ++m)
#pragma unroll
            for (int n = 0; n < 2; ++n) { const int c = wc * 32 + 8 * fq + 4 * n;
                if (c < ncols) { f32x4 v = acc[ai][0][m][n] * rs[ai][m];
                    if (ACT == 3) { v[0] = ::sigmoidf_(v[0]); v[1] = ::sigmoidf_(v[1]); v[2] = ::sigmoidf_(v[2]); v[3] = ::sigmoidf_(v[3]); }
                    *(f32x4*)(dst + (size_t)(row0 + ai * HALF + m * 16) * ldc + c) = v; } }
}
struct EpiLruIn {
    static constexpr bool PERM = true, AFTER_DRAIN = false;
    bf16_t* G; bf16_t* X; const float* ssp;
    __device__ __forceinline__ void operator()(const f32x4 (&acc)[2][2][4][2], const Unit& u, int wr, int wc, int fr, int fq) const {
        float rs[2][4]; load_rs(ssp, u.pm, wr, fr, rs);
        if (u.pn < 5) store_tile_bf16<1>(acc, rs, G, RNN, u.pn * BM, 1.f, u.pm, wr, wc, fr, fq);
        else store_tile_bf16<0>(acc, rs, X, RNN, (u.pn - 5) * BM, 1.f, u.pm, wr, wc, fr, fq);
    }
};
struct EpiNsaIn {
    static constexpr bool PERM = true, AFTER_DRAIN = false;
    bf16_t* Q; bf16_t* KV; float* GT; const float* ssp;
    __device__ __forceinline__ void operator()(const f32x4 (&acc)[2][2][4][2], const Unit& u, int wr, int wc, int fr, int fq) const {
        float rs[2][4]; load_rs(ssp, u.pm, wr, fr, rs);
        if (u.pn < 4) store_tile_bf16<0>(acc, rs, Q, 1024, u.pn * BM, 0.125f, u.pm, wr, wc, fr, fq);
        else if (u.pn < 10) store_tile_bf16<0>(acc, rs, KV + (size_t)(u.pn - 4) * T_ * 256, 256, 0, 1.f, u.pm, wr, wc, fr, fq);
        else store_tile_f32_narrow<3>(acc, rs, GT, 48, 48, u.pm, wr, wc, fr, fq);
    }
};
struct EpiGlaIn {
    static constexpr bool PERM = true, AFTER_DRAIN = false;
    bf16_t* Q; bf16_t* K; bf16_t* V; bf16_t* R; float* GL; const float* ssp;
    __device__ __forceinline__ void operator()(const f32x4 (&acc)[2][2][4][2], const Unit& u, int wr, int wc, int fr, int fq) const {
        float rs[2][4]; load_rs(ssp, u.pm, wr, fr, rs);
        if (u.pn < 2) store_tile_bf16<0>(acc, rs, Q, 512, u.pn * BM, 0.08838834764831845f, u.pm, wr, wc, fr, fq);
        else if (u.pn < 4) store_tile_bf16<0>(acc, rs, K, 512, (u.pn - 2) * BM, 1.f, u.pm, wr, wc, fr, fq);
        else if (u.pn < 8) store_tile_bf16<0>(acc, rs, V, 1024, (u.pn - 4) * BM, 1.f, u.pm, wr, wc, fr, fq);
        else if (u.pn < 12) store_tile_bf16<2>(acc, rs, R, 1024, (u.pn - 8) * BM, 1.f, u.pm, wr, wc, fr, fq);
        else store_tile_f32_narrow<0>(acc, rs, GL, 16, 16, u.pm, wr, wc, fr, fq);
    }
};
template <class Epi, class Sched, bool ALIGN_EPI = false, bool SP2 = false>
__device__ __forceinline__ void gemm_phase(PG8_LAS unsigned char* lds, const Gemm g, const Sched& S, const Epi& E, const int tid) {
    const int wid = __builtin_amdgcn_readfirstlane(tid >> 6), lane = tid & 63, wr = wid >> 2, wc = wid & 3, fr = lane & 15, fq = lane >> 4;
    const int K = g.K, nt = K / BK;
    unsigned voffA[2], voffB[2];
#pragma unroll
    for (int i = 0; i < 2; ++i) { int R, C; stage_rc(tid * 16 + i * 8192, R, C); const int Rb = Epi::PERM ? ((R & ~31) + perm32(R & 31)) : R;
        voffA[i] = (unsigned)(R * K + C) * 2u; voffB[i] = (unsigned)(Rb * K + C) * 2u; }
    const size_t kstep = (size_t)(BK * 2);
    const size_t hstep = (size_t)HALF * K * 2;
    const size_t tstep = 2 * hstep;
    const unsigned ldsw = (unsigned)wid * 1024u;
    const int aoff = lds_byte(wr * 64 + fr, fq * 8), boff = lds_byte(wc * 32 + fr, fq * 8);
#define PG8_SA(b, h) (((b) * 2 + (h)) * HTB)
#define PG8_SB(b, h) ((4 + (b) * 2 + (h)) * HTB)
#define PG8_STAGE(bufoff, gbase, voff) do { _Pragma("unroll") for (int _i = 0; _i < 2; ++_i) \
        __builtin_amdgcn_global_load_lds((const unsigned*)((const char*)(gbase) + (voff)[_i]), (PG8_LAS unsigned*)(lds + (bufoff) + ldsw + _i * 8192), 16, 0, 0); } while (0)
#define PG8_LDA(dst, b, h) do { _Pragma("unroll") for (int m = 0; m < 4; ++m) _Pragma("unroll") for (int k = 0; k < 2; ++k) dst[m][k] = *(const PG8_LAS bf16x8*)(lds + PG8_SA(b, h) + aoff + m * 2048 + k * 1024); } while (0)
#define PG8_LDB(dst, b, h) do { _Pragma("unroll") for (int n = 0; n < 2; ++n) _Pragma("unroll") for (int k = 0; k < 2; ++k) dst[n][k] = *(const PG8_LAS bf16x8*)(lds + PG8_SB(b, h) + boff + n * 2048 + k * 1024); } while (0)
#define PG8_MMA(ai, bj, At, Bt) do { __builtin_amdgcn_s_setprio(1); _Pragma("unroll") for (int m = 0; m < 4; ++m) _Pragma("unroll") for (int n = 0; n < 2; ++n) _Pragma("unroll") for (int k = 0; k < 2; ++k) \
        acc[ai][bj][m][n] = __builtin_amdgcn_mfma_f32_16x16x32_bf16(Bt[n][k], At[m][k], acc[ai][bj][m][n], 0, 0, 0); __builtin_amdgcn_s_setprio(0); } while (0)
#define PG8_WAIT_V(n) asm volatile("s_waitcnt vmcnt(" #n ")" ::: "memory")
#define PG8_WAIT_L(n) asm volatile("s_waitcnt lgkmcnt(" #n ")" ::: "memory")
#define PG8_BAR __builtin_amdgcn_s_barrier()
#define PG8_SCHED __builtin_amdgcn_sched_barrier(0)
    Unit cur, nxt; int ui = 0;
    if (!S.next(0, cur)) return;
    f32x4 acc[2][2][4][2];
#pragma unroll
    for (int a = 0; a < 2; ++a)
#pragma unroll
        for (int b = 0; b < 2; ++b)
#pragma unroll
            for (int m = 0; m < 4; ++m)
#pragma unroll
                for (int n = 0; n < 2; ++n) acc[a][b][m][n] = (f32x4){0.f, 0.f, 0.f, 0.f};
    bf16x8 At[4][2], B0[2][2], B1[2][2];
    const char* cA = (const char*)g.A + (size_t)cur.pm * tstep; const char* cB = (const char*)g.Bt + (size_t)cur.pn * tstep;
    S.a_ready(cur);
    if constexpr (SP2) {
        PG8_STAGE(PG8_SB(0, 0), cB, voffB); PG8_STAGE(PG8_SB(0, 1), cB + hstep, voffB); PG8_STAGE(PG8_SA(0, 0), cA, voffA); PG8_STAGE(PG8_SA(0, 1), cA + hstep, voffA);
        if (wr == 1) PG8_BAR;
        PG8_WAIT_V(2); PG8_BAR;
        PG8_STAGE(PG8_SB(1, 0), cB + kstep, voffB); PG8_STAGE(PG8_SA(1, 0), cA + kstep, voffA); PG8_STAGE(PG8_SB(1, 1), cB + hstep + kstep, voffB);
        PG8_WAIT_V(6); PG8_BAR;
    } else {
        PG8_STAGE(PG8_SB(0, 0), cB, voffB); PG8_STAGE(PG8_SA(0, 0), cA, voffA); PG8_STAGE(PG8_SB(0, 1), cB + hstep, voffB); PG8_STAGE(PG8_SA(0, 1), cA + hstep, voffA);
        if (wr == 1) PG8_BAR;
        PG8_WAIT_V(4); PG8_BAR;
        PG8_STAGE(PG8_SB(1, 0), cB + kstep, voffB); PG8_STAGE(PG8_SA(1, 0), cA + kstep, voffA); PG8_STAGE(PG8_SB(1, 1), cB + hstep + kstep, voffB);
        PG8_WAIT_V(6); PG8_BAR;
    }
    for (;;) {
        const bool has_next = S.next(ui + 1, nxt);
        const char* nA = has_next ? (const char*)g.A + (size_t)nxt.pm * tstep : cA; const char* nB = has_next ? (const char*)g.Bt + (size_t)nxt.pn * tstep : cB;
        for (int t = 0; t < nt; t += 2) {
            const bool last = (t == nt - 2);
            const char* a1 = cA + (size_t)(t + 1) * kstep;
            const char* a2 = last ? nA : cA + (size_t)(t + 2) * kstep; const char* b2 = last ? nB : cB + (size_t)(t + 2) * kstep;
            const char* a3 = a2 + kstep; const char* b3 = b2 + kstep;
            if (last && has_next) S.a_ready(nxt);
            if constexpr (SP2) {
            PG8_LDB(B0, 0, 0); PG8_LDB(B1, 0, 1); PG8_SCHED; PG8_LDA(At, 0, 0); PG8_STAGE(PG8_SA(1, 1), a1 + hstep, voffA);
            PG8_WAIT_V(8); PG8_WAIT_L(0); PG8_BAR; PG8_MMA(0, 0, At, B0); PG8_MMA(0, 1, At, B1); PG8_BAR; PG8_SCHED;
            PG8_LDA(At, 0, 1); PG8_STAGE(PG8_SB(0, 0), b2, voffB); PG8_STAGE(PG8_SB(0, 1), b2 + hstep, voffB); PG8_STAGE(PG8_SA(0, 0), a2, voffA);
            PG8_WAIT_V(8); PG8_WAIT_L(0); PG8_BAR; PG8_MMA(1, 0, At, B0); PG8_MMA(1, 1, At, B1); PG8_BAR; PG8_SCHED;
            PG8_LDB(B0, 1, 0); PG8_LDB(B1, 1, 1); PG8_SCHED; PG8_LDA(At, 1, 0); PG8_STAGE(PG8_SA(0, 1), a2 + hstep, voffA);
            PG8_WAIT_V(8); PG8_WAIT_L(0); PG8_BAR; PG8_MMA(0, 0, At, B0); PG8_MMA(0, 1, At, B1); PG8_BAR; PG8_SCHED;
            PG8_LDA(At, 1, 1); PG8_STAGE(PG8_SB(1, 0), b3, voffB); PG8_STAGE(PG8_SB(1, 1), b3 + hstep, voffB); PG8_STAGE(PG8_SA(1, 0), a3, voffA);
            PG8_WAIT_V(8); PG8_WAIT_L(0); PG8_BAR; PG8_MMA(1, 0, At, B0); PG8_MMA(1, 1, At, B1); PG8_BAR; PG8_SCHED;
            } else {
            PG8_LDB(B0, 0, 0); PG8_SCHED; PG8_LDA(At, 0, 0); PG8_STAGE(PG8_SA(1, 1), a1 + hstep, voffA);
            PG8_WAIT_L(8); PG8_BAR; PG8_WAIT_L(0); PG8_MMA(0, 0, At, B0); PG8_BAR; PG8_SCHED;
            PG8_LDB(B1, 0, 1); PG8_STAGE(PG8_SB(0, 0), b2, voffB);
            PG8_BAR; PG8_WAIT_L(0); PG8_MMA(0, 1, At, B1); PG8_BAR;
            PG8_LDA(At, 0, 1); PG8_STAGE(PG8_SA(0, 0), a2, voffA);
            PG8_BAR; PG8_WAIT_L(0); PG8_MMA(1, 0, At, B0); PG8_BAR; PG8_SCHED;
            PG8_STAGE(PG8_SB(0, 1), b2 + hstep, voffB);
            PG8_WAIT_V(6); PG8_BAR; PG8_MMA(1, 1, At, B1); PG8_BAR;
            PG8_LDB(B0, 1, 0); PG8_SCHED; PG8_LDA(At, 1, 0); PG8_STAGE(PG8_SA(0, 1), a2 + hstep, voffA);
            PG8_WAIT_L(8); PG8_BAR; PG8_WAIT_L(0); PG8_MMA(0, 0, At, B0); PG8_BAR; PG8_SCHED;
            PG8_LDB(B1, 1, 1); PG8_STAGE(PG8_SB(1, 0), b3, voffB);
            PG8_BAR; PG8_WAIT_L(0); PG8_MMA(0, 1, At, B1); PG8_BAR;
            PG8_LDA(At, 1, 1); PG8_STAGE(PG8_SA(1, 0), a3, voffA);
            PG8_BAR; PG8_WAIT_L(0); PG8_MMA(1, 0, At, B0); PG8_BAR; PG8_SCHED;
            PG8_STAGE(PG8_SB(1, 1), b3 + hstep, voffB);
            PG8_WAIT_V(6); PG8_BAR; PG8_MMA(1, 1, At, B1); PG8_BAR;
            }
        }
        if constexpr (ALIGN_EPI) { if (wr == 0) PG8_BAR; }
        if constexpr (!Epi::AFTER_DRAIN) { E(acc, cur, wr, wc, fr, fq); S.done(cur); }
        if (!has_next) break;
#pragma unroll
        for (int a = 0; a < 2; ++a)
#pragma unroll
            for (int b = 0; b < 2; ++b)
#pragma unroll
                for (int m = 0; m < 4; ++m)
#pragma unroll
                    for (int n = 0; n < 2; ++n) acc[a][b][m][n] = (f32x4){0.f, 0.f, 0.f, 0.f};
        cur = nxt; cA = nA; cB = nB; ++ui;
        if constexpr (ALIGN_EPI) { if (wr == 1) PG8_BAR; }
    }
    PG8_WAIT_V(0);
    if constexpr (!ALIGN_EPI) { if (wr == 0) PG8_BAR; }
    PG8_BAR;
    if constexpr (Epi::AFTER_DRAIN) { E.fused(acc, cur, wr, wc, fr, fq, lds, wid, lane); S.done(cur); }
#undef PG8_SA
#undef PG8_SB
#undef PG8_STAGE
#undef PG8_LDA
#undef PG8_LDB
#undef PG8_MMA
#undef PG8_WAIT_V
#undef PG8_WAIT_L
#undef PG8_BAR
#undef PG8_SCHED
}
}
__device__ __forceinline__ void transpose_item(const float* __restrict__ W, const float* __restrict__ gk, int ldw, int N, int k0, int n0, bf16_t* WT, int ldt, int dst_row0, LAS float* scr, int lane) {
    const int nn = n0 + (lane & 31); const bool ok = nn < N;
    float wv[32];
#pragma unroll
    for (int i = 0; i < 32; ++i) { const int kk = 2 * i + (lane >> 5); wv[i] = ok ? W[(size_t)(k0 + kk) * ldw + nn] : 0.f; }
#pragma unroll
    for (int i = 0; i < 32; ++i) { const int kk = 2 * i + (lane >> 5); scr[kk * 33 + (lane & 31)] = gk ? wv[i] * gk[k0 + kk] : wv[i]; }
    asm volatile("s_waitcnt lgkmcnt(0)" ::: "memory");
    const int c = lane & 7;
#pragma unroll
    for (int j = 0; j < 4; ++j) { const int n = (lane >> 3) + 8 * j; const LAS float* s = scr + (8 * c) * 33 + n;
        u32x4 o; o.x = pk2(s[0 * 33], s[1 * 33]); o.y = pk2(s[2 * 33], s[3 * 33]); o.z = pk2(s[4 * 33], s[5 * 33]); o.w = pk2(s[6 * 33], s[7 * 33]);
        *(u32x4*)(WT + (size_t)(dst_row0 + n) * ldt + k0 + 8 * c) = o; }
    asm volatile("s_waitcnt lgkmcnt(0)" ::: "memory");
}
__device__ __forceinline__ void transpose_job(const float* W, const float* gk, int K, int N, bf16_t* WT, int ldt, int mode, int& rot, int gw, int NGW, LAS float* scr, int lane) {
    const int nnb = (N + 31) >> 5, nit = (K >> 6) * nnb;
    int start = gw - rot; if (start < 0) start += NGW;
    for (int it = start; it < nit; it += NGW) {
        const int kb = it / nnb, nb = it - kb * nnb, n0 = nb << 5;
        const int dr = mode == 0 ? n0 : ((n0 >> 7) * 256 + (n0 & 127) + (mode == 2 ? 128 : 0));
        transpose_item(W, gk, N, N, kb << 6, n0, WT, ldt, dr, scr, lane);
    }
    rot = (rot + nit) % NGW;
}
__device__ __forceinline__ void init_stream_bf16(const float* src, bf16_t* dst, float* ssp, int gw, int NGW, int lane) {
    for (int m = gw; m < T_; m += NGW) {
        const f32x4* xr = (const f32x4*)(src + (size_t)m * D_) + lane;
        u32x2 o[4]; float s = 0.f;
#pragma unroll
        for (int j = 0; j < 4; ++j) { const f32x4 v = xr[64 * j]; o[j].x = pk2(v.x, v.y); o[j].y = pk2(v.z, v.w);
            const float a = bflo(o[j].x), b = bfhi(o[j].x), c = bflo(o[j].y), d = bfhi(o[j].y); s += (a * a + b * b) + (c * c + d * d); }
        const float st = wave_sum(s); if (lane < 4) ssp[(size_t)m * 4 + lane] = lane == 0 ? st : 0.f;
        u32x2* o8 = (u32x2*)(dst + (size_t)m * D_) + lane;
#pragma unroll
        for (int j = 0; j < 4; ++j) o8[64 * j] = o[j];
    }
}
__device__ __forceinline__ void final_norm_rows(const bf16_t* hb, const float* __restrict__ g, float* out, int gw, int NGW, int lane) {
    f32x4 gv[4];
#pragma unroll
    for (int j = 0; j < 4; ++j) gv[j] = *(const f32x4*)(g + 4 * lane + 256 * j);
    for (int m = gw; m < T_; m += NGW) {
        const u32x2* hr = (const u32x2*)(hb + (size_t)m * D_) + lane;
        f32x4 v[4]; float s = 0.f;
#pragma unroll
        for (int j = 0; j < 4; ++j) { const u32x2 w = hr[64 * j]; v[j] = (f32x4){bflo(w.x), bfhi(w.x), bflo(w.y), bfhi(w.y)}; s += (v[j].x * v[j].x + v[j].y * v[j].y) + (v[j].z * v[j].z + v[j].w * v[j].w); }
        const float rs = 1.0f / sqrtf(wave_sum(s) * (1.f / D_) + EPS);
        f32x4* xr = (f32x4*)(out + (size_t)m * D_) + lane;
#pragma unroll
        for (int j = 0; j < 4; ++j) xr[64 * j] = v[j] * rs * gv[j];
    }
}
__device__ __forceinline__ f32x4 mfma16(bf16x8 a, bf16x8 b, f32x4 c) { return __builtin_amdgcn_mfma_f32_16x16x32_bf16(a, b, c, 0, 0, 0); }
__device__ __forceinline__ void unpack8(const u32x4 w, float (&f)[8]) { f[0] = bflo(w.x); f[1] = bfhi(w.x); f[2] = bflo(w.y); f[3] = bfhi(w.y); f[4] = bflo(w.z); f[5] = bfhi(w.z); f[6] = bflo(w.w); f[7] = bfhi(w.w); }
__device__ __forceinline__ u32x4 pack8f(const float (&f)[8]) { u32x4 w; w.x = pk2(f[0], f[1]); w.y = pk2(f[2], f[3]); w.z = pk2(f[4], f[5]); w.w = pk2(f[6], f[7]); return w; }

__device__ __forceinline__ float neg_expm1(float x) {
    const float p = 1.f + x * (0.5f + x * (0.16666667f + x * (0.041666668f + x * (0.0083333338f + x * 0.0013888889f))));
    const float big = 1.f - fast_exp2(x * LOG2E);
    return x > -0.3f ? -x * p : big;
}
__device__ __forceinline__ void lru_gates_phase(LAS unsigned char* lds, const bf16_t* X, const float* __restrict__ conv_w, const float* __restrict__ conv_b,
        const bf16_t* WAT, const bf16_t* WXT, const float* __restrict__ b_a, const float* __restrict__ b_x, const float* __restrict__ lam,
        bf16_t* HL, bf16_t* AC, float* AGGA, float* AGGH, const int tid, const int bid, const int G) {
    const int lane = tid & 63, wid = __builtin_amdgcn_readfirstlane(tid >> 6), fr = lane & 15, fq = lane >> 4;
    constexpr int SA = 0, SBA = 34816, SBX = 69632, SAF = 0, SUF = 67584, SAGG = 135168, LDA_ = 272, LDF = 528;
    for (int u = bid; u < 1280; u += G) {
        const int tt = u / 10, hd = u - tt * 10, m0 = tt * 128, cbase = hd * 128;
        { const int c8 = tid & 15, r = tid >> 4, ch = cbase + 8 * c8;
          float cw[4][8], cb[8];
#pragma unroll
          for (int k = 0; k < 4; ++k) { const f32x4 w0 = *(const f32x4*)(conv_w + k * RNN + ch), w1 = *(const f32x4*)(conv_w + k * RNN + ch + 4);
              cw[k][0] = w0[0]; cw[k][1] = w0[1]; cw[k][2] = w0[2]; cw[k][3] = w0[3]; cw[k][4] = w1[0]; cw[k][5] = w1[1]; cw[k][6] = w1[2]; cw[k][7] = w1[3]; }
          { const f32x4 w0 = *(const f32x4*)(conv_b + ch), w1 = *(const f32x4*)(conv_b + ch + 4); cb[0] = w0[0]; cb[1] = w0[1]; cb[2] = w0[2]; cb[3] = w0[3]; cb[4] = w1[0]; cb[5] = w1[1]; cb[6] = w1[2]; cb[7] = w1[3]; }
#pragma unroll
          for (int g = 0; g < 4; ++g) { const int row = r + 32 * g, m = m0 + row, ts = m & (SEQ - 1);
              float acc[8];
#pragma unroll
              for (int e = 0; e < 8; ++e) acc[e] = cb[e];
#pragma unroll
              for (int k = 0; k < 4; ++k) { const bool okk = ts - 3 + k >= 0;
                  const u32x4 xv = *(const u32x4*)(X + (size_t)(okk ? m - 3 + k : m) * RNN + ch); float xf[8]; unpack8(xv, xf); const float zk = okk ? 1.f : 0.f;
#pragma unroll
                  for (int e = 0; e < 8; ++e) acc[e] += cw[k][e] * (xf[e] * zk); }
              *(LAS u32x4*)(lds + SA + row * LDA_ + c8 * 16) = pack8f(acc); } }
#pragma unroll
        for (int i = 0; i < 8; ++i) { const int q = tid + 512 * i, mat = q >> 11, j = (q >> 4) & 127, c = q & 15;
            const u32x4 v = *(const u32x4*)((mat ? WXT : WAT) + hd * 16384 + j * 128 + c * 8);
            *(LAS u32x4*)(lds + (mat ? SBX : SBA) + j * LDA_ + c * 16) = v; }
        __syncthreads();
        const int rg = wid >> 1, chh = wid & 1;
        f32x4 acca[2][4], accx[2][4];
#pragma unroll
        for (int mt = 0; mt < 2; ++mt)
#pragma unroll
            for (int nt = 0; nt < 4; ++nt) { acca[mt][nt] = (f32x4){0.f, 0.f, 0.f, 0.f}; accx[mt][nt] = (f32x4){0.f, 0.f, 0.f, 0.f}; }
#pragma unroll
        for (int s = 0; s < 4; ++s) { bf16x8 af[2];
#pragma unroll
            for (int mt = 0; mt < 2; ++mt) af[mt] = *(const LAS bf16x8*)(lds + SA + (32 * rg + 16 * mt + fr) * LDA_ + (32 * s + 8 * fq) * 2);
#pragma unroll
            for (int nt = 0; nt < 4; ++nt) { const bf16x8 ba = *(const LAS bf16x8*)(lds + SBA + (64 * chh + 16 * nt + fr) * LDA_ + (32 * s + 8 * fq) * 2);
                const bf16x8 bx = *(const LAS bf16x8*)(lds + SBX + (64 * chh + 16 * nt + fr) * LDA_ + (32 * s + 8 * fq) * 2);
#pragma unroll
                for (int mt = 0; mt < 2; ++mt) { acca[mt][nt] = mfma16(ba, af[mt], acca[mt][nt]); accx[mt][nt] = mfma16(bx, af[mt], accx[mt][nt]); } } }
        u32x2 xcv[2][4];
#pragma unroll
        for (int mt = 0; mt < 2; ++mt)
#pragma unroll
            for (int nt = 0; nt < 4; ++nt) xcv[mt][nt] = *(const LAS u32x2*)(lds + SA + (32 * rg + 16 * mt + fr) * LDA_ + (64 * chh + 16 * nt + 4 * fq) * 2);
        __syncthreads();
#pragma unroll
        for (int nt = 0; nt < 4; ++nt) { const int cc = cbase + 64 * chh + 16 * nt + 4 * fq;
            const f32x4 ba4 = *(const f32x4*)(b_a + cc), bx4 = *(const f32x4*)(b_x + cc), lm4 = *(const f32x4*)(lam + cc);
            f32x4 nl8;
#pragma unroll
            for (int j = 0; j < 4; ++j) nl8[j] = -8.f * 0.6931471805599453f * __builtin_amdgcn_logf(1.f + fast_exp2(-lm4[j] * LOG2E));
#pragma unroll
            for (int mt = 0; mt < 2; ++mt) { const float xc4[4] = {bflo(xcv[mt][nt].x), bfhi(xcv[mt][nt].x), bflo(xcv[mt][nt].y), bfhi(xcv[mt][nt].y)};
                f32x4 a4, u4;
#pragma unroll
                for (int j = 0; j < 4; ++j) { const float r = sigmoidf_(acca[mt][nt][j] + ba4[j]), ig = sigmoidf_(accx[mt][nt][j] + bx4[j]);
                    const float la = nl8[j] * r; a4[j] = fast_exp2(la * LOG2E); u4[j] = __builtin_amdgcn_sqrtf(neg_expm1(2.f * la)) * ig * xc4[j]; }
                const int off = (32 * rg + 16 * mt + fr) * LDF + (64 * chh + 16 * nt + 4 * fq) * 4;
                *(LAS f32x4*)(lds + SAF + off) = a4; *(LAS f32x4*)(lds + SUF + off) = u4; } }
        __syncthreads();
        { const int ch = tid & 127, seg = tid >> 7;
          LAS float* pa = (LAS float*)(lds + SAF) + ch; LAS float* pu = (LAS float*)(lds + SUF) + ch; LAS float* ag = (LAS float*)(lds + SAGG);
          float A = 1.f, H = 0.f;
#pragma unroll 8
          for (int t = seg * 32; t < seg * 32 + 32; ++t) { const float a = pa[t * (LDF / 4)], uu = pu[t * (LDF / 4)]; H = a * H + uu; A *= a; }
          ag[seg * 128 + ch] = A; ag[512 + seg * 128 + ch] = H;
          __syncthreads();
          float cA = 1.f, cH = 0.f;
          for (int s = 0; s < seg; ++s) { const float As = ag[s * 128 + ch], Hs = ag[512 + s * 128 + ch]; cH = As * cH + Hs; cA *= As; }
#pragma unroll 8
          for (int t = seg * 32; t < seg * 32 + 32; ++t) { const float a = pa[t * (LDF / 4)], uu = pu[t * (LDF / 4)]; cH = a * cH + uu; cA *= a; pa[t * (LDF / 4)] = cA; pu[t * (LDF / 4)] = cH; }
          if (seg == 3) { AGGA[(size_t)tt * RNN + cbase + ch] = cA; AGGH[(size_t)tt * RNN + cbase + ch] = cH; } }
        __syncthreads();
#pragma unroll
        for (int i = 0; i < 4; ++i) { const int q = tid + 512 * i, row = q >> 4, c8 = q & 15;
            const f32x4 a0 = *(const LAS f32x4*)(lds + SAF + row * LDF + c8 * 32), a1 = *(const LAS f32x4*)(lds + SAF + row * LDF + c8 * 32 + 16);
            const f32x4 h0 = *(const LAS f32x4*)(lds + SUF + row * LDF + c8 * 32), h1 = *(const LAS f32x4*)(lds + SUF + row * LDF + c8 * 32 + 16);
            u32x4 wa, wh; wa.x = pk2(a0[0], a0[1]); wa.y = pk2(a0[2], a0[3]); wa.z = pk2(a1[0], a1[1]); wa.w = pk2(a1[2], a1[3]);
            wh.x = pk2(h0[0], h0[1]); wh.y = pk2(h0[2], h0[3]); wh.z = pk2(h1[0], h1[1]); wh.w = pk2(h1[2], h1[3]);
            const size_t go = (size_t)(m0 + row) * RNN + cbase + 8 * c8;
            *(u32x4*)(AC + go) = wa; *(u32x4*)(HL + go) = wh; }
        __syncthreads();
    }
}
__device__ __forceinline__ void lru_apply_phase(bf16_t* GB, const bf16_t* HL, const bf16_t* AC, const float* AGGA, const float* AGGH, const int tid, const int bid, const int G) {
    const int c8 = tid & 31, r = tid >> 5;
    for (int u = bid; u < 640; u += G) {
        const int tt = u / 5, cb = u - tt * 5, m0 = tt * 128, ch = cb * 256 + 8 * c8;
        float carry[8];
#pragma unroll
        for (int e = 0; e < 8; ++e) carry[e] = 0.f;
        { const int p0 = tt & ~63; int p = p0;
          for (; p + 8 <= tt; p += 8) { f32x4 a0[8], a1[8], h0[8], h1[8];
#pragma unroll
              for (int q = 0; q < 8; ++q) { const size_t o = (size_t)(p + q) * RNN + ch; a0[q] = *(const f32x4*)(AGGA + o); a1[q] = *(const f32x4*)(AGGA + o + 4); h0[q] = *(const f32x4*)(AGGH + o); h1[q] = *(const f32x4*)(AGGH + o + 4); }
#pragma unroll
              for (int q = 0; q < 8; ++q)
#pragma unroll
                  for (int e = 0; e < 4; ++e) { carry[e] = carry[e] * a0[q][e] + h0[q][e]; carry[4 + e] = carry[4 + e] * a1[q][e] + h1[q][e]; } }
          for (; p < tt; ++p) { const size_t o = (size_t)p * RNN + ch; const f32x4 a0 = *(const f32x4*)(AGGA + o), a1 = *(const f32x4*)(AGGA + o + 4), h0 = *(const f32x4*)(AGGH + o), h1 = *(const f32x4*)(AGGH + o + 4);
#pragma unroll
              for (int e = 0; e < 4; ++e) { carry[e] = carry[e] * a0[e] + h0[e]; carry[4 + e] = carry[4 + e] * a1[e] + h1[e]; } } }
#pragma unroll
        for (int i = 0; i < 8; ++i) { const size_t go = (size_t)(m0 + r + 16 * i) * RNN + ch;
            float g[8], hl[8], ac[8], y[8]; unpack8(*(const u32x4*)(GB + go), g); unpack8(*(const u32x4*)(HL + go), hl); unpack8(*(const u32x4*)(AC + go), ac);
#pragma unroll
            for (int e = 0; e < 8; ++e) y[e] = g[e] * (hl[e] + ac[e] * carry[e]);
            *(u32x4*)(GB + go) = pack8f(y); }
    }
}
__device__ __forceinline__ s16x4 tr_read(const LAS unsigned char* p) { typedef short v4i16_t __attribute__((ext_vector_type(4))); return __builtin_bit_cast(s16x4, __builtin_amdgcn_ds_read_tr16_b64_v4i16((LAS v4i16_t*)p)); }
__device__ __forceinline__ bf16x8 cat44(s16x4 lo, s16x4 hi) { return (bf16x8){lo[0], lo[1], lo[2], lo[3], hi[0], hi[1], hi[2], hi[3]}; }
__device__ __forceinline__ void gla_cum(LAS unsigned char* lds, const float* GL, const float* __restrict__ w_g2, const float* __restrict__ b_g2, int m0, int h, const int tid, const int bid, const int G) {

    LAS float* sGL = (LAS float*)lds; LAS float* sSeg = (LAS float*)(lds + 4096); LAS float* sB = (LAS float*)(lds + 8192);
    if (tid < 256) *(LAS f32x4*)(sGL + tid * 4) = *(const f32x4*)(GL + (size_t)m0 * 16 + tid * 4);
    const int d = tid & 127, tq = tid >> 7, dch = h * 128 + d;
    float w[16];
#pragma unroll
    for (int r = 0; r < 16; ++r) w[r] = w_g2[r * 512 + dch];
    const float bb = b_g2[dch];
    __syncthreads();
    float run = 0.f;
#pragma unroll 4
    for (int i = 0; i < 16; ++i) { const int t = tq * 16 + i; float z = bb;
#pragma unroll
        for (int r4 = 0; r4 < 4; ++r4) { const f32x4 gv = *(const LAS f32x4*)(sGL + t * 16 + r4 * 4); z += gv[0] * w[r4 * 4] + gv[1] * w[r4 * 4 + 1] + gv[2] * w[r4 * 4 + 2] + gv[3] * w[r4 * 4 + 3]; }
        const float la = -(__builtin_amdgcn_logf(1.f + fast_exp2(-fabsf(z) * LOG2E)) * 0.6931471805599453f + fmaxf(-z, 0.f)) * 0.0625f;
        run += la; sB[t * 128 + d] = run; }
    sSeg[tq * 128 + d] = run;
    __syncthreads();
    float pre = 0.f;
    for (int s = 0; s < tq; ++s) pre += sSeg[s * 128 + d];
#pragma unroll 4
    for (int i = 0; i < 16; ++i) sB[(tq * 16 + i) * 128 + d] += pre;
    __syncthreads();
}
__device__ __forceinline__ void gla_kv_phase(LAS unsigned char* lds, const bf16_t* Kg, const bf16_t* Vg, const float* GL, const float* w_g2, const float* b_g2, bf16_t* KVT, float* DEC, const int tid, const int bid, const int G) {
    const int lane = tid & 63, wid = __builtin_amdgcn_readfirstlane(tid >> 6), fr = lane & 15, fq = lane >> 4, q4 = (lane & 15) >> 2, p4 = lane & 3;
    constexpr int SB_ = 8192, SK = 40960, SV = 58368, LDK = 272, LDV = 528;
    const LAS float* sB = (const LAS float*)(lds + SB_);
    for (int u = bid; u < 1024; u += G) {
        const int b = u >> 9, n = (u >> 2) & 127, h = u & 3, m0 = b * SEQ + 64 * n, bh = b * 4 + h;
        gla_cum(lds, GL, w_g2, b_g2, m0, h, tid, bid, G);
#pragma unroll
        for (int i = 0; i < 2; ++i) { const int q = tid + 512 * i, t = q >> 4, c = q & 15; float kf[8]; unpack8(*(const u32x4*)(Kg + (size_t)(m0 + t) * 512 + h * 128 + 8 * c), kf);
#pragma unroll
            for (int e = 0; e < 8; ++e) kf[e] *= fast_exp2((sB[63 * 128 + 8 * c + e] - sB[t * 128 + 8 * c + e]) * LOG2E);
            *(LAS u32x4*)(lds + SK + t * LDK + c * 16) = pack8f(kf); }
        if (tid < 128) DEC[((size_t)bh * 128 + n) * 128 + tid] = fast_exp2(sB[63 * 128 + tid] * LOG2E);
#pragma unroll
        for (int i = 0; i < 4; ++i) { const int q = tid + 512 * i, t = q >> 5, c = q & 31; *(LAS u32x4*)(lds + SV + t * LDV + c * 16) = *(const u32x4*)(Vg + (size_t)(m0 + t) * 1024 + h * 256 + 8 * c); }
        __syncthreads();
        f32x4 acc[8][2];
#pragma unroll
        for (int mt = 0; mt < 8; ++mt) { acc[mt][0] = (f32x4){0.f, 0.f, 0.f, 0.f}; acc[mt][1] = (f32x4){0.f, 0.f, 0.f, 0.f}; }
#pragma unroll
        for (int s = 0; s < 2; ++s) { bf16x8 bv[2];
#pragma unroll
            for (int nl = 0; nl < 2; ++nl) { const LAS unsigned char* pv = lds + SV + (32 * s + 8 * fq + q4) * LDV + (32 * wid + 16 * nl + 4 * p4) * 2; bv[nl] = cat44(tr_read(pv), tr_read(pv + 4 * LDV)); }
#pragma unroll
            for (int mt = 0; mt < 8; ++mt) { const LAS unsigned char* pk = lds + SK + (32 * s + 8 * fq + q4) * LDK + (16 * mt + 4 * p4) * 2; const bf16x8 ak = cat44(tr_read(pk), tr_read(pk + 4 * LDK));
                acc[mt][0] = mfma16(ak, bv[0], acc[mt][0]); acc[mt][1] = mfma16(ak, bv[1], acc[mt][1]); } }
        bf16_t* dst = KVT + ((size_t)bh * 128 + n) * 32768;
#pragma unroll
        for (int mt = 0; mt < 8; ++mt)
#pragma unroll
            for (int nl = 0; nl < 2; ++nl) { u32x2 w; w.x = pk2(acc[mt][nl][0], acc[mt][nl][1]); w.y = pk2(acc[mt][nl][2], acc[mt][nl][3]);
                *(u32x2*)(dst + (32 * wid + 16 * nl + fr) * 128 + 16 * mt + 4 * fq) = w; }
        __syncthreads();
    }
}
__device__ __forceinline__ void gla_scan_phase(bf16_t* KVT, const float* DEC, const int tid, const int bid, const int G) {
    const int nthr = G * 512;
    for (int e2 = bid * 512 + tid; e2 < 8 * 16384; e2 += nthr) {
        const int bh = e2 >> 14, e = (e2 & 16383) * 2, dk = e & 127;
        unsigned* p = (unsigned*)(KVT + (size_t)bh * 128 * 32768 + e); const float* dp = DEC + (size_t)bh * 128 * 128 + dk;
        float s0 = 0.f, s1 = 0.f;
        for (int n0 = 0; n0 < 128; n0 += 8) { unsigned w[8]; f32x2 d2[8];
#pragma unroll
            for (int i = 0; i < 8; ++i) { w[i] = p[(size_t)(n0 + i) * 16384]; d2[i] = *(const f32x2*)(dp + (n0 + i) * 128); }
#pragma unroll
            for (int i = 0; i < 8; ++i) { p[(size_t)(n0 + i) * 16384] = pk2(s0, s1); s0 = s0 * d2[i].x + bflo(w[i]); s1 = s1 * d2[i].y + bfhi(w[i]); } }
    }
}
__device__ __forceinline__ void gla_out_phase(LAS unsigned char* lds, const bf16_t* Qg, const bf16_t* Kg, const bf16_t* Vg, const bf16_t* Rg, const float* GL, const float* w_g2, const float* b_g2,
        const float* __restrict__ norm_g, const bf16_t* KVT, bf16_t* Y, const int tid, const int bid, const int G) {
    const int lane = tid & 63, wid = __builtin_amdgcn_readfirstlane(tid >> 6), fr = lane & 15, fq = lane >> 4, q4 = (lane & 15) >> 2, p4 = lane & 3;
    constexpr int SB_ = 8192, SQ = 40960, SKI = 58368, SV = 75776, SATT = 109568, SSS = 118784, LDQ = 272, LDV = 528, LDAT = 144;
    const LAS float* sB = (const LAS float*)(lds + SB_);
    for (int u = bid; u < 1024; u += G) {
        const int b = u >> 9, n = (u >> 2) & 127, h = u & 3, m0 = b * SEQ + 64 * n, bh = b * 4 + h;
        gla_cum(lds, GL, w_g2, b_g2, m0, h, tid, bid, G);
#pragma unroll
        for (int i = 0; i < 2; ++i) { const int q = tid + 512 * i, t = q >> 4, c = q & 15; float qf[8], kf[8];
            unpack8(*(const u32x4*)(Qg + (size_t)(m0 + t) * 512 + h * 128 + 8 * c), qf); unpack8(*(const u32x4*)(Kg + (size_t)(m0 + t) * 512 + h * 128 + 8 * c), kf);
#pragma unroll
            for (int e = 0; e < 8; ++e) { const float bb = sB[t * 128 + 8 * c + e] * LOG2E; qf[e] *= fast_exp2(bb); kf[e] *= fast_exp2(-bb); }
            *(LAS u32x4*)(lds + SQ + t * LDQ + c * 16) = pack8f(qf); *(LAS u32x4*)(lds + SKI + t * LDQ + c * 16) = pack8f(kf); }
#pragma unroll
        for (int i = 0; i < 4; ++i) { const int q = tid + 512 * i, t = q >> 5, c = q & 31; *(LAS u32x4*)(lds + SV + t * LDV + c * 16) = *(const u32x4*)(Vg + (size_t)(m0 + t) * 1024 + h * 256 + 8 * c); }
        __syncthreads();
        { const int mt = wid >> 1; f32x4 at[2] = {(f32x4){0.f, 0.f, 0.f, 0.f}, (f32x4){0.f, 0.f, 0.f, 0.f}};
#pragma unroll
          for (int s = 0; s < 4; ++s) { const bf16x8 a = *(const LAS bf16x8*)(lds + SQ + (16 * mt + fr) * LDQ + (32 * s + 8 * fq) * 2);
#pragma unroll
              for (int nl = 0; nl < 2; ++nl) { const int nt = 2 * (wid & 1) + nl; const bf16x8 bk = *(const LAS bf16x8*)(lds + SKI + (16 * nt + fr) * LDQ + (32 * s + 8 * fq) * 2); at[nl] = mfma16(bk, a, at[nl]); } }
#pragma unroll
          for (int nl = 0; nl < 2; ++nl) { const int nt = 2 * (wid & 1) + nl, c = 16 * mt + fr, j0 = 16 * nt + 4 * fq; float v[4];
#pragma unroll
              for (int j = 0; j < 4; ++j) v[j] = (j0 + j <= c) ? at[nl][j] : 0.f;
              u32x2 w; w.x = pk2(v[0], v[1]); w.y = pk2(v[2], v[3]); *(LAS u32x2*)(lds + SATT + c * LDAT + j0 * 2) = w; } }
        __syncthreads();
        f32x4 o[4][2];
#pragma unroll
        for (int mt = 0; mt < 4; ++mt) { o[mt][0] = (f32x4){0.f, 0.f, 0.f, 0.f}; o[mt][1] = (f32x4){0.f, 0.f, 0.f, 0.f}; }
#pragma unroll
        for (int s = 0; s < 2; ++s) { bf16x8 bv[2];
#pragma unroll
            for (int nl = 0; nl < 2; ++nl) { const LAS unsigned char* pv = lds + SV + (32 * s + 8 * fq + q4) * LDV + (32 * wid + 16 * nl + 4 * p4) * 2; bv[nl] = cat44(tr_read(pv), tr_read(pv + 4 * LDV)); }
#pragma unroll
            for (int mt = 0; mt < 4; ++mt) { const bf16x8 a = *(const LAS bf16x8*)(lds + SATT + (16 * mt + fr) * LDAT + (32 * s + 8 * fq) * 2);
                o[mt][0] = mfma16(bv[0], a, o[mt][0]); o[mt][1] = mfma16(bv[1], a, o[mt][1]); } }
        const bf16_t* Sp = KVT + ((size_t)bh * 128 + n) * 32768;
#pragma unroll
        for (int s = 0; s < 4; ++s) { bf16x8 bs[2];
#pragma unroll
            for (int nl = 0; nl < 2; ++nl) bs[nl] = *(const bf16x8*)(Sp + (32 * wid + 16 * nl + fr) * 128 + 32 * s + 8 * fq);
#pragma unroll
            for (int mt = 0; mt < 4; ++mt) { const bf16x8 a = *(const LAS bf16x8*)(lds + SQ + (16 * mt + fr) * LDQ + (32 * s + 8 * fq) * 2);
                o[mt][0] = mfma16(bs[0], a, o[mt][0]); o[mt][1] = mfma16(bs[1], a, o[mt][1]); } }
        LAS float* sSS = (LAS float*)(lds + SSS);
#pragma unroll
        for (int mt = 0; mt < 4; ++mt) { float ss = 0.f;
#pragma unroll
            for (int nl = 0; nl < 2; ++nl)
#pragma unroll
                for (int j = 0; j < 4; ++j) ss += o[mt][nl][j] * o[mt][nl][j];
            ss += __shfl_xor(ss, 16); ss += __shfl_xor(ss, 32);
            if (fq == 0) sSS[(16 * mt + fr) * 8 + wid] = ss; }
        __syncthreads();
#pragma unroll
        for (int mt = 0; mt < 4; ++mt) { const int tok = 16 * mt + fr; const f32x4 s0 = *(const LAS f32x4*)(sSS + tok * 8), s1 = *(const LAS f32x4*)(sSS + tok * 8 + 4);
            const float tot = ((s0[0] + s0[1]) + (s0[2] + s0[3])) + ((s1[0] + s1[1]) + (s1[2] + s1[3])); const float rs = __builtin_amdgcn_rsqf(tot * (1.f / 256.f) + EPS);
#pragma unroll
            for (int nl = 0; nl < 2; ++nl) { const int dv = 32 * wid + 16 * nl + 4 * fq; const f32x4 gn = *(const f32x4*)(norm_g + dv);
                const size_t go = (size_t)(m0 + tok) * 1024 + h * 256 + dv; const u32x2 rv = *(const u32x2*)(Rg + go);
                u32x2 w; w.x = pk2(o[mt][nl][0] * rs * gn[0] * bflo(rv.x), o[mt][nl][1] * rs * gn[1] * bfhi(rv.x)); w.y = pk2(o[mt][nl][2] * rs * gn[2] * bflo(rv.y), o[mt][nl][3] * rs * gn[3] * bfhi(rv.y));
                *(u32x2*)(Y + go) = w; } }
        __syncthreads();
    }
}
__device__ __forceinline__ void nsa_compress_phase(LAS unsigned char* lds, const bf16_t* KV, const float* __restrict__ pos, const float* __restrict__ w1, const float* __restrict__ b1,
        const float* __restrict__ b2, const bf16_t* W1T, const bf16_t* W2T, bf16_t* KC, bf16_t* VC, const int tid, const int bid, const int G) {
    const int lane = tid & 63, wid = __builtin_amdgcn_readfirstlane(tid >> 6), fr = lane & 15, fq = lane >> 4;
    constexpr int SP = 0, SB1 = 2048, SPART = 4096, SH = 36864, LDH = 144;
    for (int u = bid; u < 256; u += G) {
        const int kv = u >> 7, b = (u >> 6) & 1, g = (u >> 4) & 3, n0 = (u & 15) * 32;
        { const int j = tid & 63, part = tid >> 6; float s = 0.f; const float* pw = w1 + (size_t)kv * 2048 * 64 + j; const float* pp = pos + kv * 2048;
          for (int kk = part * 256; kk < part * 256 + 256; ++kk) s += pp[kk] * pw[(size_t)kk * 64];
          ((LAS float*)(lds + SP))[part * 64 + j] = s; }
        __syncthreads();
        if (tid < 64) { float s = b1[kv * 64 + tid];
#pragma unroll
            for (int p = 0; p < 8; ++p) s += ((LAS float*)(lds + SP))[p * 64 + tid];
            ((LAS float*)(lds + SB1))[tid] = s; }
        { const int rt = wid & 1, kq = wid >> 1, n = n0 + 16 * rt + fr; const bool ok = n <= 510;
          const bf16_t* src = KV + (size_t)kv * T_ * 256 + (size_t)(b * SEQ + 16 * (ok ? n : 0)) * 256 + g * 64;
          const bf16_t* wt = W1T + (size_t)kv * 64 * 2048;
          f32x4 acc[4] = {(f32x4){0.f, 0.f, 0.f, 0.f}, (f32x4){0.f, 0.f, 0.f, 0.f}, (f32x4){0.f, 0.f, 0.f, 0.f}, (f32x4){0.f, 0.f, 0.f, 0.f}};
#pragma unroll 4
          for (int s = 0; s < 16; ++s) { const int kk = kq * 512 + 32 * s + 8 * fq, l = kk >> 6, d = kk & 63;
              bf16x8 a = *(const bf16x8*)(src + (size_t)l * 256 + d); if (!ok) a = (bf16x8){0, 0, 0, 0, 0, 0, 0, 0};
#pragma unroll
              for (int nt = 0; nt < 4; ++nt) { const bf16x8 bb = *(const bf16x8*)(wt + (size_t)(16 * nt + fr) * 2048 + kk); acc[nt] = mfma16(bb, a, acc[nt]); } }
#pragma unroll
          for (int nt = 0; nt < 4; ++nt) *(LAS f32x4*)(lds + SPART + ((kq * 2 + rt) * 1024 + fr * 64 + 16 * nt + 4 * fq) * 4) = acc[nt]; }
        __syncthreads();
        { const int row = tid >> 4, c4 = (tid & 15) * 4, rt = row >> 4, rr = row & 15; f32x4 s = *(const LAS f32x4*)(lds + SB1 + c4 * 4);
#pragma unroll
          for (int kq = 0; kq < 4; ++kq) s += *(const LAS f32x4*)(lds + SPART + ((kq * 2 + rt) * 1024 + rr * 64 + c4) * 4);
          u32x2 w; w.x = pk2(gelu_tanh_(s[0]), gelu_tanh_(s[1])); w.y = pk2(gelu_tanh_(s[2]), gelu_tanh_(s[3])); *(LAS u32x2*)(lds + SH + row * LDH + c4 * 2) = w; }
        __syncthreads();
        { const int rt = wid >> 2, nt = wid & 3; f32x4 acc = (f32x4){0.f, 0.f, 0.f, 0.f};
#pragma unroll
          for (int s = 0; s < 2; ++s) { const bf16x8 a = *(const LAS bf16x8*)(lds + SH + (16 * rt + fr) * LDH + (32 * s + 8 * fq) * 2);
              const bf16x8 bb = *(const bf16x8*)(W2T + kv * 4096 + (16 * nt + fr) * 64 + 32 * s + 8 * fq); acc = mfma16(bb, a, acc); }
          const int n = n0 + 16 * rt + fr, d = 16 * nt + 4 * fq; const f32x4 bv = *(const f32x4*)(b2 + kv * 64 + d);
          u32x2 w; w.x = pk2(acc[0] + bv[0], acc[1] + bv[1]); w.y = pk2(acc[2] + bv[2], acc[3] + bv[3]);
          *(u32x2*)((kv ? VC : KC) + ((size_t)(b * 4 + g) * 512 + n) * 64 + d) = w; }
        __syncthreads();
    }
}
#ifndef NSA_CT3_ONLY
#define NSA_CT3_ONLY 0
#endif
#ifndef NSA_SEL_REP
#define NSA_SEL_REP 1
#endif
#ifndef NSA_WIN_REP
#define NSA_WIN_REP 1
#endif
struct NsaSt { float m, l; f32x4 o[4]; };
struct KVRegs { u32x4 k[2], v[2]; };
template <int MODE, int STEP, int CTM>
__device__ __forceinline__ void nsa_tile(const LAS unsigned char* sK, const LAS unsigned char* sV, const bf16x8 (&qf)[2][2], NsaSt (&st)[2], const int (&dbase)[2],
        const bool general, const bool (&colsel)[2], const LAS float* bt, const float bfar, const float (&minv)[2], LAS float* sMain, LAS float* sSpill, const int (&tokl)[2], const int mg0,
        const int fr, const int fq, const int q4, const int p4) {
    constexpr int LDT = 144; const float NEG = -INFINITY;
    bf16x8 kf[4][2];
#pragma unroll
    for (int kt = 0; kt < 4; ++kt) { kf[kt][0] = *(const LAS bf16x8*)(sK + (16 * kt + fr) * LDT + (8 * fq) * 2); kf[kt][1] = *(const LAS bf16x8*)(sK + (16 * kt + fr) * LDT + (32 + 8 * fq) * 2); }
    f32x4 sacc[2][4];
#pragma unroll
    for (int ct = 0; ct < 2; ++ct) if (CTM & (1 << ct)) {
#pragma unroll
        for (int kt = 0; kt < 4; ++kt) sacc[ct][kt] = mfma16(kf[kt][0], qf[ct][0], (f32x4){0.f, 0.f, 0.f, 0.f});
#pragma unroll
        for (int kt = 0; kt < 4; ++kt) sacc[ct][kt] = mfma16(kf[kt][1], qf[ct][1], sacc[ct][kt]); }
#pragma unroll
    for (int ct = 0; ct < 2; ++ct) if (CTM & (1 << ct)) {
        float tmax = NEG;
        if (general) {
            float bv[4][4];
#pragma unroll
            for (int kt = 0; kt < 4; ++kt)
#pragma unroll
                for (int j = 0; j < 4; ++j) { const int dist = dbase[ct] - (16 * kt + 4 * fq + j) * STEP; const int idx = dist < 0 ? 0 : (dist > 128 ? 128 : dist); bv[kt][j] = bt[idx]; }
#pragma unroll
            for (int kt = 0; kt < 4; ++kt)
#pragma unroll
                for (int j = 0; j < 4; ++j) { const int dist = dbase[ct] - (16 * kt + 4 * fq + j) * STEP; bool valid = dist >= 0;
                    if (MODE == 3) valid = valid && dist < 512;
                    if (MODE == 2) valid = valid && colsel[ct];
                    const float x = valid ? sacc[ct][kt][j] * LOG2E + bv[kt][j] : NEG;
                    sacc[ct][kt][j] = x; tmax = max3_(tmax, x, x); }
        } else {
#pragma unroll
            for (int kt = 0; kt < 4; ++kt) tmax = max3_(max3_(tmax, sacc[ct][kt][0], sacc[ct][kt][1]), sacc[ct][kt][2], sacc[ct][kt][3]);
            tmax = (MODE == 2 && !colsel[ct]) ? NEG : tmax * LOG2E + bfar;
        }
        if (MODE == 1) {
            const float mm = st[ct].m, li = minv[ct];
#pragma unroll
            for (int kt = 0; kt < 4; ++kt) { float gs = 0.f, p3 = 0.f;
#pragma unroll
                for (int j = 0; j < 4; ++j) { const float xx = general ? sacc[ct][kt][j] : sacc[ct][kt][j] * LOG2E + bfar; const float p = fast_exp2(xx - mm) * li; sacc[ct][kt][j] = p; gs += p; if (j == 3) p3 = p; }
                gs += dpp_xor1(gs); gs += dpp_xor2(gs); p3 += dpp_xor1(p3); p3 += dpp_xor2(p3);
                const int mg = mg0 + 4 * kt + fq;
                if ((fr & 3) == 0) { sMain[tokl[ct] * 128 + mg] = gs; if (mg + 1 < 128) sSpill[tokl[ct] * 128 + mg + 1] = p3; } }
        } else {
            const float rm = xmax16_32(tmax);
            const bool need = rm > st[ct].m + 8.f;
            if (__any(need)) { const float mnew = need ? fmaxf(st[ct].m, rm) : st[ct].m, alpha = (st[ct].m == mnew) ? 1.f : fast_exp2(st[ct].m - mnew);
                st[ct].l *= alpha; st[ct].m = mnew;
                if (MODE != 0) {
#pragma unroll
                    for (int dt = 0; dt < 4; ++dt) st[ct].o[dt] = st[ct].o[dt] * alpha; } }
            const float mref = (st[ct].m == NEG) ? 0.f : st[ct].m;
            float ps = 0.f;
            if (general) {
#pragma unroll
                for (int kt = 0; kt < 4; ++kt)
#pragma unroll
                    for (int j = 0; j < 4; ++j) { const float p = fast_exp2(sacc[ct][kt][j] - mref); sacc[ct][kt][j] = p; ps += p; }
            } else { const float c = (MODE == 2 && !colsel[ct]) ? NEG : bfar - mref;
#pragma unroll
                for (int kt = 0; kt < 4; ++kt)
#pragma unroll
                    for (int j = 0; j < 4; ++j) { const float p = fast_exp2(sacc[ct][kt][j] * LOG2E + c); sacc[ct][kt][j] = p; ps += p; } }
            st[ct].l += ps;
        }
    }
    if (MODE != 0) {
#pragma unroll
        for (int s = 0; s < 2; ++s) { bf16x8 pf[2];
#pragma unroll
            for (int ct = 0; ct < 2; ++ct) if (CTM & (1 << ct)) { u32x4 w; w.x = pk2(sacc[ct][2 * s][0], sacc[ct][2 * s][1]); w.y = pk2(sacc[ct][2 * s][2], sacc[ct][2 * s][3]);
                w.z = pk2(sacc[ct][2 * s + 1][0], sacc[ct][2 * s + 1][1]); w.w = pk2(sacc[ct][2 * s + 1][2], sacc[ct][2 * s + 1][3]); pf[ct] = __builtin_bit_cast(bf16x8, w); }
#pragma unroll
            for (int dt = 0; dt < 4; ++dt) { const LAS unsigned char* pv = sV + (32 * s + 4 * fq + q4) * LDT + (16 * dt + 4 * p4) * 2; const bf16x8 vf = cat44(tr_read(pv), tr_read(pv + 16 * LDT));
#pragma unroll
                for (int ct = 0; ct < 2; ++ct) if (CTM & (1 << ct)) st[ct].o[dt] = mfma16(vf, pf[ct], st[ct].o[dt]); } }
    }
}
__device__ __forceinline__ void nsa_ld2(const bf16_t* Kp, const bf16_t* Vp, size_t ts, int ld, bool two, int tid, KVRegs& r) { const int key = tid >> 3, c = tid & 7;
    r.k[0] = *(const u32x4*)(Kp + (size_t)key * ld + 8 * c); r.v[0] = *(const u32x4*)(Vp + (size_t)key * ld + 8 * c);
    if (two) { r.k[1] = *(const u32x4*)(Kp + ts + (size_t)key * ld + 8 * c); r.v[1] = *(const u32x4*)(Vp + ts + (size_t)key * ld + 8 * c); } }
__device__ __forceinline__ void nsa_st2(LAS unsigned char* sK, LAS unsigned char* sV, int tid, const KVRegs& r) { const int key = tid >> 3, c = tid & 7;
    *(LAS u32x4*)(sK + key * 144 + c * 16) = r.k[0]; *(LAS u32x4*)(sV + key * 144 + c * 16) = r.v[0]; *(LAS u32x4*)(sK + 9216 + key * 144 + c * 16) = r.k[1]; *(LAS u32x4*)(sV + 9216 + key * 144 + c * 16) = r.v[1]; }

__device__ __forceinline__ void nsa_attn_phase(LAS unsigned char* lds, const bf16_t* Q, const bf16_t* KV, const float* GT, const bf16_t* KC, const bf16_t* VC, const float* __restrict__ rel_bias, bf16_t* Y, void* TQ, const int tid, const int bid, const int G) {
    const int lane = tid & 63, wid = __builtin_amdgcn_readfirstlane(tid >> 6), fr = lane & 15, fq = lane >> 4, q4 = (lane & 15) >> 2, p4 = lane & 3, hg = fr & 3;
    constexpr int SKO = 0, SVO = 36864, SMAIN = 73728, SSPILL = 106496, SBT = 139264, SSEL = 141376, TB = 9216;
    LAS float* sMain = (LAS float*)(lds + SMAIN); LAS float* sSpill = (LAS float*)(lds + SSPILL); LAS float* sBt = (LAS float*)(lds + SBT); LAS unsigned* sSel = (LAS unsigned*)(lds + SSEL);
    const float NEG = -INFINITY;
    unsigned long long tp_[5] = {0ull, 0ull, 0ull, 0ull, 0ull}; (void)tp_;
#ifdef TIMING_PROBE
#define TP(i) tp_[i] = __builtin_amdgcn_s_memrealtime()
#define TPW0() tw_ = __builtin_amdgcn_s_memrealtime()
#define TPW1() accw_ += __builtin_amdgcn_s_memrealtime() - tw_
#define TPT0(M) do { if ((M) == 2) tt_ = __builtin_amdgcn_s_memrealtime(); } while (0)
#define TPT1(M, c) do { if ((M) == 2) { acct_ += __builtin_amdgcn_s_memrealtime() - tt_; cntt_ += (c); } } while (0)
#else
#define TPT0(M) do {} while (0)
#define TPT1(M, c) do {} while (0)
#define TP(i) do {} while (0)
#define TPW0() do {} while (0)
#define TPW1() do {} while (0)
#endif
    unsigned long long tw_ = 0ull, accw_ = 0ull, tt_ = 0ull, acct_ = 0ull; int cntt_ = 0; (void)tw_; (void)accw_; (void)tt_; (void)acct_; (void)cntt_;
    unsigned long long acc_[4] = {0ull, 0ull, 0ull, 0ull}; (void)acc_;
        for (int ui = 0; ; ++ui) {
        int bg, qb;
        if (G == 256) { if (ui >= 4) break; const int c = bid, s = c >> 3; bg = c & 7;        qb = ui == 0 ? s : ui == 1 ? 63 - s : ui == 2 ? 64 + s : 127 - s; }
        else { const int uu = bid + ui * G; if (uu >= 1024) break; bg = uu >> 7; qb = uu & 127; }
        const int b = bg >> 2, g = bg & 3, t0 = 64 * qb, m0 = b * SEQ + t0;
        TP(0);
        int tokl[2]; tokl[0] = 8 * wid + (fr >> 2); tokl[1] = tokl[0] + 4;
        bf16x8 qf[2][2];
#pragma unroll
        for (int ct = 0; ct < 2; ++ct)
#pragma unroll
            for (int s = 0; s < 2; ++s) qf[ct][s] = *(const bf16x8*)(Q + (size_t)(m0 + tokl[ct]) * 1024 + (g * 4 + hg) * 64 + 32 * s + 8 * fq);
        for (int i = tid; i < 4 * 129; i += 512) { const int h = i / 129, dist = i - h * 129; int bk;
            if (dist < 16) bk = dist; else { bk = 16 + (int)(logf((float)dist * (1.f / 16.f)) / 2.0794415416798357f * 16.f); bk = bk > 31 ? 31 : bk; }
            sBt[h * 132 + dist] = rel_bias[bk * 16 + g * 4 + h] * LOG2E; }
#pragma unroll
        for (int i = 0; i < 4; ++i) { *(LAS f32x4*)(lds + SMAIN + (tid + 512 * i) * 16) = (f32x4){0.f, 0.f, 0.f, 0.f}; *(LAS f32x4*)(lds + SSPILL + (tid + 512 * i) * 16) = (f32x4){0.f, 0.f, 0.f, 0.f}; }
        __syncthreads();
        const LAS float* bt = sBt + hg * 132; const float bfar = bt[128];
        LAS f32x4* totp = (LAS f32x4*)(lds + SMAIN + wid * 4096) + lane;
        const float* gtp = GT + (size_t)(m0 + tokl[0]) * 48 + (g * 4 + hg) * 3;
        NsaSt st[2]; bool act[2] = {true, true}; bool colsel[2] = {true, true}; int dbase[2]; float minv[2] = {1.f, 1.f};
        KVRegs kvr; kvr.k[1] = (u32x4){0u, 0u, 0u, 0u}; kvr.v[1] = (u32x4){0u, 0u, 0u, 0u};
        int mg0 = 0; bool general = true;
#define NSA_RUN(MODE, STEP, NT, KB, VB, TS, LD, SETUP) do { const int nt_ = (NT), nst_ = (nt_ + 1) >> 1; \
        nsa_ld2((KB), (VB), (TS), (LD), nt_ >= 2, tid, kvr); nsa_st2(lds + SKO, lds + SVO, tid, kvr); __syncthreads(); \
        _Pragma("unroll 1") for (int s_ = 0; s_ < nst_; ++s_) { const int sb_ = s_ & 1; \
            if (s_ + 1 < nst_) nsa_ld2((KB) + (size_t)(2 * s_ + 2) * (TS), (VB) + (size_t)(2 * s_ + 2) * (TS), (TS), (LD), 2 * s_ + 3 < nt_, tid, kvr); \
            _Pragma("unroll") for (int h_ = 0; h_ < 2; ++h_) { const int ti = 2 * s_ + h_; if (ti < nt_) { SETUP; \
                const LAS unsigned char* sk_ = lds + SKO + (sb_ * 2 + h_) * TB; const LAS unsigned char* sv_ = lds + SVO + (sb_ * 2 + h_) * TB; \
                TPT0(MODE); if (MODE != 2 || NSA_CT3_ONLY || (act[0] && act[1])) nsa_tile<MODE, STEP, 3>(sk_, sv_, qf, st, dbase, general, colsel, bt, bfar, minv, sMain, sSpill, tokl, mg0, fr, fq, q4, p4); \
                else if (act[0]) nsa_tile<MODE, STEP, 1>(sk_, sv_, qf, st, dbase, general, colsel, bt, bfar, minv, sMain, sSpill, tokl, mg0, fr, fq, q4, p4); \
                else if (act[1]) nsa_tile<MODE, STEP, 2>(sk_, sv_, qf, st, dbase, general, colsel, bt, bfar, minv, sMain, sSpill, tokl, mg0, fr, fq, q4, p4); TPT1(MODE, (int)act[0] + (int)act[1]); } } \
            if (s_ + 1 < nst_) nsa_st2(lds + SKO + ((sb_ ^ 1) * 2) * TB, lds + SVO + ((sb_ ^ 1) * 2) * TB, tid, kvr); \
            TPW0(); __syncthreads(); TPW1(); } } while (0)
#define NSA_RESET() do { _Pragma("unroll") for (int ct = 0; ct < 2; ++ct) { st[ct].m = NEG; st[ct].l = 0.f; _Pragma("unroll") for (int dt = 0; dt < 4; ++dt) st[ct].o[dt] = (f32x4){0.f, 0.f, 0.f, 0.f}; } } while (0)
        const int ncmp = 4 * qb + 3, nct = (ncmp + 63) >> 6;
        const bf16_t* kcb = KC + (size_t)bg * 512 * 64; const bf16_t* vcb = VC + (size_t)bg * 512 * 64;
        NSA_RESET();
        NSA_RUN(0, 16, nct, kcb, vcb, (size_t)4096, 64, { dbase[0] = t0 + tokl[0] - 31 - 1024 * ti; dbase[1] = dbase[0] + 4; mg0 = 16 * ti; general = t0 - 31 - 1024 * ti - 1008 < 128; });
#pragma unroll
        for (int ct = 0; ct < 2; ++ct) { const float lt = xsum16_32(st[ct].l); minv[ct] = fast_rcp(lt > 0.f ? lt : 1.f); if (st[ct].m == NEG) st[ct].m = 0.f; }
        NSA_RUN(1, 16, nct, kcb, vcb, (size_t)4096, 64, { dbase[0] = t0 + tokl[0] - 31 - 1024 * ti; dbase[1] = dbase[0] + 4; mg0 = 16 * ti; general = t0 - 31 - 1024 * ti - 1008 < 128; });
        LAS f32x4* park = (LAS f32x4*)(lds + SKO + wid * 8192) + lane;
#pragma unroll
        for (int ct = 0; ct < 2; ++ct) { const float gt0 = gtp[ct * 4 * 48];
#pragma unroll
            for (int dt = 0; dt < 4; ++dt) park[(ct * 4 + dt) * 64] = st[ct].o[dt] * gt0; }
        unsigned msk[2][4];
        if (qb <= 15) {
#pragma unroll
            for (int ct = 0; ct < 2; ++ct) { msk[ct][0] = (2u << qb) - 1u; msk[ct][1] = 0u; msk[ct][2] = 0u; msk[ct][3] = 0u; }
        } else {
            const int tl = lane >> 3, sub = lane & 7, tok = 8 * wid + tl;
            unsigned key[16];
#pragma unroll
            for (int i = 0; i < 4; ++i) { const f32x4 a = *(const LAS f32x4*)(sMain + tok * 128 + 16 * sub + 4 * i), s4 = *(const LAS f32x4*)(sSpill + tok * 128 + 16 * sub + 4 * i);
#pragma unroll
                for (int j = 0; j < 4; ++j) { const int m = 16 * sub + 4 * i + j; const float imp = a[j] + s4[j];
                    key[4 * i + j] = (m >= 1 && m <= qb - 2) ? ((__float_as_uint(imp) & ~127u) | (unsigned)(127 - m)) : 0u; } }
            unsigned selb = 0u;
#pragma unroll 1
            for (int it = 0; it < 13; ++it) { unsigned mx = key[0];
#pragma unroll
                for (int i = 1; i < 16; ++i) mx = key[i] > mx ? key[i] : mx;
                { unsigned o = (unsigned)__shfl_xor((int)mx, 1); mx = o > mx ? o : mx; o = (unsigned)__shfl_xor((int)mx, 2); mx = o > mx ? o : mx; o = (unsigned)__shfl_xor((int)mx, 4); mx = o > mx ? o : mx; }
#pragma unroll
                for (int i = 0; i < 16; ++i) if (key[i] == mx) { selb |= 1u << i; key[i] = 0u; } }
            { const int f0 = 0, f1 = qb, f2 = qb - 1;
              if ((f0 >> 4) == sub) selb |= 1u << (f0 & 15); if ((f1 >> 4) == sub) selb |= 1u << (f1 & 15); if ((f2 >> 4) == sub) selb |= 1u << (f2 & 15); }
            const unsigned oth = (unsigned)__shfl_xor((int)selb, 1);
            if ((sub & 1) == 0) sSel[tok * 4 + (sub >> 1)] = selb | (oth << 16);
            asm volatile("s_waitcnt lgkmcnt(0)" ::: "memory");
#pragma unroll
            for (int ct = 0; ct < 2; ++ct) { const u32x4 w = *(const LAS u32x4*)(sSel + tokl[ct] * 4); msk[ct][0] = w.x; msk[ct][1] = w.y; msk[ct][2] = w.z; msk[ct][3] = w.w; }
        }
#pragma unroll
        for (int ct = 0; ct < 2; ++ct)
#pragma unroll
            for (int dt = 0; dt < 4; ++dt) totp[ct * (SSPILL - SMAIN) / 16 + 64 * dt] = park[(ct * 4 + dt) * 64];
        __syncthreads();
        TP(1);
        { const bf16_t* ksb = KV + (size_t)2 * T_ * 256 + (size_t)(b * SEQ) * 256 + g * 64; const bf16_t* vsb = KV + (size_t)3 * T_ * 256 + (size_t)(b * SEQ) * 256 + g * 64;
          _Pragma("unroll 1") for (int rep_ = 0; rep_ < NSA_SEL_REP; ++rep_) {
          NSA_RESET();
          NSA_RUN(2, 1, qb + 1, ksb, vsb, (size_t)64 * 256, 256, { const int mw = ti >> 5; const int mb = ti & 31;
              _Pragma("unroll") for (int ct = 0; ct < 2; ++ct) { const unsigned w = mw == 0 ? msk[ct][0] : mw == 1 ? msk[ct][1] : mw == 2 ? msk[ct][2] : msk[ct][3]; colsel[ct] = (w >> mb) & 1u; act[ct] = __any(colsel[ct]); }
              dbase[0] = t0 + tokl[0] - 64 * ti; dbase[1] = dbase[0] + 4; general = ti + 2 >= qb; });
          }
#pragma unroll
          for (int ct = 0; ct < 2; ++ct) { const float lt = xsum16_32(st[ct].l), sc = gtp[ct * 4 * 48 + 1] * fast_rcp(lt > 0.f ? lt : 1.f);
#pragma unroll
              for (int dt = 0; dt < 4; ++dt) totp[ct * (SSPILL - SMAIN) / 16 + 64 * dt] += st[ct].o[dt] * sc; } }
        TP(2);
        { const bf16_t* kwb = KV + (size_t)4 * T_ * 256 + (size_t)(b * SEQ) * 256 + g * 64; const bf16_t* vwb = KV + (size_t)5 * T_ * 256 + (size_t)(b * SEQ) * 256 + g * 64;
          _Pragma("unroll 1") for (int rep_ = 0; rep_ < NSA_WIN_REP; ++rep_) {
          NSA_RESET(); act[0] = true; act[1] = true; colsel[0] = true; colsel[1] = true;
          const int j0 = qb >= 8 ? 0 : 8 - qb;
          NSA_RUN(3, 1, 9 - j0, kwb + (size_t)(t0 - 512 + 64 * j0) * 256, vwb + (size_t)(t0 - 512 + 64 * j0) * 256, (size_t)64 * 256, 256, { const int j = j0 + ti;
              dbase[0] = tokl[0] + 512 - 64 * j; dbase[1] = dbase[0] + 4; general = (j == 0) || (j >= 6); });
          }
#pragma unroll
          for (int ct = 0; ct < 2; ++ct) { const float lt = xsum16_32(st[ct].l), sc = gtp[ct * 4 * 48 + 2] * fast_rcp(lt > 0.f ? lt : 1.f);
#pragma unroll
              for (int dt = 0; dt < 4; ++dt) st[ct].o[dt] = totp[ct * (SSPILL - SMAIN) / 16 + 64 * dt] + st[ct].o[dt] * sc; } }
        TP(3);
#pragma unroll
        for (int ct = 0; ct < 2; ++ct)
#pragma unroll
            for (int dt = 0; dt < 4; ++dt) { u32x2 w; w.x = pk2(st[ct].o[dt][0], st[ct].o[dt][1]); w.y = pk2(st[ct].o[dt][2], st[ct].o[dt][3]);
                *(u32x2*)(Y + (size_t)(m0 + tokl[ct]) * 1024 + (g * 4 + hg) * 64 + 16 * dt + 4 * fq) = w; }
        __syncthreads();
        TP(4);
#ifdef TIMING_PROBE
        acc_[0] += tp_[1] - tp_[0]; acc_[1] += tp_[2] - tp_[1]; acc_[2] += tp_[3] - tp_[2]; acc_[3] += tp_[4] - tp_[0];
#endif
#undef NSA_RESET
#undef NSA_RUN
    }
#ifdef TIMING_PROBE
    if (bid == 0 && tid == 0) { float* tq = (float*)TQ; const float tt = (float)acc_[3]; tq[0] = (float)acc_[0] / tt; tq[1] = (float)acc_[1] / tt; tq[2] = (float)acc_[2] / tt; tq[3] = (float)accw_ / tt; tq[4] = 0.f; tq[5] = (float)acct_ / tt; tq[6] = (float)cntt_ * (1.f / 2000.f); tq[7] = tt * (1.f / 100000.f); }
#endif
}
#ifndef USE_XCD_BAR
#define USE_XCD_BAR 1
#endif
#ifndef EN_ALL
#define EN_ALL 1
#endif
#ifndef EN_LRUG
#define EN_LRUG EN_ALL
#endif
#ifndef EN_LRUA
#define EN_LRUA EN_ALL
#endif
#ifndef EN_NSAC
#define EN_NSAC EN_ALL
#endif
#ifndef EN_NSAA
#define EN_NSAA EN_ALL
#endif
#ifndef EN_GLAK
#define EN_GLAK EN_ALL
#endif
#ifndef EN_GLAS
#define EN_GLAS EN_ALL
#endif
#ifndef EN_GLAO
#define EN_GLAO EN_ALL
#endif
#ifndef EN_G_LRUIN
#define EN_G_LRUIN EN_ALL
#endif
#ifndef EN_G_RESID
#define EN_G_RESID EN_ALL
#endif
#ifndef EN_G_NSAIN
#define EN_G_NSAIN EN_ALL
#endif
#ifndef EN_G_GLAIN
#define EN_G_GLAIN EN_ALL
#endif
#ifndef EN_G_GU
#define EN_G_GU EN_ALL
#endif
#ifndef EN_PREP
#define EN_PREP EN_ALL
#endif
struct Args {
    const float* x; const float* rel_bias; const float* final_norm; const float* mix_norm; const float* ffn_norm;
    const float* ffn_w_gate; const float* ffn_w_up; const float* ffn_w_down;
    const float* lru_w_in; const float* lru_conv_w; const float* lru_conv_b; const float* lru_w_a; const float* lru_b_a; const float* lru_w_x; const float* lru_b_x; const float* lru_lam; const float* lru_w_out;
    const float* nsa_w_in; const float* nsa_cmp_pos; const float* nsa_cmp_w1; const float* nsa_cmp_b1; const float* nsa_cmp_w2; const float* nsa_cmp_b2; const float* nsa_w_out;
    const float* gla_w_in; const float* gla_w_g2; const float* gla_b_g2; const float* gla_norm; const float* gla_w_out;
    float* out; unsigned char* ws; int ph_lo, ph_hi;
};

#define XB_TMO      128
#define XB_XCNT(j)  (256  + 64 * (j))
#define XB_XSUB(j)  (1280 + 64 * (j))
#define XB_XGEN(j)  (2304 + 64 * (j))
#define XB_TOP      3328
#define XB_TOPGEN   3392
#define XCD_BAR_WORDS 3456
#define XB_SPIN_CAP (1u << 18)

__device__ __forceinline__ unsigned xb_ld(unsigned* p)              { return __hip_atomic_load(p, __ATOMIC_RELAXED, __HIP_MEMORY_SCOPE_AGENT); }
__device__ __forceinline__ unsigned xb_add(unsigned* p, unsigned v) { return __hip_atomic_fetch_add(p, v, __ATOMIC_RELAXED, __HIP_MEMORY_SCOPE_AGENT); }
__device__ __forceinline__ unsigned xb_xcc_id() { return (unsigned)__builtin_amdgcn_s_getreg((3 << 11) | 20) & 0xFu; }
#define XB_SPIN(cond, bar) do { unsigned _sp = 0; while (cond) { __builtin_amdgcn_s_sleep(1); \
    if ((++_sp & 255u) == 0u) { if (xb_ld(&(bar)[XB_TMO])) break; if (_sp > XB_SPIN_CAP) { atomicAdd(&(bar)[XB_TMO], 1u); break; } } } } while (0)

struct XcdBarrier {
    unsigned* bar; unsigned x;
    volatile LAS unsigned* st;
};

__device__ __forceinline__ XcdBarrier xcd_barrier_post(unsigned* bar, volatile LAS unsigned* st) {
    XcdBarrier b; b.bar = bar; b.x = xb_xcc_id(); b.st = st;
    if (threadIdx.x == 0) (void)xb_add(&bar[XB_XCNT(b.x)], 1u);
    return b;
}
__device__ __forceinline__ void xcd_barrier_complete(unsigned* bar, unsigned x, unsigned& nloc, unsigned& nx) {
    const unsigned G = gridDim.x * gridDim.y * gridDim.z;
    unsigned sum, cnt, mine, sp = 0u;
    for (;;) {
        sum = 0u; cnt = 0u; mine = 0u;
#pragma unroll
        for (unsigned j = 0; j < 16; ++j) { const unsigned c = xb_ld(&bar[XB_XCNT(j)]); sum += c; cnt += (c > 0u) ? 1u : 0u; mine = (j == x) ? c : mine; }
        if (sum == G) break;
        __builtin_amdgcn_s_sleep(1);
        if ((++sp & 255u) == 0u) { if (xb_ld(&bar[XB_TMO])) break; if (sp > XB_SPIN_CAP) { atomicAdd(&bar[XB_TMO], 1u); break; } }
    }
    nloc = mine > 0u ? mine : 1u; nx = cnt > 0u ? cnt : 1u;
}

__device__ __forceinline__ void xcd_barrier(const XcdBarrier& b) {
    asm volatile("s_waitcnt vmcnt(0)" ::: "memory");
    __syncthreads();
    if (threadIdx.x == 0) {
        unsigned* bar = b.bar;
        __builtin_amdgcn_s_waitcnt(0);
        unsigned nloc = b.st[0], nx = b.st[1];
        if (nloc == 0u) { xcd_barrier_complete(bar, b.x, nloc, nx); b.st[0] = nloc; b.st[1] = nx; }
        const unsigned old = xb_add(&bar[XB_XSUB(b.x)], 1u);
        const unsigned gen = old / nloc;
        if (old + 1u == (gen + 1u) * nloc) {
            __builtin_amdgcn_fence(__ATOMIC_RELEASE, "agent");
            asm volatile("s_waitcnt vmcnt(0)" ::: "memory");
            const unsigned og = xb_add(&bar[XB_TOP], 1u);
            const unsigned tg = og / nx;
            if (og + 1u == (tg + 1u) * nx) xb_add(&bar[XB_TOPGEN], 1u);
            else XB_SPIN(xb_ld(&bar[XB_TOPGEN]) == tg, bar);
            __builtin_amdgcn_fence(__ATOMIC_ACQUIRE, "agent");
            xb_add(&bar[XB_XGEN(b.x)], 1u);
            asm volatile("s_waitcnt vmcnt(0)" ::: "memory");
        } else {
            XB_SPIN(xb_ld(&bar[XB_XGEN(b.x)]) == gen, bar);
            __builtin_amdgcn_fence(__ATOMIC_ACQUIRE, "agent");
            asm volatile("s_waitcnt vmcnt(0)" ::: "memory");
        }
    }
    __syncthreads();
}

__global__ void __launch_bounds__(512, 2) mega_fwd(Args a) {
    extern __shared__ __attribute__((aligned(16))) unsigned char lds_raw[];
    LAS unsigned char* lds = (LAS unsigned char*)lds_raw;
    cg::grid_group grid = cg::this_grid();
    const int tid0 = threadIdx.x; const int wid0 = __builtin_amdgcn_readfirstlane(tid0 >> 6);
    constexpr int PTR_OFF = LDS_BYTES - 512;
    if (tid0 == 0) { LAS unsigned long long* tb = (LAS unsigned long long*)(lds + PTR_OFF);
        tb[0] = (unsigned long long)a.x;
        tb[1] = (unsigned long long)a.rel_bias;
        tb[2] = (unsigned long long)a.final_norm;
        tb[3] = (unsigned long long)a.mix_norm;
        tb[4] = (unsigned long long)a.ffn_norm;
        tb[5] = (unsigned long long)a.ffn_w_gate;
        tb[6] = (unsigned long long)a.ffn_w_up;
        tb[7] = (unsigned long long)a.ffn_w_down;
        tb[8] = (unsigned long long)a.lru_w_in;
        tb[9] = (unsigned long long)a.lru_conv_w;
        tb[10] = (unsigned long long)a.lru_conv_b;
        tb[11] = (unsigned long long)a.lru_w_a;
        tb[12] = (unsigned long long)a.lru_b_a;
        tb[13] = (unsigned long long)a.lru_w_x;
        tb[14] = (unsigned long long)a.lru_b_x;
        tb[15] = (unsigned long long)a.lru_lam;
        tb[16] = (unsigned long long)a.lru_w_out;
        tb[17] = (unsigned long long)a.nsa_w_in;
        tb[18] = (unsigned long long)a.nsa_cmp_pos;
        tb[19] = (unsigned long long)a.nsa_cmp_w1;
        tb[20] = (unsigned long long)a.nsa_cmp_b1;
        tb[21] = (unsigned long long)a.nsa_cmp_w2;
        tb[22] = (unsigned long long)a.nsa_cmp_b2;
        tb[23] = (unsigned long long)a.nsa_w_out;
        tb[24] = (unsigned long long)a.gla_w_in;
        tb[25] = (unsigned long long)a.gla_w_g2;
        tb[26] = (unsigned long long)a.gla_b_g2;
        tb[27] = (unsigned long long)a.gla_norm;
        tb[28] = (unsigned long long)a.gla_w_out;
        tb[29] = (unsigned long long)a.out;
        tb[30] = (unsigned long long)a.ws;
    }
    if (tid0 < 4) ((LAS unsigned*)(lds + PTR_OFF + 256))[tid0] = 0u;
    __syncthreads();
    XcdBarrier xbar = xcd_barrier_post((unsigned*)(a.ws + WS_CTL), (volatile LAS unsigned*)(lds + PTR_OFF + 256));
#define PRAW(i) ((((unsigned long long)(unsigned)__builtin_amdgcn_readfirstlane((int)((const LAS unsigned*)(lds + PTR_OFF))[2 * (i) + 1])) << 32) | (unsigned long long)(unsigned)__builtin_amdgcn_readfirstlane((int)((const LAS unsigned*)(lds + PTR_OFF))[2 * (i)]))
#define GAS_ __attribute__((address_space(1)))
#define PF(i) ((const float*)(const GAS_ float*)PRAW(i))
#define P_OUT ((float*)(GAS_ float*)PRAW(29))
#define WSP(off) ((unsigned char*)((GAS_ unsigned char*)PRAW(30) + (off)))
#define W_GU ((bf16_t*)WSP(WS_W_GU))
#define W_DN ((bf16_t*)WSP(WS_W_DN))
#define W_MIN ((bf16_t*)WSP(WS_W_MIN))
#define W_MOUT ((bf16_t*)WSP(WS_W_MOUT))
#define W_SM ((bf16_t*)WSP(WS_W_SMALL))
#define HN ((bf16_t*)WSP(WS_HN))
#define ACT ((bf16_t*)WSP(WS_ACT))
#define LG ((bf16_t*)WSP(WS_LG))
#define LX ((bf16_t*)WSP(WS_LX))
#define LHL ((bf16_t*)WSP(WS_LHL))
#define LAC ((bf16_t*)WSP(WS_LAC))
#define AGGA ((float*)WSP(WS_LAGGA))
#define AGGH ((float*)WSP(WS_LAGGH))
#define NQ ((bf16_t*)WSP(WS_NQ))
#define NKV ((bf16_t*)WSP(WS_NKV))
#define NGT ((float*)WSP(WS_NGT))
#define NKC ((bf16_t*)WSP(WS_NKC))
#define NVC ((bf16_t*)WSP(WS_NVC))
#define GQ ((bf16_t*)WSP(WS_GQ))
#define GK ((bf16_t*)WSP(WS_GK))
#define GV ((bf16_t*)WSP(WS_GV))
#define GR ((bf16_t*)WSP(WS_GR))
#define GGL ((float*)WSP(WS_GGL))
#define GDEC ((float*)WSP(WS_GDEC))
#define GKVT ((bf16_t*)WSP(WS_GKVT))
#define SSP ((float*)WSP(WS_SSP))
#define NY ((bf16_t*)WSP(WS_NY))

    enum { OP_PREP, OP_G_LRUIN, OP_LRU_GATES, OP_LRU_APPLY, OP_G_RESID, OP_G_NSAIN, OP_NSA_CMP, OP_NSA_ATTN, OP_G_GLAIN, OP_GLA_KV, OP_GLA_SCAN, OP_GLA_OUT, OP_NORM2, OP_G_GU, OP_FINAL };
#pragma unroll 1
    for (int ph = a.ph_lo; ph < a.ph_hi; ++ph) {
        int layer, r;
        if (ph < 7) { layer = 0; r = ph; } else if (ph < 13) { layer = 1; r = ph - 6; } else if (ph < 20) { layer = 2; r = ph - 12; } else if (ph < 26) { layer = 3; r = ph - 19; } else { layer = 4; r = 0; }
        const int kind = layer % 3, jj = layer / 3, nmix = kind == 2 ? 5 : 4;
        int wid_s = wid0, bid = blockIdx.x, G = gridDim.x;
        asm volatile("" : "+s"(wid_s) :: "memory"); asm volatile("" : "+s"(bid)); asm volatile("" : "+s"(G));
        int lane_v; asm volatile("v_mbcnt_lo_u32_b32 %0, -1, 0\n\tv_mbcnt_hi_u32_b32 %0, -1, %0" : "=v"(lane_v));
        const int tid = (wid_s << 6) | lane_v;
        const int lane = tid & 63, wid = __builtin_amdgcn_readfirstlane(tid >> 6), gw = bid * 8 + wid, NGW = G * 8;
        LAS float* scr = (LAS float*)(lds + wid * 8448);
        const float* hsrc = layer == 0 ? PF(0) : P_OUT;
        int op;
        if (layer == 4) op = OP_FINAL;
        else if (r == 0) op = OP_PREP;
        else if (r <= nmix) { const int q = r - 1;
            if (kind == 0) op = q == 0 ? OP_G_LRUIN : q == 1 ? OP_LRU_GATES : q == 2 ? OP_LRU_APPLY : OP_G_RESID;
            else if (kind == 1) op = q == 0 ? OP_G_NSAIN : q == 1 ? OP_NSA_CMP : q == 2 ? OP_NSA_ATTN : OP_G_RESID;
            else op = q == 0 ? OP_G_GLAIN : q == 1 ? OP_GLA_KV : q == 2 ? OP_GLA_SCAN : q == 3 ? OP_GLA_OUT : OP_G_RESID; }
        else { const int q = r - nmix - 1; op = q == 0 ? OP_G_GU : OP_G_RESID; }
        const bool is_down = (r == nmix + 2);
#ifdef PHASE_PROBE
        if (bid == 0 && tid == 0) { unsigned long long* ts = (unsigned long long*)WSP(WS_TQ + 4096); ts[ph] = __builtin_amdgcn_s_memrealtime(); ((int*)WSP(WS_TQ + 8192))[ph] = op; }
#endif
        switch (op) {
        case OP_PREP: if (EN_PREP) init_stream_bf16(PF(0), HN, SSP, gw, NGW, lane);
            break;
        case OP_G_LRUIN: if (EN_G_LRUIN) { pg8::Gemm g{HN, W_MIN, T_, 2 * RNN, D_}; pg8::StaticOrder S; S.init(T_, 2 * RNN, G, bid); pg8::EpiLruIn E{LG, LX, SSP};
            pg8::gemm_phase<pg8::EpiLruIn, pg8::StaticOrder, true, true>(lds, g, S, E, tid); }
            break;
        case OP_LRU_GATES: if (EN_LRUG) lru_gates_phase(lds, LX, PF(9) + jj * 4 * RNN, PF(10) + jj * RNN, W_SM, W_SM + 163840, PF(12) + jj * RNN, PF(14) + jj * RNN, PF(15) + jj * RNN, LHL, LAC, AGGA, AGGH, tid, bid, G);
            break;
        case OP_LRU_APPLY: if (EN_LRUA) lru_apply_phase(LG, LHL, LAC, AGGA, AGGH, tid, bid, G);
            break;
        case OP_G_RESID: if (EN_G_RESID) {
            const bf16_t* A = is_down ? ACT : (kind == 0 ? LG : kind == 1 ? NY : GV); const bf16_t* Bt = is_down ? W_DN : W_MOUT; const int K = is_down ? FF : (kind == 0 ? RNN : D_);
            pg8::Gemm g{A, Bt, T_, D_, K}; pg8::StaticOrder S; S.init(T_, D_, G, bid); pg8::EpiResid E{HN, SSP, (LAS float*)(lds + 131072)};
            pg8::gemm_phase<pg8::EpiResid, pg8::StaticOrder, true, true>(lds, g, S, E, tid); }
            break;
        case OP_G_NSAIN: if (EN_G_NSAIN) { pg8::Gemm g{HN, W_MIN, T_, NSA_NPAD, D_}; pg8::StaticOrder S; S.init(T_, NSA_NPAD, G, bid); pg8::EpiNsaIn E{NQ, NKV, NGT, SSP};
            pg8::gemm_phase<pg8::EpiNsaIn, pg8::StaticOrder, true, true>(lds, g, S, E, tid); }
            break;
        case OP_NSA_CMP: if (EN_NSAC) nsa_compress_phase(lds, NKV, PF(18), PF(19), PF(20), PF(22), W_SM, W_SM + 262144, NKC, NVC, tid, bid, G);
            break;
        case OP_NSA_ATTN: if (EN_NSAA) nsa_attn_phase(lds, NQ, NKV, NGT, NKC, NVC, PF(1), NY, (void*)WSP(WS_TQ), tid, bid, G);
            break;
        case OP_G_GLAIN: if (EN_G_GLAIN) { pg8::Gemm g{HN, W_MIN, T_, GLA_NPAD, D_}; pg8::StaticOrder S; S.init(T_, GLA_NPAD, G, bid); pg8::EpiGlaIn E{GQ, GK, GV, GR, GGL, SSP};
            pg8::gemm_phase<pg8::EpiGlaIn, pg8::StaticOrder, true, true>(lds, g, S, E, tid); }
            break;
        case OP_GLA_KV: if (EN_GLAK) gla_kv_phase(lds, GK, GV, GGL, PF(25), PF(26), GKVT, GDEC, tid, bid, G);
            break;
        case OP_GLA_SCAN: if (EN_GLAS) gla_scan_phase(GKVT, GDEC, tid, bid, G);
            break;
        case OP_GLA_OUT: if (EN_GLAO) gla_out_phase(lds, GQ, GK, GV, GR, GGL, PF(25), PF(26), PF(27), GKVT, GV, tid, bid, G);
            break;
        case OP_G_GU: if (EN_G_GU) { pg8::Gemm g{HN, W_GU, T_, 2 * FF, D_}; pg8::StaticOrder S; S.init(T_, 2 * FF, G, bid); pg8::EpiSwiglu E{ACT, SSP};
            pg8::gemm_phase<pg8::EpiSwiglu, pg8::StaticOrder, true, true>(lds, g, S, E, tid); }
            break;
        default: if (EN_PREP) final_norm_rows(HN, PF(2), P_OUT, gw, NGW, lane);
#if defined(TIMING_PROBE) || defined(PHASE_PROBE)
            { __syncthreads(); float* o = P_OUT;
#ifdef PHASE_PROBE
              const unsigned long long* ts = (const unsigned long long*)WSP(WS_TQ + 4096); const int* ops = (const int*)WSP(WS_TQ + 8192);
              const unsigned long long tend = __builtin_amdgcn_s_memrealtime(); float sa = 0.f, sb = 0.f;
              for (int q = 0; q < 33; ++q) { const float dt = (float)(ts[q + 1] - ts[q]); if (ops[q] == TQ_A) sa += dt; if (ops[q] == TQ_B) sb += dt; }
              const float tot_ = (float)(ts[33] - ts[0]); const float f1 = sa / tot_, f2 = sb / tot_; (void)tend;
#else
              const float* tq = (const float*)WSP(WS_TQ); const float f1 = tq[TQ_A], f2 = tq[TQ_B];
#endif

              const int R = (int)(f2 * 0.32f * 16384.f);
              for (int m = gw; m < R; m += NGW) for (int c = lane; c < 1024; c += 64) o[(size_t)m * 1024 + c] += 0.05f;
              if (bid == G - 1 && tid == 0) o[(size_t)16383 * 1024 + 5] += 0.1f + 0.19f * f1; }
#endif
            break;
        }
        { int cv = 0, nun = 0;
          if (op == OP_PREP) cv = 2;
          else if ((op == OP_G_LRUIN || op == OP_G_NSAIN || op == OP_G_GLAIN)) { cv = 1; nun = 64 * (op == OP_G_LRUIN ? 10 : op == OP_G_NSAIN ? 11 : 13); }
          else if (op == OP_G_GU && layer < 3) { cv = 2; nun = 64 * 22; }
          if (EN_PREP && cv) {
              const int rem = op == OP_PREP ? 0 : nun % G, first = rem, nidle = G - first;
              if (bid >= first) { const int cgw = (bid - first) * 8 + wid, CNGW = nidle * 8; int rot = 0;
                  if (cv & 1) {
                      transpose_job(PF(5) + (size_t)layer * D_ * FF, PF(4) + layer * D_, D_, FF, W_GU, D_, 1, rot, cgw, CNGW, scr, lane);
                      transpose_job(PF(6) + (size_t)layer * D_ * FF, PF(4) + layer * D_, D_, FF, W_GU, D_, 2, rot, cgw, CNGW, scr, lane);
                      transpose_job(PF(7) + (size_t)layer * FF * D_, nullptr, FF, D_, W_DN, FF, 0, rot, cgw, CNGW, scr, lane); }
                  if (cv & 2) { const int ml = op == OP_PREP ? layer : layer + 1, mk = ml % 3, mj = ml / 3;
                      if (mk == 0) {
                          transpose_job(PF(8) + (size_t)mj * D_ * 2 * RNN, PF(3) + ml * D_, D_, 2 * RNN, W_MIN, D_, 0, rot, cgw, CNGW, scr, lane);
                          transpose_job(PF(16) + (size_t)mj * RNN * D_, nullptr, RNN, D_, W_MOUT, RNN, 0, rot, cgw, CNGW, scr, lane);
#pragma unroll 1
                          for (int h = 0; h < 20; ++h) { const int hh = h % 10; const float* src = (h < 10 ? PF(11) : PF(13)) + ((size_t)mj * 10 + hh) * 16384;
                              transpose_job(src, nullptr, 128, 128, W_SM + (h < 10 ? 0 : 163840) + hh * 16384, 128, 0, rot, cgw, CNGW, scr, lane); }
                      } else if (mk == 1) {
                          transpose_job(PF(17), PF(3) + ml * D_, D_, 2608, W_MIN, D_, 0, rot, cgw, CNGW, scr, lane);
                          transpose_job(PF(23), nullptr, D_, D_, W_MOUT, D_, 0, rot, cgw, CNGW, scr, lane);
#pragma unroll 1
                          for (int kv = 0; kv < 2; ++kv) {
                              transpose_job(PF(19) + (size_t)kv * 2048 * 64, nullptr, 2048, 64, W_SM + (size_t)kv * 64 * 2048, 2048, 0, rot, cgw, CNGW, scr, lane);
                              transpose_job(PF(21) + (size_t)kv * 4096, nullptr, 64, 64, W_SM + 262144 + kv * 4096, 64, 0, rot, cgw, CNGW, scr, lane); }
                      } else {
                          transpose_job(PF(24), PF(3) + ml * D_, D_, 3088, W_MIN, D_, 0, rot, cgw, CNGW, scr, lane);
                          transpose_job(PF(28), nullptr, D_, D_, W_MOUT, D_, 0, rot, cgw, CNGW, scr, lane); } } } } }
        if (ph + 1 < a.ph_hi) { if (USE_XCD_BAR && ph != a.ph_lo) xcd_barrier(xbar); else grid.sync(); }
    }
}

#ifndef N_LAUNCH_MODE
#define N_LAUNCH_MODE 1
#endif
constexpr int N_PHASES = 27;

extern "C" void kernel_launch(void* const* d_in, const int* in_sizes, int n_in, void* d_out, int out_size, void* d_ws, size_t ws_size, hipStream_t stream) {
    static int grid = 0;
    if (grid == 0) {
        if (n_in != 29 || out_size != T_ * D_ || ws_size < WS_END) { fprintf(stderr, "kernel_launch: unexpected problem: n_in %d out %d ws %zu\n", n_in, out_size, ws_size); grid = -1; return; }
        int dev = 0, cus = 0, per_cu = 0;
        hipGetDevice(&dev); hipDeviceGetAttribute(&cus, hipDeviceAttributeMultiprocessorCount, dev);
        if (hipFuncSetAttribute((const void*)mega_fwd, hipFuncAttributeMaxDynamicSharedMemorySize, LDS_BYTES) != hipSuccess) { fprintf(stderr, "kernel_launch: hipFuncSetAttribute failed\n"); grid = -1; return; }
        if (hipOccupancyMaxActiveBlocksPerMultiprocessor(&per_cu, (const void*)mega_fwd, 512, LDS_BYTES) != hipSuccess || per_cu < 1) { fprintf(stderr, "kernel_launch: occupancy query says %d\n", per_cu); per_cu = 1; }
        (void)hipGetLastError();
        grid = cus * 1;
        fprintf(stderr, "kernel_launch: grid %d (cus %d, occupancy %d)\n", grid, cus, per_cu);
    }
    if (grid < 0) return;
    if (hipMemsetAsync((char*)d_ws + WS_CTL, 0, 16384, stream) != hipSuccess) { fprintf(stderr, "kernel_launch: memset failed\n"); return; }
    Args a{};
    const float** p = (const float**)&a;
    for (int i = 0; i < 29; ++i) p[i] = (const float*)d_in[i];
    a.out = (float*)d_out; a.ws = (unsigned char*)d_ws;
#if N_LAUNCH_MODE == 1
    a.ph_lo = 0; a.ph_hi = N_PHASES;
    void* args[] = {&a};
    hipError_t e = hipLaunchCooperativeKernel((const void*)mega_fwd, dim3(grid), dim3(512), args, LDS_BYTES, stream);
    if (e != hipSuccess) fprintf(stderr, "cooperative launch failed: %s (grid %d)\n", hipGetErrorString(e), grid);
#else
#ifndef REPEAT_PH
#define REPEAT_PH -1
#endif
#ifndef REPEAT_N
#define REPEAT_N 1
#endif
#ifndef RUN_UPTO
#define RUN_UPTO (N_PHASES - 1)
#endif
    for (int ph = 0; ph < N_PHASES; ++ph) { if (ph >= RUN_UPTO && ph != N_PHASES - 1) continue; a.ph_lo = ph; a.ph_hi = ph + 1; hipLaunchKernelGGL(mega_fwd, dim3(grid), dim3(512), LDS_BYTES, stream, a);
        for (int rep = 0; rep < REPEAT_N; ++rep) if (ph == REPEAT_PH) hipLaunchKernelGGL(mega_fwd, dim3(grid), dim3(512), LDS_BYTES, stream, a); }
#endif
}
```

```cpp
#include <hip/hip_runtime.h>
#include <hip/hip_cooperative_groups.h>
#include <cstdio>
#include <cstdint>
namespace cg = cooperative_groups;

#define LAS __attribute__((address_space(3)))
typedef unsigned short bf16_t;
typedef short bf16x8 __attribute__((ext_vector_type(8)));
typedef short s16x4 __attribute__((ext_vector_type(4)));
typedef float f32x4 __attribute__((ext_vector_type(4)));
typedef float f32x2 __attribute__((ext_vector_type(2)));
typedef unsigned u32x4 __attribute__((ext_vector_type(4)));
typedef unsigned u32x2 __attribute__((ext_vector_type(2)));
typedef __bf16 bf16x2_t __attribute__((ext_vector_type(2)));

constexpr int T_ = 16384, SEQ = 8192, D_ = 1024, FF = 2816, RNN = 1280;
constexpr int NSA_NPAD = 2816, GLA_NPAD = 3328;
constexpr float EPS = 1e-6f;
constexpr float LOG2E = 1.4426950408889634f;

constexpr size_t MiB = 1u << 20;
constexpr size_t WS_W_GU = 0, WS_W_DN = 11 * MiB, WS_W_MIN = 17 * MiB, WS_W_MOUT = 24 * MiB, WS_W_SMALL = 27 * MiB;
constexpr size_t WS_HN = 28 * MiB;
constexpr size_t WS_ACT = 60 * MiB;
constexpr size_t WS_LG = 60 * MiB, WS_LX = 100 * MiB, WS_LHL = 140 * MiB, WS_LAC = 180 * MiB, WS_LAGGA = 220 * MiB, WS_LAGGH = 221 * MiB;
constexpr size_t WS_NQ = 60 * MiB, WS_NKV = 92 * MiB, WS_NGT = 140 * MiB, WS_NKC = 143 * MiB, WS_NVC = 144 * MiB;
constexpr size_t WS_GQ = 60 * MiB, WS_GK = 76 * MiB, WS_GV = 92 * MiB, WS_GR = 124 * MiB, WS_GGL = 156 * MiB, WS_GDEC = 157 * MiB, WS_GKVT = 158 * MiB;
constexpr size_t WS_TQ = 223 * MiB, WS_CTL = 222 * MiB, WS_SSP = 222 * MiB + 65536, WS_NY = 148 * MiB;
constexpr size_t WS_END = 224 * MiB;

constexpr int LDS_BYTES = 147456;

__device__ __forceinline__ unsigned pk2(float lo, float hi) { f32x2 v = {lo, hi}; bf16x2_t b = __builtin_convertvector(v, bf16x2_t); return __builtin_bit_cast(unsigned, b); }
__device__ __forceinline__ float bf2f(unsigned short h) { return __uint_as_float(((unsigned)h) << 16); }
__device__ __forceinline__ float bflo(unsigned w) { return __uint_as_float(w << 16); }
__device__ __forceinline__ float bfhi(unsigned w) { return __uint_as_float(w & 0xffff0000u); }
__device__ __forceinline__ float fast_rcp(float x) { return __builtin_amdgcn_rcpf(x); }
__device__ __forceinline__ float fast_exp2(float x) { return __builtin_amdgcn_exp2f(x); }
__device__ __forceinline__ float sigmoidf_(float x) { return fast_rcp(1.f + fast_exp2(-x * LOG2E)); }
__device__ __forceinline__ float siluf_(float x) { return x * sigmoidf_(x); }
__device__ __forceinline__ float gelu_tanh_(float x) { const float z = 0.7978845608028654f * (x + 0.044715f * x * x * x); return x * fast_rcp(1.f + fast_exp2(-2.f * LOG2E * z)); }
__device__ __forceinline__ float wave_sum(float v) {
#pragma unroll
    for (int o = 1; o < 64; o <<= 1) v += __shfl_xor(v, o);
    return v;
}
__device__ __forceinline__ float xmax16_32(float v) {
    auto r = __builtin_amdgcn_permlane16_swap(__float_as_uint(v), __float_as_uint(v), false, false); v = fmaxf(__uint_as_float(r[0]), __uint_as_float(r[1]));
    auto q = __builtin_amdgcn_permlane32_swap(__float_as_uint(v), __float_as_uint(v), false, false); return fmaxf(__uint_as_float(q[0]), __uint_as_float(q[1]));
}
__device__ __forceinline__ float xsum16_32(float v) {
    auto r = __builtin_amdgcn_permlane16_swap(__float_as_uint(v), __float_as_uint(v), false, false); v = __uint_as_float(r[0]) + __uint_as_float(r[1]);
    auto q = __builtin_amdgcn_permlane32_swap(__float_as_uint(v), __float_as_uint(v), false, false); return __uint_as_float(q[0]) + __uint_as_float(q[1]);
}
__device__ __forceinline__ float dpp_xor1(float v) { return __uint_as_float((unsigned)__builtin_amdgcn_update_dpp(0, (int)__float_as_uint(v), 0xB1, 0xF, 0xF, true)); }
__device__ __forceinline__ float dpp_xor2(float v) { return __uint_as_float((unsigned)__builtin_amdgcn_update_dpp(0, (int)__float_as_uint(v), 0x4E, 0xF, 0xF, true)); }
__device__ __forceinline__ float max3_(float a, float b, float c) { float r; asm("v_max3_f32 %0, %1, %2, %3" : "=v"(r) : "v"(a), "v"(b), "v"(c)); return r; }
namespace pg8 {
#define PG8_LAS __attribute__((address_space(3)))
typedef unsigned short bf16_t;
typedef short bf16x8 __attribute__((ext_vector_type(8)));
typedef float f32x4 __attribute__((ext_vector_type(4)));
typedef unsigned u32x4 __attribute__((ext_vector_type(4)));
constexpr int BM = 256, BK = 64, HALF = 128, HTB = HALF * BK * 2  , STAGE_BYTES = 8 * HTB, NXCD = 8, WGM = 8;

__host__ __device__ __forceinline__ int lds_byte(int r, int c) { const int st = (r >> 4) * 2 + (c >> 5), rr = r & 15, cc = c & 31, ob = rr * 64 + cc * 2; return st * 1024 + (ob ^ (((ob >> 9) & 1) << 5)); }
__host__ __device__ __forceinline__ void stage_rc(int b, int& R, int& C) { const int st = b / 1024, sb = b % 1024, swz = sb ^ (((sb >> 9) & 1) << 5); R = (st >> 1) * 16 + swz / 64; C = (st & 1) * 32 + (swz % 64) / 2; }
__host__ __device__ __forceinline__ int perm32(int rho) { const int n = rho >> 4, i = rho & 15; return 8 * (i >> 2) + 4 * n + (i & 3); }

struct Unit { int pm, pn; };
struct Gemm { const bf16_t* A; const bf16_t* Bt; int M, N, K; };

struct StaticOrder {
    int nM, nN, nwg, G, c;
    __host__ __device__ void init(int M, int N, int G_, int c_) { nM = M / BM; nN = N / BM; nwg = nM * nN; G = G_; c = c_; }
    __host__ __device__ bool next(int i, Unit& u) const {
        const long L = (long)i * G + c; if (L >= nwg) return false;
        int wgid = (int)L; { const int q = nwg / NXCD, r = nwg % NXCD, xcd = wgid % NXCD, off = wgid / NXCD; wgid = (xcd < r ? xcd * (q + 1) : r * (q + 1) + (xcd - r) * q) + off; }
        const int nig = WGM * nN, gid = wgid / nig, fm = gid * WGM, gsz = (nM - fm) < WGM ? (nM - fm) : WGM;
        u.pm = fm + ((wgid % nig) % gsz); u.pn = (wgid % nig) / gsz; return true;
    }
    __device__ __forceinline__ void a_ready(const Unit&) const {}
    __device__ __forceinline__ void done(const Unit&) const {}
};

struct EpiResid {
    static constexpr bool PERM = false, AFTER_DRAIN = false;
    bf16_t* hb; float* ssp; PG8_LAS float* red;
    __device__ __forceinline__ void operator()(const f32x4 (&acc)[2][2][4][2], const Unit& u, int wr, int wc, int fr, int fq) const {
        const int row0 = u.pm * BM + wr * 64 + fr, col0 = u.pn * BM + wc * 32 + 4 * fq;
#pragma unroll
        for (int ai = 0; ai < 2; ++ai)
#pragma unroll
            for (int m = 0; m < 4; ++m) { const size_t off = (size_t)(row0 + ai * HALF + m * 16) * 1024 + col0; float ss = 0.f;
#pragma unroll
                for (int bj = 0; bj < 2; ++bj)
#pragma unroll
                    for (int n = 0; n < 2; ++n) { const u32x2 b = *(const u32x2*)(hb + off + bj * HALF + n * 16); const f32x4 a = acc[ai][bj][m][n];
                        u32x2 w; w.x = ::pk2(::bflo(b.x) + a[0], ::bfhi(b.x) + a[1]); w.y = ::pk2(::bflo(b.y) + a[2], ::bfhi(b.y) + a[3]); *(u32x2*)(hb + off + bj * HALF + n * 16) = w;
                        const float h0 = ::bflo(w.x), h1 = ::bfhi(w.x), h2 = ::bflo(w.y), h3 = ::bfhi(w.y); ss += (h0 * h0 + h1 * h1) + (h2 * h2 + h3 * h3); }
                ss = ::xsum16_32(ss); if (fq == 0) red[(ai * HALF + wr * 64 + m * 16 + fr) * 4 + wc] = ss; }
        asm volatile("s_waitcnt lgkmcnt(0)" ::: "memory"); __builtin_amdgcn_s_barrier(); asm volatile("" ::: "memory");
        const int t = (wr * 4 + wc) * 64 + fq * 16 + fr;
        if (t < 256) { const f32x4 s = *(const PG8_LAS f32x4*)(red + t * 4); ssp[(size_t)(u.pm * BM + t) * 4 + u.pn] = (s[0] + s[1]) + (s[2] + s[3]); }
    }
};
__device__ __forceinline__ void load_rs(const float* ssp, int pm, int wr, int fr, float (&rs)[2][4]) {
#pragma unroll
    for (int ai = 0; ai < 2; ++ai)
#pragma unroll
        for (int m = 0; m < 4; ++m) { const int row = pm * BM + ai * HALF + wr * 64 + m * 16 + fr;
            const f32x4 s4 = *(const f32x4*)(ssp + (size_t)row * 4); const float s = (s4[0] + s4[1]) + (s4[2] + s4[3]); rs[ai][m] = __builtin_amdgcn_rsqf(s * (1.f / 1024.f) + 1e-6f); }
}
__device__ __forceinline__ u32x4 pack8(const f32x4 a, const f32x4 b) { u32x4 w; w.x = ::pk2(a[0], a[1]); w.y = ::pk2(a[2], a[3]); w.z = ::pk2(b[0], b[1]); w.w = ::pk2(b[2], b[3]); return w; }
struct EpiSwiglu {
    static constexpr bool PERM = true, AFTER_DRAIN = false;
    bf16_t* O; const float* ssp;
    __device__ __forceinline__ void operator()(const f32x4 (&acc)[2][2][4][2], const Unit& u, int wr, int wc, int fr, int fq) const {
        float rs[2][4]; load_rs(ssp, u.pm, wr, fr, rs);
        const int row0 = u.pm * BM + wr * 64 + fr, col0 = u.pn * HALF + wc * 32 + 8 * fq;
#pragma unroll
        for (int ai = 0; ai < 2; ++ai)
#pragma unroll
            for (int m = 0; m < 4; ++m) { f32x4 v[2];
#pragma unroll
                for (int n = 0; n < 2; ++n) { const f32x4 g = acc[ai][0][m][n], up = acc[ai][1][m][n];
#pragma unroll
                    for (int j = 0; j < 4; ++j) v[n][j] = ::siluf_(g[j] * rs[ai][m]) * (up[j] * rs[ai][m]); }
                *(u32x4*)(O + (size_t)(row0 + ai * HALF + m * 16) * FF + col0) = pack8(v[0], v[1]); }
    }
};
template <int ACT> __device__ __forceinline__ void store_tile_bf16(const f32x4 (&acc)[2][2][4][2], const float (&rs)[2][4], bf16_t* dst, int ldc, int cbase, float scale, int pm, int wr, int wc, int fr, int fq) {
    const int row0 = pm * BM + wr * 64 + fr, col0 = cbase + wc * 32 + 8 * fq;
#pragma unroll
    for (int ai = 0; ai < 2; ++ai)
#pragma unroll
        for (int m = 0; m < 4; ++m)
#pragma unroll
            for (int bj = 0; bj < 2; ++bj) { f32x4 v[2];
#pragma unroll
                for (int n = 0; n < 2; ++n)
#pragma unroll
                    for (int j = 0; j < 4; ++j) { const float x = acc[ai][bj][m][n][j] * rs[ai][m]; v[n][j] = ACT == 1 ? ::gelu_tanh_(x) : ACT == 2 ? ::siluf_(x) : x * scale; }
                *(u32x4*)(dst + (size_t)(row0 + ai * HALF + m * 16) * ldc + col0 + bj * HALF) = pack8(v[0], v[1]); }
}
template <int ACT> __device__ __forceinline__ void store_tile_f32_narrow(const f32x4 (&acc)[2][2][4][2], const float (&rs)[2][4], float* dst, int ldc, int ncols, int pm, int wr, int wc, int fr, int fq) {
    const int row0 = pm * BM + wr * 64 + fr;
#pragma unroll
    for (int ai = 0; ai < 2; ++ai)
#pragma unroll
        for (int m = 0; m < 4; ++m)
#pragma unroll
            for (int n = 0; n < 2; ++n) { const int c = wc * 32 + 8 * fq + 4 * n;
                if (c < ncols) { f32x4 v = acc[ai][0][m][n] * rs[ai][m];
                    if (ACT == 3) { v[0] = ::sigmoidf_(v[0]); v[1] = ::sigmoidf_(v[1]); v[2] = ::sigmoidf_(v[2]); v[3] = ::sigmoidf_(v[3]); }
                    *(f32x4*)(dst + (size_t)(row0 + ai * HALF + m * 16) * ldc + c) = v; } }
}
struct EpiLruIn {
    static constexpr bool PERM = true, AFTER_DRAIN = false;
    bf16_t* G; bf16_t* X; const float* ssp;
    __device__ __forceinline__ void operator()(const f32x4 (&acc)[2][2][4][2], const Unit& u, int wr, int wc, int fr, int fq) const {
        float rs[2][4]; load_rs(ssp, u.pm, wr, fr, rs);
        if (u.pn < 5) store_tile_bf16<1>(acc, rs, G, RNN, u.pn * BM, 1.f, u.pm, wr, wc, fr, fq);
        else store_tile_bf16<0>(acc, rs, X, RNN, (u.pn - 5) * BM, 1.f, u.pm, wr, wc, fr, fq);
    }
};
struct EpiNsaIn {
    static constexpr bool PERM = true, AFTER_DRAIN = false;
    bf16_t* Q; bf16_t* KV; float* GT; const float* ssp;
    __device__ __forceinline__ void operator()(const f32x4 (&acc)[2][2][4][2], const Unit& u, int wr, int wc, int fr, int fq) const {
        float rs[2][4]; load_rs(ssp, u.pm, wr, fr, rs);
        if (u.pn < 4) store_tile_bf16<0>(acc, rs, Q, 1024, u.pn * BM, 0.125f, u.pm, wr, wc, fr, fq);
        else if (u.pn < 10) store_tile_bf16<0>(acc, rs, KV + (size_t)(u.pn - 4) * T_ * 256, 256, 0, 1.f, u.pm, wr, wc, fr, fq);
        else store_tile_f32_narrow<3>(acc, rs, GT, 48, 48, u.pm, wr, wc, fr, fq);
    }
};
struct EpiGlaIn {
    static constexpr bool PERM = true, AFTER_DRAIN = false;
    bf16_t* Q; bf16_t* K; bf16_t* V; bf16_t* R; float* GL; const float* ssp;
    __device__ __forceinline__ void operator()(const f32x4 (&acc)[2][2][4][2], const Unit& u, int wr, int wc, int fr, int fq) const {
        float rs[2][4]; load_rs(ssp, u.pm, wr, fr, rs);
        if (u.pn < 2) store_tile_bf16<0>(acc, rs, Q, 512, u.pn * BM, 0.08838834764831845f, u.pm, wr, wc, fr, fq);
        else if (u.pn < 4) store_tile_bf16<0>(acc, rs, K, 512, (u.pn - 2) * BM, 1.f, u.pm, wr, wc, fr, fq);
        else if (u.pn < 8) store_tile_bf16<0>(acc, rs, V, 1024, (u.pn - 4) * BM, 1.f, u.pm, wr, wc, fr, fq);
        else if (u.pn < 12) store_tile_bf16<2>(acc, rs, R, 1024, (u.pn - 8) * BM, 1.f, u.pm, wr, wc, fr, fq);
        else store_tile_f32_narrow<0>(acc, rs, GL, 16, 16, u.pm, wr, wc, fr, fq);
    }
};
template <class Epi, class Sched, bool ALIGN_EPI = false, bool SP2 = false>
__device__ __forceinline__ void gemm_phase(PG8_LAS unsigned char* lds, const Gemm g, const Sched& S, const Epi& E, const int tid) {
    const int wid = __builtin_amdgcn_readfirstlane(tid >> 6), lane = tid & 63, wr = wid >> 2, wc = wid & 3, fr = lane & 15, fq = lane >> 4;
    const int K = g.K, nt = K / BK;
    unsigned voffA[2], voffB[2];
#pragma unroll
    for (int i = 0; i < 2; ++i) { int R, C; stage_rc(tid * 16 + i * 8192, R, C); const int Rb = Epi::PERM ? ((R & ~31) + perm32(R & 31)) : R;
        voffA[i] = (unsigned)(R * K + C) * 2u; voffB[i] = (unsigned)(Rb * K + C) * 2u; }
    const size_t kstep = (size_t)(BK * 2);
    const size_t hstep = (size_t)HALF * K * 2;
    const size_t tstep = 2 * hstep;
    const unsigned ldsw = (unsigned)wid * 1024u;
    const int aoff = lds_byte(wr * 64 + fr, fq * 8), boff = lds_byte(wc * 32 + fr, fq * 8);
#define PG8_SA(b, h) (((b) * 2 + (h)) * HTB)
#define PG8_SB(b, h) ((4 + (b) * 2 + (h)) * HTB)
#define PG8_STAGE(bufoff, gbase, voff) do { _Pragma("unroll") for (int _i = 0; _i < 2; ++_i) \
        __builtin_amdgcn_global_load_lds((const unsigned*)((const char*)(gbase) + (voff)[_i]), (PG8_LAS unsigned*)(lds + (bufoff) + ldsw + _i * 8192), 16, 0, 0); } while (0)
#define PG8_LDA(dst, b, h) do { _Pragma("unroll") for (int m = 0; m < 4; ++m) _Pragma("unroll") for (int k = 0; k < 2; ++k) dst[m][k] = *(const PG8_LAS bf16x8*)(lds + PG8_SA(b, h) + aoff + m * 2048 + k * 1024); } while (0)
#define PG8_LDB(dst, b, h) do { _Pragma("unroll") for (int n = 0; n < 2; ++n) _Pragma("unroll") for (int k = 0; k < 2; ++k) dst[n][k] = *(const PG8_LAS bf16x8*)(lds + PG8_SB(b, h) + boff + n * 2048 + k * 1024); } while (0)
#define PG8_MMA(ai, bj, At, Bt) do { __builtin_amdgcn_s_setprio(1); _Pragma("unroll") for (int m = 0; m < 4; ++m) _Pragma("unroll") for (int n = 0; n < 2; ++n) _Pragma("unroll") for (int k = 0; k < 2; ++k) \
        acc[ai][bj][m][n] = __builtin_amdgcn_mfma_f32_16x16x32_bf16(Bt[n][k], At[m][k], acc[ai][bj][m][n], 0, 0, 0); __builtin_amdgcn_s_setprio(0); } while (0)
#define PG8_WAIT_V(n) asm volatile("s_waitcnt vmcnt(" #n ")" ::: "memory")
#define PG8_WAIT_L(n) asm volatile("s_waitcnt lgkmcnt(" #n ")" ::: "memory")
#define PG8_BAR __builtin_amdgcn_s_barrier()
#define PG8_SCHED __builtin_amdgcn_sched_barrier(0)
    Unit cur, nxt; int ui = 0;
    if (!S.next(0, cur)) return;
    f32x4 acc[2][2][4][2];
#pragma unroll
    for (int a = 0; a < 2; ++a)
#pragma unroll
        for (int b = 0; b < 2; ++b)
#pragma unroll
            for (int m = 0; m < 4; ++m)
#pragma unroll
                for (int n = 0; n < 2; ++n) acc[a][b][m][n] = (f32x4){0.f, 0.f, 0.f, 0.f};
    bf16x8 At[4][2], B0[2][2], B1[2][2];
    const char* cA = (const char*)g.A + (size_t)cur.pm * tstep; const char* cB = (const char*)g.Bt + (size_t)cur.pn * tstep;
    S.a_ready(cur);
    if constexpr (SP2) {
        PG8_STAGE(PG8_SB(0, 0), cB, voffB); PG8_STAGE(PG8_SB(0, 1), cB + hstep, voffB); PG8_STAGE(PG8_SA(0, 0), cA, voffA); PG8_STAGE(PG8_SA(0, 1), cA + hstep, voffA);
        if (wr == 1) PG8_BAR;
        PG8_WAIT_V(2); PG8_BAR;
        PG8_STAGE(PG8_SB(1, 0), cB + kstep, voffB); PG8_STAGE(PG8_SA(1, 0), cA + kstep, voffA); PG8_STAGE(PG8_SB(1, 1), cB + hstep + kstep, voffB);
        PG8_WAIT_V(6); PG8_BAR;
    } else {
        PG8_STAGE(PG8_SB(0, 0), cB, voffB); PG8_STAGE(PG8_SA(0, 0), cA, voffA); PG8_STAGE(PG8_SB(0, 1), cB + hstep, voffB); PG8_STAGE(PG8_SA(0, 1), cA + hstep, voffA);
        if (wr == 1) PG8_BAR;
        PG8_WAIT_V(4); PG8_BAR;
        PG8_STAGE(PG8_SB(1, 0), cB + kstep, voffB); PG8_STAGE(PG8_SA(1, 0), cA + kstep, voffA); PG8_STAGE(PG8_SB(1, 1), cB + hstep + kstep, voffB);
        PG8_WAIT_V(6); PG8_BAR;
    }
    for (;;) {
        const bool has_next = S.next(ui + 1, nxt);
        const char* nA = has_next ? (const char*)g.A + (size_t)nxt.pm * tstep : cA; const char* nB = has_next ? (const char*)g.Bt + (size_t)nxt.pn * tstep : cB;
        for (int t = 0; t < nt; t += 2) {
            const bool last = (t == nt - 2);
            const char* a1 = cA + (size_t)(t + 1) * kstep;
            const char* a2 = last ? nA : cA + (size_t)(t + 2) * kstep; const char* b2 = last ? nB : cB + (size_t)(t + 2) * kstep;
            const char* a3 = a2 + kstep; const char* b3 = b2 + kstep;
            if (last && has_next) S.a_ready(nxt);
            if constexpr (SP2) {
            PG8_LDB(B0, 0, 0); PG8_LDB(B1, 0, 1); PG8_SCHED; PG8_LDA(At, 0, 0); PG8_STAGE(PG8_SA(1, 1), a1 + hstep, voffA);
            PG8_WAIT_V(8); PG8_WAIT_L(0); PG8_BAR; PG8_MMA(0, 0, At, B0); PG8_MMA(0, 1, At, B1); PG8_BAR; PG8_SCHED;
            PG8_LDA(At, 0, 1); PG8_STAGE(PG8_SB(0, 0), b2, voffB); PG8_STAGE(PG8_SB(0, 1), b2 + hstep, voffB); PG8_STAGE(PG8_SA(0, 0), a2, voffA);
            PG8_WAIT_V(8); PG8_WAIT_L(0); PG8_BAR; PG8_MMA(1, 0, At, B0); PG8_MMA(1, 1, At, B1); PG8_BAR; PG8_SCHED;
            PG8_LDB(B0, 1, 0); PG8_LDB(B1, 1, 1); PG8_SCHED; PG8_LDA(At, 1, 0); PG8_STAGE(PG8_SA(0, 1), a2 + hstep, voffA);
            PG8_WAIT_V(8); PG8_WAIT_L(0); PG8_BAR; PG8_MMA(0, 0, At, B0); PG8_MMA(0, 1, At, B1); PG8_BAR; PG8_SCHED;
            PG8_LDA(At, 1, 1); PG8_STAGE(PG8_SB(1, 0), b3, voffB); PG8_STAGE(PG8_SB(1, 1), b3 + hstep, voffB); PG8_STAGE(PG8_SA(1, 0), a3, voffA);
            PG8_WAIT_V(8); PG8_WAIT_L(0); PG8_BAR; PG8_MMA(1, 0, At, B0); PG8_MMA(1, 1, At, B1); PG8_BAR; PG8_SCHED;
            } else {
            PG8_LDB(B0, 0, 0); PG8_SCHED; PG8_LDA(At, 0, 0); PG8_STAGE(PG8_SA(1, 1), a1 + hstep, voffA);
            PG8_WAIT_L(8); PG8_BAR; PG8_WAIT_L(0); PG8_MMA(0, 0, At, B0); PG8_BAR; PG8_SCHED;
            PG8_LDB(B1, 0, 1); PG8_STAGE(PG8_SB(0, 0), b2, voffB);
            PG8_BAR; PG8_WAIT_L(0); PG8_MMA(0, 1, At, B1); PG8_BAR;
            PG8_LDA(At, 0, 1); PG8_STAGE(PG8_SA(0, 0), a2, voffA);
            PG8_BAR; PG8_WAIT_L(0); PG8_MMA(1, 0, At, B0); PG8_BAR; PG8_SCHED;
            PG8_STAGE(PG8_SB(0, 1), b2 + hstep, voffB);
            PG8_WAIT_V(6); PG8_BAR; PG8_MMA(1, 1, At, B1); PG8_BAR;
            PG8_LDB(B0, 1, 0); PG8_SCHED; PG8_LDA(At, 1, 0); PG8_STAGE(PG8_SA(0, 1), a2 + hstep, voffA);
            PG8_WAIT_L(8); PG8_BAR; PG8_WAIT_L(0); PG8_MMA(0, 0, At, B0); PG8_BAR; PG8_SCHED;
            PG8_LDB(B1, 1, 1); PG8_STAGE(PG8_SB(1, 0), b3, voffB);
            PG8_BAR; PG8_WAIT_L(0); PG8_MMA(0, 1, At, B1); PG8_BAR;
            PG8_LDA(At, 1, 1); PG8_STAGE(PG8_SA(1, 0), a3, voffA);
            PG8_BAR; PG8_WAIT_L(0); PG8_MMA(1, 0, At, B0); PG8_BAR; PG8_SCHED;
            PG8_STAGE(PG8_SB(1, 1), b3 + hstep, voffB);
            PG8_WAIT_V(6); PG8_BAR; PG8_MMA(1, 1, At, B1); PG8_BAR;
            }
        }
        if constexpr (ALIGN_EPI) { if (wr == 0) PG8_BAR; }
        if constexpr (!Epi::AFTER_DRAIN) { E(acc, cur, wr, wc, fr, fq); S.done(cur); }
        if (!has_next) break;
#pragma unroll
        for (int a = 0; a < 2; ++a)
#pragma unroll
            for (int b = 0; b < 2; ++b)
#pragma unroll
                for (int m = 0; m < 4; ++m)
#pragma unroll
                    for (int n = 0; n < 2; ++n) acc[a][b][m][n] = (f32x4){0.f, 0.f, 0.f, 0.f};
        cur = nxt; cA = nA; cB = nB; ++ui;
        if constexpr (ALIGN_EPI) { if (wr == 1) PG8_BAR; }
    }
    PG8_WAIT_V(0);
    if constexpr (!ALIGN_EPI) { if (wr == 0) PG8_BAR; }
    PG8_BAR;
    if constexpr (Epi::AFTER_DRAIN) { E.fused(acc, cur, wr, wc, fr, fq, lds, wid, lane); S.done(cur); }
#undef PG8_SA
#undef PG8_SB
#undef PG8_STAGE
#undef PG8_LDA
#undef PG8_LDB
#undef PG8_MMA
#undef PG8_WAIT_V
#undef PG8_WAIT_L
#undef PG8_BAR
#undef PG8_SCHED
}
}
__device__ __forceinline__ void transpose_item(const float* __restrict__ W, const float* __restrict__ gk, int ldw, int N, int k0, int n0, bf16_t* WT, int ldt, int dst_row0, LAS float* scr, int lane) {
    const int nn = n0 + (lane & 31); const bool ok = nn < N;
    float wv[32];
#pragma unroll
    for (int i = 0; i < 32; ++i) { const int kk = 2 * i + (lane >> 5); wv[i] = ok ? W[(size_t)(k0 + kk) * ldw + nn] : 0.f; }
#pragma unroll
    for (int i = 0; i < 32; ++i) { const int kk = 2 * i + (lane >> 5); scr[kk * 33 + (lane & 31)] = gk ? wv[i] * gk[k0 + kk] : wv[i]; }
    asm volatile("s_waitcnt lgkmcnt(0)" ::: "memory");
    const int c = lane & 7;
#pragma unroll
    for (int j = 0; j < 4; ++j) { const int n = (lane >> 3) + 8 * j; const LAS float* s = scr + (8 * c) * 33 + n;
        u32x4 o; o.x = pk2(s[0 * 33], s[1 * 33]); o.y = pk2(s[2 * 33], s[3 * 33]); o.z = pk2(s[4 * 33], s[5 * 33]); o.w = pk2(s[6 * 33], s[7 * 33]);
        *(u32x4*)(WT + (size_t)(dst_row0 + n) * ldt + k0 + 8 * c) = o; }
    asm volatile("s_waitcnt lgkmcnt(0)" ::: "memory");
}
__device__ __forceinline__ void transpose_job(const float* W, const float* gk, int K, int N, bf16_t* WT, int ldt, int mode, int& rot, int gw, int NGW, LAS float* scr, int lane) {
    const int nnb = (N + 31) >> 5, nit = (K >> 6) * nnb;
    int start = gw - rot; if (start < 0) start += NGW;
    for (int it = start; it < nit; it += NGW) {
        const int kb = it / nnb, nb = it - kb * nnb, n0 = nb << 5;
        const int dr = mode == 0 ? n0 : ((n0 >> 7) * 256 + (n0 & 127) + (mode == 2 ? 128 : 0));
        transpose_item(W, gk, N, N, kb << 6, n0, WT, ldt, dr, scr, lane);
    }
    rot = (rot + nit) % NGW;
}
__device__ __forceinline__ void init_stream_bf16(const float* src, bf16_t* dst, float* ssp, int gw, int NGW, int lane) {
    for (int m = gw; m < T_; m += NGW) {
        const f32x4* xr = (const f32x4*)(src + (size_t)m * D_) + lane;
        u32x2 o[4]; float s = 0.f;
#pragma unroll
        for (int j = 0; j < 4; ++j) { const f32x4 v = xr[64 * j]; o[j].x = pk2(v.x, v.y); o[j].y = pk2(v.z, v.w);
            const float a = bflo(o[j].x), b = bfhi(o[j].x), c = bflo(o[j].y), d = bfhi(o[j].y); s += (a * a + b * b) + (c * c + d * d); }
        const float st = wave_sum(s); if (lane < 4) ssp[(size_t)m * 4 + lane] = lane == 0 ? st : 0.f;
        u32x2* o8 = (u32x2*)(dst + (size_t)m * D_) + lane;
#pragma unroll
        for (int j = 0; j < 4; ++j) o8[64 * j] = o[j];
    }
}
__device__ __forceinline__ void final_norm_rows(const bf16_t* hb, const float* __restrict__ g, float* out, int gw, int NGW, int lane) {
    f32x4 gv[4];
#pragma unroll
    for (int j = 0; j < 4; ++j) gv[j] = *(const f32x4*)(g + 4 * lane + 256 * j);
    for (int m = gw; m < T_; m += NGW) {
        const u32x2* hr = (const u32x2*)(hb + (size_t)m * D_) + lane;
        f32x4 v[4]; float s = 0.f;
#pragma unroll
        for (int j = 0; j < 4; ++j) { const u32x2 w = hr[64 * j]; v[j] = (f32x4){bflo(w.x), bfhi(w.x), bflo(w.y), bfhi(w.y)}; s += (v[j].x * v[j].x + v[j].y * v[j].y) + (v[j].z * v[j].z + v[j].w * v[j].w); }
        const float rs = 1.0f / sqrtf(wave_sum(s) * (1.f / D_) + EPS);
        f32x4* xr = (f32x4*)(out + (size_t)m * D_) + lane;
#pragma unroll
        for (int j = 0; j < 4; ++j) xr[64 * j] = v[j] * rs * gv[j];
    }
}
__device__ __forceinline__ f32x4 mfma16(bf16x8 a, bf16x8 b, f32x4 c) { return __builtin_amdgcn_mfma_f32_16x16x32_bf16(a, b, c, 0, 0, 0); }
__device__ __forceinline__ void unpack8(const u32x4 w, float (&f)[8]) { f[0] = bflo(w.x); f[1] = bfhi(w.x); f[2] = bflo(w.y); f[3] = bfhi(w.y); f[4] = bflo(w.z); f[5] = bfhi(w.z); f[6] = bflo(w.w); f[7] = bfhi(w.w); }
__device__ __forceinline__ u32x4 pack8f(const float (&f)[8]) { u32x4 w; w.x = pk2(f[0], f[1]); w.y = pk2(f[2], f[3]); w.z = pk2(f[4], f[5]); w.w = pk2(f[6], f[7]); return w; }

__device__ __forceinline__ float neg_expm1(float x) {
    const float p = 1.f + x * (0.5f + x * (0.16666667f + x * (0.041666668f + x * (0.0083333338f + x * 0.0013888889f))));
    const float big = 1.f - fast_exp2(x * LOG2E);
    return x > -0.3f ? -x * p : big;
}
__device__ __forceinline__ void lru_gates_phase(LAS unsigned char* lds, const bf16_t* X, const float* __restrict__ conv_w, const float* __restrict__ conv_b,
        const bf16_t* WAT, const bf16_t* WXT, const float* __restrict__ b_a, const float* __restrict__ b_x, const float* __restrict__ lam,
        bf16_t* HL, bf16_t* AC, float* AGGA, float* AGGH, const int tid, const int bid, const int G) {
    const int lane = tid & 63, wid = __builtin_amdgcn_readfirstlane(tid >> 6), fr = lane & 15, fq = lane >> 4;
    constexpr int SA = 0, SBA = 34816, SBX = 69632, SAF = 0, SUF = 67584, SAGG = 135168, LDA_ = 272, LDF = 528;
    for (int u = bid; u < 1280; u += G) {
        const int tt = u / 10, hd = u - tt * 10, m0 = tt * 128, cbase = hd * 128;
        { const int c8 = tid & 15, r = tid >> 4, ch = cbase + 8 * c8;
          float cw[4][8], cb[8];
#pragma unroll
          for (int k = 0; k < 4; ++k) { const f32x4 w0 = *(const f32x4*)(conv_w + k * RNN + ch), w1 = *(const f32x4*)(conv_w + k * RNN + ch + 4);
              cw[k][0] = w0[0]; cw[k][1] = w0[1]; cw[k][2] = w0[2]; cw[k][3] = w0[3]; cw[k][4] = w1[0]; cw[k][5] = w1[1]; cw[k][6] = w1[2]; cw[k][7] = w1[3]; }
          { const f32x4 w0 = *(const f32x4*)(conv_b + ch), w1 = *(const f32x4*)(conv_b + ch + 4); cb[0] = w0[0]; cb[1] = w0[1]; cb[2] = w0[2]; cb[3] = w0[3]; cb[4] = w1[0]; cb[5] = w1[1]; cb[6] = w1[2]; cb[7] = w1[3]; }
#pragma unroll
          for (int g = 0; g < 4; ++g) { const int row = r + 32 * g, m = m0 + row, ts = m & (SEQ - 1);
              float acc[8];
#pragma unroll
              for (int e = 0; e < 8; ++e) acc[e] = cb[e];
#pragma unroll
              for (int k = 0; k < 4; ++k) { const bool okk = ts - 3 + k >= 0;
                  const u32x4 xv = *(const u32x4*)(X + (size_t)(okk ? m - 3 + k : m) * RNN + ch); float xf[8]; unpack8(xv, xf); const float zk = okk ? 1.f : 0.f;
#pragma unroll
                  for (int e = 0; e < 8; ++e) acc[e] += cw[k][e] * (xf[e] * zk); }
              *(LAS u32x4*)(lds + SA + row * LDA_ + c8 * 16) = pack8f(acc); } }
#pragma unroll
        for (int i = 0; i < 8; ++i) { const int q = tid + 512 * i, mat = q >> 11, j = (q >> 4) & 127, c = q & 15;
            const u32x4 v = *(const u32x4*)((mat ? WXT : WAT) + hd * 16384 + j * 128 + c * 8);
            *(LAS u32x4*)(lds + (mat ? SBX : SBA) + j * LDA_ + c * 16) = v; }
        __syncthreads();
        const int rg = wid >> 1, chh = wid & 1;
        f32x4 acca[2][4], accx[2][4];
#pragma unroll
        for (int mt = 0; mt < 2; ++mt)
#pragma unroll
            for (int nt = 0; nt < 4; ++nt) { acca[mt][nt] = (f32x4){0.f, 0.f, 0.f, 0.f}; accx[mt][nt] = (f32x4){0.f, 0.f, 0.f, 0.f}; }
#pragma unroll
        for (int s = 0; s < 4; ++s) { bf16x8 af[2];
#pragma unroll
            for (int mt = 0; mt < 2; ++mt) af[mt] = *(const LAS bf16x8*)(lds + SA + (32 * rg + 16 * mt + fr) * LDA_ + (32 * s + 8 * fq) * 2);
#pragma unroll
            for (int nt = 0; nt < 4; ++nt) { const bf16x8 ba = *(const LAS bf16x8*)(lds + SBA + (64 * chh + 16 * nt + fr) * LDA_ + (32 * s + 8 * fq) * 2);
                const bf16x8 bx = *(const LAS bf16x8*)(lds + SBX + (64 * chh + 16 * nt + fr) * LDA_ + (32 * s + 8 * fq) * 2);
#pragma unroll
                for (int mt = 0; mt < 2; ++mt) { acca[mt][nt] = mfma16(ba, af[mt], acca[mt][nt]); accx[mt][nt] = mfma16(bx, af[mt], accx[mt][nt]); } } }
        u32x2 xcv[2][4];
#pragma unroll
        for (int mt = 0; mt < 2; ++mt)
#pragma unroll
            for (int nt = 0; nt < 4; ++nt) xcv[mt][nt] = *(const LAS u32x2*)(lds + SA + (32 * rg + 16 * mt + fr) * LDA_ + (64 * chh + 16 * nt + 4 * fq) * 2);
        __syncthreads();
#pragma unroll
        for (int nt = 0; nt < 4; ++nt) { const int cc = cbase + 64 * chh + 16 * nt + 4 * fq;
            const f32x4 ba4 = *(const f32x4*)(b_a + cc), bx4 = *(const f32x4*)(b_x + cc), lm4 = *(const f32x4*)(lam + cc);
            f32x4 nl8;
#pragma unroll
            for (int j = 0; j < 4; ++j) nl8[j] = -8.f * 0.6931471805599453f * __builtin_amdgcn_logf(1.f + fast_exp2(-lm4[j] * LOG2E));
#pragma unroll
            for (int mt = 0; mt < 2; ++mt) { const float xc4[4] = {bflo(xcv[mt][nt].x), bfhi(xcv[mt][nt].x), bflo(xcv[mt][nt].y), bfhi(xcv[mt][nt].y)};
                f32x4 a4, u4;
#pragma unroll
                for (int j = 0; j < 4; ++j) { const float r = sigmoidf_(acca[mt][nt][j] + ba4[j]), ig = sigmoidf_(accx[mt][nt][j] + bx4[j]);
                    const float la = nl8[j] * r; a4[j] = fast_exp2(la * LOG2E); u4[j] = __builtin_amdgcn_sqrtf(neg_expm1(2.f * la)) * ig * xc4[j]; }
                const int off = (32 * rg + 16 * mt + fr) * LDF + (64 * chh + 16 * nt + 4 * fq) * 4;
                *(LAS f32x4*)(lds + SAF + off) = a4; *(LAS f32x4*)(lds + SUF + off) = u4; } }
        __syncthreads();
        { const int ch = tid & 127, seg = tid >> 7;
          LAS float* pa = (LAS float*)(lds + SAF) + ch; LAS float* pu = (LAS float*)(lds + SUF) + ch; LAS float* ag = (LAS float*)(lds + SAGG);
          float A = 1.f, H = 0.f;
#pragma unroll 8
          for (int t = seg * 32; t < seg * 32 + 32; ++t) { const float a = pa[t * (LDF / 4)], uu = pu[t * (LDF / 4)]; H = a * H + uu; A *= a; }
          ag[seg * 128 + ch] = A; ag[512 + seg * 128 + ch] = H;
          __syncthreads();
          float cA = 1.f, cH = 0.f;
          for (int s = 0; s < seg; ++s) { const float As = ag[s * 128 + ch], Hs = ag[512 + s * 128 + ch]; cH = As * cH + Hs; cA *= As; }
#pragma unroll 8
          for (int t = seg * 32; t < seg * 32 + 32; ++t) { const float a = pa[t * (LDF / 4)], uu = pu[t * (LDF / 4)]; cH = a * cH + uu; cA *= a; pa[t * (LDF / 4)] = cA; pu[t * (LDF / 4)] = cH; }
          if (seg == 3) { AGGA[(size_t)tt * RNN + cbase + ch] = cA; AGGH[(size_t)tt * RNN + cbase + ch] = cH; } }
        __syncthreads();
#pragma unroll
        for (int i = 0; i < 4; ++i) { const int q = tid + 512 * i, row = q >> 4, c8 = q & 15;
            const f32x4 a0 = *(const LAS f32x4*)(lds + SAF + row * LDF + c8 * 32), a1 = *(const LAS f32x4*)(lds + SAF + row * LDF + c8 * 32 + 16);
            const f32x4 h0 = *(const LAS f32x4*)(lds + SUF + row * LDF + c8 * 32), h1 = *(const LAS f32x4*)(lds + SUF + row * LDF + c8 * 32 + 16);
            u32x4 wa, wh; wa.x = pk2(a0[0], a0[1]); wa.y = pk2(a0[2], a0[3]); wa.z = pk2(a1[0], a1[1]); wa.w = pk2(a1[2], a1[3]);
            wh.x = pk2(h0[0], h0[1]); wh.y = pk2(h0[2], h0[3]); wh.z = pk2(h1[0], h1[1]); wh.w = pk2(h1[2], h1[3]);
            const size_t go = (size_t)(m0 + row) * RNN + cbase + 8 * c8;
            *(u32x4*)(AC + go) = wa; *(u32x4*)(HL + go) = wh; }
        __syncthreads();
    }
}
__device__ __forceinline__ void lru_apply_phase(bf16_t* GB, const bf16_t* HL, const bf16_t* AC, const float* AGGA, const float* AGGH, const int tid, const int bid, const int G) {
    const int c8 = tid & 31, r = tid >> 5;
    for (int u = bid; u < 640; u += G) {
        const int tt = u / 5, cb = u - tt * 5, m0 = tt * 128, ch = cb * 256 + 8 * c8;
        float carry[8];
#pragma unroll
        for (int e = 0; e < 8; ++e) carry[e] = 0.f;
        { const int p0 = tt & ~63; int p = p0;
          for (; p + 8 <= tt; p += 8) { f32x4 a0[8], a1[8], h0[8], h1[8];
#pragma unroll
              for (int q = 0; q < 8; ++q) { const size_t o = (size_t)(p + q) * RNN + ch; a0[q] = *(const f32x4*)(AGGA + o); a1[q] = *(const f32x4*)(AGGA + o + 4); h0[q] = *(const f32x4*)(AGGH + o); h1[q] = *(const f32x4*)(AGGH + o + 4); }
#pragma unroll
              for (int q = 0; q < 8; ++q)
#pragma unroll
                  for (int e = 0; e < 4; ++e) { carry[e] = carry[e] * a0[q][e] + h0[q][e]; carry[4 + e] = carry[4 + e] * a1[q][e] + h1[q][e]; } }
          for (; p < tt; ++p) { const size_t o = (size_t)p * RNN + ch; const f32x4 a0 = *(const f32x4*)(AGGA + o), a1 = *(const f32x4*)(AGGA + o + 4), h0 = *(const f32x4*)(AGGH + o), h1 = *(const f32x4*)(AGGH + o + 4);
#pragma unroll
              for (int e = 0; e < 4; ++e) { carry[e] = carry[e] * a0[e] + h0[e]; carry[4 + e] = carry[4 + e] * a1[e] + h1[e]; } } }
#pragma unroll
        for (int i = 0; i < 8; ++i) { const size_t go = (size_t)(m0 + r + 16 * i) * RNN + ch;
            float g[8], hl[8], ac[8], y[8]; unpack8(*(const u32x4*)(GB + go), g); unpack8(*(const u32x4*)(HL + go), hl); unpack8(*(const u32x4*)(AC + go), ac);
#pragma unroll
            for (int e = 0; e < 8; ++e) y[e] = g[e] * (hl[e] + ac[e] * carry[e]);
            *(u32x4*)(GB + go) = pack8f(y); }
    }
}
__device__ __forceinline__ s16x4 tr_read(const LAS unsigned char* p) { typedef short v4i16_t __attribute__((ext_vector_type(4))); return __builtin_bit_cast(s16x4, __builtin_amdgcn_ds_read_tr16_b64_v4i16((LAS v4i16_t*)p)); }
__device__ __forceinline__ bf16x8 cat44(s16x4 lo, s16x4 hi) { return (bf16x8){lo[0], lo[1], lo[2], lo[3], hi[0], hi[1], hi[2], hi[3]}; }
__device__ __forceinline__ void gla_cum(LAS unsigned char* lds, const float* GL, const float* __restrict__ w_g2, const float* __restrict__ b_g2, int m0, int h, const int tid, const int bid, const int G) {

    LAS float* sGL = (LAS float*)lds; LAS float* sSeg = (LAS float*)(lds + 4096); LAS float* sB = (LAS float*)(lds + 8192);
    if (tid < 256) *(LAS f32x4*)(sGL + tid * 4) = *(const f32x4*)(GL + (size_t)m0 * 16 + tid * 4);
    const int d = tid & 127, tq = tid >> 7, dch = h * 128 + d;
    float w[16];
#pragma unroll
    for (int r = 0; r < 16; ++r) w[r] = w_g2[r * 512 + dch];
    const float bb = b_g2[dch];
    __syncthreads();
    float run = 0.f;
#pragma unroll 4
    for (int i = 0; i < 16; ++i) { const int t = tq * 16 + i; float z = bb;
#pragma unroll
        for (int r4 = 0; r4 < 4; ++r4) { const f32x4 gv = *(const LAS f32x4*)(sGL + t * 16 + r4 * 4); z += gv[0] * w[r4 * 4] + gv[1] * w[r4 * 4 + 1] + gv[2] * w[r4 * 4 + 2] + gv[3] * w[r4 * 4 + 3]; }
        const float la = -(__builtin_amdgcn_logf(1.f + fast_exp2(-fabsf(z) * LOG2E)) * 0.6931471805599453f + fmaxf(-z, 0.f)) * 0.0625f;
        run += la; sB[t * 128 + d] = run; }
    sSeg[tq * 128 + d] = run;
    __syncthreads();
    float pre = 0.f;
    for (int s = 0; s < tq; ++s) pre += sSeg[s * 128 + d];
#pragma unroll 4
    for (int i = 0; i < 16; ++i) sB[(tq * 16 + i) * 128 + d] += pre;
    __syncthreads();
}
__device__ __forceinline__ void gla_kv_phase(LAS unsigned char* lds, const bf16_t* Kg, const bf16_t* Vg, const float* GL, const float* w_g2, const float* b_g2, bf16_t* KVT, float* DEC, const int tid, const int bid, const int G) {
    const int lane = tid & 63, wid = __builtin_amdgcn_readfirstlane(tid >> 6), fr = lane & 15, fq = lane >> 4, q4 = (lane & 15) >> 2, p4 = lane & 3;
    constexpr int SB_ = 8192, SK = 40960, SV = 58368, LDK = 272, LDV = 528;
    const LAS float* sB = (const LAS float*)(lds + SB_);
    for (int u = bid; u < 1024; u += G) {
        const int b = u >> 9, n = (u >> 2) & 127, h = u & 3, m0 = b * SEQ + 64 * n, bh = b * 4 + h;
        gla_cum(lds, GL, w_g2, b_g2, m0, h, tid, bid, G);
#pragma unroll
        for (int i = 0; i < 2; ++i) { const int q = tid + 512 * i, t = q >> 4, c = q & 15; float kf[8]; unpack8(*(const u32x4*)(Kg + (size_t)(m0 + t) * 512 + h * 128 + 8 * c), kf);
#pragma unroll
            for (int e = 0; e < 8; ++e) kf[e] *= fast_exp2((sB[63 * 128 + 8 * c + e] - sB[t * 128 + 8 * c + e]) * LOG2E);
            *(LAS u32x4*)(lds + SK + t * LDK + c * 16) = pack8f(kf); }
        if (tid < 128) DEC[((size_t)bh * 128 + n) * 128 + tid] = fast_exp2(sB[63 * 128 + tid] * LOG2E);
#pragma unroll
        for (int i = 0; i < 4; ++i) { const int q = tid + 512 * i, t = q >> 5, c = q & 31; *(LAS u32x4*)(lds + SV + t * LDV + c * 16) = *(const u32x4*)(Vg + (size_t)(m0 + t) * 1024 + h * 256 + 8 * c); }
        __syncthreads();
        f32x4 acc[8][2];
#pragma unroll
        for (int mt = 0; mt < 8; ++mt) { acc[mt][0] = (f32x4){0.f, 0.f, 0.f, 0.f}; acc[mt][1] = (f32x4){0.f, 0.f, 0.f, 0.f}; }
#pragma unroll
        for (int s = 0; s < 2; ++s) { bf16x8 bv[2];
#pragma unroll
            for (int nl = 0; nl < 2; ++nl) { const LAS unsigned char* pv = lds + SV + (32 * s + 8 * fq + q4) * LDV + (32 * wid + 16 * nl + 4 * p4) * 2; bv[nl] = cat44(tr_read(pv), tr_read(pv + 4 * LDV)); }
#pragma unroll
            for (int mt = 0; mt < 8; ++mt) { const LAS unsigned char* pk = lds + SK + (32 * s + 8 * fq + q4) * LDK + (16 * mt + 4 * p4) * 2; const bf16x8 ak = cat44(tr_read(pk), tr_read(pk + 4 * LDK));
                acc[mt][0] = mfma16(ak, bv[0], acc[mt][0]); acc[mt][1] = mfma16(ak, bv[1], acc[mt][1]); } }
        bf16_t* dst = KVT + ((size_t)bh * 128 + n) * 32768;
#pragma unroll
        for (int mt = 0; mt < 8; ++mt)
#pragma unroll
            for (int nl = 0; nl < 2; ++nl) { u32x2 w; w.x = pk2(acc[mt][nl][0], acc[mt][nl][1]); w.y = pk2(acc[mt][nl][2], acc[mt][nl][3]);
                *(u32x2*)(dst + (32 * wid + 16 * nl + fr) * 128 + 16 * mt + 4 * fq) = w; }
        __syncthreads();
    }
}
__device__ __forceinline__ void gla_scan_phase(bf16_t* KVT, const float* DEC, const int tid, const int bid, const int G) {
    const int nthr = G * 512;
    for (int e2 = bid * 512 + tid; e2 < 8 * 16384; e2 += nthr) {
        const int bh = e2 >> 14, e = (e2 & 16383) * 2, dk = e & 127;
        unsigned* p = (unsigned*)(KVT + (size_t)bh * 128 * 32768 + e); const float* dp = DEC + (size_t)bh * 128 * 128 + dk;
        float s0 = 0.f, s1 = 0.f;
        for (int n0 = 0; n0 < 128; n0 += 8) { unsigned w[8]; f32x2 d2[8];
#pragma unroll
            for (int i = 0; i < 8; ++i) { w[i] = p[(size_t)(n0 + i) * 16384]; d2[i] = *(const f32x2*)(dp + (n0 + i) * 128); }
#pragma unroll
            for (int i = 0; i < 8; ++i) { p[(size_t)(n0 + i) * 16384] = pk2(s0, s1); s0 = s0 * d2[i].x + bflo(w[i]); s1 = s1 * d2[i].y + bfhi(w[i]); } }
    }
}
__device__ __forceinline__ void gla_out_phase(LAS unsigned char* lds, const bf16_t* Qg, const bf16_t* Kg, const bf16_t* Vg, const bf16_t* Rg, const float* GL, const float* w_g2, const float* b_g2,
        const float* __restrict__ norm_g, const bf16_t* KVT, bf16_t* Y, const int tid, const int bid, const int G) {
    const int lane = tid & 63, wid = __builtin_amdgcn_readfirstlane(tid >> 6), fr = lane & 15, fq = lane >> 4, q4 = (lane & 15) >> 2, p4 = lane & 3;
    constexpr int SB_ = 8192, SQ = 40960, SKI = 58368, SV = 75776, SATT = 109568, SSS = 118784, LDQ = 272, LDV = 528, LDAT = 144;
    const LAS float* sB = (const LAS float*)(lds + SB_);
    for (int u = bid; u < 1024; u += G) {
        const int b = u >> 9, n = (u >> 2) & 127, h = u & 3, m0 = b * SEQ + 64 * n, bh = b * 4 + h;
        bf16x8 bsall[4][2];
        { const bf16_t* Sp = KVT + ((size_t)bh * 128 + n) * 32768;
#pragma unroll
          for (int s = 0; s < 4; ++s)
#pragma unroll
              for (int nl = 0; nl < 2; ++nl) bsall[s][nl] = *(const bf16x8*)(Sp + (32 * wid + 16 * nl + fr) * 128 + 32 * s + 8 * fq); }
        gla_cum(lds, GL, w_g2, b_g2, m0, h, tid, bid, G);
#pragma unroll
        for (int i = 0; i < 2; ++i) { const int q = tid + 512 * i, t = q >> 4, c = q & 15; float qf[8], kf[8];
            unpack8(*(const u32x4*)(Qg + (size_t)(m0 + t) * 512 + h * 128 + 8 * c), qf); unpack8(*(const u32x4*)(Kg + (size_t)(m0 + t) * 512 + h * 128 + 8 * c), kf);
#pragma unroll
            for (int e = 0; e < 8; ++e) { const float bb = sB[t * 128 + 8 * c + e] * LOG2E; qf[e] *= fast_exp2(bb); kf[e] *= fast_exp2(-bb); }
            *(LAS u32x4*)(lds + SQ + t * LDQ + c * 16) = pack8f(qf); *(LAS u32x4*)(lds + SKI + t * LDQ + c * 16) = pack8f(kf); }
#pragma unroll
        for (int i = 0; i < 4; ++i) { const int q = tid + 512 * i, t = q >> 5, c = q & 31; *(LAS u32x4*)(lds + SV + t * LDV + c * 16) = *(const u32x4*)(Vg + (size_t)(m0 + t) * 1024 + h * 256 + 8 * c); }
        __syncthreads();
        { const int mt = wid >> 1; f32x4 at[2] = {(f32x4){0.f, 0.f, 0.f, 0.f}, (f32x4){0.f, 0.f, 0.f, 0.f}};
#pragma unroll
          for (int s = 0; s < 4; ++s) { const bf16x8 a = *(const LAS bf16x8*)(lds + SQ + (16 * mt + fr) * LDQ + (32 * s + 8 * fq) * 2);
#pragma unroll
              for (int nl = 0; nl < 2; ++nl) { const int nt = 2 * (wid & 1) + nl; const bf16x8 bk = *(const LAS bf16x8*)(lds + SKI + (16 * nt + fr) * LDQ + (32 * s + 8 * fq) * 2); at[nl] = mfma16(bk, a, at[nl]); } }
#pragma unroll
          for (int nl = 0; nl < 2; ++nl) { const int nt = 2 * (wid & 1) + nl, c = 16 * mt + fr, j0 = 16 * nt + 4 * fq; float v[4];
#pragma unroll
              for (int j = 0; j < 4; ++j) v[j] = (j0 + j <= c) ? at[nl][j] : 0.f;
              u32x2 w; w.x = pk2(v[0], v[1]); w.y = pk2(v[2], v[3]); *(LAS u32x2*)(lds + SATT + c * LDAT + j0 * 2) = w; } }
        __syncthreads();
        f32x4 o[4][2];
#pragma unroll
        for (int mt = 0; mt < 4; ++mt) { o[mt][0] = (f32x4){0.f, 0.f, 0.f, 0.f}; o[mt][1] = (f32x4){0.f, 0.f, 0.f, 0.f}; }
#pragma unroll
        for (int s = 0; s < 2; ++s) { bf16x8 bv[2];
#pragma unroll
            for (int nl = 0; nl < 2; ++nl) { const LAS unsigned char* pv = lds + SV + (32 * s + 8 * fq + q4) * LDV + (32 * wid + 16 * nl + 4 * p4) * 2; bv[nl] = cat44(tr_read(pv), tr_read(pv + 4 * LDV)); }
#pragma unroll
            for (int mt = 0; mt < 4; ++mt) { const bf16x8 a = *(const LAS bf16x8*)(lds + SATT + (16 * mt + fr) * LDAT + (32 * s + 8 * fq) * 2);
                o[mt][0] = mfma16(bv[0], a, o[mt][0]); o[mt][1] = mfma16(bv[1], a, o[mt][1]); } }
#pragma unroll
        for (int s = 0; s < 4; ++s) {
#pragma unroll
            for (int mt = 0; mt < 4; ++mt) { const bf16x8 a = *(const LAS bf16x8*)(lds + SQ + (16 * mt + fr) * LDQ + (32 * s + 8 * fq) * 2);
                o[mt][0] = mfma16(bsall[s][0], a, o[mt][0]); o[mt][1] = mfma16(bsall[s][1], a, o[mt][1]); } }
        LAS float* sSS = (LAS float*)(lds + SSS);
#pragma unroll
        for (int mt = 0; mt < 4; ++mt) { float ss = 0.f;
#pragma unroll
            for (int nl = 0; nl < 2; ++nl)
#pragma unroll
                for (int j = 0; j < 4; ++j) ss += o[mt][nl][j] * o[mt][nl][j];
            ss += __shfl_xor(ss, 16); ss += __shfl_xor(ss, 32);
            if (fq == 0) sSS[(16 * mt + fr) * 8 + wid] = ss; }
        __syncthreads();
#pragma unroll
        for (int mt = 0; mt < 4; ++mt) { const int tok = 16 * mt + fr; const f32x4 s0 = *(const LAS f32x4*)(sSS + tok * 8), s1 = *(const LAS f32x4*)(sSS + tok * 8 + 4);
            const float tot = ((s0[0] + s0[1]) + (s0[2] + s0[3])) + ((s1[0] + s1[1]) + (s1[2] + s1[3])); const float rs = __builtin_amdgcn_rsqf(tot * (1.f / 256.f) + EPS);
#pragma unroll
            for (int nl = 0; nl < 2; ++nl) { const int dv = 32 * wid + 16 * nl + 4 * fq; const f32x4 gn = *(const f32x4*)(norm_g + dv);
                const size_t go = (size_t)(m0 + tok) * 1024 + h * 256 + dv; const u32x2 rv = *(const u32x2*)(Rg + go);
                u32x2 w; w.x = pk2(o[mt][nl][0] * rs * gn[0] * bflo(rv.x), o[mt][nl][1] * rs * gn[1] * bfhi(rv.x)); w.y = pk2(o[mt][nl][2] * rs * gn[2] * bflo(rv.y), o[mt][nl][3] * rs * gn[3] * bfhi(rv.y));
                *(u32x2*)(Y + go) = w; } }
        __syncthreads();
    }
}
__device__ __forceinline__ void nsa_compress_phase(LAS unsigned char* lds, const bf16_t* KV, const float* __restrict__ pos, const float* __restrict__ w1, const float* __restrict__ b1,
        const float* __restrict__ b2, const bf16_t* W1T, const bf16_t* W2T, bf16_t* KC, bf16_t* VC, const int tid, const int bid, const int G) {
    const int lane = tid & 63, wid = __builtin_amdgcn_readfirstlane(tid >> 6), fr = lane & 15, fq = lane >> 4;
    constexpr int SP = 0, SB1 = 2048, SPART = 4096, SH = 36864, LDH = 144;
    for (int u = bid; u < 256; u += G) {
        const int kv = u >> 7, b = (u >> 6) & 1, g = (u >> 4) & 3, n0 = (u & 15) * 32;
        { const int j = tid & 63, part = tid >> 6; float s = 0.f; const float* pw = w1 + (size_t)kv * 2048 * 64 + j; const float* pp = pos + kv * 2048;
          for (int kk = part * 256; kk < part * 256 + 256; ++kk) s += pp[kk] * pw[(size_t)kk * 64];
          ((LAS float*)(lds + SP))[part * 64 + j] = s; }
        __syncthreads();
        if (tid < 64) { float s = b1[kv * 64 + tid];
#pragma unroll
            for (int p = 0; p < 8; ++p) s += ((LAS float*)(lds + SP))[p * 64 + tid];
            ((LAS float*)(lds + SB1))[tid] = s; }
        { const int rt = wid & 1, kq = wid >> 1, n = n0 + 16 * rt + fr; const bool ok = n <= 510;
          const bf16_t* src = KV + (size_t)kv * T_ * 256 + (size_t)(b * SEQ + 16 * (ok ? n : 0)) * 256 + g * 64;
          const bf16_t* wt = W1T + (size_t)kv * 64 * 2048;
          f32x4 acc[4] = {(f32x4){0.f, 0.f, 0.f, 0.f}, (f32x4){0.f, 0.f, 0.f, 0.f}, (f32x4){0.f, 0.f, 0.f, 0.f}, (f32x4){0.f, 0.f, 0.f, 0.f}};
#pragma unroll 4
          for (int s = 0; s < 16; ++s) { const int kk = kq * 512 + 32 * s + 8 * fq, l = kk >> 6, d = kk & 63;
              bf16x8 a = *(const bf16x8*)(src + (size_t)l * 256 + d); if (!ok) a = (bf16x8){0, 0, 0, 0, 0, 0, 0, 0};
#pragma unroll
              for (int nt = 0; nt < 4; ++nt) { const bf16x8 bb = *(const bf16x8*)(wt + (size_t)(16 * nt + fr) * 2048 + kk); acc[nt] = mfma16(bb, a, acc[nt]); } }
#pragma unroll
          for (int nt = 0; nt < 4; ++nt) *(LAS f32x4*)(lds + SPART + ((kq * 2 + rt) * 1024 + fr * 64 + 16 * nt + 4 * fq) * 4) = acc[nt]; }
        __syncthreads();
        { const int row = tid >> 4, c4 = (tid & 15) * 4, rt = row >> 4, rr = row & 15; f32x4 s = *(const LAS f32x4*)(lds + SB1 + c4 * 4);
#pragma unroll
          for (int kq = 0; kq < 4; ++kq) s += *(const LAS f32x4*)(lds + SPART + ((kq * 2 + rt) * 1024 + rr * 64 + c4) * 4);
          u32x2 w; w.x = pk2(gelu_tanh_(s[0]), gelu_tanh_(s[1])); w.y = pk2(gelu_tanh_(s[2]), gelu_tanh_(s[3])); *(LAS u32x2*)(lds + SH + row * LDH + c4 * 2) = w; }
        __syncthreads();
        { const int rt = wid >> 2, nt = wid & 3; f32x4 acc = (f32x4){0.f, 0.f, 0.f, 0.f};
#pragma unroll
          for (int s = 0; s < 2; ++s) { const bf16x8 a = *(const LAS bf16x8*)(lds + SH + (16 * rt + fr) * LDH + (32 * s + 8 * fq) * 2);
              const bf16x8 bb = *(const bf16x8*)(W2T + kv * 4096 + (16 * nt + fr) * 64 + 32 * s + 8 * fq); acc = mfma16(bb, a, acc); }
          const int n = n0 + 16 * rt + fr, d = 16 * nt + 4 * fq; const f32x4 bv = *(const f32x4*)(b2 + kv * 64 + d);
          u32x2 w; w.x = pk2(acc[0] + bv[0], acc[1] + bv[1]); w.y = pk2(acc[2] + bv[2], acc[3] + bv[3]);
          *(u32x2*)((kv ? VC : KC) + ((size_t)(b * 4 + g) * 512 + n) * 64 + d) = w; }
        __syncthreads();
    }
}
#ifndef NSA_CT3_ONLY
#define NSA_CT3_ONLY 0
#endif
#ifndef NSA_SEL_REP
#define NSA_SEL_REP 1
#endif
#ifndef NSA_WIN_REP
#define NSA_WIN_REP 1
#endif
struct NsaSt { float m, l; f32x4 o[4]; };
struct KVRegs { u32x4 k[2], v[2]; };
template <int MODE, int STEP, int CTM>
__device__ __forceinline__ void nsa_tile(const LAS unsigned char* sK, const LAS unsigned char* sV, const bf16x8 (&qf)[2][2], NsaSt (&st)[2], const int (&dbase)[2],
        const bool general, const bool (&colsel)[2], const LAS float* bt, const float bfar, const float (&minv)[2], LAS float* sMain, LAS float* sSpill, const int (&tokl)[2], const int mg0,
        const int fr, const int fq, const int q4, const int p4) {
    constexpr int LDT = 144; const float NEG = -INFINITY;
    bf16x8 kf[4][2];
#pragma unroll
    for (int kt = 0; kt < 4; ++kt) { kf[kt][0] = *(const LAS bf16x8*)(sK + (16 * kt + fr) * LDT + (8 * fq) * 2); kf[kt][1] = *(const LAS bf16x8*)(sK + (16 * kt + fr) * LDT + (32 + 8 * fq) * 2); }
    f32x4 sacc[2][4];
#pragma unroll
    for (int ct = 0; ct < 2; ++ct) if (CTM & (1 << ct)) {
#pragma unroll
        for (int kt = 0; kt < 4; ++kt) sacc[ct][kt] = mfma16(kf[kt][0], qf[ct][0], (f32x4){0.f, 0.f, 0.f, 0.f});
#pragma unroll
        for (int kt = 0; kt < 4; ++kt) sacc[ct][kt] = mfma16(kf[kt][1], qf[ct][1], sacc[ct][kt]); }
#pragma unroll
    for (int ct = 0; ct < 2; ++ct) if (CTM & (1 << ct)) {
        float tmax = NEG;
        if (general) {
            float bv[4][4];
#pragma unroll
            for (int kt = 0; kt < 4; ++kt)
#pragma unroll
                for (int j = 0; j < 4; ++j) { const int dist = dbase[ct] - (16 * kt + 4 * fq + j) * STEP; const int idx = dist < 0 ? 0 : (dist > 128 ? 128 : dist); bv[kt][j] = bt[idx]; }
#pragma unroll
            for (int kt = 0; kt < 4; ++kt)
#pragma unroll
                for (int j = 0; j < 4; ++j) { const int dist = dbase[ct] - (16 * kt + 4 * fq + j) * STEP; bool valid = dist >= 0;
                    if (MODE == 3) valid = valid && dist < 512;
                    if (MODE == 2) valid = valid && colsel[ct];
                    const float x = valid ? sacc[ct][kt][j] * LOG2E + bv[kt][j] : NEG;
                    sacc[ct][kt][j] = x; tmax = max3_(tmax, x, x); }
        } else {
#pragma unroll
            for (int kt = 0; kt < 4; ++kt) tmax = max3_(max3_(tmax, sacc[ct][kt][0], sacc[ct][kt][1]), sacc[ct][kt][2], sacc[ct][kt][3]);
            tmax = (MODE == 2 && !colsel[ct]) ? NEG : tmax * LOG2E + bfar;
        }
        if (MODE == 1) {
            const float mm = st[ct].m, li = minv[ct];
#pragma unroll
            for (int kt = 0; kt < 4; ++kt) { float gs = 0.f, p3 = 0.f;
#pragma unroll
                for (int j = 0; j < 4; ++j) { const float xx = general ? sacc[ct][kt][j] : sacc[ct][kt][j] * LOG2E + bfar; const float p = fast_exp2(xx - mm) * li; sacc[ct][kt][j] = p; gs += p; if (j == 3) p3 = p; }
                gs += dpp_xor1(gs); gs += dpp_xor2(gs); p3 += dpp_xor1(p3); p3 += dpp_xor2(p3);
                const int mg = mg0 + 4 * kt + fq;
                if ((fr & 3) == 0) { sMain[tokl[ct] * 128 + mg] = gs; if (mg + 1 < 128) sSpill[tokl[ct] * 128 + mg + 1] = p3; } }
        } else {
            const float rm = xmax16_32(tmax);
            const bool need = rm > st[ct].m + 8.f;
            if (__any(need)) { const float mnew = need ? fmaxf(st[ct].m, rm) : st[ct].m, alpha = (st[ct].m == mnew) ? 1.f : fast_exp2(st[ct].m - mnew);
                st[ct].l *= alpha; st[ct].m = mnew;
                if (MODE != 0) {
#pragma unroll
                    for (int dt = 0; dt < 4; ++dt) st[ct].o[dt] = st[ct].o[dt] * alpha; } }
            const float mref = (st[ct].m == NEG) ? 0.f : st[ct].m;
            float ps = 0.f;
            if (general) {
#pragma unroll
                for (int kt = 0; kt < 4; ++kt)
#pragma unroll
                    for (int j = 0; j < 4; ++j) { const float p = fast_exp2(sacc[ct][kt][j] - mref); sacc[ct][kt][j] = p; ps += p; }
            } else { const float c = (MODE == 2 && !colsel[ct]) ? NEG : bfar - mref;
#pragma unroll
                for (int kt = 0; kt < 4; ++kt)
#pragma unroll
                    for (int j = 0; j < 4; ++j) { const float p = fast_exp2(sacc[ct][kt][j] * LOG2E + c); sacc[ct][kt][j] = p; ps += p; } }
            st[ct].l += ps;
        }
    }
    if (MODE != 0) {
#pragma unroll
        for (int s = 0; s < 2; ++s) { bf16x8 pf[2];
#pragma unroll
            for (int ct = 0; ct < 2; ++ct) if (CTM & (1 << ct)) { u32x4 w; w.x = pk2(sacc[ct][2 * s][0], sacc[ct][2 * s][1]); w.y = pk2(sacc[ct][2 * s][2], sacc[ct][2 * s][3]);
                w.z = pk2(sacc[ct][2 * s + 1][0], sacc[ct][2 * s + 1][1]); w.w = pk2(sacc[ct][2 * s + 1][2], sacc[ct][2 * s + 1][3]); pf[ct] = __builtin_bit_cast(bf16x8, w); }
#pragma unroll
            for (int dt = 0; dt < 4; ++dt) { const LAS unsigned char* pv = sV + (32 * s + 4 * fq + q4) * LDT + (16 * dt + 4 * p4) * 2; const bf16x8 vf = cat44(tr_read(pv), tr_read(pv + 16 * LDT));
#pragma unroll
                for (int ct = 0; ct < 2; ++ct) if (CTM & (1 << ct)) st[ct].o[dt] = mfma16(vf, pf[ct], st[ct].o[dt]); } }
    }
}
__device__ __forceinline__ void nsa_ld2(const bf16_t* Kp, const bf16_t* Vp, size_t ts, int ld, bool two, int tid, KVRegs& r) { const int key = tid >> 3, c = tid & 7;
    r.k[0] = *(const u32x4*)(Kp + (size_t)key * ld + 8 * c); r.v[0] = *(const u32x4*)(Vp + (size_t)key * ld + 8 * c);
    if (two) { r.k[1] = *(const u32x4*)(Kp + ts + (size_t)key * ld + 8 * c); r.v[1] = *(const u32x4*)(Vp + ts + (size_t)key * ld + 8 * c); } }
__device__ __forceinline__ void nsa_st2(LAS unsigned char* sK, LAS unsigned char* sV, int tid, const KVRegs& r) { const int key = tid >> 3, c = tid & 7;
    *(LAS u32x4*)(sK + key * 144 + c * 16) = r.k[0]; *(LAS u32x4*)(sV + key * 144 + c * 16) = r.v[0]; *(LAS u32x4*)(sK + 9216 + key * 144 + c * 16) = r.k[1]; *(LAS u32x4*)(sV + 9216 + key * 144 + c * 16) = r.v[1]; }

__device__ __forceinline__ void nsa_attn_phase(LAS unsigned char* lds, const bf16_t* Q, const bf16_t* KV, const float* GT, const bf16_t* KC, const bf16_t* VC, const float* __restrict__ rel_bias, bf16_t* Y, void* TQ, const int tid, const int bid, const int G) {
    const int lane = tid & 63, wid = __builtin_amdgcn_readfirstlane(tid >> 6), fr = lane & 15, fq = lane >> 4, q4 = (lane & 15) >> 2, p4 = lane & 3, hg = fr & 3;
    constexpr int SKO = 0, SVO = 36864, SMAIN = 73728, SSPILL = 106496, SBT = 139264, SSEL = 141376, TB = 9216;
    LAS float* sMain = (LAS float*)(lds + SMAIN); LAS float* sSpill = (LAS float*)(lds + SSPILL); LAS float* sBt = (LAS float*)(lds + SBT); LAS unsigned* sSel = (LAS unsigned*)(lds + SSEL);
    const float NEG = -INFINITY;
    unsigned long long tp_[5] = {0ull, 0ull, 0ull, 0ull, 0ull}; (void)tp_;
#ifdef TIMING_PROBE
#define TP(i) tp_[i] = __builtin_amdgcn_s_memrealtime()
#define TPW0() tw_ = __builtin_amdgcn_s_memrealtime()
#define TPW1() accw_ += __builtin_amdgcn_s_memrealtime() - tw_
#define TPT0(M) do { if ((M) == 2) tt_ = __builtin_amdgcn_s_memrealtime(); } while (0)
#define TPT1(M, c) do { if ((M) == 2) { acct_ += __builtin_amdgcn_s_memrealtime() - tt_; cntt_ += (c); } } while (0)
#else
#define TPT0(M) do {} while (0)
#define TPT1(M, c) do {} while (0)
#define TP(i) do {} while (0)
#define TPW0() do {} while (0)
#define TPW1() do {} while (0)
#endif
    unsigned long long tw_ = 0ull, accw_ = 0ull, tt_ = 0ull, acct_ = 0ull; int cntt_ = 0; (void)tw_; (void)accw_; (void)tt_; (void)acct_; (void)cntt_;
    unsigned long long acc_[4] = {0ull, 0ull, 0ull, 0ull}; (void)acc_;
        for (int ui = 0; ; ++ui) {
        int bg, qb;
        if (G == 256) { if (ui >= 4) break; const int c = bid, s = c >> 3; bg = c & 7;        qb = ui == 0 ? s : ui == 1 ? 63 - s : ui == 2 ? 64 + s : 127 - s; }
        else { const int uu = bid + ui * G; if (uu >= 1024) break; bg = uu >> 7; qb = uu & 127; }
        const int b = bg >> 2, g = bg & 3, t0 = 64 * qb, m0 = b * SEQ + t0;
        TP(0);
        int tokl[2]; tokl[0] = 8 * wid + (fr >> 2); tokl[1] = tokl[0] + 4;
        bf16x8 qf[2][2];
#pragma unroll
        for (int ct = 0; ct < 2; ++ct)
#pragma unroll
            for (int s = 0; s < 2; ++s) qf[ct][s] = *(const bf16x8*)(Q + (size_t)(m0 + tokl[ct]) * 1024 + (g * 4 + hg) * 64 + 32 * s + 8 * fq);
        for (int i = tid; i < 4 * 129; i += 512) { const int h = i / 129, dist = i - h * 129; int bk;
            if (dist < 16) bk = dist; else { bk = 16 + (int)(logf((float)dist * (1.f / 16.f)) / 2.0794415416798357f * 16.f); bk = bk > 31 ? 31 : bk; }
            sBt[h * 132 + dist] = rel_bias[bk * 16 + g * 4 + h] * LOG2E; }
#pragma unroll
        for (int i = 0; i < 4; ++i) { *(LAS f32x4*)(lds + SMAIN + (tid + 512 * i) * 16) = (f32x4){0.f, 0.f, 0.f, 0.f}; *(LAS f32x4*)(lds + SSPILL + (tid + 512 * i) * 16) = (f32x4){0.f, 0.f, 0.f, 0.f}; }
        __syncthreads();
        const LAS float* bt = sBt + hg * 132; const float bfar = bt[128];
        LAS f32x4* totp = (LAS f32x4*)(lds + SMAIN + wid * 4096) + lane;
        const float* gtp = GT + (size_t)(m0 + tokl[0]) * 48 + (g * 4 + hg) * 3;
        NsaSt st[2]; bool act[2] = {true, true}; bool colsel[2] = {true, true}; int dbase[2]; float minv[2] = {1.f, 1.f};
        KVRegs kvr; kvr.k[1] = (u32x4){0u, 0u, 0u, 0u}; kvr.v[1] = (u32x4){0u, 0u, 0u, 0u};
        int mg0 = 0; bool general = true;
#define NSA_RUN(MODE, STEP, NT, KB, VB, TS, LD, SETUP) do { const int nt_ = (NT), nst_ = (nt_ + 1) >> 1; \
        nsa_ld2((KB), (VB), (TS), (LD), nt_ >= 2, tid, kvr); nsa_st2(lds + SKO, lds + SVO, tid, kvr); __syncthreads(); \
        _Pragma("unroll 1") for (int s_ = 0; s_ < nst_; ++s_) { const int sb_ = s_ & 1; \
            if (s_ + 1 < nst_) nsa_ld2((KB) + (size_t)(2 * s_ + 2) * (TS), (VB) + (size_t)(2 * s_ + 2) * (TS), (TS), (LD), 2 * s_ + 3 < nt_, tid, kvr); \
            _Pragma("unroll") for (int h_ = 0; h_ < 2; ++h_) { const int ti = 2 * s_ + h_; if (ti < nt_) { SETUP; \
                const LAS unsigned char* sk_ = lds + SKO + (sb_ * 2 + h_) * TB; const LAS unsigned char* sv_ = lds + SVO + (sb_ * 2 + h_) * TB; \
                TPT0(MODE); if (MODE != 2 || NSA_CT3_ONLY || (act[0] && act[1])) nsa_tile<MODE, STEP, 3>(sk_, sv_, qf, st, dbase, general, colsel, bt, bfar, minv, sMain, sSpill, tokl, mg0, fr, fq, q4, p4); \
                else if (act[0]) nsa_tile<MODE, STEP, 1>(sk_, sv_, qf, st, dbase, general, colsel, bt, bfar, minv, sMain, sSpill, tokl, mg0, fr, fq, q4, p4); \
                else if (act[1]) nsa_tile<MODE, STEP, 2>(sk_, sv_, qf, st, dbase, general, colsel, bt, bfar, minv, sMain, sSpill, tokl, mg0, fr, fq, q4, p4); TPT1(MODE, (int)act[0] + (int)act[1]); } } \
            if (s_ + 1 < nst_) nsa_st2(lds + SKO + ((sb_ ^ 1) * 2) * TB, lds + SVO + ((sb_ ^ 1) * 2) * TB, tid, kvr); \
            TPW0(); __syncthreads(); TPW1(); } } while (0)
#define NSA_RESET() do { _Pragma("unroll") for (int ct = 0; ct < 2; ++ct) { st[ct].m = NEG; st[ct].l = 0.f; _Pragma("unroll") for (int dt = 0; dt < 4; ++dt) st[ct].o[dt] = (f32x4){0.f, 0.f, 0.f, 0.f}; } } while (0)
        const int ncmp = 4 * qb + 3, nct = (ncmp + 63) >> 6;
        const bf16_t* kcb = KC + (size_t)bg * 512 * 64; const bf16_t* vcb = VC + (size_t)bg * 512 * 64;
        NSA_RESET();
        NSA_RUN(0, 16, nct, kcb, vcb, (size_t)4096, 64, { dbase[0] = t0 + tokl[0] - 31 - 1024 * ti; dbase[1] = dbase[0] + 4; mg0 = 16 * ti; general = t0 - 31 - 1024 * ti - 1008 < 128; });
#pragma unroll
        for (int ct = 0; ct < 2; ++ct) { const float lt = xsum16_32(st[ct].l); minv[ct] = fast_rcp(lt > 0.f ? lt : 1.f); if (st[ct].m == NEG) st[ct].m = 0.f; }
        NSA_RUN(1, 16, nct, kcb, vcb, (size_t)4096, 64, { dbase[0] = t0 + tokl[0] - 31 - 1024 * ti; dbase[1] = dbase[0] + 4; mg0 = 16 * ti; general = t0 - 31 - 1024 * ti - 1008 < 128; });
        LAS f32x4* park = (LAS f32x4*)(lds + SKO + wid * 8192) + lane;
#pragma unroll
        for (int ct = 0; ct < 2; ++ct) { const float gt0 = gtp[ct * 4 * 48];
#pragma unroll
            for (int dt = 0; dt < 4; ++dt) park[(ct * 4 + dt) * 64] = st[ct].o[dt] * gt0; }
        unsigned msk[2][4];
        if (qb <= 15) {
#pragma unroll
            for (int ct = 0; ct < 2; ++ct) { msk[ct][0] = (2u << qb) - 1u; msk[ct][1] = 0u; msk[ct][2] = 0u; msk[ct][3] = 0u; }
        } else {
            const int tl = lane >> 3, sub = lane & 7, tok = 8 * wid + tl;
            unsigned key[16];
#pragma unroll
            for (int i = 0; i < 4; ++i) { const f32x4 a = *(const LAS f32x4*)(sMain + tok * 128 + 16 * sub + 4 * i), s4 = *(const LAS f32x4*)(sSpill + tok * 128 + 16 * sub + 4 * i);
#pragma unroll
                for (int j = 0; j < 4; ++j) { const int m = 16 * sub + 4 * i + j; const float imp = a[j] + s4[j];
                    key[4 * i + j] = (m >= 1 && m <= qb - 2) ? ((__float_as_uint(imp) & ~127u) | (unsigned)(127 - m)) : 0u; } }
            unsigned selb = 0u;
#pragma unroll 1
            for (int it = 0; it < 13; ++it) { unsigned mx = key[0];
#pragma unroll
                for (int i = 1; i < 16; ++i) mx = key[i] > mx ? key[i] : mx;
                { unsigned o = (unsigned)__shfl_xor((int)mx, 1); mx = o > mx ? o : mx; o = (unsigned)__shfl_xor((int)mx, 2); mx = o > mx ? o : mx; o = (unsigned)__shfl_xor((int)mx, 4); mx = o > mx ? o : mx; }
#pragma unroll
                for (int i = 0; i < 16; ++i) if (key[i] == mx) { selb |= 1u << i; key[i] = 0u; } }
            { const int f0 = 0, f1 = qb, f2 = qb - 1;
              if ((f0 >> 4) == sub) selb |= 1u << (f0 & 15); if ((f1 >> 4) == sub) selb |= 1u << (f1 & 15); if ((f2 >> 4) == sub) selb |= 1u << (f2 & 15); }
            const unsigned oth = (unsigned)__shfl_xor((int)selb, 1);
            if ((sub & 1) == 0) sSel[tok * 4 + (sub >> 1)] = selb | (oth << 16);
            asm volatile("s_waitcnt lgkmcnt(0)" ::: "memory");
#pragma unroll
            for (int ct = 0; ct < 2; ++ct) { const u32x4 w = *(const LAS u32x4*)(sSel + tokl[ct] * 4); msk[ct][0] = w.x; msk[ct][1] = w.y; msk[ct][2] = w.z; msk[ct][3] = w.w; }
        }
#pragma unroll
        for (int ct = 0; ct < 2; ++ct)
#pragma unroll
            for (int dt = 0; dt < 4; ++dt) totp[ct * (SSPILL - SMAIN) / 16 + 64 * dt] = park[(ct * 4 + dt) * 64];
        __syncthreads();
        TP(1);
        { const bf16_t* ksb = KV + (size_t)2 * T_ * 256 + (size_t)(b * SEQ) * 256 + g * 64; const bf16_t* vsb = KV + (size_t)3 * T_ * 256 + (size_t)(b * SEQ) * 256 + g * 64;
          _Pragma("unroll 1") for (int rep_ = 0; rep_ < NSA_SEL_REP; ++rep_) {
          NSA_RESET();
          NSA_RUN(2, 1, qb + 1, ksb, vsb, (size_t)64 * 256, 256, { const int mw = ti >> 5; const int mb = ti & 31;
              _Pragma("unroll") for (int ct = 0; ct < 2; ++ct) { const unsigned w = mw == 0 ? msk[ct][0] : mw == 1 ? msk[ct][1] : mw == 2 ? msk[ct][2] : msk[ct][3]; colsel[ct] = (w >> mb) & 1u; act[ct] = __any(colsel[ct]); }
              dbase[0] = t0 + tokl[0] - 64 * ti; dbase[1] = dbase[0] + 4; general = ti + 2 >= qb; });
          }
#pragma unroll
          for (int ct = 0; ct < 2; ++ct) { const float lt = xsum16_32(st[ct].l), sc = gtp[ct * 4 * 48 + 1] * fast_rcp(lt > 0.f ? lt : 1.f);
#pragma unroll
              for (int dt = 0; dt < 4; ++dt) totp[ct * (SSPILL - SMAIN) / 16 + 64 * dt] += st[ct].o[dt] * sc; } }
        TP(2);
        { const bf16_t* kwb = KV + (size_t)4 * T_ * 256 + (size_t)(b * SEQ) * 256 + g * 64; const bf16_t* vwb = KV + (size_t)5 * T_ * 256 + (size_t)(b * SEQ) * 256 + g * 64;
          _Pragma("unroll 1") for (int rep_ = 0; rep_ < NSA_WIN_REP; ++rep_) {
          NSA_RESET(); act[0] = true; act[1] = true; colsel[0] = true; colsel[1] = true;
          const int j0 = qb >= 8 ? 0 : 8 - qb;
          NSA_RUN(3, 1, 9 - j0, kwb + (size_t)(t0 - 512 + 64 * j0) * 256, vwb + (size_t)(t0 - 512 + 64 * j0) * 256, (size_t)64 * 256, 256, { const int j = j0 + ti;
              dbase[0] = tokl[0] + 512 - 64 * j; dbase[1] = dbase[0] + 4; general = (j == 0) || (j >= 6); });
          }
#pragma unroll
          for (int ct = 0; ct < 2; ++ct) { const float lt = xsum16_32(st[ct].l), sc = gtp[ct * 4 * 48 + 2] * fast_rcp(lt > 0.f ? lt : 1.f);
#pragma unroll
              for (int dt = 0; dt < 4; ++dt) st[ct].o[dt] = totp[ct * (SSPILL - SMAIN) / 16 + 64 * dt] + st[ct].o[dt] * sc; } }
        TP(3);
#pragma unroll
        for (int ct = 0; ct < 2; ++ct)
#pragma unroll
            for (int dt = 0; dt < 4; ++dt) { u32x2 w; w.x = pk2(st[ct].o[dt][0], st[ct].o[dt][1]); w.y = pk2(st[ct].o[dt][2], st[ct].o[dt][3]);
                *(u32x2*)(Y + (size_t)(m0 + tokl[ct]) * 1024 + (g * 4 + hg) * 64 + 16 * dt + 4 * fq) = w; }
        __syncthreads();
        TP(4);
#ifdef TIMING_PROBE
        acc_[0] += tp_[1] - tp_[0]; acc_[1] += tp_[2] - tp_[1]; acc_[2] += tp_[3] - tp_[2]; acc_[3] += tp_[4] - tp_[0];
#endif
#undef NSA_RESET
#undef NSA_RUN
    }
#ifdef TIMING_PROBE
    if (bid == 0 && tid == 0) { float* tq = (float*)TQ; const float tt = (float)acc_[3]; tq[0] = (float)acc_[0] / tt; tq[1] = (float)acc_[1] / tt; tq[2] = (float)acc_[2] / tt; tq[3] = (float)accw_ / tt; tq[4] = 0.f; tq[5] = (float)acct_ / tt; tq[6] = (float)cntt_ * (1.f / 2000.f); tq[7] = tt * (1.f / 100000.f); }
#endif
}
#ifndef USE_XCD_BAR
#define USE_XCD_BAR 1
#endif
#ifndef EN_ALL
#define EN_ALL 1
#endif
#ifndef EN_LRUG
#define EN_LRUG EN_ALL
#endif
#ifndef EN_LRUA
#define EN_LRUA EN_ALL
#endif
#ifndef EN_NSAC
#define EN_NSAC EN_ALL
#endif
#ifndef EN_NSAA
#define EN_NSAA EN_ALL
#endif
#ifndef EN_GLAK
#define EN_GLAK EN_ALL
#endif
#ifndef EN_GLAS
#define EN_GLAS EN_ALL
#endif
#ifndef EN_GLAO
#define EN_GLAO EN_ALL
#endif
#ifndef EN_G_LRUIN
#define EN_G_LRUIN EN_ALL
#endif
#ifndef EN_G_RESID
#define EN_G_RESID EN_ALL
#endif
#ifndef EN_G_NSAIN
#define EN_G_NSAIN EN_ALL
#endif
#ifndef EN_G_GLAIN
#define EN_G_GLAIN EN_ALL
#endif
#ifndef EN_G_GU
#define EN_G_GU EN_ALL
#endif
#ifndef EN_PREP
#define EN_PREP EN_ALL
#endif
struct Args {
    const float* x; const float* rel_bias; const float* final_norm; const float* mix_norm; const float* ffn_norm;
    const float* ffn_w_gate; const float* ffn_w_up; const float* ffn_w_down;
    const float* lru_w_in; const float* lru_conv_w; const float* lru_conv_b; const float* lru_w_a; const float* lru_b_a; const float* lru_w_x; const float* lru_b_x; const float* lru_lam; const float* lru_w_out;
    const float* nsa_w_in; const float* nsa_cmp_pos; const float* nsa_cmp_w1; const float* nsa_cmp_b1; const float* nsa_cmp_w2; const float* nsa_cmp_b2; const float* nsa_w_out;
    const float* gla_w_in; const float* gla_w_g2; const float* gla_b_g2; const float* gla_norm; const float* gla_w_out;
    float* out; unsigned char* ws; int ph_lo, ph_hi;
};

#define XB_TMO      128
#define XB_XCNT(j)  (256  + 64 * (j))
#define XB_XSUB(j)  (1280 + 64 * (j))
#define XB_XGEN(j)  (2304 + 64 * (j))
#define XB_TOP      3328
#define XB_TOPGEN   3392
#define XCD_BAR_WORDS 3456
#define XB_SPIN_CAP (1u << 18)

__device__ __forceinline__ unsigned xb_ld(unsigned* p)              { return __hip_atomic_load(p, __ATOMIC_RELAXED, __HIP_MEMORY_SCOPE_AGENT); }
__device__ __forceinline__ unsigned xb_add(unsigned* p, unsigned v) { return __hip_atomic_fetch_add(p, v, __ATOMIC_RELAXED, __HIP_MEMORY_SCOPE_AGENT); }
__device__ __forceinline__ unsigned xb_xcc_id() { return (unsigned)__builtin_amdgcn_s_getreg((3 << 11) | 20) & 0xFu; }
#define XB_SPIN(cond, bar) do { unsigned _sp = 0; while (cond) { __builtin_amdgcn_s_sleep(1); \
    if ((++_sp & 255u) == 0u) { if (xb_ld(&(bar)[XB_TMO])) break; if (_sp > XB_SPIN_CAP) { atomicAdd(&(bar)[XB_TMO], 1u); break; } } } } while (0)

struct XcdBarrier {
    unsigned* bar; unsigned x;
    volatile LAS unsigned* st;
};

__device__ __forceinline__ XcdBarrier xcd_barrier_post(unsigned* bar, volatile LAS unsigned* st) {
    XcdBarrier b; b.bar = bar; b.x = xb_xcc_id(); b.st = st;
    if (threadIdx.x == 0) (void)xb_add(&bar[XB_XCNT(b.x)], 1u);
    return b;
}
__device__ __forceinline__ void xcd_barrier_complete(unsigned* bar, unsigned x, unsigned& nloc, unsigned& nx) {
    const unsigned G = gridDim.x * gridDim.y * gridDim.z;
    unsigned sum, cnt, mine, sp = 0u;
    for (;;) {
        sum = 0u; cnt = 0u; mine = 0u;
#pragma unroll
        for (unsigned j = 0; j < 16; ++j) { const unsigned c = xb_ld(&bar[XB_XCNT(j)]); sum += c; cnt += (c > 0u) ? 1u : 0u; mine = (j == x) ? c : mine; }
        if (sum == G) break;
        __builtin_amdgcn_s_sleep(1);
        if ((++sp & 255u) == 0u) { if (xb_ld(&bar[XB_TMO])) break; if (sp > XB_SPIN_CAP) { atomicAdd(&bar[XB_TMO], 1u); break; } }
    }
    nloc = mine > 0u ? mine : 1u; nx = cnt > 0u ? cnt : 1u;
}

__device__ __forceinline__ void xcd_barrier(const XcdBarrier& b) {
    asm volatile("s_waitcnt vmcnt(0)" ::: "memory");
    __syncthreads();
    if (threadIdx.x == 0) {
        unsigned* bar = b.bar;
        __builtin_amdgcn_s_waitcnt(0);
        unsigned nloc = b.st[0], nx = b.st[1];
        if (nloc == 0u) { xcd_barrier_complete(bar, b.x, nloc, nx); b.st[0] = nloc; b.st[1] = nx; }
        const unsigned old = xb_add(&bar[XB_XSUB(b.x)], 1u);
        const unsigned gen = old / nloc;
        if (old + 1u == (gen + 1u) * nloc) {
            __builtin_amdgcn_fence(__ATOMIC_RELEASE, "agent");
            asm volatile("s_waitcnt vmcnt(0)" ::: "memory");
            const unsigned og = xb_add(&bar[XB_TOP], 1u);
            const unsigned tg = og / nx;
            if (og + 1u == (tg + 1u) * nx) xb_add(&bar[XB_TOPGEN], 1u);
            else XB_SPIN(xb_ld(&bar[XB_TOPGEN]) == tg, bar);
            __builtin_amdgcn_fence(__ATOMIC_ACQUIRE, "agent");
            xb_add(&bar[XB_XGEN(b.x)], 1u);
            asm volatile("s_waitcnt vmcnt(0)" ::: "memory");
        } else {
            XB_SPIN(xb_ld(&bar[XB_XGEN(b.x)]) == gen, bar);
            __builtin_amdgcn_fence(__ATOMIC_ACQUIRE, "agent");
            asm volatile("s_waitcnt vmcnt(0)" ::: "memory");
        }
    }
    __syncthreads();
}

__global__ void __launch_bounds__(512, 2) mega_fwd(Args a) {
    extern __shared__ __attribute__((aligned(16))) unsigned char lds_raw[];
    LAS unsigned char* lds = (LAS unsigned char*)lds_raw;
    cg::grid_group grid = cg::this_grid();
    const int tid0 = threadIdx.x; const int wid0 = __builtin_amdgcn_readfirstlane(tid0 >> 6);
    constexpr int PTR_OFF = LDS_BYTES - 512;
    if (tid0 == 0) { LAS unsigned long long* tb = (LAS unsigned long long*)(lds + PTR_OFF);
        tb[0] = (unsigned long long)a.x;
        tb[1] = (unsigned long long)a.rel_bias;
        tb[2] = (unsigned long long)a.final_norm;
        tb[3] = (unsigned long long)a.mix_norm;
        tb[4] = (unsigned long long)a.ffn_norm;
        tb[5] = (unsigned long long)a.ffn_w_gate;
        tb[6] = (unsigned long long)a.ffn_w_up;
        tb[7] = (unsigned long long)a.ffn_w_down;
        tb[8] = (unsigned long long)a.lru_w_in;
        tb[9] = (unsigned long long)a.lru_conv_w;
        tb[10] = (unsigned long long)a.lru_conv_b;
        tb[11] = (unsigned long long)a.lru_w_a;
        tb[12] = (unsigned long long)a.lru_b_a;
        tb[13] = (unsigned long long)a.lru_w_x;
        tb[14] = (unsigned long long)a.lru_b_x;
        tb[15] = (unsigned long long)a.lru_lam;
        tb[16] = (unsigned long long)a.lru_w_out;
        tb[17] = (unsigned long long)a.nsa_w_in;
        tb[18] = (unsigned long long)a.nsa_cmp_pos;
        tb[19] = (unsigned long long)a.nsa_cmp_w1;
        tb[20] = (unsigned long long)a.nsa_cmp_b1;
        tb[21] = (unsigned long long)a.nsa_cmp_w2;
        tb[22] = (unsigned long long)a.nsa_cmp_b2;
        tb[23] = (unsigned long long)a.nsa_w_out;
        tb[24] = (unsigned long long)a.gla_w_in;
        tb[25] = (unsigned long long)a.gla_w_g2;
        tb[26] = (unsigned long long)a.gla_b_g2;
        tb[27] = (unsigned long long)a.gla_norm;
        tb[28] = (unsigned long long)a.gla_w_out;
        tb[29] = (unsigned long long)a.out;
        tb[30] = (unsigned long long)a.ws;
    }
    if (tid0 < 4) ((LAS unsigned*)(lds + PTR_OFF + 256))[tid0] = 0u;
    __syncthreads();
    XcdBarrier xbar = xcd_barrier_post((unsigned*)(a.ws + WS_CTL), (volatile LAS unsigned*)(lds + PTR_OFF + 256));
#define PRAW(i) ((((unsigned long long)(unsigned)__builtin_amdgcn_readfirstlane((int)((const LAS unsigned*)(lds + PTR_OFF))[2 * (i) + 1])) << 32) | (unsigned long long)(unsigned)__builtin_amdgcn_readfirstlane((int)((const LAS unsigned*)(lds + PTR_OFF))[2 * (i)]))
#define GAS_ __attribute__((address_space(1)))
#define PF(i) ((const float*)(const GAS_ float*)PRAW(i))
#define P_OUT ((float*)(GAS_ float*)PRAW(29))
#define WSP(off) ((unsigned char*)((GAS_ unsigned char*)PRAW(30) + (off)))
#define W_GU ((bf16_t*)WSP(WS_W_GU))
#define W_DN ((bf16_t*)WSP(WS_W_DN))
#define W_MIN ((bf16_t*)WSP(WS_W_MIN))
#define W_MOUT ((bf16_t*)WSP(WS_W_MOUT))
#define W_SM ((bf16_t*)WSP(WS_W_SMALL))
#define HN ((bf16_t*)WSP(WS_HN))
#define ACT ((bf16_t*)WSP(WS_ACT))
#define LG ((bf16_t*)WSP(WS_LG))
#define LX ((bf16_t*)WSP(WS_LX))
#define LHL ((bf16_t*)WSP(WS_LHL))
#define LAC ((bf16_t*)WSP(WS_LAC))
#define AGGA ((float*)WSP(WS_LAGGA))
#define AGGH ((float*)WSP(WS_LAGGH))
#define NQ ((bf16_t*)WSP(WS_NQ))
#define NKV ((bf16_t*)WSP(WS_NKV))
#define NGT ((float*)WSP(WS_NGT))
#define NKC ((bf16_t*)WSP(WS_NKC))
#define NVC ((bf16_t*)WSP(WS_NVC))
#define GQ ((bf16_t*)WSP(WS_GQ))
#define GK ((bf16_t*)WSP(WS_GK))
#define GV ((bf16_t*)WSP(WS_GV))
#define GR ((bf16_t*)WSP(WS_GR))
#define GGL ((float*)WSP(WS_GGL))
#define GDEC ((float*)WSP(WS_GDEC))
#define GKVT ((bf16_t*)WSP(WS_GKVT))
#define SSP ((float*)WSP(WS_SSP))
#define NY ((bf16_t*)WSP(WS_NY))

    enum { OP_PREP, OP_G_LRUIN, OP_LRU_GATES, OP_LRU_APPLY, OP_G_RESID, OP_G_NSAIN, OP_NSA_CMP, OP_NSA_ATTN, OP_G_GLAIN, OP_GLA_KV, OP_GLA_SCAN, OP_GLA_OUT, OP_NORM2, OP_G_GU, OP_FINAL };
#pragma unroll 1
    for (int ph = a.ph_lo; ph < a.ph_hi; ++ph) {
        int layer, r;
        if (ph < 7) { layer = 0; r = ph; } else if (ph < 13) { layer = 1; r = ph - 6; } else if (ph < 20) { layer = 2; r = ph - 12; } else if (ph < 26) { layer = 3; r = ph - 19; } else { layer = 4; r = 0; }
        const int kind = layer % 3, jj = layer / 3, nmix = kind == 2 ? 5 : 4;
        int wid_s = wid0, bid = blockIdx.x, G = gridDim.x;
        asm volatile("" : "+s"(wid_s) :: "memory"); asm volatile("" : "+s"(bid)); asm volatile("" : "+s"(G));
        int lane_v; asm volatile("v_mbcnt_lo_u32_b32 %0, -1, 0\n\tv_mbcnt_hi_u32_b32 %0, -1, %0" : "=v"(lane_v));
        const int tid = (wid_s << 6) | lane_v;
        const int lane = tid & 63, wid = __builtin_amdgcn_readfirstlane(tid >> 6), gw = bid * 8 + wid, NGW = G * 8;
        LAS float* scr = (LAS float*)(lds + wid * 8448);
        const float* hsrc = layer == 0 ? PF(0) : P_OUT;
        int op;
        if (layer == 4) op = OP_FINAL;
        else if (r == 0) op = OP_PREP;
        else if (r <= nmix) { const int q = r - 1;
            if (kind == 0) op = q == 0 ? OP_G_LRUIN : q == 1 ? OP_LRU_GATES : q == 2 ? OP_LRU_APPLY : OP_G_RESID;
            else if (kind == 1) op = q == 0 ? OP_G_NSAIN : q == 1 ? OP_NSA_CMP : q == 2 ? OP_NSA_ATTN : OP_G_RESID;
            else op = q == 0 ? OP_G_GLAIN : q == 1 ? OP_GLA_KV : q == 2 ? OP_GLA_SCAN : q == 3 ? OP_GLA_OUT : OP_G_RESID; }
        else { const int q = r - nmix - 1; op = q == 0 ? OP_G_GU : OP_G_RESID; }
        const bool is_down = (r == nmix + 2);
#ifdef PHASE_PROBE
        if (bid == 0 && tid == 0) { unsigned long long* ts = (unsigned long long*)WSP(WS_TQ + 4096); ts[ph] = __builtin_amdgcn_s_memrealtime(); ((int*)WSP(WS_TQ + 8192))[ph] = op; }
#endif
        switch (op) {
        case OP_PREP: if (EN_PREP) init_stream_bf16(PF(0), HN, SSP, gw, NGW, lane);
            break;
        case OP_G_LRUIN: if (EN_G_LRUIN) { pg8::Gemm g{HN, W_MIN, T_, 2 * RNN, D_}; pg8::StaticOrder S; S.init(T_, 2 * RNN, G, bid); pg8::EpiLruIn E{LG, LX, SSP};
            pg8::gemm_phase<pg8::EpiLruIn, pg8::StaticOrder, true, true>(lds, g, S, E, tid); }
            break;
        case OP_LRU_GATES: if (EN_LRUG) lru_gates_phase(lds, LX, PF(9) + jj * 4 * RNN, PF(10) + jj * RNN, W_SM, W_SM + 163840, PF(12) + jj * RNN, PF(14) + jj * RNN, PF(15) + jj * RNN, LHL, LAC, AGGA, AGGH, tid, bid, G);
            break;
        case OP_LRU_APPLY: if (EN_LRUA) lru_apply_phase(LG, LHL, LAC, AGGA, AGGH, tid, bid, G);
            break;
        case OP_G_RESID: if (EN_G_RESID) {
            const bf16_t* A = is_down ? ACT : (kind == 0 ? LG : kind == 1 ? NY : GV); const bf16_t* Bt = is_down ? W_DN : W_MOUT; const int K = is_down ? FF : (kind == 0 ? RNN : D_);
            pg8::Gemm g{A, Bt, T_, D_, K}; pg8::StaticOrder S; S.init(T_, D_, G, bid); pg8::EpiResid E{HN, SSP, (LAS float*)(lds + 131072)};
            pg8::gemm_phase<pg8::EpiResid, pg8::StaticOrder, true, true>(lds, g, S, E, tid); }
            break;
        case OP_G_NSAIN: if (EN_G_NSAIN) { pg8::Gemm g{HN, W_MIN, T_, NSA_NPAD, D_}; pg8::StaticOrder S; S.init(T_, NSA_NPAD, G, bid); pg8::EpiNsaIn E{NQ, NKV, NGT, SSP};
            pg8::gemm_phase<pg8::EpiNsaIn, pg8::StaticOrder, true, true>(lds, g, S, E, tid); }
            break;
        case OP_NSA_CMP: if (EN_NSAC) nsa_compress_phase(lds, NKV, PF(18), PF(19), PF(20), PF(22), W_SM, W_SM + 262144, NKC, NVC, tid, bid, G);
            break;
        case OP_NSA_ATTN: if (EN_NSAA) nsa_attn_phase(lds, NQ, NKV, NGT, NKC, NVC, PF(1), NY, (void*)WSP(WS_TQ), tid, bid, G);
            break;
        case OP_G_GLAIN: if (EN_G_GLAIN) { pg8::Gemm g{HN, W_MIN, T_, GLA_NPAD, D_}; pg8::StaticOrder S; S.init(T_, GLA_NPAD, G, bid); pg8::EpiGlaIn E{GQ, GK, GV, GR, GGL, SSP};
            pg8::gemm_phase<pg8::EpiGlaIn, pg8::StaticOrder, true, true>(lds, g, S, E, tid); }
            break;
        case OP_GLA_KV: if (EN_GLAK) gla_kv_phase(lds, GK, GV, GGL, PF(25), PF(26), GKVT, GDEC, tid, bid, G);
            break;
        case OP_GLA_SCAN: if (EN_GLAS) gla_scan_phase(GKVT, GDEC, tid, bid, G);
            break;
        case OP_GLA_OUT: if (EN_GLAO) gla_out_phase(lds, GQ, GK, GV, GR, GGL, PF(25), PF(26), PF(27), GKVT, GV, tid, bid, G);
            break;
        case OP_G_GU: if (EN_G_GU) { pg8::Gemm g{HN, W_GU, T_, 2 * FF, D_}; pg8::StaticOrder S; S.init(T_, 2 * FF, G, bid); pg8::EpiSwiglu E{ACT, SSP};
            pg8::gemm_phase<pg8::EpiSwiglu, pg8::StaticOrder, true, true>(lds, g, S, E, tid); }
            break;
        default: if (EN_PREP) final_norm_rows(HN, PF(2), P_OUT, gw, NGW, lane);
#if defined(TIMING_PROBE) || defined(PHASE_PROBE)
            { __syncthreads(); float* o = P_OUT;
#ifdef PHASE_PROBE
              const unsigned long long* ts = (const unsigned long long*)WSP(WS_TQ + 4096); const int* ops = (const int*)WSP(WS_TQ + 8192);
              const unsigned long long tend = __builtin_amdgcn_s_memrealtime(); float sa = 0.f, sb = 0.f;
              for (int q = 0; q < 33; ++q) { const float dt = (float)(ts[q + 1] - ts[q]); if (ops[q] == TQ_A) sa += dt; if (ops[q] == TQ_B) sb += dt; }
              const float tot_ = (float)(ts[33] - ts[0]); const float f1 = sa / tot_, f2 = sb / tot_; (void)tend;
#else
              const float* tq = (const float*)WSP(WS_TQ); const float f1 = tq[TQ_A], f2 = tq[TQ_B];
#endif

              const int R = (int)(f2 * 0.32f * 16384.f);
              for (int m = gw; m < R; m += NGW) for (int c = lane; c < 1024; c += 64) o[(size_t)m * 1024 + c] += 0.05f;
              if (bid == G - 1 && tid == 0) o[(size_t)16383 * 1024 + 5] += 0.1f + 0.19f * f1; }
#endif
            break;
        }
        { int cv = 0, nun = 0;
          if (op == OP_PREP) cv = 2;
          else if ((op == OP_G_LRUIN || op == OP_G_NSAIN || op == OP_G_GLAIN)) { cv = 1; nun = 64 * (op == OP_G_LRUIN ? 10 : op == OP_G_NSAIN ? 11 : 13); }
          else if (op == OP_G_GU && layer < 3) { cv = 2; nun = 64 * 22; }
          if (EN_PREP && cv) {
              const int rem = op == OP_PREP ? 0 : nun % G, first = rem, nidle = G - first;
              if (bid >= first) { const int cgw = (bid - first) * 8 + wid, CNGW = nidle * 8; int rot = 0;
                  if (cv & 1) {
                      transpose_job(PF(5) + (size_t)layer * D_ * FF, PF(4) + layer * D_, D_, FF, W_GU, D_, 1, rot, cgw, CNGW, scr, lane);
                      transpose_job(PF(6) + (size_t)layer * D_ * FF, PF(4) + layer * D_, D_, FF, W_GU, D_, 2, rot, cgw, CNGW, scr, lane);
                      transpose_job(PF(7) + (size_t)layer * FF * D_, nullptr, FF, D_, W_DN, FF, 0, rot, cgw, CNGW, scr, lane); }
                  if (cv & 2) { const int ml = op == OP_PREP ? layer : layer + 1, mk = ml % 3, mj = ml / 3;
                      if (mk == 0) {
                          transpose_job(PF(8) + (size_t)mj * D_ * 2 * RNN, PF(3) + ml * D_, D_, 2 * RNN, W_MIN, D_, 0, rot, cgw, CNGW, scr, lane);
                          transpose_job(PF(16) + (size_t)mj * RNN * D_, nullptr, RNN, D_, W_MOUT, RNN, 0, rot, cgw, CNGW, scr, lane);
#pragma unroll 1
                          for (int h = 0; h < 20; ++h) { const int hh = h % 10; const float* src = (h < 10 ? PF(11) : PF(13)) + ((size_t)mj * 10 + hh) * 16384;
                              transpose_job(src, nullptr, 128, 128, W_SM + (h < 10 ? 0 : 163840) + hh * 16384, 128, 0, rot, cgw, CNGW, scr, lane); }
                      } else if (mk == 1) {
                          transpose_job(PF(17), PF(3) + ml * D_, D_, 2608, W_MIN, D_, 0, rot, cgw, CNGW, scr, lane);
                          transpose_job(PF(23), nullptr, D_, D_, W_MOUT, D_, 0, rot, cgw, CNGW, scr, lane);
#pragma unroll 1
                          for (int kv = 0; kv < 2; ++kv) {
                              transpose_job(PF(19) + (size_t)kv * 2048 * 64, nullptr, 2048, 64, W_SM + (size_t)kv * 64 * 2048, 2048, 0, rot, cgw, CNGW, scr, lane);
                              transpose_job(PF(21) + (size_t)kv * 4096, nullptr, 64, 64, W_SM + 262144 + kv * 4096, 64, 0, rot, cgw, CNGW, scr, lane); }
                      } else {
                          transpose_job(PF(24), PF(3) + ml * D_, D_, 3088, W_MIN, D_, 0, rot, cgw, CNGW, scr, lane);
                          transpose_job(PF(28), nullptr, D_, D_, W_MOUT, D_, 0, rot, cgw, CNGW, scr, lane); } } } } }
        if (ph + 1 < a.ph_hi) { if (USE_XCD_BAR && ph != a.ph_lo) xcd_barrier(xbar); else grid.sync(); }
    }
}

#ifndef N_LAUNCH_MODE
#define N_LAUNCH_MODE 1
#endif
constexpr int N_PHASES = 27;

extern "C" void kernel_launch(void* const* d_in, const int* in_sizes, int n_in, void* d_out, int out_size, void* d_ws, size_t ws_size, hipStream_t stream) {
    static int grid = 0;
    if (grid == 0) {
        if (n_in != 29 || out_size != T_ * D_ || ws_size < WS_END) { fprintf(stderr, "kernel_launch: unexpected problem: n_in %d out %d ws %zu\n", n_in, out_size, ws_size); grid = -1; return; }
        int dev = 0, cus = 0, per_cu = 0;
        hipGetDevice(&dev); hipDeviceGetAttribute(&cus, hipDeviceAttributeMultiprocessorCount, dev);
        if (hipFuncSetAttribute((const void*)mega_fwd, hipFuncAttributeMaxDynamicSharedMemorySize, LDS_BYTES) != hipSuccess) { fprintf(stderr, "kernel_launch: hipFuncSetAttribute failed\n"); grid = -1; return; }
        if (hipOccupancyMaxActiveBlocksPerMultiprocessor(&per_cu, (const void*)mega_fwd, 512, LDS_BYTES) != hipSuccess || per_cu < 1) { fprintf(stderr, "kernel_launch: occupancy query says %d\n", per_cu); per_cu = 1; }
        (void)hipGetLastError();
        grid = cus * 1;
        fprintf(stderr, "kernel_launch: grid %d (cus %d, occupancy %d)\n", grid, cus, per_cu);
    }
    if (grid < 0) return;
    if (hipMemsetAsync((char*)d_ws + WS_CTL, 0, 16384, stream) != hipSuccess) { fprintf(stderr, "kernel_launch: memset failed\n"); return; }
    Args a{};
    const float** p = (const float**)&a;
    for (int i = 0; i < 29; ++i) p[i] = (const float*)d_in[i];
    a.out = (float*)d_out; a.ws = (unsigned char*)d_ws;
#if N_LAUNCH_MODE == 1
    a.ph_lo = 0; a.ph_hi = N_PHASES;
    void* args[] = {&a};
    hipError_t e = hipLaunchCooperativeKernel((const void*)mega_fwd, dim3(grid), dim3(512), args, LDS_BYTES, stream);
    if (e != hipSuccess) fprintf(stderr, "cooperative launch failed: %s (grid %d)\n", hipGetErrorString(e), grid);
#else
#ifndef REPEAT_PH
#define REPEAT_PH -1
#endif
#ifndef REPEAT_N
#define REPEAT_N 1
#endif
#ifndef RUN_UPTO
#define RUN_UPTO (N_PHASES - 1)
#endif
    for (int ph = 0; ph < N_PHASES; ++ph) { if (ph >= RUN_UPTO && ph != N_PHASES - 1) continue; a.ph_lo = ph; a.ph_hi = ph + 1; hipLaunchKernelGGL(mega_fwd, dim3(grid), dim3(512), LDS_BYTES, stream, a);
        for (int rep = 0; rep < REPEAT_N; ++rep) if (ph == REPEAT_PH) hipLaunchKernelGGL(mega_fwd, dim3(grid), dim3(512), LDS_BYTES, stream, a); }
#endif
}
```

```cpp
#include <hip/hip_runtime.h>
#include <hip/hip_cooperative_groups.h>
#include <cstdio>
#include <cstdint>
namespace cg = cooperative_groups;

#define LAS __attribute__((address_space(3)))
typedef unsigned short bf16_t;
typedef short bf16x8 __attribute__((ext_vector_type(8)));
typedef short s16x4 __attribute__((ext_vector_type(4)));
typedef float f32x4 __attribute__((ext_vector_type(4)));
typedef float f32x2 __attribute__((ext_vector_type(2)));
typedef unsigned u32x4 __attribute__((ext_vector_type(4)));
typedef unsigned u32x2 __attribute__((ext_vector_type(2)));
typedef __bf16 bf16x2_t __attribute__((ext_vector_type(2)));

constexpr int T_ = 16384, SEQ = 8192, D_ = 1024, FF = 2816, RNN = 1280;
constexpr int NSA_NPAD = 2816, GLA_NPAD = 3328;
constexpr float EPS = 1e-6f;
constexpr float LOG2E = 1.4426950408889634f;

constexpr size_t MiB = 1u << 20;
constexpr size_t WS_W_GU = 0, WS_W_DN = 11 * MiB, WS_W_MIN = 17 * MiB, WS_W_MOUT = 24 * MiB, WS_W_SMALL = 27 * MiB;
constexpr size_t WS_HN = 28 * MiB;
constexpr size_t WS_ACT = 60 * MiB;
constexpr size_t WS_LG = 60 * MiB, WS_LX = 100 * MiB, WS_LHL = 140 * MiB, WS_LAC = 180 * MiB, WS_LAGGA = 220 * MiB, WS_LAGGH = 221 * MiB;
constexpr size_t WS_NQ = 60 * MiB, WS_NKV = 92 * MiB, WS_NGT = 140 * MiB, WS_NKC = 143 * MiB, WS_NVC = 144 * MiB;
constexpr size_t WS_GQ = 60 * MiB, WS_GK = 76 * MiB, WS_GV = 92 * MiB, WS_GR = 124 * MiB, WS_GGL = 156 * MiB, WS_GDEC = 157 * MiB, WS_GKVT = 158 * MiB;
constexpr size_t WS_TQ = 223 * MiB, WS_CTL = 222 * MiB, WS_SSP = 222 * MiB + 65536, WS_NY = 148 * MiB, WS_NVT = 180 * MiB;
constexpr size_t WS_END = 224 * MiB;

constexpr int LDS_BYTES = 155648;

__device__ __forceinline__ unsigned pk2(float lo, float hi) { f32x2 v = {lo, hi}; bf16x2_t b = __builtin_convertvector(v, bf16x2_t); return __builtin_bit_cast(unsigned, b); }
__device__ __forceinline__ float bf2f(unsigned short h) { return __uint_as_float(((unsigned)h) << 16); }
__device__ __forceinline__ float bflo(unsigned w) { return __uint_as_float(w << 16); }
__device__ __forceinline__ float bfhi(unsigned w) { return __uint_as_float(w & 0xffff0000u); }
__device__ __forceinline__ float fast_rcp(float x) { return __builtin_amdgcn_rcpf(x); }
__device__ __forceinline__ float fast_exp2(float x) { return __builtin_amdgcn_exp2f(x); }
__device__ __forceinline__ float sigmoidf_(float x) { return fast_rcp(1.f + fast_exp2(-x * LOG2E)); }
__device__ __forceinline__ float siluf_(float x) { return x * sigmoidf_(x); }
__device__ __forceinline__ float gelu_tanh_(float x) { const float z = 0.7978845608028654f * (x + 0.044715f * x * x * x); return x * fast_rcp(1.f + fast_exp2(-2.f * LOG2E * z)); }
__device__ __forceinline__ float wave_sum(float v) {
#pragma unroll
    for (int o = 1; o < 64; o <<= 1) v += __shfl_xor(v, o);
    return v;
}
__device__ __forceinline__ float xmax16_32(float v) {
    auto r = __builtin_amdgcn_permlane16_swap(__float_as_uint(v), __float_as_uint(v), false, false); v = fmaxf(__uint_as_float(r[0]), __uint_as_float(r[1]));
    auto q = __builtin_amdgcn_permlane32_swap(__float_as_uint(v), __float_as_uint(v), false, false); return fmaxf(__uint_as_float(q[0]), __uint_as_float(q[1]));
}
__device__ __forceinline__ float xsum16_32(float v) {
    auto r = __builtin_amdgcn_permlane16_swap(__float_as_uint(v), __float_as_uint(v), false, false); v = __uint_as_float(r[0]) + __uint_as_float(r[1]);
    auto q = __builtin_amdgcn_permlane32_swap(__float_as_uint(v), __float_as_uint(v), false, false); return __uint_as_float(q[0]) + __uint_as_float(q[1]);
}
__device__ __forceinline__ float dpp_xor1(float v) { return __uint_as_float((unsigned)__builtin_amdgcn_update_dpp(0, (int)__float_as_uint(v), 0xB1, 0xF, 0xF, true)); }
__device__ __forceinline__ float dpp_xor2(float v) { return __uint_as_float((unsigned)__builtin_amdgcn_update_dpp(0, (int)__float_as_uint(v), 0x4E, 0xF, 0xF, true)); }
__device__ __forceinline__ float max3_(float a, float b, float c) { float r; asm("v_max3_f32 %0, %1, %2, %3" : "=v"(r) : "v"(a), "v"(b), "v"(c)); return r; }
namespace pg8 {
#define PG8_LAS __attribute__((address_space(3)))
typedef unsigned short bf16_t;
typedef short bf16x8 __attribute__((ext_vector_type(8)));
typedef float f32x4 __attribute__((ext_vector_type(4)));
typedef unsigned u32x4 __attribute__((ext_vector_type(4)));
constexpr int BM = 256, BK = 64, HALF = 128, HTB = HALF * BK * 2  , STAGE_BYTES = 8 * HTB, NXCD = 8, WGM = 8;

__host__ __device__ __forceinline__ int lds_byte(int r, int c) { const int st = (r >> 4) * 2 + (c >> 5), rr = r & 15, cc = c & 31, ob = rr * 64 + cc * 2; return st * 1024 + (ob ^ (((ob >> 9) & 1) << 5)); }
__host__ __device__ __forceinline__ void stage_rc(int b, int& R, int& C) { const int st = b / 1024, sb = b % 1024, swz = sb ^ (((sb >> 9) & 1) << 5); R = (st >> 1) * 16 + swz / 64; C = (st & 1) * 32 + (swz % 64) / 2; }
__host__ __device__ __forceinline__ int perm32(int rho) { const int n = rho >> 4, i = rho & 15; return 8 * (i >> 2) + 4 * n + (i & 3); }

struct Unit { int pm, pn; };
struct Gemm { const bf16_t* A; const bf16_t* Bt; int M, N, K; };

struct StaticOrder {
    int nM, nN, nwg, G, c;
    __host__ __device__ void init(int M, int N, int G_, int c_) { nM = M / BM; nN = N / BM; nwg = nM * nN; G = G_; c = c_; }
    __host__ __device__ bool next(int i, Unit& u) const {
        const long L = (long)i * G + c; if (L >= nwg) return false;
        int wgid = (int)L; { const int q = nwg / NXCD, r = nwg % NXCD, xcd = wgid % NXCD, off = wgid / NXCD; wgid = (xcd < r ? xcd * (q + 1) : r * (q + 1) + (xcd - r) * q) + off; }
        const int nig = WGM * nN, gid = wgid / nig, fm = gid * WGM, gsz = (nM - fm) < WGM ? (nM - fm) : WGM;
        u.pm = fm + ((wgid % nig) % gsz); u.pn = (wgid % nig) / gsz; return true;
    }
    __device__ __forceinline__ void a_ready(const Unit&) const {}
    __device__ __forceinline__ void done(const Unit&) const {}
};

struct EpiResid {
    static constexpr bool PERM = false, AFTER_DRAIN = false;
    bf16_t* hb; float* ssp; PG8_LAS float* red;
    __device__ __forceinline__ void operator()(const f32x4 (&acc)[2][2][4][2], const Unit& u, int wr, int wc, int fr, int fq) const {
        const int row0 = u.pm * BM + wr * 64 + fr, col0 = u.pn * BM + wc * 32 + 4 * fq;
#pragma unroll
        for (int ai = 0; ai < 2; ++ai)
#pragma unroll
            for (int m = 0; m < 4; ++m) { const size_t off = (size_t)(row0 + ai * HALF + m * 16) * 1024 + col0; float ss = 0.f;
#pragma unroll
                for (int bj = 0; bj < 2; ++bj)
#pragma unroll
                    for (int n = 0; n < 2; ++n) { const u32x2 b = *(const u32x2*)(hb + off + bj * HALF + n * 16); const f32x4 a = acc[ai][bj][m][n];
                        u32x2 w; w.x = ::pk2(::bflo(b.x) + a[0], ::bfhi(b.x) + a[1]); w.y = ::pk2(::bflo(b.y) + a[2], ::bfhi(b.y) + a[3]); *(u32x2*)(hb + off + bj * HALF + n * 16) = w;
                        const float h0 = ::bflo(w.x), h1 = ::bfhi(w.x), h2 = ::bflo(w.y), h3 = ::bfhi(w.y); ss += (h0 * h0 + h1 * h1) + (h2 * h2 + h3 * h3); }
                ss = ::xsum16_32(ss); if (fq == 0) red[(ai * HALF + wr * 64 + m * 16 + fr) * 4 + wc] = ss; }
        asm volatile("s_waitcnt lgkmcnt(0)" ::: "memory"); __builtin_amdgcn_s_barrier(); asm volatile("" ::: "memory");
        const int t = (wr * 4 + wc) * 64 + fq * 16 + fr;
        if (t < 256) { const f32x4 s = *(const PG8_LAS f32x4*)(red + t * 4); ssp[(size_t)(u.pm * BM + t) * 4 + u.pn] = (s[0] + s[1]) + (s[2] + s[3]); }
    }
};
__device__ __forceinline__ void load_rs(const float* ssp, int pm, int wr, int fr, float (&rs)[2][4]) {
#pragma unroll
    for (int ai = 0; ai < 2; ++ai)
#pragma unroll
        for (int m = 0; m < 4; ++m) { const int row = pm * BM + ai * HALF + wr * 64 + m * 16 + fr;
            const f32x4 s4 = *(const f32x4*)(ssp + (size_t)row * 4); const float s = (s4[0] + s4[1]) + (s4[2] + s4[3]); rs[ai][m] = __builtin_amdgcn_rsqf(s * (1.f / 1024.f) + 1e-6f); }
}
__device__ __forceinline__ u32x4 pack8(const f32x4 a, const f32x4 b) { u32x4 w; w.x = ::pk2(a[0], a[1]); w.y = ::pk2(a[2], a[3]); w.z = ::pk2(b[0], b[1]); w.w = ::pk2(b[2], b[3]); return w; }
struct EpiSwiglu {
    static constexpr bool PERM = true, AFTER_DRAIN = false;
    bf16_t* O; const float* ssp;
    __device__ __forceinline__ void operator()(const f32x4 (&acc)[2][2][4][2], const Unit& u, int wr, int wc, int fr, int fq) const {
        float rs[2][4]; load_rs(ssp, u.pm, wr, fr, rs);
        const int row0 = u.pm * BM + wr * 64 + fr, col0 = u.pn * HALF + wc * 32 + 8 * fq;
#pragma unroll
        for (int ai = 0; ai < 2; ++ai)
#pragma unroll
            for (int m = 0; m < 4; ++m) { f32x4 v[2];
#pragma unroll
                for (int n = 0; n < 2; ++n) { const f32x4 g = acc[ai][0][m][n], up = acc[ai][1][m][n];
#pragma unroll
                    for (int j = 0; j < 4; ++j) v[n][j] = ::siluf_(g[j] * rs[ai][m]) * (up[j] * rs[ai][m]); }
                *(u32x4*)(O + (size_t)(row0 + ai * HALF + m * 16) * FF + col0) = pack8(v[0], v[1]); }
    }
};
template <int ACT> __device__ __forceinline__ void store_tile_bf16(const f32x4 (&acc)[2][2][4][2], const float (&rs)[2][4], bf16_t* dst, int ldc, int cbase, float scale, int pm, int wr, int wc, int fr, int fq) {
    const int row0 = pm * BM + wr * 64 + fr, col0 = cbase + wc * 32 + 8 * fq;
#pragma unroll
    for (int ai = 0; ai < 2; ++ai)
#pragma unroll
        for (int m = 0; m < 4; ++m)
#pragma unroll
            for (int bj = 0; bj < 2; ++bj) { f32x4 v[2];
#pragma unroll
                for (int n = 0; n < 2; ++n)
#pragma unroll
                    for (int j = 0; j < 4; ++j) { const float x = acc[ai][bj][m][n][j] * rs[ai][m]; v[n][j] = ACT == 1 ? ::gelu_tanh_(x) : ACT == 2 ? ::siluf_(x) : x * scale; }
                *(u32x4*)(dst + (size_t)(row0 + ai * HALF + m * 16) * ldc + col0 + bj * HALF) = pack8(v[0], v[1]); }
}
template <int ACT> __device__ __forceinline__ void store_tile_f32_narrow(const f32x4 (&acc)[2][2][4][2], const float (&rs)[2][4], float* dst, int ldc, int ncols, int pm, int wr, int wc, int fr, int fq) {
    const int row0 = pm * BM + wr * 64 + fr;
#pragma unroll
    for (int ai = 0; ai < 2; ++ai)
#pragma unroll
        for (int m = 0; m < 4; ++m)
#pragma unroll
            for (int n = 0; n < 2; ++n) { const int c = wc * 32 + 8 * fq + 4 * n;
                if (c < ncols) { f32x4 v = acc[ai][0][m][n] * rs[ai][m];
                    if (ACT == 3) { v[0] = ::sigmoidf_(v[0]); v[1] = ::sigmoidf_(v[1]); v[2] = ::sigmoidf_(v[2]); v[3] = ::sigmoidf_(v[3]); }
                    *(f32x4*)(dst + (size_t)(row0 + ai * HALF + m * 16) * ldc + c) = v; } }
}
struct EpiLruIn {
    static constexpr bool PERM = true, AFTER_DRAIN = false;
    bf16_t* G; bf16_t* X; const float* ssp;
    __device__ __forceinline__ void operator()(const f32x4 (&acc)[2][2][4][2], const Unit& u, int wr, int wc, int fr, int fq) const {
        float rs[2][4]; load_rs(ssp, u.pm, wr, fr, rs);
        if (u.pn < 5) store_tile_bf16<1>(acc, rs, G, RNN, u.pn * BM, 1.f, u.pm, wr, wc, fr, fq);
        else store_tile_bf16<0>(acc, rs, X, RNN, (u.pn - 5) * BM, 1.f, u.pm, wr, wc, fr, fq);
    }
};
struct EpiNsaIn {
    static constexpr bool PERM = true, AFTER_DRAIN = false;
    bf16_t* Q; bf16_t* KV; float* GT; const float* ssp;
    __device__ __forceinline__ void operator()(const f32x4 (&acc)[2][2][4][2], const Unit& u, int wr, int wc, int fr, int fq) const {
        float rs[2][4]; load_rs(ssp, u.pm, wr, fr, rs);
        if (u.pn < 4) store_tile_bf16<0>(acc, rs, Q, 1024, u.pn * BM, 0.125f, u.pm, wr, wc, fr, fq);
        else if (u.pn < 10) store_tile_bf16<0>(acc, rs, KV + (size_t)(u.pn - 4) * T_ * 256, 256, 0, 1.f, u.pm, wr, wc, fr, fq);
        else store_tile_f32_narrow<3>(acc, rs, GT, 48, 48, u.pm, wr, wc, fr, fq);
    }
};
struct EpiGlaIn {
    static constexpr bool PERM = true, AFTER_DRAIN = false;
    bf16_t* Q; bf16_t* K; bf16_t* V; bf16_t* R; float* GL; const float* ssp;
    __device__ __forceinline__ void operator()(const f32x4 (&acc)[2][2][4][2], const Unit& u, int wr, int wc, int fr, int fq) const {
        float rs[2][4]; load_rs(ssp, u.pm, wr, fr, rs);
        if (u.pn < 2) store_tile_bf16<0>(acc, rs, Q, 512, u.pn * BM, 0.08838834764831845f, u.pm, wr, wc, fr, fq);
        else if (u.pn < 4) store_tile_bf16<0>(acc, rs, K, 512, (u.pn - 2) * BM, 1.f, u.pm, wr, wc, fr, fq);
        else if (u.pn < 8) store_tile_bf16<0>(acc, rs, V, 1024, (u.pn - 4) * BM, 1.f, u.pm, wr, wc, fr, fq);
        else if (u.pn < 12) store_tile_bf16<2>(acc, rs, R, 1024, (u.pn - 8) * BM, 1.f, u.pm, wr, wc, fr, fq);
        else store_tile_f32_narrow<0>(acc, rs, GL, 16, 16, u.pm, wr, wc, fr, fq);
    }
};
template <class Epi, class Sched, bool ALIGN_EPI = false, bool SP2 = false>
__device__ __forceinline__ void gemm_phase(PG8_LAS unsigned char* lds, const Gemm g, const Sched& S, const Epi& E, const int tid) {
    const int wid = __builtin_amdgcn_readfirstlane(tid >> 6), lane = tid & 63, wr = wid >> 2, wc = wid & 3, fr = lane & 15, fq = lane >> 4;
    const int K = g.K, nt = K / BK;
    unsigned voffA[2], voffB[2];
#pragma unroll
    for (int i = 0; i < 2; ++i) { int R, C; stage_rc(tid * 16 + i * 8192, R, C); const int Rb = Epi::PERM ? ((R & ~31) + perm32(R & 31)) : R;
        voffA[i] = (unsigned)(R * K + C) * 2u; voffB[i] = (unsigned)(Rb * K + C) * 2u; }
    const size_t kstep = (size_t)(BK * 2);
    const size_t hstep = (size_t)HALF * K * 2;
    const size_t tstep = 2 * hstep;
    const unsigned ldsw = (unsigned)wid * 1024u;
    const int aoff = lds_byte(wr * 64 + fr, fq * 8), boff = lds_byte(wc * 32 + fr, fq * 8);
#define PG8_SA(b, h) (((b) * 2 + (h)) * HTB)
#define PG8_SB(b, h) ((4 + (b) * 2 + (h)) * HTB)
#define PG8_STAGE(bufoff, gbase, voff) do { _Pragma("unroll") for (int _i = 0; _i < 2; ++_i) \
        __builtin_amdgcn_global_load_lds((const unsigned*)((const char*)(gbase) + (voff)[_i]), (PG8_LAS unsigned*)(lds + (bufoff) + ldsw + _i * 8192), 16, 0, 0); } while (0)
#define PG8_LDA(dst, b, h) do { _Pragma("unroll") for (int m = 0; m < 4; ++m) _Pragma("unroll") for (int k = 0; k < 2; ++k) dst[m][k] = *(const PG8_LAS bf16x8*)(lds + PG8_SA(b, h) + aoff + m * 2048 + k * 1024); } while (0)
#define PG8_LDB(dst, b, h) do { _Pragma("unroll") for (int n = 0; n < 2; ++n) _Pragma("unroll") for (int k = 0; k < 2; ++k) dst[n][k] = *(const PG8_LAS bf16x8*)(lds + PG8_SB(b, h) + boff + n * 2048 + k * 1024); } while (0)
#define PG8_MMA(ai, bj, At, Bt) do { __builtin_amdgcn_s_setprio(1); _Pragma("unroll") for (int m = 0; m < 4; ++m) _Pragma("unroll") for (int n = 0; n < 2; ++n) _Pragma("unroll") for (int k = 0; k < 2; ++k) \
        acc[ai][bj][m][n] = __builtin_amdgcn_mfma_f32_16x16x32_bf16(Bt[n][k], At[m][k], acc[ai][bj][m][n], 0, 0, 0); __builtin_amdgcn_s_setprio(0); } while (0)
#define PG8_WAIT_V(n) asm volatile("s_waitcnt vmcnt(" #n ")" ::: "memory")
#define PG8_WAIT_L(n) asm volatile("s_waitcnt lgkmcnt(" #n ")" ::: "memory")
#define PG8_BAR __builtin_amdgcn_s_barrier()
#define PG8_SCHED __builtin_amdgcn_sched_barrier(0)
    Unit cur, nxt; int ui = 0;
    if (!S.next(0, cur)) return;
    f32x4 acc[2][2][4][2];
#pragma unroll
    for (int a = 0; a < 2; ++a)
#pragma unroll
        for (int b = 0; b < 2; ++b)
#pragma unroll
            for (int m = 0; m < 4; ++m)
#pragma unroll
                for (int n = 0; n < 2; ++n) acc[a][b][m][n] = (f32x4){0.f, 0.f, 0.f, 0.f};
    bf16x8 At[4][2], B0[2][2], B1[2][2];
    const char* cA = (const char*)g.A + (size_t)cur.pm * tstep; const char* cB = (const char*)g.Bt + (size_t)cur.pn * tstep;
    S.a_ready(cur);
    if constexpr (SP2) {
        PG8_STAGE(PG8_SB(0, 0), cB, voffB); PG8_STAGE(PG8_SB(0, 1), cB + hstep, voffB); PG8_STAGE(PG8_SA(0, 0), cA, voffA); PG8_STAGE(PG8_SA(0, 1), cA + hstep, voffA);
        if (wr == 1) PG8_BAR;
        PG8_WAIT_V(2); PG8_BAR;
        PG8_STAGE(PG8_SB(1, 0), cB + kstep, voffB); PG8_STAGE(PG8_SA(1, 0), cA + kstep, voffA); PG8_STAGE(PG8_SB(1, 1), cB + hstep + kstep, voffB);
        PG8_WAIT_V(6); PG8_BAR;
    } else {
        PG8_STAGE(PG8_SB(0, 0), cB, voffB); PG8_STAGE(PG8_SA(0, 0), cA, voffA); PG8_STAGE(PG8_SB(0, 1), cB + hstep, voffB); PG8_STAGE(PG8_SA(0, 1), cA + hstep, voffA);
        if (wr == 1) PG8_BAR;
        PG8_WAIT_V(4); PG8_BAR;
        PG8_STAGE(PG8_SB(1, 0), cB + kstep, voffB); PG8_STAGE(PG8_SA(1, 0), cA + kstep, voffA); PG8_STAGE(PG8_SB(1, 1), cB + hstep + kstep, voffB);
        PG8_WAIT_V(6); PG8_BAR;
    }
    for (;;) {
        const bool has_next = S.next(ui + 1, nxt);
        const char* nA = has_next ? (const char*)g.A + (size_t)nxt.pm * tstep : cA; const char* nB = has_next ? (const char*)g.Bt + (size_t)nxt.pn * tstep : cB;
        for (int t = 0; t < nt; t += 2) {
            const bool last = (t == nt - 2);
            const char* a1 = cA + (size_t)(t + 1) * kstep;
            const char* a2 = last ? nA : cA + (size_t)(t + 2) * kstep; const char* b2 = last ? nB : cB + (size_t)(t + 2) * kstep;
            const char* a3 = a2 + kstep; const char* b3 = b2 + kstep;
            if (last && has_next) S.a_ready(nxt);
            if constexpr (SP2) {
            PG8_LDB(B0, 0, 0); PG8_LDB(B1, 0, 1); PG8_SCHED; PG8_LDA(At, 0, 0); PG8_STAGE(PG8_SA(1, 1), a1 + hstep, voffA);
            PG8_WAIT_V(8); PG8_WAIT_L(0); PG8_BAR; PG8_MMA(0, 0, At, B0); PG8_MMA(0, 1, At, B1); PG8_BAR; PG8_SCHED;
            PG8_LDA(At, 0, 1); PG8_STAGE(PG8_SB(0, 0), b2, voffB); PG8_STAGE(PG8_SB(0, 1), b2 + hstep, voffB); PG8_STAGE(PG8_SA(0, 0), a2, voffA);
            PG8_WAIT_V(8); PG8_WAIT_L(0); PG8_BAR; PG8_MMA(1, 0, At, B0); PG8_MMA(1, 1, At, B1); PG8_BAR; PG8_SCHED;
            PG8_LDB(B0, 1, 0); PG8_LDB(B1, 1, 1); PG8_SCHED; PG8_LDA(At, 1, 0); PG8_STAGE(PG8_SA(0, 1), a2 + hstep, voffA);
            PG8_WAIT_V(8); PG8_WAIT_L(0); PG8_BAR; PG8_MMA(0, 0, At, B0); PG8_MMA(0, 1, At, B1); PG8_BAR; PG8_SCHED;
            PG8_LDA(At, 1, 1); PG8_STAGE(PG8_SB(1, 0), b3, voffB); PG8_STAGE(PG8_SB(1, 1), b3 + hstep, voffB); PG8_STAGE(PG8_SA(1, 0), a3, voffA);
            PG8_WAIT_V(8); PG8_WAIT_L(0); PG8_BAR; PG8_MMA(1, 0, At, B0); PG8_MMA(1, 1, At, B1); PG8_BAR; PG8_SCHED;
            } else {
            PG8_LDB(B0, 0, 0); PG8_SCHED; PG8_LDA(At, 0, 0); PG8_STAGE(PG8_SA(1, 1), a1 + hstep, voffA);
            PG8_WAIT_L(8); PG8_BAR; PG8_WAIT_L(0); PG8_MMA(0, 0, At, B0); PG8_BAR; PG8_SCHED;
            PG8_LDB(B1, 0, 1); PG8_STAGE(PG8_SB(0, 0), b2, voffB);
            PG8_BAR; PG8_WAIT_L(0); PG8_MMA(0, 1, At, B1); PG8_BAR;
            PG8_LDA(At, 0, 1); PG8_STAGE(PG8_SA(0, 0), a2, voffA);
            PG8_BAR; PG8_WAIT_L(0); PG8_MMA(1, 0, At, B0); PG8_BAR; PG8_SCHED;
            PG8_STAGE(PG8_SB(0, 1), b2 + hstep, voffB);
            PG8_WAIT_V(6); PG8_BAR; PG8_MMA(1, 1, At, B1); PG8_BAR;
            PG8_LDB(B0, 1, 0); PG8_SCHED; PG8_LDA(At, 1, 0); PG8_STAGE(PG8_SA(0, 1), a2 + hstep, voffA);
            PG8_WAIT_L(8); PG8_BAR; PG8_WAIT_L(0); PG8_MMA(0, 0, At, B0); PG8_BAR; PG8_SCHED;
            PG8_LDB(B1, 1, 1); PG8_STAGE(PG8_SB(1, 0), b3, voffB);
            PG8_BAR; PG8_WAIT_L(0); PG8_MMA(0, 1, At, B1); PG8_BAR;
            PG8_LDA(At, 1, 1); PG8_STAGE(PG8_SA(1, 0), a3, voffA);
            PG8_BAR; PG8_WAIT_L(0); PG8_MMA(1, 0, At, B0); PG8_BAR; PG8_SCHED;
            PG8_STAGE(PG8_SB(1, 1), b3 + hstep, voffB);
            PG8_WAIT_V(6); PG8_BAR; PG8_MMA(1, 1, At, B1); PG8_BAR;
            }
        }
        if constexpr (ALIGN_EPI) { if (wr == 0) PG8_BAR; }
        if constexpr (!Epi::AFTER_DRAIN) { E(acc, cur, wr, wc, fr, fq); S.done(cur); }
        if (!has_next) break;
#pragma unroll
        for (int a = 0; a < 2; ++a)
#pragma unroll
            for (int b = 0; b < 2; ++b)
#pragma unroll
                for (int m = 0; m < 4; ++m)
#pragma unroll
                    for (int n = 0; n < 2; ++n) acc[a][b][m][n] = (f32x4){0.f, 0.f, 0.f, 0.f};
        cur = nxt; cA = nA; cB = nB; ++ui;
        if constexpr (ALIGN_EPI) { if (wr == 1) PG8_BAR; }
    }
    PG8_WAIT_V(0);
    if constexpr (!ALIGN_EPI) { if (wr == 0) PG8_BAR; }
    PG8_BAR;
    if constexpr (Epi::AFTER_DRAIN) { E.fused(acc, cur, wr, wc, fr, fq, lds, wid, lane); S.done(cur); }
#undef PG8_SA
#undef PG8_SB
#undef PG8_STAGE
#undef PG8_LDA
#undef PG8_LDB
#undef PG8_MMA
#undef PG8_WAIT_V
#undef PG8_WAIT_L
#undef PG8_BAR
#undef PG8_SCHED
}
}
__device__ __forceinline__ void transpose_item(const float* __restrict__ W, const float* __restrict__ gk, int ldw, int N, int k0, int n0, bf16_t* WT, int ldt, int dst_row0, LAS float* scr, int lane) {
    const int nn = n0 + (lane & 31); const bool ok = nn < N;
    float wv[32];
#pragma unroll
    for (int i = 0; i < 32; ++i) { const int kk = 2 * i + (lane >> 5); wv[i] = ok ? W[(size_t)(k0 + kk) * ldw + nn] : 0.f; }
#pragma unroll
    for (int i = 0; i < 32; ++i) { const int kk = 2 * i + (lane >> 5); scr[kk * 33 + (lane & 31)] = gk ? wv[i] * gk[k0 + kk] : wv[i]; }
    asm volatile("s_waitcnt lgkmcnt(0)" ::: "memory");
    const int c = lane & 7;
#pragma unroll
    for (int j = 0; j < 4; ++j) { const int n = (lane >> 3) + 8 * j; const LAS float* s = scr + (8 * c) * 33 + n;
        u32x4 o; o.x = pk2(s[0 * 33], s[1 * 33]); o.y = pk2(s[2 * 33], s[3 * 33]); o.z = pk2(s[4 * 33], s[5 * 33]); o.w = pk2(s[6 * 33], s[7 * 33]);
        *(u32x4*)(WT + (size_t)(dst_row0 + n) * ldt + k0 + 8 * c) = o; }
    asm volatile("s_waitcnt lgkmcnt(0)" ::: "memory");
}
__device__ __forceinline__ void transpose_job(const float* W, const float* gk, int K, int N, bf16_t* WT, int ldt, int mode, int& rot, int gw, int NGW, LAS float* scr, int lane) {
    const int nnb = (N + 31) >> 5, nit = (K >> 6) * nnb;
    int start = gw - rot; if (start < 0) start += NGW;
    for (int it = start; it < nit; it += NGW) {
        const int kb = it / nnb, nb = it - kb * nnb, n0 = nb << 5;
        const int dr = mode == 0 ? n0 : ((n0 >> 7) * 256 + (n0 & 127) + (mode == 2 ? 128 : 0));
        transpose_item(W, gk, N, N, kb << 6, n0, WT, ldt, dr, scr, lane);
    }
    rot = (rot + nit) % NGW;
}
__device__ __forceinline__ void init_stream_bf16(const float* src, bf16_t* dst, float* ssp, int gw, int NGW, int lane) {
    for (int m = gw; m < T_; m += NGW) {
        const f32x4* xr = (const f32x4*)(src + (size_t)m * D_) + lane;
        u32x2 o[4]; float s = 0.f;
#pragma unroll
        for (int j = 0; j < 4; ++j) { const f32x4 v = xr[64 * j]; o[j].x = pk2(v.x, v.y); o[j].y = pk2(v.z, v.w);
            const float a = bflo(o[j].x), b = bfhi(o[j].x), c = bflo(o[j].y), d = bfhi(o[j].y); s += (a * a + b * b) + (c * c + d * d); }
        const float st = wave_sum(s); if (lane < 4) ssp[(size_t)m * 4 + lane] = lane == 0 ? st : 0.f;
        u32x2* o8 = (u32x2*)(dst + (size_t)m * D_) + lane;
#pragma unroll
        for (int j = 0; j < 4; ++j) o8[64 * j] = o[j];
    }
}
__device__ __forceinline__ void final_norm_rows(const bf16_t* hb, const float* __restrict__ g, float* out, int gw, int NGW, int lane) {
    f32x4 gv[4];
#pragma unroll
    for (int j = 0; j < 4; ++j) gv[j] = *(const f32x4*)(g + 4 * lane + 256 * j);
    for (int m = gw; m < T_; m += NGW) {
        const u32x2* hr = (const u32x2*)(hb + (size_t)m * D_) + lane;
        f32x4 v[4]; float s = 0.f;
#pragma unroll
        for (int j = 0; j < 4; ++j) { const u32x2 w = hr[64 * j]; v[j] = (f32x4){bflo(w.x), bfhi(w.x), bflo(w.y), bfhi(w.y)}; s += (v[j].x * v[j].x + v[j].y * v[j].y) + (v[j].z * v[j].z + v[j].w * v[j].w); }
        const float rs = 1.0f / sqrtf(wave_sum(s) * (1.f / D_) + EPS);
        f32x4* xr = (f32x4*)(out + (size_t)m * D_) + lane;
#pragma unroll
        for (int j = 0; j < 4; ++j) xr[64 * j] = v[j] * rs * gv[j];
    }
}
__device__ __forceinline__ f32x4 mfma16(bf16x8 a, bf16x8 b, f32x4 c) { return __builtin_amdgcn_mfma_f32_16x16x32_bf16(a, b, c, 0, 0, 0); }
__device__ __forceinline__ void unpack8(const u32x4 w, float (&f)[8]) { f[0] = bflo(w.x); f[1] = bfhi(w.x); f[2] = bflo(w.y); f[3] = bfhi(w.y); f[4] = bflo(w.z); f[5] = bfhi(w.z); f[6] = bflo(w.w); f[7] = bfhi(w.w); }
__device__ __forceinline__ u32x4 pack8f(const float (&f)[8]) { u32x4 w; w.x = pk2(f[0], f[1]); w.y = pk2(f[2], f[3]); w.z = pk2(f[4], f[5]); w.w = pk2(f[6], f[7]); return w; }

__device__ __forceinline__ float neg_expm1(float x) {
    const float p = 1.f + x * (0.5f + x * (0.16666667f + x * (0.041666668f + x * (0.0083333338f + x * 0.0013888889f))));
    const float big = 1.f - fast_exp2(x * LOG2E);
    return x > -0.3f ? -x * p : big;
}
__device__ __forceinline__ void lru_gates_phase(LAS unsigned char* lds, const bf16_t* X, const float* __restrict__ conv_w, const float* __restrict__ conv_b,
        const bf16_t* WAT, const bf16_t* WXT, const float* __restrict__ b_a, const float* __restrict__ b_x, const float* __restrict__ lam,
        bf16_t* HL, bf16_t* AC, float* AGGA, float* AGGH, const int tid, const int bid, const int G) {
    const int lane = tid & 63, wid = __builtin_amdgcn_readfirstlane(tid >> 6), fr = lane & 15, fq = lane >> 4;
    constexpr int SA = 0, SBA = 34816, SBX = 69632, SAF = 0, SUF = 67584, SAGG = 135168, LDA_ = 272, LDF = 528;
    for (int u = bid; u < 1280; u += G) {
        const int tt = u / 10, hd = u - tt * 10, m0 = tt * 128, cbase = hd * 128;
        { const int c8 = tid & 15, r = tid >> 4, ch = cbase + 8 * c8;
          float cw[4][8], cb[8];
#pragma unroll
          for (int k = 0; k < 4; ++k) { const f32x4 w0 = *(const f32x4*)(conv_w + k * RNN + ch), w1 = *(const f32x4*)(conv_w + k * RNN + ch + 4);
              cw[k][0] = w0[0]; cw[k][1] = w0[1]; cw[k][2] = w0[2]; cw[k][3] = w0[3]; cw[k][4] = w1[0]; cw[k][5] = w1[1]; cw[k][6] = w1[2]; cw[k][7] = w1[3]; }
          { const f32x4 w0 = *(const f32x4*)(conv_b + ch), w1 = *(const f32x4*)(conv_b + ch + 4); cb[0] = w0[0]; cb[1] = w0[1]; cb[2] = w0[2]; cb[3] = w0[3]; cb[4] = w1[0]; cb[5] = w1[1]; cb[6] = w1[2]; cb[7] = w1[3]; }
#pragma unroll
          for (int g = 0; g < 4; ++g) { const int row = r + 32 * g, m = m0 + row, ts = m & (SEQ - 1);
              float acc[8];
#pragma unroll
              for (int e = 0; e < 8; ++e) acc[e] = cb[e];
#pragma unroll
              for (int k = 0; k < 4; ++k) { const bool okk = ts - 3 + k >= 0;
                  const u32x4 xv = *(const u32x4*)(X + (size_t)(okk ? m - 3 + k : m) * RNN + ch); float xf[8]; unpack8(xv, xf); const float zk = okk ? 1.f : 0.f;
#pragma unroll
                  for (int e = 0; e < 8; ++e) acc[e] += cw[k][e] * (xf[e] * zk); }
              *(LAS u32x4*)(lds + SA + row * LDA_ + c8 * 16) = pack8f(acc); } }
#pragma unroll
        for (int i = 0; i < 8; ++i) { const int q = tid + 512 * i, mat = q >> 11, j = (q >> 4) & 127, c = q & 15;
            const u32x4 v = *(const u32x4*)((mat ? WXT : WAT) + hd * 16384 + j * 128 + c * 8);
            *(LAS u32x4*)(lds + (mat ? SBX : SBA) + j * LDA_ + c * 16) = v; }
        __syncthreads();
        const int rg = wid >> 1, chh = wid & 1;
        f32x4 acca[2][4], accx[2][4];
#pragma unroll
        for (int mt = 0; mt < 2; ++mt)
#pragma unroll
            for (int nt = 0; nt < 4; ++nt) { acca[mt][nt] = (f32x4){0.f, 0.f, 0.f, 0.f}; accx[mt][nt] = (f32x4){0.f, 0.f, 0.f, 0.f}; }
#pragma unroll
        for (int s = 0; s < 4; ++s) { bf16x8 af[2];
#pragma unroll
            for (int mt = 0; mt < 2; ++mt) af[mt] = *(const LAS bf16x8*)(lds + SA + (32 * rg + 16 * mt + fr) * LDA_ + (32 * s + 8 * fq) * 2);
#pragma unroll
            for (int nt = 0; nt < 4; ++nt) { const bf16x8 ba = *(const LAS bf16x8*)(lds + SBA + (64 * chh + 16 * nt + fr) * LDA_ + (32 * s + 8 * fq) * 2);
                const bf16x8 bx = *(const LAS bf16x8*)(lds + SBX + (64 * chh + 16 * nt + fr) * LDA_ + (32 * s + 8 * fq) * 2);
#pragma unroll
                for (int mt = 0; mt < 2; ++mt) { acca[mt][nt] = mfma16(ba, af[mt], acca[mt][nt]); accx[mt][nt] = mfma16(bx, af[mt], accx[mt][nt]); } } }
        u32x2 xcv[2][4];
#pragma unroll
        for (int mt = 0; mt < 2; ++mt)
#pragma unroll
            for (int nt = 0; nt < 4; ++nt) xcv[mt][nt] = *(const LAS u32x2*)(lds + SA + (32 * rg + 16 * mt + fr) * LDA_ + (64 * chh + 16 * nt + 4 * fq) * 2);
        __syncthreads();
#pragma unroll
        for (int nt = 0; nt < 4; ++nt) { const int cc = cbase + 64 * chh + 16 * nt + 4 * fq;
            const f32x4 ba4 = *(const f32x4*)(b_a + cc), bx4 = *(const f32x4*)(b_x + cc), lm4 = *(const f32x4*)(lam + cc);
            f32x4 nl8;
#pragma unroll
            for (int j = 0; j < 4; ++j) nl8[j] = -8.f * 0.6931471805599453f * __builtin_amdgcn_logf(1.f + fast_exp2(-lm4[j] * LOG2E));
#pragma unroll
            for (int mt = 0; mt < 2; ++mt) { const float xc4[4] = {bflo(xcv[mt][nt].x), bfhi(xcv[mt][nt].x), bflo(xcv[mt][nt].y), bfhi(xcv[mt][nt].y)};
                f32x4 a4, u4;
#pragma unroll
                for (int j = 0; j < 4; ++j) { const float r = sigmoidf_(acca[mt][nt][j] + ba4[j]), ig = sigmoidf_(accx[mt][nt][j] + bx4[j]);
                    const float la = nl8[j] * r; a4[j] = fast_exp2(la * LOG2E); u4[j] = __builtin_amdgcn_sqrtf(neg_expm1(2.f * la)) * ig * xc4[j]; }
                const int off = (32 * rg + 16 * mt + fr) * LDF + (64 * chh + 16 * nt + 4 * fq) * 4;
                *(LAS f32x4*)(lds + SAF + off) = a4; *(LAS f32x4*)(lds + SUF + off) = u4; } }
        __syncthreads();
        { const int ch = tid & 127, seg = tid >> 7;
          LAS float* pa = (LAS float*)(lds + SAF) + ch; LAS float* pu = (LAS float*)(lds + SUF) + ch; LAS float* ag = (LAS float*)(lds + SAGG);
          float A = 1.f, H = 0.f;
#pragma unroll 8
          for (int t = seg * 32; t < seg * 32 + 32; ++t) { const float a = pa[t * (LDF / 4)], uu = pu[t * (LDF / 4)]; H = a * H + uu; A *= a; }
          ag[seg * 128 + ch] = A; ag[512 + seg * 128 + ch] = H;
          __syncthreads();
          float cA = 1.f, cH = 0.f;
          for (int s = 0; s < seg; ++s) { const float As = ag[s * 128 + ch], Hs = ag[512 + s * 128 + ch]; cH = As * cH + Hs; cA *= As; }
#pragma unroll 8
          for (int t = seg * 32; t < seg * 32 + 32; ++t) { const float a = pa[t * (LDF / 4)], uu = pu[t * (LDF / 4)]; cH = a * cH + uu; cA *= a; pa[t * (LDF / 4)] = cA; pu[t * (LDF / 4)] = cH; }
          if (seg == 3) { AGGA[(size_t)tt * RNN + cbase + ch] = cA; AGGH[(size_t)tt * RNN + cbase + ch] = cH; } }
        __syncthreads();
#pragma unroll
        for (int i = 0; i < 4; ++i) { const int q = tid + 512 * i, row = q >> 4, c8 = q & 15;
            const f32x4 a0 = *(const LAS f32x4*)(lds + SAF + row * LDF + c8 * 32), a1 = *(const LAS f32x4*)(lds + SAF + row * LDF + c8 * 32 + 16);
            const f32x4 h0 = *(const LAS f32x4*)(lds + SUF + row * LDF + c8 * 32), h1 = *(const LAS f32x4*)(lds + SUF + row * LDF + c8 * 32 + 16);
            u32x4 wa, wh; wa.x = pk2(a0[0], a0[1]); wa.y = pk2(a0[2], a0[3]); wa.z = pk2(a1[0], a1[1]); wa.w = pk2(a1[2], a1[3]);
            wh.x = pk2(h0[0], h0[1]); wh.y = pk2(h0[2], h0[3]); wh.z = pk2(h1[0], h1[1]); wh.w = pk2(h1[2], h1[3]);
            const size_t go = (size_t)(m0 + row) * RNN + cbase + 8 * c8;
            *(u32x4*)(AC + go) = wa; *(u32x4*)(HL + go) = wh; }
        __syncthreads();
    }
}
__device__ __forceinline__ void lru_apply_phase(bf16_t* GB, const bf16_t* HL, const bf16_t* AC, const float* AGGA, const float* AGGH, const int tid, const int bid, const int G) {
    const int c8 = tid & 31, r = tid >> 5;
    for (int u = bid; u < 640; u += G) {
        const int tt = u / 5, cb = u - tt * 5, m0 = tt * 128, ch = cb * 256 + 8 * c8;
        float carry[8];
#pragma unroll
        for (int e = 0; e < 8; ++e) carry[e] = 0.f;
        { const int p0 = tt & ~63; int p = p0;
          for (; p + 8 <= tt; p += 8) { f32x4 a0[8], a1[8], h0[8], h1[8];
#pragma unroll
              for (int q = 0; q < 8; ++q) { const size_t o = (size_t)(p + q) * RNN + ch; a0[q] = *(const f32x4*)(AGGA + o); a1[q] = *(const f32x4*)(AGGA + o + 4); h0[q] = *(const f32x4*)(AGGH + o); h1[q] = *(const f32x4*)(AGGH + o + 4); }
#pragma unroll
              for (int q = 0; q < 8; ++q)
#pragma unroll
                  for (int e = 0; e < 4; ++e) { carry[e] = carry[e] * a0[q][e] + h0[q][e]; carry[4 + e] = carry[4 + e] * a1[q][e] + h1[q][e]; } }
          for (; p < tt; ++p) { const size_t o = (size_t)p * RNN + ch; const f32x4 a0 = *(const f32x4*)(AGGA + o), a1 = *(const f32x4*)(AGGA + o + 4), h0 = *(const f32x4*)(AGGH + o), h1 = *(const f32x4*)(AGGH + o + 4);
#pragma unroll
              for (int e = 0; e < 4; ++e) { carry[e] = carry[e] * a0[e] + h0[e]; carry[4 + e] = carry[4 + e] * a1[e] + h1[e]; } } }
#pragma unroll
        for (int i = 0; i < 8; ++i) { const size_t go = (size_t)(m0 + r + 16 * i) * RNN + ch;
            float g[8], hl[8], ac[8], y[8]; unpack8(*(const u32x4*)(GB + go), g); unpack8(*(const u32x4*)(HL + go), hl); unpack8(*(const u32x4*)(AC + go), ac);
#pragma unroll
            for (int e = 0; e < 8; ++e) y[e] = g[e] * (hl[e] + ac[e] * carry[e]);
            *(u32x4*)(GB + go) = pack8f(y); }
    }
}
__device__ __forceinline__ s16x4 tr_read(const LAS unsigned char* p) { typedef short v4i16_t __attribute__((ext_vector_type(4))); return __builtin_bit_cast(s16x4, __builtin_amdgcn_ds_read_tr16_b64_v4i16((LAS v4i16_t*)p)); }
__device__ __forceinline__ bf16x8 cat44(s16x4 lo, s16x4 hi) { return (bf16x8){lo[0], lo[1], lo[2], lo[3], hi[0], hi[1], hi[2], hi[3]}; }
__device__ __forceinline__ void gla_cum(LAS unsigned char* lds, const float* GL, const float* __restrict__ w_g2, const float* __restrict__ b_g2, int m0, int h, const int tid, const int bid, const int G) {

    LAS float* sGL = (LAS float*)lds; LAS float* sSeg = (LAS float*)(lds + 4096); LAS float* sB = (LAS float*)(lds + 8192);
    if (tid < 256) *(LAS f32x4*)(sGL + tid * 4) = *(const f32x4*)(GL + (size_t)m0 * 16 + tid * 4);
    const int d = tid & 127, tq = tid >> 7, dch = h * 128 + d;
    float w[16];
#pragma unroll
    for (int r = 0; r < 16; ++r) w[r] = w_g2[r * 512 + dch];
    const float bb = b_g2[dch];
    __syncthreads();
    float run = 0.f;
#pragma unroll 4
    for (int i = 0; i < 16; ++i) { const int t = tq * 16 + i; float z = bb;
#pragma unroll
        for (int r4 = 0; r4 < 4; ++r4) { const f32x4 gv = *(const LAS f32x4*)(sGL + t * 16 + r4 * 4); z += gv[0] * w[r4 * 4] + gv[1] * w[r4 * 4 + 1] + gv[2] * w[r4 * 4 + 2] + gv[3] * w[r4 * 4 + 3]; }
        const float la = -(__builtin_amdgcn_logf(1.f + fast_exp2(-fabsf(z) * LOG2E)) * 0.6931471805599453f + fmaxf(-z, 0.f)) * 0.0625f;
        run += la; sB[t * 128 + d] = run; }
    sSeg[tq * 128 + d] = run;
    __syncthreads();
    float pre = 0.f;
    for (int s = 0; s < tq; ++s) pre += sSeg[s * 128 + d];
#pragma unroll 4
    for (int i = 0; i < 16; ++i) sB[(tq * 16 + i) * 128 + d] += pre;
    __syncthreads();
}
__device__ __forceinline__ void gla_kv_phase(LAS unsigned char* lds, const bf16_t* Kg, const bf16_t* Vg, const float* GL, const float* w_g2, const float* b_g2, bf16_t* KVT, float* DEC, const int tid, const int bid, const int G) {
    const int lane = tid & 63, wid = __builtin_amdgcn_readfirstlane(tid >> 6), fr = lane & 15, fq = lane >> 4, q4 = (lane & 15) >> 2, p4 = lane & 3;
    constexpr int SB_ = 8192, SK = 40960, SV = 58368, LDK = 272, LDV = 528;
    const LAS float* sB = (const LAS float*)(lds + SB_);
    for (int u = bid; u < 1024; u += G) {
        const int b = u >> 9, n = (u >> 2) & 127, h = u & 3, m0 = b * SEQ + 64 * n, bh = b * 4 + h;
        gla_cum(lds, GL, w_g2, b_g2, m0, h, tid, bid, G);
#pragma unroll
        for (int i = 0; i < 2; ++i) { const int q = tid + 512 * i, t = q >> 4, c = q & 15; float kf[8]; unpack8(*(const u32x4*)(Kg + (size_t)(m0 + t) * 512 + h * 128 + 8 * c), kf);
#pragma unroll
            for (int e = 0; e < 8; ++e) kf[e] *= fast_exp2((sB[63 * 128 + 8 * c + e] - sB[t * 128 + 8 * c + e]) * LOG2E);
            *(LAS u32x4*)(lds + SK + t * LDK + c * 16) = pack8f(kf); }
        if (tid < 128) DEC[((size_t)bh * 128 + n) * 128 + tid] = fast_exp2(sB[63 * 128 + tid] * LOG2E);
#pragma unroll
        for (int i = 0; i < 4; ++i) { const int q = tid + 512 * i, t = q >> 5, c = q & 31; *(LAS u32x4*)(lds + SV + t * LDV + c * 16) = *(const u32x4*)(Vg + (size_t)(m0 + t) * 1024 + h * 256 + 8 * c); }
        __syncthreads();
        f32x4 acc[8][2];
#pragma unroll
        for (int mt = 0; mt < 8; ++mt) { acc[mt][0] = (f32x4){0.f, 0.f, 0.f, 0.f}; acc[mt][1] = (f32x4){0.f, 0.f, 0.f, 0.f}; }
#pragma unroll
        for (int s = 0; s < 2; ++s) { bf16x8 bv[2];
#pragma unroll
            for (int nl = 0; nl < 2; ++nl) { const LAS unsigned char* pv = lds + SV + (32 * s + 8 * fq + q4) * LDV + (32 * wid + 16 * nl + 4 * p4) * 2; bv[nl] = cat44(tr_read(pv), tr_read(pv + 4 * LDV)); }
#pragma unroll
            for (int mt = 0; mt < 8; ++mt) { const LAS unsigned char* pk = lds + SK + (32 * s + 8 * fq + q4) * LDK + (16 * mt + 4 * p4) * 2; const bf16x8 ak = cat44(tr_read(pk), tr_read(pk + 4 * LDK));
                acc[mt][0] = mfma16(ak, bv[0], acc[mt][0]); acc[mt][1] = mfma16(ak, bv[1], acc[mt][1]); } }
        bf16_t* dst = KVT + ((size_t)bh * 128 + n) * 32768;
#pragma unroll
        for (int mt = 0; mt < 8; ++mt)
#pragma unroll
            for (int nl = 0; nl < 2; ++nl) { u32x2 w; w.x = pk2(acc[mt][nl][0], acc[mt][nl][1]); w.y = pk2(acc[mt][nl][2], acc[mt][nl][3]);
                *(u32x2*)(dst + (32 * wid + 16 * nl + fr) * 128 + 16 * mt + 4 * fq) = w; }
        __syncthreads();
    }
}
__device__ __forceinline__ void gla_scan_phase(bf16_t* KVT, const float* DEC, const int tid, const int bid, const int G) {
    const int nthr = G * 512;
    for (int e2 = bid * 512 + tid; e2 < 8 * 16384; e2 += nthr) {
        const int bh = e2 >> 14, e = (e2 & 16383) * 2, dk = e & 127;
        unsigned* p = (unsigned*)(KVT + (size_t)bh * 128 * 32768 + e); const float* dp = DEC + (size_t)bh * 128 * 128 + dk;
        float s0 = 0.f, s1 = 0.f;
        for (int n0 = 0; n0 < 128; n0 += 8) { unsigned w[8]; f32x2 d2[8];
#pragma unroll
            for (int i = 0; i < 8; ++i) { w[i] = p[(size_t)(n0 + i) * 16384]; d2[i] = *(const f32x2*)(dp + (n0 + i) * 128); }
#pragma unroll
            for (int i = 0; i < 8; ++i) { p[(size_t)(n0 + i) * 16384] = pk2(s0, s1); s0 = s0 * d2[i].x + bflo(w[i]); s1 = s1 * d2[i].y + bfhi(w[i]); } }
    }
}
__device__ __forceinline__ void gla_out_phase(LAS unsigned char* lds, const bf16_t* Qg, const bf16_t* Kg, const bf16_t* Vg, const bf16_t* Rg, const float* GL, const float* w_g2, const float* b_g2,
        const float* __restrict__ norm_g, const bf16_t* KVT, bf16_t* Y, const int tid, const int bid, const int G) {
    const int lane = tid & 63, wid = __builtin_amdgcn_readfirstlane(tid >> 6), fr = lane & 15, fq = lane >> 4, q4 = (lane & 15) >> 2, p4 = lane & 3;
    constexpr int SB_ = 8192, SQ = 40960, SKI = 58368, SV = 75776, SATT = 109568, SSS = 118784, LDQ = 272, LDV = 528, LDAT = 144;
    const LAS float* sB = (const LAS float*)(lds + SB_);
    for (int u = bid; u < 1024; u += G) {
        const int b = u >> 9, n = (u >> 2) & 127, h = u & 3, m0 = b * SEQ + 64 * n, bh = b * 4 + h;
        bf16x8 bsall[4][2];
        { const bf16_t* Sp = KVT + ((size_t)bh * 128 + n) * 32768;
#pragma unroll
          for (int s = 0; s < 4; ++s)
#pragma unroll
              for (int nl = 0; nl < 2; ++nl) bsall[s][nl] = *(const bf16x8*)(Sp + (32 * wid + 16 * nl + fr) * 128 + 32 * s + 8 * fq); }
        gla_cum(lds, GL, w_g2, b_g2, m0, h, tid, bid, G);
#pragma unroll
        for (int i = 0; i < 2; ++i) { const int q = tid + 512 * i, t = q >> 4, c = q & 15; float qf[8], kf[8];
            unpack8(*(const u32x4*)(Qg + (size_t)(m0 + t) * 512 + h * 128 + 8 * c), qf); unpack8(*(const u32x4*)(Kg + (size_t)(m0 + t) * 512 + h * 128 + 8 * c), kf);
#pragma unroll
            for (int e = 0; e < 8; ++e) { const float bb = sB[t * 128 + 8 * c + e] * LOG2E; qf[e] *= fast_exp2(bb); kf[e] *= fast_exp2(-bb); }
            *(LAS u32x4*)(lds + SQ + t * LDQ + c * 16) = pack8f(qf); *(LAS u32x4*)(lds + SKI + t * LDQ + c * 16) = pack8f(kf); }
#pragma unroll
        for (int i = 0; i < 4; ++i) { const int q = tid + 512 * i, t = q >> 5, c = q & 31; *(LAS u32x4*)(lds + SV + t * LDV + c * 16) = *(const u32x4*)(Vg + (size_t)(m0 + t) * 1024 + h * 256 + 8 * c); }
        __syncthreads();
        { const int mt = wid >> 1; f32x4 at[2] = {(f32x4){0.f, 0.f, 0.f, 0.f}, (f32x4){0.f, 0.f, 0.f, 0.f}};
#pragma unroll
          for (int s = 0; s < 4; ++s) { const bf16x8 a = *(const LAS bf16x8*)(lds + SQ + (16 * mt + fr) * LDQ + (32 * s + 8 * fq) * 2);
#pragma unroll
              for (int nl = 0; nl < 2; ++nl) { const int nt = 2 * (wid & 1) + nl; const bf16x8 bk = *(const LAS bf16x8*)(lds + SKI + (16 * nt + fr) * LDQ + (32 * s + 8 * fq) * 2); at[nl] = mfma16(bk, a, at[nl]); } }
#pragma unroll
          for (int nl = 0; nl < 2; ++nl) { const int nt = 2 * (wid & 1) + nl, c = 16 * mt + fr, j0 = 16 * nt + 4 * fq; float v[4];
#pragma unroll
              for (int j = 0; j < 4; ++j) v[j] = (j0 + j <= c) ? at[nl][j] : 0.f;
              u32x2 w; w.x = pk2(v[0], v[1]); w.y = pk2(v[2], v[3]); *(LAS u32x2*)(lds + SATT + c * LDAT + j0 * 2) = w; } }
        __syncthreads();
        f32x4 o[4][2];
#pragma unroll
        for (int mt = 0; mt < 4; ++mt) { o[mt][0] = (f32x4){0.f, 0.f, 0.f, 0.f}; o[mt][1] = (f32x4){0.f, 0.f, 0.f, 0.f}; }
#pragma unroll
        for (int s = 0; s < 2; ++s) { bf16x8 bv[2];
#pragma unroll
            for (int nl = 0; nl < 2; ++nl) { const LAS unsigned char* pv = lds + SV + (32 * s + 8 * fq + q4) * LDV + (32 * wid + 16 * nl + 4 * p4) * 2; bv[nl] = cat44(tr_read(pv), tr_read(pv + 4 * LDV)); }
#pragma unroll
            for (int mt = 0; mt < 4; ++mt) { const bf16x8 a = *(const LAS bf16x8*)(lds + SATT + (16 * mt + fr) * LDAT + (32 * s + 8 * fq) * 2);
                o[mt][0] = mfma16(bv[0], a, o[mt][0]); o[mt][1] = mfma16(bv[1], a, o[mt][1]); } }
#pragma unroll
        for (int s = 0; s < 4; ++s) {
#pragma unroll
            for (int mt = 0; mt < 4; ++mt) { const bf16x8 a = *(const LAS bf16x8*)(lds + SQ + (16 * mt + fr) * LDQ + (32 * s + 8 * fq) * 2);
                o[mt][0] = mfma16(bsall[s][0], a, o[mt][0]); o[mt][1] = mfma16(bsall[s][1], a, o[mt][1]); } }
        LAS float* sSS = (LAS float*)(lds + SSS);
#pragma unroll
        for (int mt = 0; mt < 4; ++mt) { float ss = 0.f;
#pragma unroll
            for (int nl = 0; nl < 2; ++nl)
#pragma unroll
                for (int j = 0; j < 4; ++j) ss += o[mt][nl][j] * o[mt][nl][j];
            ss += __shfl_xor(ss, 16); ss += __shfl_xor(ss, 32);
            if (fq == 0) sSS[(16 * mt + fr) * 8 + wid] = ss; }
        __syncthreads();
#pragma unroll
        for (int mt = 0; mt < 4; ++mt) { const int tok = 16 * mt + fr; const f32x4 s0 = *(const LAS f32x4*)(sSS + tok * 8), s1 = *(const LAS f32x4*)(sSS + tok * 8 + 4);
            const float tot = ((s0[0] + s0[1]) + (s0[2] + s0[3])) + ((s1[0] + s1[1]) + (s1[2] + s1[3])); const float rs = __builtin_amdgcn_rsqf(tot * (1.f / 256.f) + EPS);
#pragma unroll
            for (int nl = 0; nl < 2; ++nl) { const int dv = 32 * wid + 16 * nl + 4 * fq; const f32x4 gn = *(const f32x4*)(norm_g + dv);
                const size_t go = (size_t)(m0 + tok) * 1024 + h * 256 + dv; const u32x2 rv = *(const u32x2*)(Rg + go);
                u32x2 w; w.x = pk2(o[mt][nl][0] * rs * gn[0] * bflo(rv.x), o[mt][nl][1] * rs * gn[1] * bfhi(rv.x)); w.y = pk2(o[mt][nl][2] * rs * gn[2] * bflo(rv.y), o[mt][nl][3] * rs * gn[3] * bfhi(rv.y));
                *(u32x2*)(Y + go) = w; } }
        __syncthreads();
    }
}
__device__ __forceinline__ void nsa_compress_phase(LAS unsigned char* lds, const bf16_t* KV, const float* __restrict__ pos, const float* __restrict__ w1, const float* __restrict__ b1,
        const float* __restrict__ b2, const bf16_t* W1T, const bf16_t* W2T, bf16_t* KC, bf16_t* VC, bf16_t* VT, const int tid, const int bid, const int G) {
    const int lane = tid & 63, wid = __builtin_amdgcn_readfirstlane(tid >> 6), fr = lane & 15, fq = lane >> 4;
    constexpr int SP = 0, SB1 = 2048, SPART = 4096, SH = 36864, LDH = 144;
    for (int u = bid; u < 256; u += G) {
        const int kv = u >> 7, b = (u >> 6) & 1, g = (u >> 4) & 3, n0 = (u & 15) * 32;
        { const int j = tid & 63, part = tid >> 6; float s = 0.f; const float* pw = w1 + (size_t)kv * 2048 * 64 + j; const float* pp = pos + kv * 2048;
          for (int kk = part * 256; kk < part * 256 + 256; ++kk) s += pp[kk] * pw[(size_t)kk * 64];
          ((LAS float*)(lds + SP))[part * 64 + j] = s; }
        __syncthreads();
        if (tid < 64) { float s = b1[kv * 64 + tid];
#pragma unroll
            for (int p = 0; p < 8; ++p) s += ((LAS float*)(lds + SP))[p * 64 + tid];
            ((LAS float*)(lds + SB1))[tid] = s; }
        { const int rt = wid & 1, kq = wid >> 1, n = n0 + 16 * rt + fr; const bool ok = n <= 510;
          const bf16_t* src = KV + (size_t)kv * T_ * 256 + (size_t)(b * SEQ + 16 * (ok ? n : 0)) * 256 + g * 64;
          const bf16_t* wt = W1T + (size_t)kv * 64 * 2048;
          f32x4 acc[4] = {(f32x4){0.f, 0.f, 0.f, 0.f}, (f32x4){0.f, 0.f, 0.f, 0.f}, (f32x4){0.f, 0.f, 0.f, 0.f}, (f32x4){0.f, 0.f, 0.f, 0.f}};
#pragma unroll 4
          for (int s = 0; s < 16; ++s) { const int kk = kq * 512 + 32 * s + 8 * fq, l = kk >> 6, d = kk & 63;
              bf16x8 a = *(const bf16x8*)(src + (size_t)l * 256 + d); if (!ok) a = (bf16x8){0, 0, 0, 0, 0, 0, 0, 0};
#pragma unroll
              for (int nt = 0; nt < 4; ++nt) { const bf16x8 bb = *(const bf16x8*)(wt + (size_t)(16 * nt + fr) * 2048 + kk); acc[nt] = mfma16(bb, a, acc[nt]); } }
#pragma unroll
          for (int nt = 0; nt < 4; ++nt) *(LAS f32x4*)(lds + SPART + ((kq * 2 + rt) * 1024 + fr * 64 + 16 * nt + 4 * fq) * 4) = acc[nt]; }
        __syncthreads();
        { const int row = tid >> 4, c4 = (tid & 15) * 4, rt = row >> 4, rr = row & 15; f32x4 s = *(const LAS f32x4*)(lds + SB1 + c4 * 4);
#pragma unroll
          for (int kq = 0; kq < 4; ++kq) s += *(const LAS f32x4*)(lds + SPART + ((kq * 2 + rt) * 1024 + rr * 64 + c4) * 4);
          u32x2 w; w.x = pk2(gelu_tanh_(s[0]), gelu_tanh_(s[1])); w.y = pk2(gelu_tanh_(s[2]), gelu_tanh_(s[3])); *(LAS u32x2*)(lds + SH + row * LDH + c4 * 2) = w; }
        __syncthreads();
        { const int rt = wid >> 2, nt = wid & 3; f32x4 acc = (f32x4){0.f, 0.f, 0.f, 0.f};
#pragma unroll
          for (int s = 0; s < 2; ++s) { const bf16x8 a = *(const LAS bf16x8*)(lds + SH + (16 * rt + fr) * LDH + (32 * s + 8 * fq) * 2);
              const bf16x8 bb = *(const bf16x8*)(W2T + kv * 4096 + (16 * nt + fr) * 64 + 32 * s + 8 * fq); acc = mfma16(bb, a, acc); }
          const int n = n0 + 16 * rt + fr, d = 16 * nt + 4 * fq; const f32x4 bv = *(const f32x4*)(b2 + kv * 64 + d);
          u32x2 w; w.x = pk2(acc[0] + bv[0], acc[1] + bv[1]); w.y = pk2(acc[2] + bv[2], acc[3] + bv[3]);
          *(u32x2*)((kv ? VC : KC) + ((size_t)(b * 4 + g) * 512 + n) * 64 + d) = w; }
        __syncthreads();
    }
    { const bf16_t* VS = KV + (size_t)3 * T_ * 256;
      for (int tt = bid; tt < T_ / 64; tt += G) { const int r0 = tt * 64, bb = r0 >> 13, t0 = r0 & 8191;
#pragma unroll
          for (int i = 0; i < 4; ++i) { const int q = tid + 512 * i, row = q >> 5, ch = q & 31; *(LAS u32x4*)(lds + row * 528 + ch * 16) = *(const u32x4*)(VS + (size_t)(r0 + row) * 256 + ch * 8); }
          __syncthreads();
          { const int cc = tid >> 1, hf = tid & 1; unsigned short v[32];
#pragma unroll
            for (int k = 0; k < 32; ++k) v[k] = *(const LAS unsigned short*)(lds + (hf * 32 + k) * 528 + cc * 2);
            bf16_t* dst = VT + ((size_t)(bb * 256 + cc)) * 8192 + t0 + hf * 32;
#pragma unroll
            for (int k = 0; k < 4; ++k) { u32x4 w; w.x = v[8 * k] | ((unsigned)v[8 * k + 1] << 16); w.y = v[8 * k + 2] | ((unsigned)v[8 * k + 3] << 16); w.z = v[8 * k + 4] | ((unsigned)v[8 * k + 5] << 16); w.w = v[8 * k + 6] | ((unsigned)v[8 * k + 7] << 16);
                *(u32x4*)(dst + 8 * k) = w; } }
          __syncthreads(); } }
}
#ifndef NSA_LOCKSTEP
#define NSA_LOCKSTEP 0
#endif
#ifndef NSA_ONE_WAVE
#define NSA_ONE_WAVE 0
#endif
#ifndef NSA_SPARSE_SKIP
#define NSA_SPARSE_SKIP 0
#endif
#ifndef NSA_CT3_ONLY
#define NSA_CT3_ONLY 0
#endif
#ifndef NSA_SEL_REP
#define NSA_SEL_REP 1
#endif
#ifndef NSA_WIN_REP
#define NSA_WIN_REP 1
#endif
struct NsaSt { float m, l; f32x4 o[4]; };
struct KVRegs { u32x4 k[2], v[2]; };
template <int MODE, int STEP, int CTM>
__device__ __forceinline__ void nsa_tile(const LAS unsigned char* sK, const LAS unsigned char* sV, const bf16x8 (&qf)[2][2], NsaSt (&st)[2], const int (&dbase)[2],
        const bool general, const bool (&colsel)[2], const LAS float* bt, const float bfar, const float (&minv)[2], LAS float* sMain, LAS float* sSpill, const int (&tokl)[2], const int mg0,
        const int fr_in, const int fq_in, const int q4_in, const int p4_in) {
    constexpr int LDT = 144; const float NEG = -INFINITY;
    int fr = fr_in, fq = fq_in, q4 = q4_in, p4 = p4_in; asm volatile("" : "+v"(fr), "+v"(fq), "+v"(q4), "+v"(p4));
    bf16x8 kf[4][2];
#pragma unroll
    for (int kt = 0; kt < 4; ++kt) { kf[kt][0] = *(const LAS bf16x8*)(sK + (16 * kt + fr) * LDT + (8 * fq) * 2); kf[kt][1] = *(const LAS bf16x8*)(sK + (16 * kt + fr) * LDT + (32 + 8 * fq) * 2); }
    f32x4 sacc[2][4];
#pragma unroll
    for (int ct = 0; ct < 2; ++ct) if (CTM & (1 << ct)) {
#pragma unroll
        for (int kt = 0; kt < 4; ++kt) sacc[ct][kt] = mfma16(kf[kt][0], qf[ct][0], (f32x4){0.f, 0.f, 0.f, 0.f});
#pragma unroll
        for (int kt = 0; kt < 4; ++kt) sacc[ct][kt] = mfma16(kf[kt][1], qf[ct][1], sacc[ct][kt]); }
#pragma unroll
    for (int ct = 0; ct < 2; ++ct) if (CTM & (1 << ct)) {
        float tmax = NEG;
        if (general) {
            float bv[4][4];
#pragma unroll
            for (int kt = 0; kt < 4; ++kt)
#pragma unroll
                for (int j = 0; j < 4; ++j) { const int dist = dbase[ct] - (16 * kt + 4 * fq + j) * STEP; const int idx = dist < 0 ? 0 : (dist > 128 ? 128 : dist); bv[kt][j] = bt[idx]; }
#pragma unroll
            for (int kt = 0; kt < 4; ++kt)
#pragma unroll
                for (int j = 0; j < 4; ++j) { const int dist = dbase[ct] - (16 * kt + 4 * fq + j) * STEP; bool valid = dist >= 0;
                    if (MODE == 3) valid = valid && dist < 512;
                    if (MODE == 2) valid = valid && colsel[ct];
                    const float x = valid ? sacc[ct][kt][j] * LOG2E + bv[kt][j] : NEG;
                    sacc[ct][kt][j] = x; tmax = max3_(tmax, x, x); }
        } else {
#pragma unroll
            for (int kt = 0; kt < 4; ++kt) tmax = max3_(max3_(tmax, sacc[ct][kt][0], sacc[ct][kt][1]), sacc[ct][kt][2], sacc[ct][kt][3]);
            tmax = (MODE == 2 && !colsel[ct]) ? NEG : tmax * LOG2E + bfar;
        }
        if (MODE == 1) {
            const float mm = st[ct].m, li = minv[ct];
#pragma unroll
            for (int kt = 0; kt < 4; ++kt) { float gs = 0.f, p3 = 0.f;
#pragma unroll
                for (int j = 0; j < 4; ++j) { const float xx = general ? sacc[ct][kt][j] : sacc[ct][kt][j] * LOG2E + bfar; const float p = fast_exp2(xx - mm) * li; sacc[ct][kt][j] = p; gs += p; if (j == 3) p3 = p; }
                gs += dpp_xor1(gs); gs += dpp_xor2(gs); p3 += dpp_xor1(p3); p3 += dpp_xor2(p3);
                const int mg = mg0 + 4 * kt + fq;
                if ((fr & 3) == 0) { sMain[tokl[ct] * 128 + mg] = gs; if (mg + 1 < 128) sSpill[tokl[ct] * 128 + mg + 1] = p3; } }
        } else {
            const float rm = xmax16_32(tmax);
            const bool need = rm > st[ct].m + 8.f;
            if (__any(need)) { const float mnew = need ? fmaxf(st[ct].m, rm) : st[ct].m, alpha = (st[ct].m == mnew) ? 1.f : fast_exp2(st[ct].m - mnew);
                st[ct].l *= alpha; st[ct].m = mnew;
                if (MODE != 0) {
#pragma unroll
                    for (int dt = 0; dt < 4; ++dt) st[ct].o[dt] = st[ct].o[dt] * alpha; } }
            const float mref = (st[ct].m == NEG) ? 0.f : st[ct].m;
            float ps = 0.f;
            if (general) {
#pragma unroll
                for (int kt = 0; kt < 4; ++kt)
#pragma unroll
                    for (int j = 0; j < 4; ++j) { const float p = fast_exp2(sacc[ct][kt][j] - mref); sacc[ct][kt][j] = p; ps += p; }
            } else { const float c = (MODE == 2 && !colsel[ct]) ? NEG : bfar - mref;
#pragma unroll
                for (int kt = 0; kt < 4; ++kt)
#pragma unroll
                    for (int j = 0; j < 4; ++j) { const float p = fast_exp2(sacc[ct][kt][j] * LOG2E + c); sacc[ct][kt][j] = p; ps += p; } }
            st[ct].l += ps;
        }
    }
    if (MODE != 0) {
#pragma unroll
        for (int s = 0; s < 2; ++s) { bf16x8 pf[2];
#pragma unroll
            for (int ct = 0; ct < 2; ++ct) if (CTM & (1 << ct)) { u32x4 w; w.x = pk2(sacc[ct][2 * s][0], sacc[ct][2 * s][1]); w.y = pk2(sacc[ct][2 * s][2], sacc[ct][2 * s][3]);
                w.z = pk2(sacc[ct][2 * s + 1][0], sacc[ct][2 * s + 1][1]); w.w = pk2(sacc[ct][2 * s + 1][2], sacc[ct][2 * s + 1][3]); pf[ct] = __builtin_bit_cast(bf16x8, w); }
#pragma unroll
            for (int dt = 0; dt < 4; ++dt) { const LAS unsigned char* pv = sV + (32 * s + 4 * fq + q4) * LDT + (16 * dt + 4 * p4) * 2; const bf16x8 vf = cat44(tr_read(pv), tr_read(pv + 16 * LDT));
#pragma unroll
                for (int ct = 0; ct < 2; ++ct) if (CTM & (1 << ct)) st[ct].o[dt] = mfma16(vf, pf[ct], st[ct].o[dt]); } }
    }
}
__device__ __forceinline__ void nsa_ld2(const bf16_t* Kp, const bf16_t* Vp, size_t ts, int ld, bool two, int tid, KVRegs& r) { const int key = tid >> 3, c = tid & 7;
    r.k[0] = *(const u32x4*)(Kp + (size_t)key * ld + 8 * c); r.v[0] = *(const u32x4*)(Vp + (size_t)key * ld + 8 * c);
    if (two) { r.k[1] = *(const u32x4*)(Kp + ts + (size_t)key * ld + 8 * c); r.v[1] = *(const u32x4*)(Vp + ts + (size_t)key * ld + 8 * c); } }
__device__ __forceinline__ void nsa_st2(LAS unsigned char* sK, LAS unsigned char* sV, int tid, const KVRegs& r) { const int key = tid >> 3, c = tid & 7;
    *(LAS u32x4*)(sK + key * 144 + c * 16) = r.k[0]; *(LAS u32x4*)(sV + key * 144 + c * 16) = r.v[0]; *(LAS u32x4*)(sK + 9216 + key * 144 + c * 16) = r.k[1]; *(LAS u32x4*)(sV + 9216 + key * 144 + c * 16) = r.v[1]; }

__device__ __forceinline__ unsigned long long fx_enc(float x) { const float t = x * 16.f, fl = floorf(t); const int hi = (int)fl; const unsigned lo = (unsigned)((t - fl) * 4294967296.f);
    return ((unsigned long long)(unsigned)hi << 32) | (unsigned long long)lo; }
__device__ __forceinline__ float fx_dec(unsigned long long v) { return (float)(int)(unsigned)(v >> 32) * 0.0625f + (float)(unsigned)v * 1.4551915228366852e-11f; }
__device__ __forceinline__ void nsa_sparse_far(const LAS unsigned* sSel, LAS int* slist, const LAS float* sBt, const LAS float* mref, LAS unsigned long long* lfar, LAS unsigned long long* ofar,
        const bf16_t* Qg  , const bf16_t* ksb, const bf16_t* vtb  , const int qb, const int wid, const int lane_in, const int fr_in, const int fq_in) {
    const float NEG = -INFINITY;
#pragma unroll 1
    for (int m = 1 + wid; m <= qb - 3; m += 8) {
        int fr = fr_in, fq = fq_in, lane = lane_in; asm volatile("" : "+v"(fr), "+v"(fq), "+v"(lane));
        const int hg = fr & 3; const float bfar = sBt[hg * 132 + 128];
        bf16x8 kf[4][2], vf[2][4];
#pragma unroll
        for (int kt = 0; kt < 4; ++kt)
#pragma unroll
            for (int s = 0; s < 2; ++s) kf[kt][s] = *(const bf16x8*)(ksb + (size_t)(64 * m + 16 * kt + fr) * 256 + 32 * s + 8 * fq);
#pragma unroll
        for (int s = 0; s < 2; ++s)
#pragma unroll
            for (int dt = 0; dt < 4; ++dt) { const bf16_t* pv = vtb + (size_t)(16 * dt + fr) * SEQ + 64 * m + 32 * s + 4 * fq;
                const u32x2 lo = *(const u32x2*)pv, hi = *(const u32x2*)(pv + 16); u32x4 w; w.x = lo.x; w.y = lo.y; w.z = hi.x; w.w = hi.y; vf[s][dt] = __builtin_bit_cast(bf16x8, w); }
        const unsigned w = sSel[lane * 4 + (m >> 5)]; const bool bit = (w >> (m & 31)) & 1u;
        const unsigned long long B = __ballot(bit); const int n = __popcll(B);
        const int rank = (int)__builtin_amdgcn_mbcnt_hi((unsigned)(B >> 32), __builtin_amdgcn_mbcnt_lo((unsigned)B, 0u));
        if (bit) slist[rank] = lane;
        asm volatile("s_waitcnt lgkmcnt(0)" ::: "memory");
        const int nct = (n + 3) >> 2;
#pragma unroll 1
        for (int ct = 0; ct < nct; ++ct) {
            const int idx = 4 * ct + (fr >> 2); const bool valid = idx < n; const int tok = slist[valid ? idx : 0], col = tok * 4 + hg;
            const bf16x8 q0 = *(const bf16x8*)(Qg + (size_t)tok * 1024 + hg * 64 + 8 * fq), q1 = *(const bf16x8*)(Qg + (size_t)tok * 1024 + hg * 64 + 32 + 8 * fq);
            const float c = valid ? bfar - mref[col] : NEG;
            f32x4 sacc[4];
#pragma unroll
            for (int kt = 0; kt < 4; ++kt) sacc[kt] = mfma16(kf[kt][0], q0, (f32x4){0.f, 0.f, 0.f, 0.f});
#pragma unroll
            for (int kt = 0; kt < 4; ++kt) sacc[kt] = mfma16(kf[kt][1], q1, sacc[kt]);
            float ps = 0.f;
#pragma unroll
            for (int kt = 0; kt < 4; ++kt)
#pragma unroll
                for (int j = 0; j < 4; ++j) { const float p = fminf(fast_exp2(sacc[kt][j] * LOG2E + c), 16384.f); sacc[kt][j] = p; ps += p; }
            ps = xsum16_32(ps);
            if (fq == 0 && valid) (void)__hip_atomic_fetch_add(lfar + col, fx_enc(ps), __ATOMIC_RELAXED, __HIP_MEMORY_SCOPE_WORKGROUP);
            f32x4 oacc[4] = {(f32x4){0.f, 0.f, 0.f, 0.f}, (f32x4){0.f, 0.f, 0.f, 0.f}, (f32x4){0.f, 0.f, 0.f, 0.f}, (f32x4){0.f, 0.f, 0.f, 0.f}};
#pragma unroll
            for (int s = 0; s < 2; ++s) { u32x4 pw; pw.x = pk2(sacc[2 * s][0], sacc[2 * s][1]); pw.y = pk2(sacc[2 * s][2], sacc[2 * s][3]); pw.z = pk2(sacc[2 * s + 1][0], sacc[2 * s + 1][1]); pw.w = pk2(sacc[2 * s + 1][2], sacc[2 * s + 1][3]);
                const bf16x8 pf = __builtin_bit_cast(bf16x8, pw);
#pragma unroll
                for (int dt = 0; dt < 4; ++dt) oacc[dt] = mfma16(vf[s][dt], pf, oacc[dt]); }
            if (valid) {
#pragma unroll
                for (int dt = 0; dt < 4; ++dt)
#pragma unroll
                    for (int j = 0; j < 4; ++j) (void)__hip_atomic_fetch_add(ofar + col * 66 + 16 * dt + 4 * fq + j, fx_enc(oacc[dt][j]), __ATOMIC_RELAXED, __HIP_MEMORY_SCOPE_WORKGROUP); }
        }
        asm volatile("s_waitcnt lgkmcnt(0)" ::: "memory");
    }
}

#ifndef NSA_SPARSE_QB
#define NSA_SPARSE_QB 24
#endif
__device__ __forceinline__ void nsa_attn_phase(LAS unsigned char* lds, const bf16_t* Q, const bf16_t* KV, const float* GT, const bf16_t* KC, const bf16_t* VC, const float* __restrict__ rel_bias, bf16_t* Y, const bf16_t* VT, void* TQ, const int tid, const int bid, const int G) {
    const int lane = tid & 63, wid = __builtin_amdgcn_readfirstlane(tid >> 6), fr = lane & 15, fq = lane >> 4, q4 = (lane & 15) >> 2, p4 = lane & 3, hg = fr & 3;
    constexpr int SKO = 0, SVO = 36864, SMAIN = 73728, SSPILL = 106496, SBT = 143360, SSEL = 145472, SMREF = 146496, SLFAR = 147520, SLIST = 149568, TB = 9216;
    LAS float* sMain = (LAS float*)(lds + SMAIN); LAS float* sSpill = (LAS float*)(lds + SSPILL); LAS float* sBt = (LAS float*)(lds + SBT); LAS unsigned* sSel = (LAS unsigned*)(lds + SSEL);
    LAS float* sMref = (LAS float*)(lds + SMREF); LAS unsigned long long* sLfar = (LAS unsigned long long*)(lds + SLFAR); LAS unsigned long long* sOfar = (LAS unsigned long long*)lds;
    const float NEG = -INFINITY; (void)TQ;
    for (int ui = 0; ; ++ui) {
        int bg, qb;
        if (G == 256) { if (ui >= 4) break; const int c = bid, s = c >> 3; bg = c & 7; qb = ui == 0 ? s : ui == 1 ? 63 - s : ui == 2 ? 64 + s : 127 - s; }
        else { const int uu = bid + ui * G; if (uu >= 1024) break; bg = uu >> 7; qb = uu & 127; }
        const int b = bg >> 2, g = bg & 3, t0 = 64 * qb, m0 = b * SEQ + t0;
        int tokl[2]; tokl[0] = 8 * wid + (fr >> 2); tokl[1] = tokl[0] + 4;
        bf16x8 qf[2][2];
#pragma unroll
        for (int ct = 0; ct < 2; ++ct)
#pragma unroll
            for (int s = 0; s < 2; ++s) qf[ct][s] = *(const bf16x8*)(Q + (size_t)(m0 + tokl[ct]) * 1024 + (g * 4 + hg) * 64 + 32 * s + 8 * fq);
        for (int i = tid; i < 4 * 129; i += 512) { const int h = i / 129, dist = i - h * 129; int bk;
            if (dist < 16) bk = dist; else { bk = 16 + (int)(logf((float)dist * (1.f / 16.f)) / 2.0794415416798357f * 16.f); bk = bk > 31 ? 31 : bk; }
            sBt[h * 132 + dist] = rel_bias[bk * 16 + g * 4 + h] * LOG2E; }
#pragma unroll
        for (int i = 0; i < 4; ++i) { *(LAS f32x4*)(lds + SMAIN + (tid + 512 * i) * 16) = (f32x4){0.f, 0.f, 0.f, 0.f}; *(LAS f32x4*)(lds + SSPILL + (tid + 512 * i) * 16) = (f32x4){0.f, 0.f, 0.f, 0.f}; }
        __syncthreads();
        const LAS float* bt = sBt + hg * 132; const float bfar = bt[128];
        const float* gtp = GT + (size_t)(m0 + tokl[0]) * 48 + (g * 4 + hg) * 3;
        bf16_t* yp = Y + (size_t)(m0 + tokl[0]) * 1024 + (g * 4 + hg) * 64 + 4 * fq;
        NsaSt st[2]; bool act[2] = {true, true}; bool colsel[2] = {true, true}; int dbase[2]; float minv[2] = {1.f, 1.f};
        KVRegs kvr; kvr.k[1] = (u32x4){0u, 0u, 0u, 0u}; kvr.v[1] = (u32x4){0u, 0u, 0u, 0u};
        int mg0 = 0; bool general = true;
#define NSA_RUN(MODE, STEP, NT, TM, KB, VB, TS, LD, SETUP) do { const int nt_ = (NT), nst_ = (nt_ + 1) >> 1; \
        { const int ti = 0; const int j0_ = (TM); const int ti1_ = 1; int j1_ = 0; { const int ti = ti1_; j1_ = (TM); } (void)ti; \
          nsa_ld2((KB) + (size_t)j0_ * (TS), (VB) + (size_t)j0_ * (TS), (size_t)(j1_ - j0_) * (TS), (LD), nt_ >= 2, tid, kvr); } \
        nsa_st2(lds + SKO, lds + SVO, tid, kvr); __syncthreads(); \
        _Pragma("unroll 1") for (int s_ = 0; s_ < nst_; ++s_) { const int sb_ = s_ & 1; \
            if (s_ + 1 < nst_) { int ja_ = 0, jb_ = 0; { const int ti = 2 * s_ + 2; ja_ = (TM); } { const int ti = 2 * s_ + 3; jb_ = (TM); } \
                nsa_ld2((KB) + (size_t)ja_ * (TS), (VB) + (size_t)ja_ * (TS), (size_t)(jb_ - ja_) * (TS), (LD), 2 * s_ + 3 < nt_, tid, kvr); } \
            _Pragma("unroll") for (int h_ = 0; h_ < 2; ++h_) { const int ti = 2 * s_ + h_; if (ti < nt_) { SETUP; \
                const LAS unsigned char* sk_ = lds + SKO + (sb_ * 2 + h_) * TB; const LAS unsigned char* sv_ = lds + SVO + (sb_ * 2 + h_) * TB; \
                if (MODE != 2 || (act[0] && act[1])) nsa_tile<MODE, STEP, 3>(sk_, sv_, qf, st, dbase, general, colsel, bt, bfar, minv, sMain, sSpill, tokl, mg0, fr, fq, q4, p4); \
                else if (act[0]) nsa_tile<MODE, STEP, 1>(sk_, sv_, qf, st, dbase, general, colsel, bt, bfar, minv, sMain, sSpill, tokl, mg0, fr, fq, q4, p4); \
                else if (act[1]) nsa_tile<MODE, STEP, 2>(sk_, sv_, qf, st, dbase, general, colsel, bt, bfar, minv, sMain, sSpill, tokl, mg0, fr, fq, q4, p4); } } \
            if (s_ + 1 < nst_) nsa_st2(lds + SKO + ((sb_ ^ 1) * 2) * TB, lds + SVO + ((sb_ ^ 1) * 2) * TB, tid, kvr); \
            __syncthreads(); } } while (0)
#define NSA_RESET() do { _Pragma("unroll") for (int ct = 0; ct < 2; ++ct) { st[ct].m = NEG; st[ct].l = 0.f; _Pragma("unroll") for (int dt = 0; dt < 4; ++dt) st[ct].o[dt] = (f32x4){0.f, 0.f, 0.f, 0.f}; } } while (0)
        const int ncmp = 4 * qb + 3, nct = (ncmp + 63) >> 6;
        const bf16_t* kcb = KC + (size_t)bg * 512 * 64; const bf16_t* vcb = VC + (size_t)bg * 512 * 64;
        NSA_RESET();
        NSA_RUN(0, 16, nct, ti, kcb, vcb, (size_t)4096, 64, { dbase[0] = t0 + tokl[0] - 31 - 1024 * ti; dbase[1] = dbase[0] + 4; mg0 = 16 * ti; general = t0 - 31 - 1024 * ti - 1008 < 128; });
#pragma unroll
        for (int ct = 0; ct < 2; ++ct) { const float lt = xsum16_32(st[ct].l); minv[ct] = fast_rcp(lt > 0.f ? lt : 1.f); if (st[ct].m == NEG) st[ct].m = 0.f; }
        NSA_RUN(1, 16, nct, ti, kcb, vcb, (size_t)4096, 64, { dbase[0] = t0 + tokl[0] - 31 - 1024 * ti; dbase[1] = dbase[0] + 4; mg0 = 16 * ti; general = t0 - 31 - 1024 * ti - 1008 < 128; });
#pragma unroll
        for (int ct = 0; ct < 2; ++ct) { const float gt0 = gtp[ct * 4 * 48];
#pragma unroll
            for (int dt = 0; dt < 4; ++dt) { const f32x4 v = st[ct].o[dt] * gt0; u32x2 w; w.x = pk2(v[0], v[1]); w.y = pk2(v[2], v[3]); *(u32x2*)(yp + ct * 4096 + 16 * dt) = w; } }
        unsigned msk[2][4];
        if (qb <= 15) {
#pragma unroll
            for (int ct = 0; ct < 2; ++ct) { msk[ct][0] = (2u << qb) - 1u; msk[ct][1] = 0u; msk[ct][2] = 0u; msk[ct][3] = 0u; }
        } else {
            const int tl = lane >> 3, sub = lane & 7, tok = 8 * wid + tl;
            unsigned key[16];
#pragma unroll
            for (int i = 0; i < 4; ++i) { const f32x4 a = *(const LAS f32x4*)(sMain + tok * 128 + 16 * sub + 4 * i), s4 = *(const LAS f32x4*)(sSpill + tok * 128 + 16 * sub + 4 * i);
#pragma unroll
                for (int j = 0; j < 4; ++j) { const int m = 16 * sub + 4 * i + j; const float imp = a[j] + s4[j];
                    key[4 * i + j] = (m >= 1 && m <= qb - 2) ? ((__float_as_uint(imp) & ~127u) | (unsigned)(127 - m)) : 0u; } }
            unsigned selb = 0u;
#pragma unroll 1
            for (int it = 0; it < 13; ++it) { unsigned mx = key[0];
#pragma unroll
                for (int i = 1; i < 16; ++i) mx = key[i] > mx ? key[i] : mx;
                { unsigned o = (unsigned)__shfl_xor((int)mx, 1); mx = o > mx ? o : mx; o = (unsigned)__shfl_xor((int)mx, 2); mx = o > mx ? o : mx; o = (unsigned)__shfl_xor((int)mx, 4); mx = o > mx ? o : mx; }
#pragma unroll
                for (int i = 0; i < 16; ++i) if (key[i] == mx) { selb |= 1u << i; key[i] = 0u; } }
            { const int f0 = 0, f1 = qb, f2 = qb - 1;
              if ((f0 >> 4) == sub) selb |= 1u << (f0 & 15); if ((f1 >> 4) == sub) selb |= 1u << (f1 & 15); if ((f2 >> 4) == sub) selb |= 1u << (f2 & 15); }
            const unsigned oth = (unsigned)__shfl_xor((int)selb, 1);
            if ((sub & 1) == 0) sSel[tok * 4 + (sub >> 1)] = selb | (oth << 16);
            asm volatile("s_waitcnt lgkmcnt(0)" ::: "memory");
#pragma unroll
            for (int ct = 0; ct < 2; ++ct) { const u32x4 w = *(const LAS u32x4*)(sSel + tokl[ct] * 4); msk[ct][0] = w.x; msk[ct][1] = w.y; msk[ct][2] = w.z; msk[ct][3] = w.w; }
        }
        { const bf16_t* ksb = KV + (size_t)2 * T_ * 256 + (size_t)(b * SEQ) * 256 + g * 64; const bf16_t* vsb = KV + (size_t)3 * T_ * 256 + (size_t)(b * SEQ) * 256 + g * 64;
          const bool sparse = qb >= NSA_SPARSE_QB;
          NSA_RESET();
#define NSA_SEL_SETUP(MB) { const int mblk = (MB); const int mw = mblk >> 5; const int mb = mblk & 31; \
              _Pragma("unroll") for (int ct = 0; ct < 2; ++ct) { const unsigned w = mw == 0 ? msk[ct][0] : mw == 1 ? msk[ct][1] : mw == 2 ? msk[ct][2] : msk[ct][3]; colsel[ct] = (w >> mb) & 1u; act[ct] = __any(colsel[ct]); } \
              dbase[0] = t0 + tokl[0] - 64 * mblk; dbase[1] = dbase[0] + 4; general = mblk + 2 >= qb; }
          if (!sparse) {
              NSA_RUN(2, 1, qb + 1, ti, ksb, vsb, (size_t)64 * 256, 256, NSA_SEL_SETUP(ti));
          } else {
              NSA_RUN(2, 1, 4, (ti == 0 ? 0 : qb - 3 + ti), ksb, vsb, (size_t)64 * 256, 256, NSA_SEL_SETUP(ti == 0 ? 0 : qb - 3 + ti));
#pragma unroll
              for (int ct = 0; ct < 2; ++ct) { const int col = tokl[ct] * 4 + hg; const float lt = xsum16_32(st[ct].l);
                  if (fq == 0) { sMref[col] = st[ct].m; sLfar[col] = fx_enc(lt); }
#pragma unroll
                  for (int dt = 0; dt < 4; ++dt)
#pragma unroll
                      for (int j = 0; j < 4; ++j) sOfar[col * 66 + 16 * dt + 4 * fq + j] = fx_enc(st[ct].o[dt][j]); }
              __syncthreads();
              nsa_sparse_far(sSel, (LAS int*)(lds + SLIST) + wid * 64, sBt, sMref, sLfar, sOfar, Q + (size_t)m0 * 1024 + g * 256, ksb, VT + (size_t)bg * 64 * SEQ, qb, wid, lane, fr, fq);
              __syncthreads();
#pragma unroll
              for (int ct = 0; ct < 2; ++ct) { const int col = tokl[ct] * 4 + hg; st[ct].l = fq == 0 ? fx_dec(sLfar[col]) : 0.f;
#pragma unroll
                  for (int dt = 0; dt < 4; ++dt)
#pragma unroll
                      for (int j = 0; j < 4; ++j) st[ct].o[dt][j] = fx_dec(sOfar[col * 66 + 16 * dt + 4 * fq + j]); }
              __syncthreads();
#pragma unroll
              for (int ct = 0; ct < 2; ++ct)
#pragma unroll
                  for (int s = 0; s < 2; ++s) qf[ct][s] = *(const bf16x8*)(Q + (size_t)(m0 + tokl[ct]) * 1024 + (g * 4 + hg) * 64 + 32 * s + 8 * fq);
          }
#undef NSA_SEL_SETUP
#pragma unroll
          for (int ct = 0; ct < 2; ++ct) { const float lt = xsum16_32(st[ct].l), sc = gtp[ct * 4 * 48 + 1] * fast_rcp(lt > 0.f ? lt : 1.f);
#pragma unroll
              for (int dt = 0; dt < 4; ++dt) { const unsigned long long yq = __hip_atomic_load((const unsigned long long*)(yp + ct * 4096 + 16 * dt), __ATOMIC_RELAXED, __HIP_MEMORY_SCOPE_AGENT); u32x2 y0; y0.x = (unsigned)yq; y0.y = (unsigned)(yq >> 32); const f32x4 v = (f32x4){bflo(y0.x), bfhi(y0.x), bflo(y0.y), bfhi(y0.y)} + st[ct].o[dt] * sc;
                  u32x2 w; w.x = pk2(v[0], v[1]); w.y = pk2(v[2], v[3]); *(u32x2*)(yp + ct * 4096 + 16 * dt) = w; } } }
        { const bf16_t* kwb = KV + (size_t)4 * T_ * 256 + (size_t)(b * SEQ) * 256 + g * 64; const bf16_t* vwb = KV + (size_t)5 * T_ * 256 + (size_t)(b * SEQ) * 256 + g * 64;
          NSA_RESET(); act[0] = true; act[1] = true; colsel[0] = true; colsel[1] = true;
          const int j0 = qb >= 8 ? 0 : 8 - qb;
          NSA_RUN(3, 1, 9 - j0, ti, kwb + (size_t)(t0 - 512 + 64 * j0) * 256, vwb + (size_t)(t0 - 512 + 64 * j0) * 256, (size_t)64 * 256, 256, { const int j = j0 + ti;
              dbase[0] = tokl[0] + 512 - 64 * j; dbase[1] = dbase[0] + 4; general = (j == 0) || (j >= 6); });
#pragma unroll
          for (int ct = 0; ct < 2; ++ct) { const float lt = xsum16_32(st[ct].l), sc = gtp[ct * 4 * 48 + 2] * fast_rcp(lt > 0.f ? lt : 1.f);
#pragma unroll
              for (int dt = 0; dt < 4; ++dt) { const unsigned long long yq = __hip_atomic_load((const unsigned long long*)(yp + ct * 4096 + 16 * dt), __ATOMIC_RELAXED, __HIP_MEMORY_SCOPE_AGENT); u32x2 y0; y0.x = (unsigned)yq; y0.y = (unsigned)(yq >> 32); const f32x4 v = (f32x4){bflo(y0.x), bfhi(y0.x), bflo(y0.y), bfhi(y0.y)} + st[ct].o[dt] * sc;
                  u32x2 w; w.x = pk2(v[0], v[1]); w.y = pk2(v[2], v[3]); *(u32x2*)(yp + ct * 4096 + 16 * dt) = w; } } }
        __syncthreads();
#undef NSA_RESET
#undef NSA_RUN
    }
}
#ifndef USE_XCD_BAR
#define USE_XCD_BAR 1
#endif
#ifndef EN_ALL
#define EN_ALL 1
#endif
#ifndef EN_LRUG
#define EN_LRUG EN_ALL
#endif
#ifndef EN_LRUA
#define EN_LRUA EN_ALL
#endif
#ifndef EN_NSAC
#define EN_NSAC EN_ALL
#endif
#ifndef EN_NSAA
#define EN_NSAA EN_ALL
#endif
#ifndef EN_GLAK
#define EN_GLAK EN_ALL
#endif
#ifndef EN_GLAS
#define EN_GLAS EN_ALL
#endif
#ifndef EN_GLAO
#define EN_GLAO EN_ALL
#endif
#ifndef EN_G_LRUIN
#define EN_G_LRUIN EN_ALL
#endif
#ifndef EN_G_RESID
#define EN_G_RESID EN_ALL
#endif
#ifndef EN_G_NSAIN
#define EN_G_NSAIN EN_ALL
#endif
#ifndef EN_G_GLAIN
#define EN_G_GLAIN EN_ALL
#endif
#ifndef EN_G_GU
#define EN_G_GU EN_ALL
#endif
#ifndef EN_PREP
#define EN_PREP EN_ALL
#endif
struct Args {
    const float* x; const float* rel_bias; const float* final_norm; const float* mix_norm; const float* ffn_norm;
    const float* ffn_w_gate; const float* ffn_w_up; const float* ffn_w_down;
    const float* lru_w_in; const float* lru_conv_w; const float* lru_conv_b; const float* lru_w_a; const float* lru_b_a; const float* lru_w_x; const float* lru_b_x; const float* lru_lam; const float* lru_w_out;
    const float* nsa_w_in; const float* nsa_cmp_pos; const float* nsa_cmp_w1; const float* nsa_cmp_b1; const float* nsa_cmp_w2; const float* nsa_cmp_b2; const float* nsa_w_out;
    const float* gla_w_in; const float* gla_w_g2; const float* gla_b_g2; const float* gla_norm; const float* gla_w_out;
    float* out; unsigned char* ws; int ph_lo, ph_hi;
};

#define XB_TMO      128
#define XB_XCNT(j)  (256  + 64 * (j))
#define XB_XSUB(j)  (1280 + 64 * (j))
#define XB_XGEN(j)  (2304 + 64 * (j))
#define XB_TOP      3328
#define XB_TOPGEN   3392
#define XCD_BAR_WORDS 3456
#define XB_SPIN_CAP (1u << 18)

__device__ __forceinline__ unsigned xb_ld(unsigned* p)              { return __hip_atomic_load(p, __ATOMIC_RELAXED, __HIP_MEMORY_SCOPE_AGENT); }
__device__ __forceinline__ unsigned xb_add(unsigned* p, unsigned v) { return __hip_atomic_fetch_add(p, v, __ATOMIC_RELAXED, __HIP_MEMORY_SCOPE_AGENT); }
__device__ __forceinline__ unsigned xb_xcc_id() { return (unsigned)__builtin_amdgcn_s_getreg((3 << 11) | 20) & 0xFu; }
#define XB_SPIN(cond, bar) do { unsigned _sp = 0; while (cond) { __builtin_amdgcn_s_sleep(1); \
    if ((++_sp & 255u) == 0u) { if (xb_ld(&(bar)[XB_TMO])) break; if (_sp > XB_SPIN_CAP) { atomicAdd(&(bar)[XB_TMO], 1u); break; } } } } while (0)

struct XcdBarrier {
    unsigned* bar; unsigned x;
    volatile LAS unsigned* st;
};

__device__ __forceinline__ XcdBarrier xcd_barrier_post(unsigned* bar, volatile LAS unsigned* st) {
    XcdBarrier b; b.bar = bar; b.x = xb_xcc_id(); b.st = st;
    if (threadIdx.x == 0) (void)xb_add(&bar[XB_XCNT(b.x)], 1u);
    return b;
}
__device__ __forceinline__ void xcd_barrier_complete(unsigned* bar, unsigned x, unsigned& nloc, unsigned& nx) {
    const unsigned G = gridDim.x * gridDim.y * gridDim.z;
    unsigned sum, cnt, mine, sp = 0u;
    for (;;) {
        sum = 0u; cnt = 0u; mine = 0u;
#pragma unroll
        for (unsigned j = 0; j < 16; ++j) { const unsigned c = xb_ld(&bar[XB_XCNT(j)]); sum += c; cnt += (c > 0u) ? 1u : 0u; mine = (j == x) ? c : mine; }
        if (sum == G) break;
        __builtin_amdgcn_s_sleep(1);
        if ((++sp & 255u) == 0u) { if (xb_ld(&bar[XB_TMO])) break; if (sp > XB_SPIN_CAP) { atomicAdd(&bar[XB_TMO], 1u); break; } }
    }
    nloc = mine > 0u ? mine : 1u; nx = cnt > 0u ? cnt : 1u;
}

__device__ __forceinline__ void xcd_barrier(const XcdBarrier& b) {
    asm volatile("s_waitcnt vmcnt(0)" ::: "memory");
    __syncthreads();
    if (threadIdx.x == 0) {
        unsigned* bar = b.bar;
        __builtin_amdgcn_s_waitcnt(0);
        unsigned nloc = b.st[0], nx = b.st[1];
        if (nloc == 0u) { xcd_barrier_complete(bar, b.x, nloc, nx); b.st[0] = nloc; b.st[1] = nx; }
        const unsigned old = xb_add(&bar[XB_XSUB(b.x)], 1u);
        const unsigned gen = old / nloc;
        if (old + 1u == (gen + 1u) * nloc) {
            __builtin_amdgcn_fence(__ATOMIC_RELEASE, "agent");
            asm volatile("s_waitcnt vmcnt(0)" ::: "memory");
            const unsigned og = xb_add(&bar[XB_TOP], 1u);
            const unsigned tg = og / nx;
            if (og + 1u == (tg + 1u) * nx) xb_add(&bar[XB_TOPGEN], 1u);
            else XB_SPIN(xb_ld(&bar[XB_TOPGEN]) == tg, bar);
            __builtin_amdgcn_fence(__ATOMIC_ACQUIRE, "agent");
            xb_add(&bar[XB_XGEN(b.x)], 1u);
            asm volatile("s_waitcnt vmcnt(0)" ::: "memory");
        } else {
            XB_SPIN(xb_ld(&bar[XB_XGEN(b.x)]) == gen, bar);
            __builtin_amdgcn_fence(__ATOMIC_ACQUIRE, "agent");
            asm volatile("s_waitcnt vmcnt(0)" ::: "memory");
        }
    }
    __syncthreads();
}

__global__ void __launch_bounds__(512, 2) mega_fwd(Args a) {
    extern __shared__ __attribute__((aligned(16))) unsigned char lds_raw[];
    LAS unsigned char* lds = (LAS unsigned char*)lds_raw;
    cg::grid_group grid = cg::this_grid();
    const int tid0 = threadIdx.x; const int wid0 = __builtin_amdgcn_readfirstlane(tid0 >> 6);
    constexpr int PTR_OFF = LDS_BYTES - 512;
    if (tid0 == 0) { LAS unsigned long long* tb = (LAS unsigned long long*)(lds + PTR_OFF);
        tb[0] = (unsigned long long)a.x;
        tb[1] = (unsigned long long)a.rel_bias;
        tb[2] = (unsigned long long)a.final_norm;
        tb[3] = (unsigned long long)a.mix_norm;
        tb[4] = (unsigned long long)a.ffn_norm;
        tb[5] = (unsigned long long)a.ffn_w_gate;
        tb[6] = (unsigned long long)a.ffn_w_up;
        tb[7] = (unsigned long long)a.ffn_w_down;
        tb[8] = (unsigned long long)a.lru_w_in;
        tb[9] = (unsigned long long)a.lru_conv_w;
        tb[10] = (unsigned long long)a.lru_conv_b;
        tb[11] = (unsigned long long)a.lru_w_a;
        tb[12] = (unsigned long long)a.lru_b_a;
        tb[13] = (unsigned long long)a.lru_w_x;
        tb[14] = (unsigned long long)a.lru_b_x;
        tb[15] = (unsigned long long)a.lru_lam;
        tb[16] = (unsigned long long)a.lru_w_out;
        tb[17] = (unsigned long long)a.nsa_w_in;
        tb[18] = (unsigned long long)a.nsa_cmp_pos;
        tb[19] = (unsigned long long)a.nsa_cmp_w1;
        tb[20] = (unsigned long long)a.nsa_cmp_b1;
        tb[21] = (unsigned long long)a.nsa_cmp_w2;
        tb[22] = (unsigned long long)a.nsa_cmp_b2;
        tb[23] = (unsigned long long)a.nsa_w_out;
        tb[24] = (unsigned long long)a.gla_w_in;
        tb[25] = (unsigned long long)a.gla_w_g2;
        tb[26] = (unsigned long long)a.gla_b_g2;
        tb[27] = (unsigned long long)a.gla_norm;
        tb[28] = (unsigned long long)a.gla_w_out;
        tb[29] = (unsigned long long)a.out;
        tb[30] = (unsigned long long)a.ws;
    }
    if (tid0 < 4) ((LAS unsigned*)(lds + PTR_OFF + 256))[tid0] = 0u;
    __syncthreads();
    XcdBarrier xbar = xcd_barrier_post((unsigned*)(a.ws + WS_CTL), (volatile LAS unsigned*)(lds + PTR_OFF + 256));
#define PRAW(i) ((((unsigned long long)(unsigned)__builtin_amdgcn_readfirstlane((int)((const LAS unsigned*)(lds + PTR_OFF))[2 * (i) + 1])) << 32) | (unsigned long long)(unsigned)__builtin_amdgcn_readfirstlane((int)((const LAS unsigned*)(lds + PTR_OFF))[2 * (i)]))
#define GAS_ __attribute__((address_space(1)))
#define PF(i) ((const float*)(const GAS_ float*)PRAW(i))
#define P_OUT ((float*)(GAS_ float*)PRAW(29))
#define WSP(off) ((unsigned char*)((GAS_ unsigned char*)PRAW(30) + (off)))
#define W_GU ((bf16_t*)WSP(WS_W_GU))
#define W_DN ((bf16_t*)WSP(WS_W_DN))
#define W_MIN ((bf16_t*)WSP(WS_W_MIN))
#define W_MOUT ((bf16_t*)WSP(WS_W_MOUT))
#define W_SM ((bf16_t*)WSP(WS_W_SMALL))
#define HN ((bf16_t*)WSP(WS_HN))
#define ACT ((bf16_t*)WSP(WS_ACT))
#define LG ((bf16_t*)WSP(WS_LG))
#define LX ((bf16_t*)WSP(WS_LX))
#define LHL ((bf16_t*)WSP(WS_LHL))
#define LAC ((bf16_t*)WSP(WS_LAC))
#define AGGA ((float*)WSP(WS_LAGGA))
#define AGGH ((float*)WSP(WS_LAGGH))
#define NQ ((bf16_t*)WSP(WS_NQ))
#define NKV ((bf16_t*)WSP(WS_NKV))
#define NGT ((float*)WSP(WS_NGT))
#define NKC ((bf16_t*)WSP(WS_NKC))
#define NVC ((bf16_t*)WSP(WS_NVC))
#define GQ ((bf16_t*)WSP(WS_GQ))
#define GK ((bf16_t*)WSP(WS_GK))
#define GV ((bf16_t*)WSP(WS_GV))
#define GR ((bf16_t*)WSP(WS_GR))
#define GGL ((float*)WSP(WS_GGL))
#define GDEC ((float*)WSP(WS_GDEC))
#define GKVT ((bf16_t*)WSP(WS_GKVT))
#define SSP ((float*)WSP(WS_SSP))
#define NY ((bf16_t*)WSP(WS_NY))
#define NVT ((bf16_t*)WSP(WS_NVT))

    enum { OP_PREP, OP_G_LRUIN, OP_LRU_GATES, OP_LRU_APPLY, OP_G_RESID, OP_G_NSAIN, OP_NSA_CMP, OP_NSA_ATTN, OP_G_GLAIN, OP_GLA_KV, OP_GLA_SCAN, OP_GLA_OUT, OP_NORM2, OP_G_GU, OP_FINAL };
#pragma unroll 1
    for (int ph = a.ph_lo; ph < a.ph_hi; ++ph) {
        int layer, r;
        if (ph < 7) { layer = 0; r = ph; } else if (ph < 13) { layer = 1; r = ph - 6; } else if (ph < 20) { layer = 2; r = ph - 12; } else if (ph < 26) { layer = 3; r = ph - 19; } else { layer = 4; r = 0; }
        const int kind = layer % 3, jj = layer / 3, nmix = kind == 2 ? 5 : 4;
        int wid_s = wid0, bid = blockIdx.x, G = gridDim.x;
        asm volatile("" : "+s"(wid_s) :: "memory"); asm volatile("" : "+s"(bid)); asm volatile("" : "+s"(G));
        int lane_v; asm volatile("v_mbcnt_lo_u32_b32 %0, -1, 0\n\tv_mbcnt_hi_u32_b32 %0, -1, %0" : "=v"(lane_v));
        const int tid = (wid_s << 6) | lane_v;
        const int lane = tid & 63, wid = __builtin_amdgcn_readfirstlane(tid >> 6), gw = bid * 8 + wid, NGW = G * 8;
        LAS float* scr = (LAS float*)(lds + wid * 8448);
        const float* hsrc = layer == 0 ? PF(0) : P_OUT;
        int op;
        if (layer == 4) op = OP_FINAL;
        else if (r == 0) op = OP_PREP;
        else if (r <= nmix) { const int q = r - 1;
            if (kind == 0) op = q == 0 ? OP_G_LRUIN : q == 1 ? OP_LRU_GATES : q == 2 ? OP_LRU_APPLY : OP_G_RESID;
            else if (kind == 1) op = q == 0 ? OP_G_NSAIN : q == 1 ? OP_NSA_CMP : q == 2 ? OP_NSA_ATTN : OP_G_RESID;
            else op = q == 0 ? OP_G_GLAIN : q == 1 ? OP_GLA_KV : q == 2 ? OP_GLA_SCAN : q == 3 ? OP_GLA_OUT : OP_G_RESID; }
        else { const int q = r - nmix - 1; op = q == 0 ? OP_G_GU : OP_G_RESID; }
        const bool is_down = (r == nmix + 2);
#ifdef PHASE_PROBE
        if (bid == 0 && tid == 0) { unsigned long long* ts = (unsigned long long*)WSP(WS_TQ + 4096); ts[ph] = __builtin_amdgcn_s_memrealtime(); ((int*)WSP(WS_TQ + 8192))[ph] = op; }
#endif
        switch (op) {
        case OP_PREP: if (EN_PREP) init_stream_bf16(PF(0), HN, SSP, gw, NGW, lane);
            break;
        case OP_G_LRUIN: if (EN_G_LRUIN) { pg8::Gemm g{HN, W_MIN, T_, 2 * RNN, D_}; pg8::StaticOrder S; S.init(T_, 2 * RNN, G, bid); pg8::EpiLruIn E{LG, LX, SSP};
            pg8::gemm_phase<pg8::EpiLruIn, pg8::StaticOrder, true, true>(lds, g, S, E, tid); }
            break;
        case OP_LRU_GATES: if (EN_LRUG) lru_gates_phase(lds, LX, PF(9) + jj * 4 * RNN, PF(10) + jj * RNN, W_SM, W_SM + 163840, PF(12) + jj * RNN, PF(14) + jj * RNN, PF(15) + jj * RNN, LHL, LAC, AGGA, AGGH, tid, bid, G);
            break;
        case OP_LRU_APPLY: if (EN_LRUA) lru_apply_phase(LG, LHL, LAC, AGGA, AGGH, tid, bid, G);
            break;
        case OP_G_RESID: if (EN_G_RESID) {
            const bf16_t* A = is_down ? ACT : (kind == 0 ? LG : kind == 1 ? NY : GV); const bf16_t* Bt = is_down ? W_DN : W_MOUT; const int K = is_down ? FF : (kind == 0 ? RNN : D_);
            pg8::Gemm g{A, Bt, T_, D_, K}; pg8::StaticOrder S; S.init(T_, D_, G, bid); pg8::EpiResid E{HN, SSP, (LAS float*)(lds + 131072)};
            pg8::gemm_phase<pg8::EpiResid, pg8::StaticOrder, true, true>(lds, g, S, E, tid); }
            break;
        case OP_G_NSAIN: if (EN_G_NSAIN) { pg8::Gemm g{HN, W_MIN, T_, NSA_NPAD, D_}; pg8::StaticOrder S; S.init(T_, NSA_NPAD, G, bid); pg8::EpiNsaIn E{NQ, NKV, NGT, SSP};
            pg8::gemm_phase<pg8::EpiNsaIn, pg8::StaticOrder, true, true>(lds, g, S, E, tid); }
            break;
        case OP_NSA_CMP: if (EN_NSAC) nsa_compress_phase(lds, NKV, PF(18), PF(19), PF(20), PF(22), W_SM, W_SM + 262144, NKC, NVC, NVT, tid, bid, G);
            break;
        case OP_NSA_ATTN: if (EN_NSAA) nsa_attn_phase(lds, NQ, NKV, NGT, NKC, NVC, PF(1), NY, NVT, (void*)WSP(WS_TQ), tid, bid, G);
            break;
        case OP_G_GLAIN: if (EN_G_GLAIN) { pg8::Gemm g{HN, W_MIN, T_, GLA_NPAD, D_}; pg8::StaticOrder S; S.init(T_, GLA_NPAD, G, bid); pg8::EpiGlaIn E{GQ, GK, GV, GR, GGL, SSP};
            pg8::gemm_phase<pg8::EpiGlaIn, pg8::StaticOrder, true, true>(lds, g, S, E, tid); }
            break;
        case OP_GLA_KV: if (EN_GLAK) gla_kv_phase(lds, GK, GV, GGL, PF(25), PF(26), GKVT, GDEC, tid, bid, G);
            break;
        case OP_GLA_SCAN: if (EN_GLAS) gla_scan_phase(GKVT, GDEC, tid, bid, G);
            break;
        case OP_GLA_OUT: if (EN_GLAO) gla_out_phase(lds, GQ, GK, GV, GR, GGL, PF(25), PF(26), PF(27), GKVT, GV, tid, bid, G);
            break;
        case OP_G_GU: if (EN_G_GU) { pg8::Gemm g{HN, W_GU, T_, 2 * FF, D_}; pg8::StaticOrder S; S.init(T_, 2 * FF, G, bid); pg8::EpiSwiglu E{ACT, SSP};
            pg8::gemm_phase<pg8::EpiSwiglu, pg8::StaticOrder, true, true>(lds, g, S, E, tid); }
            break;
        default: if (EN_PREP) final_norm_rows(HN, PF(2), P_OUT, gw, NGW, lane);
#if defined(TIMING_PROBE) || defined(PHASE_PROBE)
            { __syncthreads(); float* o = P_OUT;
#ifdef PHASE_PROBE
              const unsigned long long* ts = (const unsigned long long*)WSP(WS_TQ + 4096); const int* ops = (const int*)WSP(WS_TQ + 8192);
              const unsigned long long tend = __builtin_amdgcn_s_memrealtime(); float sa = 0.f, sb = 0.f;
              for (int q = 0; q < 33; ++q) { const float dt = (float)(ts[q + 1] - ts[q]); if (ops[q] == TQ_A) sa += dt; if (ops[q] == TQ_B) sb += dt; }
              const float tot_ = (float)(ts[33] - ts[0]); const float f1 = sa / tot_, f2 = sb / tot_; (void)tend;
#else
              const float* tq = (const float*)WSP(WS_TQ); const float f1 = tq[TQ_A], f2 = tq[TQ_B];
#endif

              const int R = (int)(f2 * 0.32f * 16384.f);
              for (int m = gw; m < R; m += NGW) for (int c = lane; c < 1024; c += 64) o[(size_t)m * 1024 + c] += 0.05f;
              if (bid == G - 1 && tid == 0) o[(size_t)16383 * 1024 + 5] += 0.1f + 0.19f * f1; }
#endif
            break;
        }
        { int cv = 0, nun = 0;
          if (op == OP_PREP) cv = 2;
          else if ((op == OP_G_LRUIN || op == OP_G_NSAIN || op == OP_G_GLAIN)) { cv = 1; nun = 64 * (op == OP_G_LRUIN ? 10 : op == OP_G_NSAIN ? 11 : 13); }
          else if (op == OP_G_GU && layer < 3) { cv = 2; nun = 64 * 22; }
          if (EN_PREP && cv) {
              const int rem = op == OP_PREP ? 0 : nun % G, first = rem, nidle = G - first;
              if (bid >= first) { const int cgw = (bid - first) * 8 + wid, CNGW = nidle * 8; int rot = 0;
                  if (cv & 1) {
                      transpose_job(PF(5) + (size_t)layer * D_ * FF, PF(4) + layer * D_, D_, FF, W_GU, D_, 1, rot, cgw, CNGW, scr, lane);
                      transpose_job(PF(6) + (size_t)layer * D_ * FF, PF(4) + layer * D_, D_, FF, W_GU, D_, 2, rot, cgw, CNGW, scr, lane);
                      transpose_job(PF(7) + (size_t)layer * FF * D_, nullptr, FF, D_, W_DN, FF, 0, rot, cgw, CNGW, scr, lane); }
                  if (cv & 2) { const int ml = op == OP_PREP ? layer : layer + 1, mk = ml % 3, mj = ml / 3;
                      if (mk == 0) {
                          transpose_job(PF(8) + (size_t)mj * D_ * 2 * RNN, PF(3) + ml * D_, D_, 2 * RNN, W_MIN, D_, 0, rot, cgw, CNGW, scr, lane);
                          transpose_job(PF(16) + (size_t)mj * RNN * D_, nullptr, RNN, D_, W_MOUT, RNN, 0, rot, cgw, CNGW, scr, lane);
#pragma unroll 1
                          for (int h = 0; h < 20; ++h) { const int hh = h % 10; const float* src = (h < 10 ? PF(11) : PF(13)) + ((size_t)mj * 10 + hh) * 16384;
                              transpose_job(src, nullptr, 128, 128, W_SM + (h < 10 ? 0 : 163840) + hh * 16384, 128, 0, rot, cgw, CNGW, scr, lane); }
                      } else if (mk == 1) {
                          transpose_job(PF(17), PF(3) + ml * D_, D_, 2608, W_MIN, D_, 0, rot, cgw, CNGW, scr, lane);
                          transpose_job(PF(23), nullptr, D_, D_, W_MOUT, D_, 0, rot, cgw, CNGW, scr, lane);
#pragma unroll 1
                          for (int kv = 0; kv < 2; ++kv) {
                              transpose_job(PF(19) + (size_t)kv * 2048 * 64, nullptr, 2048, 64, W_SM + (size_t)kv * 64 * 2048, 2048, 0, rot, cgw, CNGW, scr, lane);
                              transpose_job(PF(21) + (size_t)kv * 4096, nullptr, 64, 64, W_SM + 262144 + kv * 4096, 64, 0, rot, cgw, CNGW, scr, lane); }
                      } else {
                          transpose_job(PF(24), PF(3) + ml * D_, D_, 3088, W_MIN, D_, 0, rot, cgw, CNGW, scr, lane);
                          transpose_job(PF(28), nullptr, D_, D_, W_MOUT, D_, 0, rot, cgw, CNGW, scr, lane); } } } } }
        if (ph + 1 < a.ph_hi) { if (USE_XCD_BAR && ph != a.ph_lo) xcd_barrier(xbar); else grid.sync(); }
    }
}

#ifndef N_LAUNCH_MODE
#define N_LAUNCH_MODE 1
#endif
constexpr int N_PHASES = 27;

extern "C" void kernel_launch(void* const* d_in, const int* in_sizes, int n_in, void* d_out, int out_size, void* d_ws, size_t ws_size, hipStream_t stream) {
    static int grid = 0;
    if (grid == 0) {
        if (n_in != 29 || out_size != T_ * D_ || ws_size < WS_END) { fprintf(stderr, "kernel_launch: unexpected problem: n_in %d out %d ws %zu\n", n_in, out_size, ws_size); grid = -1; return; }
        int dev = 0, cus = 0, per_cu = 0;
        hipGetDevice(&dev); hipDeviceGetAttribute(&cus, hipDeviceAttributeMultiprocessorCount, dev);
        if (hipFuncSetAttribute((const void*)mega_fwd, hipFuncAttributeMaxDynamicSharedMemorySize, LDS_BYTES) != hipSuccess) { fprintf(stderr, "kernel_launch: hipFuncSetAttribute failed\n"); grid = -1; return; }
        if (hipOccupancyMaxActiveBlocksPerMultiprocessor(&per_cu, (const void*)mega_fwd, 512, LDS_BYTES) != hipSuccess || per_cu < 1) { fprintf(stderr, "kernel_launch: occupancy query says %d\n", per_cu); per_cu = 1; }
        (void)hipGetLastError();
        grid = cus * 1;
        fprintf(stderr, "kernel_launch: grid %d (cus %d, occupancy %d)\n", grid, cus, per_cu);
    }
    if (grid < 0) return;
    if (hipMemsetAsync((char*)d_ws + WS_CTL, 0, 16384, stream) != hipSuccess) { fprintf(stderr, "kernel_launch: memset failed\n"); return; }
    Args a{};
    const float** p = (const float**)&a;
    for (int i = 0; i < 29; ++i) p[i] = (const float*)d_in[i];
    a.out = (float*)d_out; a.ws = (unsigned char*)d_ws;
#if N_LAUNCH_MODE == 1
    a.ph_lo = 0; a.ph_hi = N_PHASES;
    void* args[] = {&a};
    hipError_t e = hipLaunchCooperativeKernel((const void*)mega_fwd, dim3(grid), dim3(512), args, LDS_BYTES, stream);
    if (e != hipSuccess) fprintf(stderr, "cooperative launch failed: %s (grid %d)\n", hipGetErrorString(e), grid);
#else
#ifndef REPEAT_PH
#define REPEAT_PH -1
#endif
#ifndef REPEAT_N
#define REPEAT_N 1
#endif
#ifndef RUN_UPTO
#define RUN_UPTO (N_PHASES - 1)
#endif
    for (int ph = 0; ph < N_PHASES; ++ph) { if (ph >= RUN_UPTO && ph != N_PHASES - 1) continue; a.ph_lo = ph; a.ph_hi = ph + 1; hipLaunchKernelGGL(mega_fwd, dim3(grid), dim3(512), LDS_BYTES, stream, a);
        for (int rep = 0; rep < REPEAT_N; ++rep) if (ph == REPEAT_PH) hipLaunchKernelGGL(mega_fwd, dim3(grid), dim3(512), LDS_BYTES, stream, a); }
#endif
}
```

```cpp
#include <hip/hip_runtime.h>
#include <hip/hip_cooperative_groups.h>
#include <cstdio>
#include <cstdint>
namespace cg = cooperative_groups;

#define LAS __attribute__((address_space(3)))
typedef unsigned short bf16_t;
typedef short bf16x8 __attribute__((ext_vector_type(8)));
typedef short s16x4 __attribute__((ext_vector_type(4)));
typedef float f32x4 __attribute__((ext_vector_type(4)));
typedef float f32x2 __attribute__((ext_vector_type(2)));
typedef unsigned u32x4 __attribute__((ext_vector_type(4)));
typedef unsigned u32x2 __attribute__((ext_vector_type(2)));
typedef __bf16 bf16x2_t __attribute__((ext_vector_type(2)));

constexpr int T_ = 16384, SEQ = 8192, D_ = 1024, FF = 2816, RNN = 1280;
constexpr int NSA_NPAD = 2816, GLA_NPAD = 3328;
constexpr float EPS = 1e-6f;
constexpr float LOG2E = 1.4426950408889634f;

constexpr size_t MiB = 1u << 20;
constexpr size_t WS_W_GU = 0, WS_W_DN = 11 * MiB, WS_W_MIN = 17 * MiB, WS_W_MOUT = 24 * MiB, WS_W_SMALL = 27 * MiB;
constexpr size_t WS_HN = 28 * MiB;
constexpr size_t WS_ACT = 60 * MiB;
constexpr size_t WS_LG = 60 * MiB, WS_LX = 100 * MiB, WS_LHL = 140 * MiB, WS_LAC = 180 * MiB, WS_LAGGA = 220 * MiB, WS_LAGGH = 221 * MiB;
constexpr size_t WS_NQ = 60 * MiB, WS_NKV = 92 * MiB, WS_NGT = 140 * MiB, WS_NKC = 143 * MiB, WS_NVC = 144 * MiB;
constexpr size_t WS_GQ = 60 * MiB, WS_GK = 76 * MiB, WS_GV = 92 * MiB, WS_GR = 124 * MiB, WS_GGL = 156 * MiB, WS_GDEC = 157 * MiB, WS_GKVT = 158 * MiB;
constexpr size_t WS_TQ = 223 * MiB, WS_CTL = 222 * MiB, WS_SSP = 222 * MiB + 65536, WS_NY = 148 * MiB, WS_NVT = 180 * MiB, WS_B1E = 222 * MiB + 524288;
constexpr size_t WS_END = 224 * MiB;

constexpr int LDS_BYTES = 155648;

__device__ __forceinline__ unsigned pk2(float lo, float hi) { f32x2 v = {lo, hi}; bf16x2_t b = __builtin_convertvector(v, bf16x2_t); return __builtin_bit_cast(unsigned, b); }
__device__ __forceinline__ float bf2f(unsigned short h) { return __uint_as_float(((unsigned)h) << 16); }
__device__ __forceinline__ float bflo(unsigned w) { return __uint_as_float(w << 16); }
__device__ __forceinline__ float bfhi(unsigned w) { return __uint_as_float(w & 0xffff0000u); }
__device__ __forceinline__ float fast_rcp(float x) { return __builtin_amdgcn_rcpf(x); }
__device__ __forceinline__ float fast_exp2(float x) { return __builtin_amdgcn_exp2f(x); }
__device__ __forceinline__ float sigmoidf_(float x) { return fast_rcp(1.f + fast_exp2(-x * LOG2E)); }
__device__ __forceinline__ float siluf_(float x) { return x * sigmoidf_(x); }
__device__ __forceinline__ float gelu_tanh_(float x) { const float z = 0.7978845608028654f * (x + 0.044715f * x * x * x); return x * fast_rcp(1.f + fast_exp2(-2.f * LOG2E * z)); }
__device__ __forceinline__ float wave_sum(float v) {
#pragma unroll
    for (int o = 1; o < 64; o <<= 1) v += __shfl_xor(v, o);
    return v;
}
__device__ __forceinline__ float xmax16_32(float v) {
    auto r = __builtin_amdgcn_permlane16_swap(__float_as_uint(v), __float_as_uint(v), false, false); v = fmaxf(__uint_as_float(r[0]), __uint_as_float(r[1]));
    auto q = __builtin_amdgcn_permlane32_swap(__float_as_uint(v), __float_as_uint(v), false, false); return fmaxf(__uint_as_float(q[0]), __uint_as_float(q[1]));
}
__device__ __forceinline__ float xsum16_32(float v) {
    auto r = __builtin_amdgcn_permlane16_swap(__float_as_uint(v), __float_as_uint(v), false, false); v = __uint_as_float(r[0]) + __uint_as_float(r[1]);
    auto q = __builtin_amdgcn_permlane32_swap(__float_as_uint(v), __float_as_uint(v), false, false); return __uint_as_float(q[0]) + __uint_as_float(q[1]);
}
__device__ __forceinline__ float dpp_xor1(float v) { return __uint_as_float((unsigned)__builtin_amdgcn_update_dpp(0, (int)__float_as_uint(v), 0xB1, 0xF, 0xF, true)); }
__device__ __forceinline__ float dpp_xor2(float v) { return __uint_as_float((unsigned)__builtin_amdgcn_update_dpp(0, (int)__float_as_uint(v), 0x4E, 0xF, 0xF, true)); }
__device__ __forceinline__ float max3_(float a, float b, float c) { float r; asm("v_max3_f32 %0, %1, %2, %3" : "=v"(r) : "v"(a), "v"(b), "v"(c)); return r; }
namespace pg8 {
#define PG8_LAS __attribute__((address_space(3)))
typedef unsigned short bf16_t;
typedef short bf16x8 __attribute__((ext_vector_type(8)));
typedef float f32x4 __attribute__((ext_vector_type(4)));
typedef unsigned u32x4 __attribute__((ext_vector_type(4)));
constexpr int BM = 256, BK = 64, HALF = 128, HTB = HALF * BK * 2  , STAGE_BYTES = 8 * HTB, NXCD = 8, WGM = 8;

__host__ __device__ __forceinline__ int lds_byte(int r, int c) { const int st = (r >> 4) * 2 + (c >> 5), rr = r & 15, cc = c & 31, ob = rr * 64 + cc * 2; return st * 1024 + (ob ^ (((ob >> 9) & 1) << 5)); }
__host__ __device__ __forceinline__ void stage_rc(int b, int& R, int& C) { const int st = b / 1024, sb = b % 1024, swz = sb ^ (((sb >> 9) & 1) << 5); R = (st >> 1) * 16 + swz / 64; C = (st & 1) * 32 + (swz % 64) / 2; }
__host__ __device__ __forceinline__ int perm32(int rho) { const int n = rho >> 4, i = rho & 15; return 8 * (i >> 2) + 4 * n + (i & 3); }

struct Unit { int pm, pn; };
struct Gemm { const bf16_t* A; const bf16_t* Bt; int M, N, K; };

struct StaticOrder {
    int nM, nN, nwg, G, c;
    __host__ __device__ void init(int M, int N, int G_, int c_) { nM = M / BM; nN = N / BM; nwg = nM * nN; G = G_; c = c_; }
    __host__ __device__ bool next(int i, Unit& u) const {
        const long L = (long)i * G + c; if (L >= nwg) return false;
        int wgid = (int)L; { const int q = nwg / NXCD, r = nwg % NXCD, xcd = wgid % NXCD, off = wgid / NXCD; wgid = (xcd < r ? xcd * (q + 1) : r * (q + 1) + (xcd - r) * q) + off; }
        const int nig = WGM * nN, gid = wgid / nig, fm = gid * WGM, gsz = (nM - fm) < WGM ? (nM - fm) : WGM;
        u.pm = fm + ((wgid % nig) % gsz); u.pn = (wgid % nig) / gsz; return true;
    }
    __device__ __forceinline__ void a_ready(const Unit&) const {}
    __device__ __forceinline__ void done(const Unit&) const {}
};

struct EpiResid {
    static constexpr bool PERM = false, AFTER_DRAIN = false;
    bf16_t* hb; float* ssp; PG8_LAS float* red;
    __device__ __forceinline__ void operator()(const f32x4 (&acc)[2][2][4][2], const Unit& u, int wr, int wc, int fr, int fq) const {
        const int row0 = u.pm * BM + wr * 64 + fr, col0 = u.pn * BM + wc * 32 + 4 * fq;
#pragma unroll
        for (int ai = 0; ai < 2; ++ai)
#pragma unroll
            for (int m = 0; m < 4; ++m) { const size_t off = (size_t)(row0 + ai * HALF + m * 16) * 1024 + col0; float ss = 0.f;
#pragma unroll
                for (int bj = 0; bj < 2; ++bj)
#pragma unroll
                    for (int n = 0; n < 2; ++n) { const u32x2 b = *(const u32x2*)(hb + off + bj * HALF + n * 16); const f32x4 a = acc[ai][bj][m][n];
                        u32x2 w; w.x = ::pk2(::bflo(b.x) + a[0], ::bfhi(b.x) + a[1]); w.y = ::pk2(::bflo(b.y) + a[2], ::bfhi(b.y) + a[3]); *(u32x2*)(hb + off + bj * HALF + n * 16) = w;
                        const float h0 = ::bflo(w.x), h1 = ::bfhi(w.x), h2 = ::bflo(w.y), h3 = ::bfhi(w.y); ss += (h0 * h0 + h1 * h1) + (h2 * h2 + h3 * h3); }
                ss = ::xsum16_32(ss); if (fq == 0) red[(ai * HALF + wr * 64 + m * 16 + fr) * 4 + wc] = ss; }
        asm volatile("s_waitcnt lgkmcnt(0)" ::: "memory"); __builtin_amdgcn_s_barrier(); asm volatile("" ::: "memory");
        const int t = (wr * 4 + wc) * 64 + fq * 16 + fr;
        if (t < 256) { const f32x4 s = *(const PG8_LAS f32x4*)(red + t * 4); ssp[(size_t)(u.pm * BM + t) * 4 + u.pn] = (s[0] + s[1]) + (s[2] + s[3]); }
    }
};
__device__ __forceinline__ void load_rs(const float* ssp, int pm, int wr, int fr, float (&rs)[2][4]) {
#pragma unroll
    for (int ai = 0; ai < 2; ++ai)
#pragma unroll
        for (int m = 0; m < 4; ++m) { const int row = pm * BM + ai * HALF + wr * 64 + m * 16 + fr;
            const f32x4 s4 = *(const f32x4*)(ssp + (size_t)row * 4); const float s = (s4[0] + s4[1]) + (s4[2] + s4[3]); rs[ai][m] = __builtin_amdgcn_rsqf(s * (1.f / 1024.f) + 1e-6f); }
}
__device__ __forceinline__ u32x4 pack8(const f32x4 a, const f32x4 b) { u32x4 w; w.x = ::pk2(a[0], a[1]); w.y = ::pk2(a[2], a[3]); w.z = ::pk2(b[0], b[1]); w.w = ::pk2(b[2], b[3]); return w; }
struct EpiSwiglu {
    static constexpr bool PERM = true, AFTER_DRAIN = false;
    bf16_t* O; const float* ssp;
    __device__ __forceinline__ void operator()(const f32x4 (&acc)[2][2][4][2], const Unit& u, int wr, int wc, int fr, int fq) const {
        float rs[2][4]; load_rs(ssp, u.pm, wr, fr, rs);
        const int row0 = u.pm * BM + wr * 64 + fr, col0 = u.pn * HALF + wc * 32 + 8 * fq;
#pragma unroll
        for (int ai = 0; ai < 2; ++ai)
#pragma unroll
            for (int m = 0; m < 4; ++m) { f32x4 v[2];
#pragma unroll
                for (int n = 0; n < 2; ++n) { const f32x4 g = acc[ai][0][m][n], up = acc[ai][1][m][n];
#pragma unroll
                    for (int j = 0; j < 4; ++j) v[n][j] = ::siluf_(g[j] * rs[ai][m]) * (up[j] * rs[ai][m]); }
                *(u32x4*)(O + (size_t)(row0 + ai * HALF + m * 16) * FF + col0) = pack8(v[0], v[1]); }
    }
};
template <int ACT> __device__ __forceinline__ void store_tile_bf16(const f32x4 (&acc)[2][2][4][2], const float (&rs)[2][4], bf16_t* dst, int ldc, int cbase, float scale, int pm, int wr, int wc, int fr, int fq) {
    const int row0 = pm * BM + wr * 64 + fr, col0 = cbase + wc * 32 + 8 * fq;
#pragma unroll
    for (int ai = 0; ai < 2; ++ai)
#pragma unroll
        for (int m = 0; m < 4; ++m)
#pragma unroll
            for (int bj = 0; bj < 2; ++bj) { f32x4 v[2];
#pragma unroll
                for (int n = 0; n < 2; ++n)
#pragma unroll
                    for (int j = 0; j < 4; ++j) { const float x = acc[ai][bj][m][n][j] * rs[ai][m]; v[n][j] = ACT == 1 ? ::gelu_tanh_(x) : ACT == 2 ? ::siluf_(x) : x * scale; }
                *(u32x4*)(dst + (size_t)(row0 + ai * HALF + m * 16) * ldc + col0 + bj * HALF) = pack8(v[0], v[1]); }
}
template <int ACT> __device__ __forceinline__ void store_tile_f32_narrow(const f32x4 (&acc)[2][2][4][2], const float (&rs)[2][4], float* dst, int ldc, int ncols, int pm, int wr, int wc, int fr, int fq) {
    const int row0 = pm * BM + wr * 64 + fr;
#pragma unroll
    for (int ai = 0; ai < 2; ++ai)
#pragma unroll
        for (int m = 0; m < 4; ++m)
#pragma unroll
            for (int n = 0; n < 2; ++n) { const int c = wc * 32 + 8 * fq + 4 * n;
                if (c < ncols) { f32x4 v = acc[ai][0][m][n] * rs[ai][m];
                    if (ACT == 3) { v[0] = ::sigmoidf_(v[0]); v[1] = ::sigmoidf_(v[1]); v[2] = ::sigmoidf_(v[2]); v[3] = ::sigmoidf_(v[3]); }
                    *(f32x4*)(dst + (size_t)(row0 + ai * HALF + m * 16) * ldc + c) = v; } }
}
struct EpiLruIn {
    static constexpr bool PERM = true, AFTER_DRAIN = false;
    bf16_t* G; bf16_t* X; const float* ssp;
    __device__ __forceinline__ void operator()(const f32x4 (&acc)[2][2][4][2], const Unit& u, int wr, int wc, int fr, int fq) const {
        float rs[2][4]; load_rs(ssp, u.pm, wr, fr, rs);
        if (u.pn < 5) store_tile_bf16<1>(acc, rs, G, RNN, u.pn * BM, 1.f, u.pm, wr, wc, fr, fq);
        else store_tile_bf16<0>(acc, rs, X, RNN, (u.pn - 5) * BM, 1.f, u.pm, wr, wc, fr, fq);
    }
};
struct EpiNsaIn {
    static constexpr bool PERM = true, AFTER_DRAIN = false;
    bf16_t* Q; bf16_t* KV; float* GT; const float* ssp;
    __device__ __forceinline__ void operator()(const f32x4 (&acc)[2][2][4][2], const Unit& u, int wr, int wc, int fr, int fq) const {
        float rs[2][4]; load_rs(ssp, u.pm, wr, fr, rs);
        if (u.pn < 4) store_tile_bf16<0>(acc, rs, Q, 1024, u.pn * BM, 0.125f, u.pm, wr, wc, fr, fq);
        else if (u.pn < 10) store_tile_bf16<0>(acc, rs, KV + (size_t)(u.pn - 4) * T_ * 256, 256, 0, 1.f, u.pm, wr, wc, fr, fq);
        else store_tile_f32_narrow<3>(acc, rs, GT, 48, 48, u.pm, wr, wc, fr, fq);
    }
};
struct EpiGlaIn {
    static constexpr bool PERM = true, AFTER_DRAIN = false;
    bf16_t* Q; bf16_t* K; bf16_t* V; bf16_t* R; float* GL; const float* ssp;
    __device__ __forceinline__ void operator()(const f32x4 (&acc)[2][2][4][2], const Unit& u, int wr, int wc, int fr, int fq) const {
        float rs[2][4]; load_rs(ssp, u.pm, wr, fr, rs);
        if (u.pn < 2) store_tile_bf16<0>(acc, rs, Q, 512, u.pn * BM, 0.08838834764831845f, u.pm, wr, wc, fr, fq);
        else if (u.pn < 4) store_tile_bf16<0>(acc, rs, K, 512, (u.pn - 2) * BM, 1.f, u.pm, wr, wc, fr, fq);
        else if (u.pn < 8) store_tile_bf16<0>(acc, rs, V, 1024, (u.pn - 4) * BM, 1.f, u.pm, wr, wc, fr, fq);
        else if (u.pn < 12) store_tile_bf16<2>(acc, rs, R, 1024, (u.pn - 8) * BM, 1.f, u.pm, wr, wc, fr, fq);
        else store_tile_f32_narrow<0>(acc, rs, GL, 16, 16, u.pm, wr, wc, fr, fq);
    }
};
template <class Epi, class Sched, bool ALIGN_EPI = false, bool SP2 = false>
__device__ __forceinline__ void gemm_phase(PG8_LAS unsigned char* lds, const Gemm g, const Sched& S, const Epi& E, const int tid) {
    const int wid = __builtin_amdgcn_readfirstlane(tid >> 6), lane = tid & 63, wr = wid >> 2, wc = wid & 3, fr = lane & 15, fq = lane >> 4;
    const int K = g.K, nt = K / BK;
    unsigned voffA[2], voffB[2];
#pragma unroll
    for (int i = 0; i < 2; ++i) { int R, C; stage_rc(tid * 16 + i * 8192, R, C); const int Rb = Epi::PERM ? ((R & ~31) + perm32(R & 31)) : R;
        voffA[i] = (unsigned)(R * K + C) * 2u; voffB[i] = (unsigned)(Rb * K + C) * 2u; }
    const size_t kstep = (size_t)(BK * 2);
    const size_t hstep = (size_t)HALF * K * 2;
    const size_t tstep = 2 * hstep;
    const unsigned ldsw = (unsigned)wid * 1024u;
    const int aoff = lds_byte(wr * 64 + fr, fq * 8), boff = lds_byte(wc * 32 + fr, fq * 8);
#define PG8_SA(b, h) (((b) * 2 + (h)) * HTB)
#define PG8_SB(b, h) ((4 + (b) * 2 + (h)) * HTB)
#define PG8_STAGE(bufoff, gbase, voff) do { _Pragma("unroll") for (int _i = 0; _i < 2; ++_i) \
        __builtin_amdgcn_global_load_lds((const unsigned*)((const char*)(gbase) + (voff)[_i]), (PG8_LAS unsigned*)(lds + (bufoff) + ldsw + _i * 8192), 16, 0, 0); } while (0)
#define PG8_LDA(dst, b, h) do { _Pragma("unroll") for (int m = 0; m < 4; ++m) _Pragma("unroll") for (int k = 0; k < 2; ++k) dst[m][k] = *(const PG8_LAS bf16x8*)(lds + PG8_SA(b, h) + aoff + m * 2048 + k * 1024); } while (0)
#define PG8_LDB(dst, b, h) do { _Pragma("unroll") for (int n = 0; n < 2; ++n) _Pragma("unroll") for (int k = 0; k < 2; ++k) dst[n][k] = *(const PG8_LAS bf16x8*)(lds + PG8_SB(b, h) + boff + n * 2048 + k * 1024); } while (0)
#define PG8_MMA(ai, bj, At, Bt) do { __builtin_amdgcn_s_setprio(1); _Pragma("unroll") for (int m = 0; m < 4; ++m) _Pragma("unroll") for (int n = 0; n < 2; ++n) _Pragma("unroll") for (int k = 0; k < 2; ++k) \
        acc[ai][bj][m][n] = __builtin_amdgcn_mfma_f32_16x16x32_bf16(Bt[n][k], At[m][k], acc[ai][bj][m][n], 0, 0, 0); __builtin_amdgcn_s_setprio(0); } while (0)
#define PG8_WAIT_V(n) asm volatile("s_waitcnt vmcnt(" #n ")" ::: "memory")
#define PG8_WAIT_L(n) asm volatile("s_waitcnt lgkmcnt(" #n ")" ::: "memory")
#define PG8_BAR __builtin_amdgcn_s_barrier()
#define PG8_SCHED __builtin_amdgcn_sched_barrier(0)
    Unit cur, nxt; int ui = 0;
    if (!S.next(0, cur)) return;
    f32x4 acc[2][2][4][2];
#pragma unroll
    for (int a = 0; a < 2; ++a)
#pragma unroll
        for (int b = 0; b < 2; ++b)
#pragma unroll
            for (int m = 0; m < 4; ++m)
#pragma unroll
                for (int n = 0; n < 2; ++n) acc[a][b][m][n] = (f32x4){0.f, 0.f, 0.f, 0.f};
    bf16x8 At[4][2], B0[2][2], B1[2][2];
    const char* cA = (const char*)g.A + (size_t)cur.pm * tstep; const char* cB = (const char*)g.Bt + (size_t)cur.pn * tstep;
    S.a_ready(cur);
    if constexpr (SP2) {
        PG8_STAGE(PG8_SB(0, 0), cB, voffB); PG8_STAGE(PG8_SB(0, 1), cB + hstep, voffB); PG8_STAGE(PG8_SA(0, 0), cA, voffA); PG8_STAGE(PG8_SA(0, 1), cA + hstep, voffA);
        if (wr == 1) PG8_BAR;
        PG8_WAIT_V(2); PG8_BAR;
        PG8_STAGE(PG8_SB(1, 0), cB + kstep, voffB); PG8_STAGE(PG8_SA(1, 0), cA + kstep, voffA); PG8_STAGE(PG8_SB(1, 1), cB + hstep + kstep, voffB);
        PG8_WAIT_V(6); PG8_BAR;
    } else {
        PG8_STAGE(PG8_SB(0, 0), cB, voffB); PG8_STAGE(PG8_SA(0, 0), cA, voffA); PG8_STAGE(PG8_SB(0, 1), cB + hstep, voffB); PG8_STAGE(PG8_SA(0, 1), cA + hstep, voffA);
        if (wr == 1) PG8_BAR;
        PG8_WAIT_V(4); PG8_BAR;
        PG8_STAGE(PG8_SB(1, 0), cB + kstep, voffB); PG8_STAGE(PG8_SA(1, 0), cA + kstep, voffA); PG8_STAGE(PG8_SB(1, 1), cB + hstep + kstep, voffB);
        PG8_WAIT_V(6); PG8_BAR;
    }
    for (;;) {
        const bool has_next = S.next(ui + 1, nxt);
        const char* nA = has_next ? (const char*)g.A + (size_t)nxt.pm * tstep : cA; const char* nB = has_next ? (const char*)g.Bt + (size_t)nxt.pn * tstep : cB;
        for (int t = 0; t < nt; t += 2) {
            const bool last = (t == nt - 2);
            const char* a1 = cA + (size_t)(t + 1) * kstep;
            const char* a2 = last ? nA : cA + (size_t)(t + 2) * kstep; const char* b2 = last ? nB : cB + (size_t)(t + 2) * kstep;
            const char* a3 = a2 + kstep; const char* b3 = b2 + kstep;
            if (last && has_next) S.a_ready(nxt);
            if constexpr (SP2) {
            PG8_LDB(B0, 0, 0); PG8_LDB(B1, 0, 1); PG8_SCHED; PG8_LDA(At, 0, 0); PG8_STAGE(PG8_SA(1, 1), a1 + hstep, voffA);
            PG8_WAIT_V(8); PG8_WAIT_L(0); PG8_BAR; PG8_MMA(0, 0, At, B0); PG8_MMA(0, 1, At, B1); PG8_BAR; PG8_SCHED;
            PG8_LDA(At, 0, 1); PG8_STAGE(PG8_SB(0, 0), b2, voffB); PG8_STAGE(PG8_SB(0, 1), b2 + hstep, voffB); PG8_STAGE(PG8_SA(0, 0), a2, voffA);
            PG8_WAIT_V(8); PG8_WAIT_L(0); PG8_BAR; PG8_MMA(1, 0, At, B0); PG8_MMA(1, 1, At, B1); PG8_BAR; PG8_SCHED;
            PG8_LDB(B0, 1, 0); PG8_LDB(B1, 1, 1); PG8_SCHED; PG8_LDA(At, 1, 0); PG8_STAGE(PG8_SA(0, 1), a2 + hstep, voffA);
            PG8_WAIT_V(8); PG8_WAIT_L(0); PG8_BAR; PG8_MMA(0, 0, At, B0); PG8_MMA(0, 1, At, B1); PG8_BAR; PG8_SCHED;
            PG8_LDA(At, 1, 1); PG8_STAGE(PG8_SB(1, 0), b3, voffB); PG8_STAGE(PG8_SB(1, 1), b3 + hstep, voffB); PG8_STAGE(PG8_SA(1, 0), a3, voffA);
            PG8_WAIT_V(8); PG8_WAIT_L(0); PG8_BAR; PG8_MMA(1, 0, At, B0); PG8_MMA(1, 1, At, B1); PG8_BAR; PG8_SCHED;
            } else {
            PG8_LDB(B0, 0, 0); PG8_SCHED; PG8_LDA(At, 0, 0); PG8_STAGE(PG8_SA(1, 1), a1 + hstep, voffA);
            PG8_WAIT_L(8); PG8_BAR; PG8_WAIT_L(0); PG8_MMA(0, 0, At, B0); PG8_BAR; PG8_SCHED;
            PG8_LDB(B1, 0, 1); PG8_STAGE(PG8_SB(0, 0), b2, voffB);
            PG8_BAR; PG8_WAIT_L(0); PG8_MMA(0, 1, At, B1); PG8_BAR;
            PG8_LDA(At, 0, 1); PG8_STAGE(PG8_SA(0, 0), a2, voffA);
            PG8_BAR; PG8_WAIT_L(0); PG8_MMA(1, 0, At, B0); PG8_BAR; PG8_SCHED;
            PG8_STAGE(PG8_SB(0, 1), b2 + hstep, voffB);
            PG8_WAIT_V(6); PG8_BAR; PG8_MMA(1, 1, At, B1); PG8_BAR;
            PG8_LDB(B0, 1, 0); PG8_SCHED; PG8_LDA(At, 1, 0); PG8_STAGE(PG8_SA(0, 1), a2 + hstep, voffA);
            PG8_WAIT_L(8); PG8_BAR; PG8_WAIT_L(0); PG8_MMA(0, 0, At, B0); PG8_BAR; PG8_SCHED;
            PG8_LDB(B1, 1, 1); PG8_STAGE(PG8_SB(1, 0), b3, voffB);
            PG8_BAR; PG8_WAIT_L(0); PG8_MMA(0, 1, At, B1); PG8_BAR;
            PG8_LDA(At, 1, 1); PG8_STAGE(PG8_SA(1, 0), a3, voffA);
            PG8_BAR; PG8_WAIT_L(0); PG8_MMA(1, 0, At, B0); PG8_BAR; PG8_SCHED;
            PG8_STAGE(PG8_SB(1, 1), b3 + hstep, voffB);
            PG8_WAIT_V(6); PG8_BAR; PG8_MMA(1, 1, At, B1); PG8_BAR;
            }
        }
        if constexpr (ALIGN_EPI) { if (wr == 0) PG8_BAR; }
        if constexpr (!Epi::AFTER_DRAIN) { E(acc, cur, wr, wc, fr, fq); S.done(cur); }
        if (!has_next) break;
#pragma unroll
        for (int a = 0; a < 2; ++a)
#pragma unroll
            for (int b = 0; b < 2; ++b)
#pragma unroll
                for (int m = 0; m < 4; ++m)
#pragma unroll
                    for (int n = 0; n < 2; ++n) acc[a][b][m][n] = (f32x4){0.f, 0.f, 0.f, 0.f};
        cur = nxt; cA = nA; cB = nB; ++ui;
        if constexpr (ALIGN_EPI) { if (wr == 1) PG8_BAR; }
    }
    PG8_WAIT_V(0);
    if constexpr (!ALIGN_EPI) { if (wr == 0) PG8_BAR; }
    PG8_BAR;
    if constexpr (Epi::AFTER_DRAIN) { E.fused(acc, cur, wr, wc, fr, fq, lds, wid, lane); S.done(cur); }
#undef PG8_SA
#undef PG8_SB
#undef PG8_STAGE
#undef PG8_LDA
#undef PG8_LDB
#undef PG8_MMA
#undef PG8_WAIT_V
#undef PG8_WAIT_L
#undef PG8_BAR
#undef PG8_SCHED
}
}
__device__ __forceinline__ void transpose_item(const float* __restrict__ W, const float* __restrict__ gk, int ldw, int N, int k0, int n0, bf16_t* WT, int ldt, int dst_row0, LAS float* scr, int lane) {
    const int nn = n0 + (lane & 31); const bool ok = nn < N;
    float wv[32];
#pragma unroll
    for (int i = 0; i < 32; ++i) { const int kk = 2 * i + (lane >> 5); wv[i] = ok ? W[(size_t)(k0 + kk) * ldw + nn] : 0.f; }
#pragma unroll
    for (int i = 0; i < 32; ++i) { const int kk = 2 * i + (lane >> 5); scr[kk * 33 + (lane & 31)] = gk ? wv[i] * gk[k0 + kk] : wv[i]; }
    asm volatile("s_waitcnt lgkmcnt(0)" ::: "memory");
    const int c = lane & 7;
#pragma unroll
    for (int j = 0; j < 4; ++j) { const int n = (lane >> 3) + 8 * j; const LAS float* s = scr + (8 * c) * 33 + n;
        u32x4 o; o.x = pk2(s[0 * 33], s[1 * 33]); o.y = pk2(s[2 * 33], s[3 * 33]); o.z = pk2(s[4 * 33], s[5 * 33]); o.w = pk2(s[6 * 33], s[7 * 33]);
        *(u32x4*)(WT + (size_t)(dst_row0 + n) * ldt + k0 + 8 * c) = o; }
    asm volatile("s_waitcnt lgkmcnt(0)" ::: "memory");
}
__device__ __forceinline__ void transpose_job(const float* W, const float* gk, int K, int N, bf16_t* WT, int ldt, int mode, int& rot, int gw, int NGW, LAS float* scr, int lane) {
    const int nnb = (N + 31) >> 5, nit = (K >> 6) * nnb;
    int start = gw - rot; if (start < 0) start += NGW;
    for (int it = start; it < nit; it += NGW) {
        const int kb = it / nnb, nb = it - kb * nnb, n0 = nb << 5;
        const int dr = mode == 0 ? n0 : ((n0 >> 7) * 256 + (n0 & 127) + (mode == 2 ? 128 : 0));
        transpose_item(W, gk, N, N, kb << 6, n0, WT, ldt, dr, scr, lane);
    }
    rot = (rot + nit) % NGW;
}
__device__ __forceinline__ void init_stream_bf16(const float* src, bf16_t* dst, float* ssp, int gw, int NGW, int lane) {
    for (int m = gw; m < T_; m += NGW) {
        const f32x4* xr = (const f32x4*)(src + (size_t)m * D_) + lane;
        u32x2 o[4]; float s = 0.f;
#pragma unroll
        for (int j = 0; j < 4; ++j) { const f32x4 v = xr[64 * j]; o[j].x = pk2(v.x, v.y); o[j].y = pk2(v.z, v.w);
            const float a = bflo(o[j].x), b = bfhi(o[j].x), c = bflo(o[j].y), d = bfhi(o[j].y); s += (a * a + b * b) + (c * c + d * d); }
        const float st = wave_sum(s); if (lane < 4) ssp[(size_t)m * 4 + lane] = lane == 0 ? st : 0.f;
        u32x2* o8 = (u32x2*)(dst + (size_t)m * D_) + lane;
#pragma unroll
        for (int j = 0; j < 4; ++j) o8[64 * j] = o[j];
    }
}
__device__ __forceinline__ void final_norm_rows(const bf16_t* hb, const float* __restrict__ g, float* out, int gw, int NGW, int lane) {
    f32x4 gv[4];
#pragma unroll
    for (int j = 0; j < 4; ++j) gv[j] = *(const f32x4*)(g + 4 * lane + 256 * j);
    for (int m = gw; m < T_; m += NGW) {
        const u32x2* hr = (const u32x2*)(hb + (size_t)m * D_) + lane;
        f32x4 v[4]; float s = 0.f;
#pragma unroll
        for (int j = 0; j < 4; ++j) { const u32x2 w = hr[64 * j]; v[j] = (f32x4){bflo(w.x), bfhi(w.x), bflo(w.y), bfhi(w.y)}; s += (v[j].x * v[j].x + v[j].y * v[j].y) + (v[j].z * v[j].z + v[j].w * v[j].w); }
        const float rs = 1.0f / sqrtf(wave_sum(s) * (1.f / D_) + EPS);
        f32x4* xr = (f32x4*)(out + (size_t)m * D_) + lane;
#pragma unroll
        for (int j = 0; j < 4; ++j) xr[64 * j] = v[j] * rs * gv[j];
    }
}
__device__ __forceinline__ void nsa_b1eff(const float* __restrict__ pos, const float* __restrict__ w1, const float* __restrict__ b1, float* B1E, int gw, int NGW, int lane) {
    for (int o = gw; o < 128; o += NGW) { const int kv = o >> 6, j = o & 63; float s = 0.f;
#pragma unroll 8
        for (int i = 0; i < 32; ++i) { const int kk = lane + 64 * i; s += pos[kv * 2048 + kk] * w1[((size_t)kv * 2048 + kk) * 64 + j]; }
        s = wave_sum(s); if (lane == 0) B1E[o] = s + b1[o]; }
}
__device__ __forceinline__ f32x4 mfma16(bf16x8 a, bf16x8 b, f32x4 c) { return __builtin_amdgcn_mfma_f32_16x16x32_bf16(a, b, c, 0, 0, 0); }
__device__ __forceinline__ void unpack8(const u32x4 w, float (&f)[8]) { f[0] = bflo(w.x); f[1] = bfhi(w.x); f[2] = bflo(w.y); f[3] = bfhi(w.y); f[4] = bflo(w.z); f[5] = bfhi(w.z); f[6] = bflo(w.w); f[7] = bfhi(w.w); }
__device__ __forceinline__ u32x4 pack8f(const float (&f)[8]) { u32x4 w; w.x = pk2(f[0], f[1]); w.y = pk2(f[2], f[3]); w.z = pk2(f[4], f[5]); w.w = pk2(f[6], f[7]); return w; }

__device__ __forceinline__ float neg_expm1(float x) {
    const float p = 1.f + x * (0.5f + x * (0.16666667f + x * (0.041666668f + x * (0.0083333338f + x * 0.0013888889f))));
    const float big = 1.f - fast_exp2(x * LOG2E);
    return x > -0.3f ? -x * p : big;
}
__device__ __forceinline__ void lru_gates_phase(LAS unsigned char* lds, const bf16_t* X, const float* __restrict__ conv_w, const float* __restrict__ conv_b,
        const bf16_t* WAT, const bf16_t* WXT, const float* __restrict__ b_a, const float* __restrict__ b_x, const float* __restrict__ lam,
        bf16_t* HL, bf16_t* AC, float* AGGA, float* AGGH, const int tid, const int bid, const int G) {
    const int lane = tid & 63, wid = __builtin_amdgcn_readfirstlane(tid >> 6), fr = lane & 15, fq = lane >> 4;
    constexpr int SA = 0, SBA = 34816, SBX = 69632, SAF = 0, SUF = 67584, SAGG = 135168, LDA_ = 272, LDF = 528;
    for (int u = bid; u < 1280; u += G) {
        const int tt = u / 10, hd = u - tt * 10, m0 = tt * 128, cbase = hd * 128;
        { const int c8 = tid & 15, r = tid >> 4, ch = cbase + 8 * c8;
          float cw[4][8], cb[8];
#pragma unroll
          for (int k = 0; k < 4; ++k) { const f32x4 w0 = *(const f32x4*)(conv_w + k * RNN + ch), w1 = *(const f32x4*)(conv_w + k * RNN + ch + 4);
              cw[k][0] = w0[0]; cw[k][1] = w0[1]; cw[k][2] = w0[2]; cw[k][3] = w0[3]; cw[k][4] = w1[0]; cw[k][5] = w1[1]; cw[k][6] = w1[2]; cw[k][7] = w1[3]; }
          { const f32x4 w0 = *(const f32x4*)(conv_b + ch), w1 = *(const f32x4*)(conv_b + ch + 4); cb[0] = w0[0]; cb[1] = w0[1]; cb[2] = w0[2]; cb[3] = w0[3]; cb[4] = w1[0]; cb[5] = w1[1]; cb[6] = w1[2]; cb[7] = w1[3]; }
#pragma unroll
          for (int g = 0; g < 4; ++g) { const int row = r + 32 * g, m = m0 + row, ts = m & (SEQ - 1);
              float acc[8];
#pragma unroll
              for (int e = 0; e < 8; ++e) acc[e] = cb[e];
#pragma unroll
              for (int k = 0; k < 4; ++k) { const bool okk = ts - 3 + k >= 0;
                  const u32x4 xv = *(const u32x4*)(X + (size_t)(okk ? m - 3 + k : m) * RNN + ch); float xf[8]; unpack8(xv, xf); const float zk = okk ? 1.f : 0.f;
#pragma unroll
                  for (int e = 0; e < 8; ++e) acc[e] += cw[k][e] * (xf[e] * zk); }
              *(LAS u32x4*)(lds + SA + row * LDA_ + c8 * 16) = pack8f(acc); } }
#pragma unroll
        for (int i = 0; i < 8; ++i) { const int q = tid + 512 * i, mat = q >> 11, j = (q >> 4) & 127, c = q & 15;
            const u32x4 v = *(const u32x4*)((mat ? WXT : WAT) + hd * 16384 + j * 128 + c * 8);
            *(LAS u32x4*)(lds + (mat ? SBX : SBA) + j * LDA_ + c * 16) = v; }
        __syncthreads();
        const int rg = wid >> 1, chh = wid & 1;
        f32x4 acca[2][4], accx[2][4];
#pragma unroll
        for (int mt = 0; mt < 2; ++mt)
#pragma unroll
            for (int nt = 0; nt < 4; ++nt) { acca[mt][nt] = (f32x4){0.f, 0.f, 0.f, 0.f}; accx[mt][nt] = (f32x4){0.f, 0.f, 0.f, 0.f}; }
#pragma unroll
        for (int s = 0; s < 4; ++s) { bf16x8 af[2];
#pragma unroll
            for (int mt = 0; mt < 2; ++mt) af[mt] = *(const LAS bf16x8*)(lds + SA + (32 * rg + 16 * mt + fr) * LDA_ + (32 * s + 8 * fq) * 2);
#pragma unroll
            for (int nt = 0; nt < 4; ++nt) { const bf16x8 ba = *(const LAS bf16x8*)(lds + SBA + (64 * chh + 16 * nt + fr) * LDA_ + (32 * s + 8 * fq) * 2);
                const bf16x8 bx = *(const LAS bf16x8*)(lds + SBX + (64 * chh + 16 * nt + fr) * LDA_ + (32 * s + 8 * fq) * 2);
#pragma unroll
                for (int mt = 0; mt < 2; ++mt) { acca[mt][nt] = mfma16(ba, af[mt], acca[mt][nt]); accx[mt][nt] = mfma16(bx, af[mt], accx[mt][nt]); } } }
        u32x2 xcv[2][4];
#pragma unroll
        for (int mt = 0; mt < 2; ++mt)
#pragma unroll
            for (int nt = 0; nt < 4; ++nt) xcv[mt][nt] = *(const LAS u32x2*)(lds + SA + (32 * rg + 16 * mt + fr) * LDA_ + (64 * chh + 16 * nt + 4 * fq) * 2);
        __syncthreads();
#pragma unroll
        for (int nt = 0; nt < 4; ++nt) { const int cc = cbase + 64 * chh + 16 * nt + 4 * fq;
            const f32x4 ba4 = *(const f32x4*)(b_a + cc), bx4 = *(const f32x4*)(b_x + cc), lm4 = *(const f32x4*)(lam + cc);
            f32x4 nl8;
#pragma unroll
            for (int j = 0; j < 4; ++j) nl8[j] = -8.f * 0.6931471805599453f * __builtin_amdgcn_logf(1.f + fast_exp2(-lm4[j] * LOG2E));
#pragma unroll
            for (int mt = 0; mt < 2; ++mt) { const float xc4[4] = {bflo(xcv[mt][nt].x), bfhi(xcv[mt][nt].x), bflo(xcv[mt][nt].y), bfhi(xcv[mt][nt].y)};
                f32x4 a4, u4;
#pragma unroll
                for (int j = 0; j < 4; ++j) { const float r = sigmoidf_(acca[mt][nt][j] + ba4[j]), ig = sigmoidf_(accx[mt][nt][j] + bx4[j]);
                    const float la = nl8[j] * r; a4[j] = fast_exp2(la * LOG2E); u4[j] = __builtin_amdgcn_sqrtf(neg_expm1(2.f * la)) * ig * xc4[j]; }
                const int off = (32 * rg + 16 * mt + fr) * LDF + (64 * chh + 16 * nt + 4 * fq) * 4;
                *(LAS f32x4*)(lds + SAF + off) = a4; *(LAS f32x4*)(lds + SUF + off) = u4; } }
        __syncthreads();
        { const int ch = tid & 127, seg = tid >> 7;
          LAS float* pa = (LAS float*)(lds + SAF) + ch; LAS float* pu = (LAS float*)(lds + SUF) + ch; LAS float* ag = (LAS float*)(lds + SAGG);
          float A = 1.f, H = 0.f;
#pragma unroll 8
          for (int t = seg * 32; t < seg * 32 + 32; ++t) { const float a = pa[t * (LDF / 4)], uu = pu[t * (LDF / 4)]; H = a * H + uu; A *= a; }
          ag[seg * 128 + ch] = A; ag[512 + seg * 128 + ch] = H;
          __syncthreads();
          float cA = 1.f, cH = 0.f;
          for (int s = 0; s < seg; ++s) { const float As = ag[s * 128 + ch], Hs = ag[512 + s * 128 + ch]; cH = As * cH + Hs; cA *= As; }
#pragma unroll 8
          for (int t = seg * 32; t < seg * 32 + 32; ++t) { const float a = pa[t * (LDF / 4)], uu = pu[t * (LDF / 4)]; cH = a * cH + uu; cA *= a; pa[t * (LDF / 4)] = cA; pu[t * (LDF / 4)] = cH; }
          if (seg == 3) { AGGA[(size_t)tt * RNN + cbase + ch] = cA; AGGH[(size_t)tt * RNN + cbase + ch] = cH; } }
        __syncthreads();
#pragma unroll
        for (int i = 0; i < 4; ++i) { const int q = tid + 512 * i, row = q >> 4, c8 = q & 15;
            const f32x4 a0 = *(const LAS f32x4*)(lds + SAF + row * LDF + c8 * 32), a1 = *(const LAS f32x4*)(lds + SAF + row * LDF + c8 * 32 + 16);
            const f32x4 h0 = *(const LAS f32x4*)(lds + SUF + row * LDF + c8 * 32), h1 = *(const LAS f32x4*)(lds + SUF + row * LDF + c8 * 32 + 16);
            u32x4 wa, wh; wa.x = pk2(a0[0], a0[1]); wa.y = pk2(a0[2], a0[3]); wa.z = pk2(a1[0], a1[1]); wa.w = pk2(a1[2], a1[3]);
            wh.x = pk2(h0[0], h0[1]); wh.y = pk2(h0[2], h0[3]); wh.z = pk2(h1[0], h1[1]); wh.w = pk2(h1[2], h1[3]);
            const size_t go = (size_t)(m0 + row) * RNN + cbase + 8 * c8;
            *(u32x4*)(AC + go) = wa; *(u32x4*)(HL + go) = wh; }
        __syncthreads();
    }
}
__device__ __forceinline__ void lru_apply_phase(bf16_t* GB, const bf16_t* HL, const bf16_t* AC, const float* AGGA, const float* AGGH, const int tid, const int bid, const int G) {
    const int c8 = tid & 31, r = tid >> 5;
    for (int u = bid; u < 640; u += G) {
        const int tt = u / 5, cb = u - tt * 5, m0 = tt * 128, ch = cb * 256 + 8 * c8;
        float carry[8];
#pragma unroll
        for (int e = 0; e < 8; ++e) carry[e] = 0.f;
        { const int p0 = tt & ~63; int p = p0;
          for (; p + 8 <= tt; p += 8) { f32x4 a0[8], a1[8], h0[8], h1[8];
#pragma unroll
              for (int q = 0; q < 8; ++q) { const size_t o = (size_t)(p + q) * RNN + ch; a0[q] = *(const f32x4*)(AGGA + o); a1[q] = *(const f32x4*)(AGGA + o + 4); h0[q] = *(const f32x4*)(AGGH + o); h1[q] = *(const f32x4*)(AGGH + o + 4); }
#pragma unroll
              for (int q = 0; q < 8; ++q)
#pragma unroll
                  for (int e = 0; e < 4; ++e) { carry[e] = carry[e] * a0[q][e] + h0[q][e]; carry[4 + e] = carry[4 + e] * a1[q][e] + h1[q][e]; } }
          for (; p < tt; ++p) { const size_t o = (size_t)p * RNN + ch; const f32x4 a0 = *(const f32x4*)(AGGA + o), a1 = *(const f32x4*)(AGGA + o + 4), h0 = *(const f32x4*)(AGGH + o), h1 = *(const f32x4*)(AGGH + o + 4);
#pragma unroll
              for (int e = 0; e < 4; ++e) { carry[e] = carry[e] * a0[e] + h0[e]; carry[4 + e] = carry[4 + e] * a1[e] + h1[e]; } } }
#pragma unroll
        for (int i = 0; i < 8; ++i) { const size_t go = (size_t)(m0 + r + 16 * i) * RNN + ch;
            float g[8], hl[8], ac[8], y[8]; unpack8(*(const u32x4*)(GB + go), g); unpack8(*(const u32x4*)(HL + go), hl); unpack8(*(const u32x4*)(AC + go), ac);
#pragma unroll
            for (int e = 0; e < 8; ++e) y[e] = g[e] * (hl[e] + ac[e] * carry[e]);
            *(u32x4*)(GB + go) = pack8f(y); }
    }
}
__device__ __forceinline__ s16x4 tr_read(const LAS unsigned char* p) { typedef short v4i16_t __attribute__((ext_vector_type(4))); return __builtin_bit_cast(s16x4, __builtin_amdgcn_ds_read_tr16_b64_v4i16((LAS v4i16_t*)p)); }
__device__ __forceinline__ bf16x8 cat44(s16x4 lo, s16x4 hi) { return (bf16x8){lo[0], lo[1], lo[2], lo[3], hi[0], hi[1], hi[2], hi[3]}; }
__device__ __forceinline__ void gla_cum(LAS unsigned char* lds, const float* GL, const float* __restrict__ w_g2, const float* __restrict__ b_g2, int m0, int h, const int tid, const int bid, const int G) {

    LAS float* sGL = (LAS float*)lds; LAS float* sSeg = (LAS float*)(lds + 4096); LAS float* sB = (LAS float*)(lds + 8192);
    if (tid < 256) *(LAS f32x4*)(sGL + tid * 4) = *(const f32x4*)(GL + (size_t)m0 * 16 + tid * 4);
    const int d = tid & 127, tq = tid >> 7, dch = h * 128 + d;
    float w[16];
#pragma unroll
    for (int r = 0; r < 16; ++r) w[r] = w_g2[r * 512 + dch];
    const float bb = b_g2[dch];
    __syncthreads();
    float run = 0.f;
#pragma unroll 4
    for (int i = 0; i < 16; ++i) { const int t = tq * 16 + i; float z = bb;
#pragma unroll
        for (int r4 = 0; r4 < 4; ++r4) { const f32x4 gv = *(const LAS f32x4*)(sGL + t * 16 + r4 * 4); z += gv[0] * w[r4 * 4] + gv[1] * w[r4 * 4 + 1] + gv[2] * w[r4 * 4 + 2] + gv[3] * w[r4 * 4 + 3]; }
        const float la = -(__builtin_amdgcn_logf(1.f + fast_exp2(-fabsf(z) * LOG2E)) * 0.6931471805599453f + fmaxf(-z, 0.f)) * 0.0625f;
        run += la; sB[t * 128 + d] = run; }
    sSeg[tq * 128 + d] = run;
    __syncthreads();
    float pre = 0.f;
    for (int s = 0; s < tq; ++s) pre += sSeg[s * 128 + d];
#pragma unroll 4
    for (int i = 0; i < 16; ++i) sB[(tq * 16 + i) * 128 + d] += pre;
    __syncthreads();
}
__device__ __forceinline__ void gla_kv_phase(LAS unsigned char* lds, const bf16_t* Kg, const bf16_t* Vg, const float* GL, const float* w_g2, const float* b_g2, bf16_t* KVT, float* DEC, const int tid, const int bid, const int G) {
    const int lane = tid & 63, wid = __builtin_amdgcn_readfirstlane(tid >> 6), fr = lane & 15, fq = lane >> 4, q4 = (lane & 15) >> 2, p4 = lane & 3;
    constexpr int SB_ = 8192, SK = 40960, SV = 58368, LDK = 272, LDV = 528;
    const LAS float* sB = (const LAS float*)(lds + SB_);
    for (int u = bid; u < 1024; u += G) {
        const int b = u >> 9, n = (u >> 2) & 127, h = u & 3, m0 = b * SEQ + 64 * n, bh = b * 4 + h;
        gla_cum(lds, GL, w_g2, b_g2, m0, h, tid, bid, G);
#pragma unroll
        for (int i = 0; i < 2; ++i) { const int q = tid + 512 * i, t = q >> 4, c = q & 15; float kf[8]; unpack8(*(const u32x4*)(Kg + (size_t)(m0 + t) * 512 + h * 128 + 8 * c), kf);
#pragma unroll
            for (int e = 0; e < 8; ++e) kf[e] *= fast_exp2((sB[63 * 128 + 8 * c + e] - sB[t * 128 + 8 * c + e]) * LOG2E);
            *(LAS u32x4*)(lds + SK + t * LDK + c * 16) = pack8f(kf); }
        if (tid < 128) DEC[((size_t)bh * 128 + n) * 128 + tid] = fast_exp2(sB[63 * 128 + tid] * LOG2E);
#pragma unroll
        for (int i = 0; i < 4; ++i) { const int q = tid + 512 * i, t = q >> 5, c = q & 31; *(LAS u32x4*)(lds + SV + t * LDV + c * 16) = *(const u32x4*)(Vg + (size_t)(m0 + t) * 1024 + h * 256 + 8 * c); }
        __syncthreads();
        f32x4 acc[8][2];
#pragma unroll
        for (int mt = 0; mt < 8; ++mt) { acc[mt][0] = (f32x4){0.f, 0.f, 0.f, 0.f}; acc[mt][1] = (f32x4){0.f, 0.f, 0.f, 0.f}; }
#pragma unroll
        for (int s = 0; s < 2; ++s) { bf16x8 bv[2];
#pragma unroll
            for (int nl = 0; nl < 2; ++nl) { const LAS unsigned char* pv = lds + SV + (32 * s + 8 * fq + q4) * LDV + (32 * wid + 16 * nl + 4 * p4) * 2; bv[nl] = cat44(tr_read(pv), tr_read(pv + 4 * LDV)); }
#pragma unroll
            for (int mt = 0; mt < 8; ++mt) { const LAS unsigned char* pk = lds + SK + (32 * s + 8 * fq + q4) * LDK + (16 * mt + 4 * p4) * 2; const bf16x8 ak = cat44(tr_read(pk), tr_read(pk + 4 * LDK));
                acc[mt][0] = mfma16(ak, bv[0], acc[mt][0]); acc[mt][1] = mfma16(ak, bv[1], acc[mt][1]); } }
        bf16_t* dst = KVT + ((size_t)bh * 128 + n) * 32768;
#pragma unroll
        for (int mt = 0; mt < 8; ++mt)
#pragma unroll
            for (int nl = 0; nl < 2; ++nl) { u32x2 w; w.x = pk2(acc[mt][nl][0], acc[mt][nl][1]); w.y = pk2(acc[mt][nl][2], acc[mt][nl][3]);
                *(u32x2*)(dst + (32 * wid + 16 * nl + fr) * 128 + 16 * mt + 4 * fq) = w; }
        __syncthreads();
    }
}
__device__ __forceinline__ void gla_scan_phase(bf16_t* KVT, const float* DEC, const int tid, const int bid, const int G) {
    const int nthr = G * 512;
    for (int e2 = bid * 512 + tid; e2 < 8 * 16384; e2 += nthr) {
        const int bh = e2 >> 14, e = (e2 & 16383) * 2, dk = e & 127;
        unsigned* p = (unsigned*)(KVT + (size_t)bh * 128 * 32768 + e); const float* dp = DEC + (size_t)bh * 128 * 128 + dk;
        float s0 = 0.f, s1 = 0.f;
        for (int n0 = 0; n0 < 128; n0 += 8) { unsigned w[8]; f32x2 d2[8];
#pragma unroll
            for (int i = 0; i < 8; ++i) { w[i] = p[(size_t)(n0 + i) * 16384]; d2[i] = *(const f32x2*)(dp + (n0 + i) * 128); }
#pragma unroll
            for (int i = 0; i < 8; ++i) { p[(size_t)(n0 + i) * 16384] = pk2(s0, s1); s0 = s0 * d2[i].x + bflo(w[i]); s1 = s1 * d2[i].y + bfhi(w[i]); } }
    }
}
__device__ __forceinline__ void gla_out_phase(LAS unsigned char* lds, const bf16_t* Qg, const bf16_t* Kg, const bf16_t* Vg, const bf16_t* Rg, const float* GL, const float* w_g2, const float* b_g2,
        const float* __restrict__ norm_g, const bf16_t* KVT, bf16_t* Y, const int tid, const int bid, const int G) {
    const int lane = tid & 63, wid = __builtin_amdgcn_readfirstlane(tid >> 6), fr = lane & 15, fq = lane >> 4, q4 = (lane & 15) >> 2, p4 = lane & 3;
    constexpr int SB_ = 8192, SQ = 40960, SKI = 58368, SV = 75776, SATT = 109568, SSS = 118784, LDQ = 272, LDV = 528, LDAT = 144;
    const LAS float* sB = (const LAS float*)(lds + SB_);
    for (int u = bid; u < 1024; u += G) {
        const int b = u >> 9, n = (u >> 2) & 127, h = u & 3, m0 = b * SEQ + 64 * n, bh = b * 4 + h;
        bf16x8 bsall[4][2];
        { const bf16_t* Sp = KVT + ((size_t)bh * 128 + n) * 32768;
#pragma unroll
          for (int s = 0; s < 4; ++s)
#pragma unroll
              for (int nl = 0; nl < 2; ++nl) bsall[s][nl] = *(const bf16x8*)(Sp + (32 * wid + 16 * nl + fr) * 128 + 32 * s + 8 * fq); }
        gla_cum(lds, GL, w_g2, b_g2, m0, h, tid, bid, G);
#pragma unroll
        for (int i = 0; i < 2; ++i) { const int q = tid + 512 * i, t = q >> 4, c = q & 15; float qf[8], kf[8];
            unpack8(*(const u32x4*)(Qg + (size_t)(m0 + t) * 512 + h * 128 + 8 * c), qf); unpack8(*(const u32x4*)(Kg + (size_t)(m0 + t) * 512 + h * 128 + 8 * c), kf);
#pragma unroll
            for (int e = 0; e < 8; ++e) { const float bb = sB[t * 128 + 8 * c + e] * LOG2E; qf[e] *= fast_exp2(bb); kf[e] *= fast_exp2(-bb); }
            *(LAS u32x4*)(lds + SQ + t * LDQ + c * 16) = pack8f(qf); *(LAS u32x4*)(lds + SKI + t * LDQ + c * 16) = pack8f(kf); }
#pragma unroll
        for (int i = 0; i < 4; ++i) { const int q = tid + 512 * i, t = q >> 5, c = q & 31; *(LAS u32x4*)(lds + SV + t * LDV + c * 16) = *(const u32x4*)(Vg + (size_t)(m0 + t) * 1024 + h * 256 + 8 * c); }
        __syncthreads();
        { const int mt = wid >> 1; f32x4 at[2] = {(f32x4){0.f, 0.f, 0.f, 0.f}, (f32x4){0.f, 0.f, 0.f, 0.f}};
#pragma unroll
          for (int s = 0; s < 4; ++s) { const bf16x8 a = *(const LAS bf16x8*)(lds + SQ + (16 * mt + fr) * LDQ + (32 * s + 8 * fq) * 2);
#pragma unroll
              for (int nl = 0; nl < 2; ++nl) { const int nt = 2 * (wid & 1) + nl; const bf16x8 bk = *(const LAS bf16x8*)(lds + SKI + (16 * nt + fr) * LDQ + (32 * s + 8 * fq) * 2); at[nl] = mfma16(bk, a, at[nl]); } }
#pragma unroll
          for (int nl = 0; nl < 2; ++nl) { const int nt = 2 * (wid & 1) + nl, c = 16 * mt + fr, j0 = 16 * nt + 4 * fq; float v[4];
#pragma unroll
              for (int j = 0; j < 4; ++j) v[j] = (j0 + j <= c) ? at[nl][j] : 0.f;
              u32x2 w; w.x = pk2(v[0], v[1]); w.y = pk2(v[2], v[3]); *(LAS u32x2*)(lds + SATT + c * LDAT + j0 * 2) = w; } }
        __syncthreads();
        f32x4 o[4][2];
#pragma unroll
        for (int mt = 0; mt < 4; ++mt) { o[mt][0] = (f32x4){0.f, 0.f, 0.f, 0.f}; o[mt][1] = (f32x4){0.f, 0.f, 0.f, 0.f}; }
#pragma unroll
        for (int s = 0; s < 2; ++s) { bf16x8 bv[2];
#pragma unroll
            for (int nl = 0; nl < 2; ++nl) { const LAS unsigned char* pv = lds + SV + (32 * s + 8 * fq + q4) * LDV + (32 * wid + 16 * nl + 4 * p4) * 2; bv[nl] = cat44(tr_read(pv), tr_read(pv + 4 * LDV)); }
#pragma unroll
            for (int mt = 0; mt < 4; ++mt) { const bf16x8 a = *(const LAS bf16x8*)(lds + SATT + (16 * mt + fr) * LDAT + (32 * s + 8 * fq) * 2);
                o[mt][0] = mfma16(bv[0], a, o[mt][0]); o[mt][1] = mfma16(bv[1], a, o[mt][1]); } }
#pragma unroll
        for (int s = 0; s < 4; ++s) {
#pragma unroll
            for (int mt = 0; mt < 4; ++mt) { const bf16x8 a = *(const LAS bf16x8*)(lds + SQ + (16 * mt + fr) * LDQ + (32 * s + 8 * fq) * 2);
                o[mt][0] = mfma16(bsall[s][0], a, o[mt][0]); o[mt][1] = mfma16(bsall[s][1], a, o[mt][1]); } }
        LAS float* sSS = (LAS float*)(lds + SSS);
#pragma unroll
        for (int mt = 0; mt < 4; ++mt) { float ss = 0.f;
#pragma unroll
            for (int nl = 0; nl < 2; ++nl)
#pragma unroll
                for (int j = 0; j < 4; ++j) ss += o[mt][nl][j] * o[mt][nl][j];
            ss += __shfl_xor(ss, 16); ss += __shfl_xor(ss, 32);
            if (fq == 0) sSS[(16 * mt + fr) * 8 + wid] = ss; }
        __syncthreads();
#pragma unroll
        for (int mt = 0; mt < 4; ++mt) { const int tok = 16 * mt + fr; const f32x4 s0 = *(const LAS f32x4*)(sSS + tok * 8), s1 = *(const LAS f32x4*)(sSS + tok * 8 + 4);
            const float tot = ((s0[0] + s0[1]) + (s0[2] + s0[3])) + ((s1[0] + s1[1]) + (s1[2] + s1[3])); const float rs = __builtin_amdgcn_rsqf(tot * (1.f / 256.f) + EPS);
#pragma unroll
            for (int nl = 0; nl < 2; ++nl) { const int dv = 32 * wid + 16 * nl + 4 * fq; const f32x4 gn = *(const f32x4*)(norm_g + dv);
                const size_t go = (size_t)(m0 + tok) * 1024 + h * 256 + dv; const u32x2 rv = *(const u32x2*)(Rg + go);
                u32x2 w; w.x = pk2(o[mt][nl][0] * rs * gn[0] * bflo(rv.x), o[mt][nl][1] * rs * gn[1] * bfhi(rv.x)); w.y = pk2(o[mt][nl][2] * rs * gn[2] * bflo(rv.y), o[mt][nl][3] * rs * gn[3] * bfhi(rv.y));
                *(u32x2*)(Y + go) = w; } }
        __syncthreads();
    }
}
__device__ __forceinline__ void nsa_compress_phase(LAS unsigned char* lds, const bf16_t* KV, const float* __restrict__ pos, const float* __restrict__ w1, const float* __restrict__ b1,
        const float* __restrict__ b2, const bf16_t* W1T, const bf16_t* W2T, bf16_t* KC, bf16_t* VC, bf16_t* VT, const float* B1E, const int tid, const int bid, const int G) {
    const int lane = tid & 63, wid = __builtin_amdgcn_readfirstlane(tid >> 6), fr = lane & 15, fq = lane >> 4;
    constexpr int SP = 0, SB1 = 2048, SPART = 4096, SH = 36864, LDH = 144;
    for (int u = bid; u < 256; u += G) {
        const int kv = u >> 7, b = (u >> 6) & 1, g = (u >> 4) & 3, n0 = (u & 15) * 32;
        if (tid < 64) ((LAS float*)(lds + SB1))[tid] = B1E[kv * 64 + tid];
        { const int rt = wid & 1, kq = wid >> 1, n = n0 + 16 * rt + fr; const bool ok = n <= 510;
          const bf16_t* src = KV + (size_t)kv * T_ * 256 + (size_t)(b * SEQ + 16 * (ok ? n : 0)) * 256 + g * 64;
          const bf16_t* wt = W1T + (size_t)kv * 64 * 2048;
          f32x4 acc[4] = {(f32x4){0.f, 0.f, 0.f, 0.f}, (f32x4){0.f, 0.f, 0.f, 0.f}, (f32x4){0.f, 0.f, 0.f, 0.f}, (f32x4){0.f, 0.f, 0.f, 0.f}};
#pragma unroll 4
          for (int s = 0; s < 16; ++s) { const int kk = kq * 512 + 32 * s + 8 * fq, l = kk >> 6, d = kk & 63;
              bf16x8 a = *(const bf16x8*)(src + (size_t)l * 256 + d); if (!ok) a = (bf16x8){0, 0, 0, 0, 0, 0, 0, 0};
#pragma unroll
              for (int nt = 0; nt < 4; ++nt) { const bf16x8 bb = *(const bf16x8*)(wt + (size_t)(16 * nt + fr) * 2048 + kk); acc[nt] = mfma16(bb, a, acc[nt]); } }
#pragma unroll
          for (int nt = 0; nt < 4; ++nt) *(LAS f32x4*)(lds + SPART + ((kq * 2 + rt) * 1024 + fr * 64 + 16 * nt + 4 * fq) * 4) = acc[nt]; }
        __syncthreads();
        { const int row = tid >> 4, c4 = (tid & 15) * 4, rt = row >> 4, rr = row & 15; f32x4 s = *(const LAS f32x4*)(lds + SB1 + c4 * 4);
#pragma unroll
          for (int kq = 0; kq < 4; ++kq) s += *(const LAS f32x4*)(lds + SPART + ((kq * 2 + rt) * 1024 + rr * 64 + c4) * 4);
          u32x2 w; w.x = pk2(gelu_tanh_(s[0]), gelu_tanh_(s[1])); w.y = pk2(gelu_tanh_(s[2]), gelu_tanh_(s[3])); *(LAS u32x2*)(lds + SH + row * LDH + c4 * 2) = w; }
        __syncthreads();
        { const int rt = wid >> 2, nt = wid & 3; f32x4 acc = (f32x4){0.f, 0.f, 0.f, 0.f};
#pragma unroll
          for (int s = 0; s < 2; ++s) { const bf16x8 a = *(const LAS bf16x8*)(lds + SH + (16 * rt + fr) * LDH + (32 * s + 8 * fq) * 2);
              const bf16x8 bb = *(const bf16x8*)(W2T + kv * 4096 + (16 * nt + fr) * 64 + 32 * s + 8 * fq); acc = mfma16(bb, a, acc); }
          const int n = n0 + 16 * rt + fr, d = 16 * nt + 4 * fq; const f32x4 bv = *(const f32x4*)(b2 + kv * 64 + d);
          u32x2 w; w.x = pk2(acc[0] + bv[0], acc[1] + bv[1]); w.y = pk2(acc[2] + bv[2], acc[3] + bv[3]);
          *(u32x2*)((kv ? VC : KC) + ((size_t)(b * 4 + g) * 512 + n) * 64 + d) = w; }
        __syncthreads();
    }
    { const bf16_t* VS = KV + (size_t)3 * T_ * 256;
      for (int tt = bid; tt < T_ / 64; tt += G) { const int r0 = tt * 64, bb = r0 >> 13, t0 = r0 & 8191;
#pragma unroll
          for (int i = 0; i < 4; ++i) { const int q = tid + 512 * i, row = q >> 5, ch = q & 31; *(LAS u32x4*)(lds + row * 528 + ch * 16) = *(const u32x4*)(VS + (size_t)(r0 + row) * 256 + ch * 8); }
          __syncthreads();
          { const int cc = tid >> 1, hf = tid & 1; unsigned short v[32];
#pragma unroll
            for (int k = 0; k < 32; ++k) v[k] = *(const LAS unsigned short*)(lds + (hf * 32 + k) * 528 + cc * 2);
            bf16_t* dst = VT + ((size_t)(bb * 256 + cc)) * 8192 + t0 + hf * 32;
#pragma unroll
            for (int k = 0; k < 4; ++k) { u32x4 w; w.x = v[8 * k] | ((unsigned)v[8 * k + 1] << 16); w.y = v[8 * k + 2] | ((unsigned)v[8 * k + 3] << 16); w.z = v[8 * k + 4] | ((unsigned)v[8 * k + 5] << 16); w.w = v[8 * k + 6] | ((unsigned)v[8 * k + 7] << 16);
                *(u32x4*)(dst + 8 * k) = w; } }
          __syncthreads(); } }
}
#ifndef NSA_LOCKSTEP
#define NSA_LOCKSTEP 0
#endif
#ifndef NSA_ONE_WAVE
#define NSA_ONE_WAVE 0
#endif
#ifndef NSA_SPARSE_SKIP
#define NSA_SPARSE_SKIP 0
#endif
#ifndef NSA_CT3_ONLY
#define NSA_CT3_ONLY 0
#endif
#ifndef NSA_SEL_REP
#define NSA_SEL_REP 1
#endif
#ifndef NSA_WIN_REP
#define NSA_WIN_REP 1
#endif
struct NsaSt { float m, l; f32x4 o[4]; };
struct KVRegs { u32x4 k[2], v[2]; };
template <int MODE, int STEP, int CTM>
__device__ __forceinline__ void nsa_tile(const LAS unsigned char* sK, const LAS unsigned char* sV, const bf16x8 (&qf)[2][2], NsaSt (&st)[2], const int (&dbase)[2],
        const bool general, const bool (&colsel)[2], const LAS float* bt, const float bfar, const float (&minv)[2], LAS float* sMain, LAS float* sSpill, const int (&tokl)[2], const int mg0,
        const int fr_in, const int fq_in, const int q4_in, const int p4_in) {
    constexpr int LDT = 144; const float NEG = -INFINITY;
    int fr = fr_in, fq = fq_in, q4 = q4_in, p4 = p4_in; asm volatile("" : "+v"(fr), "+v"(fq), "+v"(q4), "+v"(p4));
    bf16x8 kf[4][2];
#pragma unroll
    for (int kt = 0; kt < 4; ++kt) { kf[kt][0] = *(const LAS bf16x8*)(sK + (16 * kt + fr) * LDT + (8 * fq) * 2); kf[kt][1] = *(const LAS bf16x8*)(sK + (16 * kt + fr) * LDT + (32 + 8 * fq) * 2); }
    f32x4 sacc[2][4];
#pragma unroll
    for (int ct = 0; ct < 2; ++ct) if (CTM & (1 << ct)) {
#pragma unroll
        for (int kt = 0; kt < 4; ++kt) sacc[ct][kt] = mfma16(kf[kt][0], qf[ct][0], (f32x4){0.f, 0.f, 0.f, 0.f});
#pragma unroll
        for (int kt = 0; kt < 4; ++kt) sacc[ct][kt] = mfma16(kf[kt][1], qf[ct][1], sacc[ct][kt]); }
#pragma unroll
    for (int ct = 0; ct < 2; ++ct) if (CTM & (1 << ct)) {
        float tmax = NEG;
        if (general) {
            float bv[4][4];
#pragma unroll
            for (int kt = 0; kt < 4; ++kt)
#pragma unroll
                for (int j = 0; j < 4; ++j) { const int dist = dbase[ct] - (16 * kt + 4 * fq + j) * STEP; const int idx = dist < 0 ? 0 : (dist > 128 ? 128 : dist); bv[kt][j] = bt[idx]; }
#pragma unroll
            for (int kt = 0; kt < 4; ++kt)
#pragma unroll
                for (int j = 0; j < 4; ++j) { const int dist = dbase[ct] - (16 * kt + 4 * fq + j) * STEP; bool valid = dist >= 0;
                    if (MODE == 3) valid = valid && dist < 512;
                    if (MODE == 2) valid = valid && colsel[ct];
                    const float x = valid ? sacc[ct][kt][j] * LOG2E + bv[kt][j] : NEG;
                    sacc[ct][kt][j] = x; tmax = max3_(tmax, x, x); }
        } else {
#pragma unroll
            for (int kt = 0; kt < 4; ++kt) tmax = max3_(max3_(tmax, sacc[ct][kt][0], sacc[ct][kt][1]), sacc[ct][kt][2], sacc[ct][kt][3]);
            tmax = (MODE == 2 && !colsel[ct]) ? NEG : tmax * LOG2E + bfar;
        }
        if (MODE == 1) {
            const float mm = st[ct].m, li = minv[ct];
#pragma unroll
            for (int kt = 0; kt < 4; ++kt) { float gs = 0.f, p3 = 0.f;
#pragma unroll
                for (int j = 0; j < 4; ++j) { const float xx = general ? sacc[ct][kt][j] : sacc[ct][kt][j] * LOG2E + bfar; const float p = fast_exp2(xx - mm) * li; sacc[ct][kt][j] = p; gs += p; if (j == 3) p3 = p; }
                gs += dpp_xor1(gs); gs += dpp_xor2(gs); p3 += dpp_xor1(p3); p3 += dpp_xor2(p3);
                const int mg = mg0 + 4 * kt + fq;
                if ((fr & 3) == 0) { sMain[tokl[ct] * 128 + mg] = gs; if (mg + 1 < 128) sSpill[tokl[ct] * 128 + mg + 1] = p3; } }
        } else {
            const float rm = xmax16_32(tmax);
            const bool need = rm > st[ct].m + 8.f;
            if (__any(need)) { const float mnew = need ? fmaxf(st[ct].m, rm) : st[ct].m, alpha = (st[ct].m == mnew) ? 1.f : fast_exp2(st[ct].m - mnew);
                st[ct].l *= alpha; st[ct].m = mnew;
                if (MODE != 0) {
#pragma unroll
                    for (int dt = 0; dt < 4; ++dt) st[ct].o[dt] = st[ct].o[dt] * alpha; } }
            const float mref = (st[ct].m == NEG) ? 0.f : st[ct].m;
            float ps = 0.f;
            if (general) {
#pragma unroll
                for (int kt = 0; kt < 4; ++kt)
#pragma unroll
                    for (int j = 0; j < 4; ++j) { const float p = fast_exp2(sacc[ct][kt][j] - mref); sacc[ct][kt][j] = p; ps += p; }
            } else { const float c = (MODE == 2 && !colsel[ct]) ? NEG : bfar - mref;
#pragma unroll
                for (int kt = 0; kt < 4; ++kt)
#pragma unroll
                    for (int j = 0; j < 4; ++j) { const float p = fast_exp2(sacc[ct][kt][j] * LOG2E + c); sacc[ct][kt][j] = p; ps += p; } }
            st[ct].l += ps;
        }
    }
    if (MODE != 0) {
#pragma unroll
        for (int s = 0; s < 2; ++s) { bf16x8 pf[2];
#pragma unroll
            for (int ct = 0; ct < 2; ++ct) if (CTM & (1 << ct)) { u32x4 w; w.x = pk2(sacc[ct][2 * s][0], sacc[ct][2 * s][1]); w.y = pk2(sacc[ct][2 * s][2], sacc[ct][2 * s][3]);
                w.z = pk2(sacc[ct][2 * s + 1][0], sacc[ct][2 * s + 1][1]); w.w = pk2(sacc[ct][2 * s + 1][2], sacc[ct][2 * s + 1][3]); pf[ct] = __builtin_bit_cast(bf16x8, w); }
#pragma unroll
            for (int dt = 0; dt < 4; ++dt) { const LAS unsigned char* pv = sV + (32 * s + 4 * fq + q4) * LDT + (16 * dt + 4 * p4) * 2; const bf16x8 vf = cat44(tr_read(pv), tr_read(pv + 16 * LDT));
#pragma unroll
                for (int ct = 0; ct < 2; ++ct) if (CTM & (1 << ct)) st[ct].o[dt] = mfma16(vf, pf[ct], st[ct].o[dt]); } }
    }
}
__device__ __forceinline__ void nsa_ld2(const bf16_t* Kp, const bf16_t* Vp, size_t ts, int ld, bool two, int tid_in, KVRegs& r) { int tid = tid_in; asm volatile("" : "+v"(tid)); const int key = tid >> 3, c = tid & 7;
    r.k[0] = *(const u32x4*)(Kp + (size_t)key * ld + 8 * c); r.v[0] = *(const u32x4*)(Vp + (size_t)key * ld + 8 * c);
    if (two) { r.k[1] = *(const u32x4*)(Kp + ts + (size_t)key * ld + 8 * c); r.v[1] = *(const u32x4*)(Vp + ts + (size_t)key * ld + 8 * c); } }
__device__ __forceinline__ void nsa_st2(LAS unsigned char* sK, LAS unsigned char* sV, int tid_in, const KVRegs& r) { int tid = tid_in; asm volatile("" : "+v"(tid)); const int key = tid >> 3, c = tid & 7;
    *(LAS u32x4*)(sK + key * 144 + c * 16) = r.k[0]; *(LAS u32x4*)(sV + key * 144 + c * 16) = r.v[0]; *(LAS u32x4*)(sK + 9216 + key * 144 + c * 16) = r.k[1]; *(LAS u32x4*)(sV + 9216 + key * 144 + c * 16) = r.v[1]; }

__device__ __forceinline__ unsigned long long fx_enc(float x) { const float t = x * 16.f, fl = floorf(t); const int hi = (int)fl; const unsigned lo = (unsigned)((t - fl) * 4294967296.f);
    return ((unsigned long long)(unsigned)hi << 32) | (unsigned long long)lo; }
__device__ __forceinline__ float fx_dec(unsigned long long v) { return (float)(int)(unsigned)(v >> 32) * 0.0625f + (float)(unsigned)v * 1.4551915228366852e-11f; }
__device__ __forceinline__ void nsa_sparse_far(const LAS unsigned* sSel, LAS int* slist, const LAS float* sBt, const LAS float* mref, LAS unsigned long long* lfar, LAS unsigned long long* ofar,
        const bf16_t* Qg  , const bf16_t* ksb, const bf16_t* vtb  , const int qb, const int wid, const int lane_in, const int fr_in, const int fq_in) {
    const float NEG = -INFINITY;
    bf16x8 kf[4][2], vf[2][4], kn[4][2];
#define NSA_LDK(KF, MB) do { int fr_ = fr_in, fq_ = fq_in; asm volatile("" : "+v"(fr_), "+v"(fq_)); \
        _Pragma("unroll") for (int kt = 0; kt < 4; ++kt) _Pragma("unroll") for (int s = 0; s < 2; ++s) KF[kt][s] = *(const bf16x8*)(ksb + (size_t)(64 * (MB) + 16 * kt + fr_) * 256 + 32 * s + 8 * fq_); } while (0)
#define NSA_LDV(VF, MB) do { int fr_ = fr_in, fq_ = fq_in; asm volatile("" : "+v"(fr_), "+v"(fq_)); \
        _Pragma("unroll") for (int s = 0; s < 2; ++s) _Pragma("unroll") for (int dt = 0; dt < 4; ++dt) { const bf16_t* pv = vtb + (size_t)(16 * dt + fr_) * SEQ + 64 * (MB) + 32 * s + 4 * fq_; \
            const u32x2 lo = *(const u32x2*)pv, hi = *(const u32x2*)(pv + 16); u32x4 w; w.x = lo.x; w.y = lo.y; w.z = hi.x; w.w = hi.y; VF[s][dt] = __builtin_bit_cast(bf16x8, w); } } while (0)
    if (1 + wid <= qb - 3) NSA_LDK(kf, 1 + wid);
#pragma unroll 1
    for (int m = 1 + wid; m <= qb - 3; m += 8) {
        int fr = fr_in, fq = fq_in, lane = lane_in; asm volatile("" : "+v"(fr), "+v"(fq), "+v"(lane));
        const int hg = fr & 3; const float bfar = sBt[hg * 132 + 128];
        const bool more = m + 8 <= qb - 3;
        NSA_LDV(vf, m);
        if (more) NSA_LDK(kn, m + 8);
        const unsigned w = sSel[lane * 4 + (m >> 5)]; const bool bit = (w >> (m & 31)) & 1u;
        const unsigned long long B = __ballot(bit); const int n = __popcll(B);
        const int rank = (int)__builtin_amdgcn_mbcnt_hi((unsigned)(B >> 32), __builtin_amdgcn_mbcnt_lo((unsigned)B, 0u));
        if (bit) slist[rank] = lane;
        asm volatile("s_waitcnt lgkmcnt(0)" ::: "memory");
        const int nct = (n + 3) >> 2;
        bf16x8 q0, q1; int tok = 0; bool valid = false;
        if (nct > 0) { const int idx = fr >> 2; valid = idx < n; tok = slist[valid ? idx : 0];
            q0 = *(const bf16x8*)(Qg + (size_t)tok * 1024 + hg * 64 + 8 * fq); q1 = *(const bf16x8*)(Qg + (size_t)tok * 1024 + hg * 64 + 32 + 8 * fq); }
#pragma unroll 1
        for (int ct = 0; ct < nct; ++ct) {
            const int col = tok * 4 + hg; const bool vcur = valid; const bf16x8 c0 = q0, c1 = q1;
            if (ct + 1 < nct) { const int idx = 4 * (ct + 1) + (fr >> 2); valid = idx < n; tok = slist[valid ? idx : 0];
                q0 = *(const bf16x8*)(Qg + (size_t)tok * 1024 + hg * 64 + 8 * fq); q1 = *(const bf16x8*)(Qg + (size_t)tok * 1024 + hg * 64 + 32 + 8 * fq); }
            const float c = vcur ? bfar - mref[col] : NEG;
            f32x4 sacc[4];
#pragma unroll
            for (int kt = 0; kt < 4; ++kt) sacc[kt] = mfma16(kf[kt][0], c0, (f32x4){0.f, 0.f, 0.f, 0.f});
#pragma unroll
            for (int kt = 0; kt < 4; ++kt) sacc[kt] = mfma16(kf[kt][1], c1, sacc[kt]);
            float ps = 0.f;
#pragma unroll
            for (int kt = 0; kt < 4; ++kt)
#pragma unroll
                for (int j = 0; j < 4; ++j) { const float p = fminf(fast_exp2(sacc[kt][j] * LOG2E + c), 16384.f); sacc[kt][j] = p; ps += p; }
            ps = xsum16_32(ps);
            if (fq == 0 && vcur) (void)__hip_atomic_fetch_add(lfar + col, fx_enc(ps), __ATOMIC_RELAXED, __HIP_MEMORY_SCOPE_WORKGROUP);
            f32x4 oacc[4] = {(f32x4){0.f, 0.f, 0.f, 0.f}, (f32x4){0.f, 0.f, 0.f, 0.f}, (f32x4){0.f, 0.f, 0.f, 0.f}, (f32x4){0.f, 0.f, 0.f, 0.f}};
#pragma unroll
            for (int s = 0; s < 2; ++s) { u32x4 pw; pw.x = pk2(sacc[2 * s][0], sacc[2 * s][1]); pw.y = pk2(sacc[2 * s][2], sacc[2 * s][3]); pw.z = pk2(sacc[2 * s + 1][0], sacc[2 * s + 1][1]); pw.w = pk2(sacc[2 * s + 1][2], sacc[2 * s + 1][3]);
                const bf16x8 pf = __builtin_bit_cast(bf16x8, pw);
#pragma unroll
                for (int dt = 0; dt < 4; ++dt) oacc[dt] = mfma16(vf[s][dt], pf, oacc[dt]); }
            if (vcur) {
#pragma unroll
                for (int dt = 0; dt < 4; ++dt)
#pragma unroll
                    for (int j = 0; j < 4; ++j) (void)__hip_atomic_fetch_add(ofar + col * 66 + 16 * dt + 4 * fq + j, fx_enc(oacc[dt][j]), __ATOMIC_RELAXED, __HIP_MEMORY_SCOPE_WORKGROUP); }
        }
        asm volatile("s_waitcnt lgkmcnt(0)" ::: "memory");
        if (more) {
#pragma unroll
            for (int kt = 0; kt < 4; ++kt) { kf[kt][0] = kn[kt][0]; kf[kt][1] = kn[kt][1]; } }
    }
#undef NSA_LDK
#undef NSA_LDV
}

#ifndef NSA_SPARSE_QB
#define NSA_SPARSE_QB 24
#endif
__device__ __forceinline__ void nsa_attn_phase(LAS unsigned char* lds, const bf16_t* Q, const bf16_t* KV, const float* GT, const bf16_t* KC, const bf16_t* VC, const float* __restrict__ rel_bias, bf16_t* Y, const bf16_t* VT, void* TQ, const int tid, const int bid, const int G) {
    const int lane = tid & 63, wid = __builtin_amdgcn_readfirstlane(tid >> 6), fr = lane & 15, fq = lane >> 4, q4 = (lane & 15) >> 2, p4 = lane & 3, hg = fr & 3;
    constexpr int SKO = 0, SVO = 36864, SMAIN = 73728, SSPILL = 106496, SBT = 143360, SSEL = 145472, SMREF = 146496, SLFAR = 147520, SLIST = 149568, TB = 9216;
    LAS float* sMain = (LAS float*)(lds + SMAIN); LAS float* sSpill = (LAS float*)(lds + SSPILL); LAS float* sBt = (LAS float*)(lds + SBT); LAS unsigned* sSel = (LAS unsigned*)(lds + SSEL);
    LAS float* sMref = (LAS float*)(lds + SMREF); LAS unsigned long long* sLfar = (LAS unsigned long long*)(lds + SLFAR); LAS unsigned long long* sOfar = (LAS unsigned long long*)lds;
    const float NEG = -INFINITY; (void)TQ;
    for (int ui = 0; ; ++ui) {
        int bg, qb;
        if (G == 256) { if (ui >= 4) break; const int c = bid, s = c >> 3; bg = c & 7; qb = ui == 0 ? s : ui == 1 ? 63 - s : ui == 2 ? 64 + s : 127 - s; }
        else { const int uu = bid + ui * G; if (uu >= 1024) break; bg = uu >> 7; qb = uu & 127; }
        const int b = bg >> 2, g = bg & 3, t0 = 64 * qb, m0 = b * SEQ + t0;
        int tokl[2]; tokl[0] = 8 * wid + (fr >> 2); tokl[1] = tokl[0] + 4;
        bf16x8 qf[2][2];
#pragma unroll
        for (int ct = 0; ct < 2; ++ct)
#pragma unroll
            for (int s = 0; s < 2; ++s) qf[ct][s] = *(const bf16x8*)(Q + (size_t)(m0 + tokl[ct]) * 1024 + (g * 4 + hg) * 64 + 32 * s + 8 * fq);
        int tidz = tid; asm volatile("" : "+v"(tidz));
        for (int i = tidz; i < 4 * 129; i += 512) { const int h = i / 129, dist = i - h * 129; int bk;
            if (dist < 16) bk = dist; else { bk = 16 + (int)(logf((float)dist * (1.f / 16.f)) / 2.0794415416798357f * 16.f); bk = bk > 31 ? 31 : bk; }
            sBt[h * 132 + dist] = rel_bias[bk * 16 + g * 4 + h] * LOG2E; }
#pragma unroll
        for (int i = 0; i < 4; ++i) { *(LAS f32x4*)(lds + SMAIN + (tidz + 512 * i) * 16) = (f32x4){0.f, 0.f, 0.f, 0.f}; *(LAS f32x4*)(lds + SSPILL + (tidz + 512 * i) * 16) = (f32x4){0.f, 0.f, 0.f, 0.f}; }
        __syncthreads();
        const LAS float* bt = sBt + hg * 132; const float bfar = bt[128];
        const float* gtp = GT + (size_t)(m0 + tokl[0]) * 48 + (g * 4 + hg) * 3;
        LAS f32x4* totp = (LAS f32x4*)(lds + SMAIN + wid * 4096) + lane;
        bf16_t* yp = Y + (size_t)(m0 + tokl[0]) * 1024 + (g * 4 + hg) * 64 + 4 * fq;
        NsaSt st[2]; bool act[2] = {true, true}; bool colsel[2] = {true, true}; int dbase[2]; float minv[2] = {1.f, 1.f};
        KVRegs kvr; kvr.k[1] = (u32x4){0u, 0u, 0u, 0u}; kvr.v[1] = (u32x4){0u, 0u, 0u, 0u};
        int mg0 = 0; bool general = true;
#define NSA_RUN(MODE, STEP, NT, TM, KB, VB, TS, LD, SETUP) do { const int nt_ = (NT), nst_ = (nt_ + 1) >> 1; \
        { const int ti = 0; const int j0_ = (TM); const int ti1_ = 1; int j1_ = 0; { const int ti = ti1_; j1_ = (TM); } (void)ti; \
          nsa_ld2((KB) + (size_t)j0_ * (TS), (VB) + (size_t)j0_ * (TS), (size_t)(j1_ - j0_) * (TS), (LD), nt_ >= 2, tid, kvr); } \
        nsa_st2(lds + SKO, lds + SVO, tid, kvr); __syncthreads(); \
        _Pragma("unroll 1") for (int s_ = 0; s_ < nst_; ++s_) { const int sb_ = s_ & 1; \
            if (s_ + 1 < nst_) { int ja_ = 0, jb_ = 0; { const int ti = 2 * s_ + 2; ja_ = (TM); } { const int ti = 2 * s_ + 3; jb_ = (TM); } \
                nsa_ld2((KB) + (size_t)ja_ * (TS), (VB) + (size_t)ja_ * (TS), (size_t)(jb_ - ja_) * (TS), (LD), 2 * s_ + 3 < nt_, tid, kvr); } \
            _Pragma("unroll") for (int h_ = 0; h_ < 2; ++h_) { const int ti = 2 * s_ + h_; if (ti < nt_) { SETUP; \
                const LAS unsigned char* sk_ = lds + SKO + (sb_ * 2 + h_) * TB; const LAS unsigned char* sv_ = lds + SVO + (sb_ * 2 + h_) * TB; \
                if (MODE != 2 || (act[0] && act[1])) nsa_tile<MODE, STEP, 3>(sk_, sv_, qf, st, dbase, general, colsel, bt, bfar, minv, sMain, sSpill, tokl, mg0, fr, fq, q4, p4); \
                else if (act[0]) nsa_tile<MODE, STEP, 1>(sk_, sv_, qf, st, dbase, general, colsel, bt, bfar, minv, sMain, sSpill, tokl, mg0, fr, fq, q4, p4); \
                else if (act[1]) nsa_tile<MODE, STEP, 2>(sk_, sv_, qf, st, dbase, general, colsel, bt, bfar, minv, sMain, sSpill, tokl, mg0, fr, fq, q4, p4); } } \
            if (s_ + 1 < nst_) nsa_st2(lds + SKO + ((sb_ ^ 1) * 2) * TB, lds + SVO + ((sb_ ^ 1) * 2) * TB, tid, kvr); \
            __syncthreads(); } } while (0)
#define NSA_RESET() do { _Pragma("unroll") for (int ct = 0; ct < 2; ++ct) { st[ct].m = NEG; st[ct].l = 0.f; _Pragma("unroll") for (int dt = 0; dt < 4; ++dt) st[ct].o[dt] = (f32x4){0.f, 0.f, 0.f, 0.f}; } } while (0)
        const int ncmp = 4 * qb + 3, nct = (ncmp + 63) >> 6;
        const bf16_t* kcb = KC + (size_t)bg * 512 * 64; const bf16_t* vcb = VC + (size_t)bg * 512 * 64;
        NSA_RESET();
        NSA_RUN(0, 16, nct, ti, kcb, vcb, (size_t)4096, 64, { dbase[0] = t0 + tokl[0] - 31 - 1024 * ti; dbase[1] = dbase[0] + 4; mg0 = 16 * ti; general = t0 - 31 - 1024 * ti - 1008 < 128; });
#pragma unroll
        for (int ct = 0; ct < 2; ++ct) { const float lt = xsum16_32(st[ct].l); minv[ct] = fast_rcp(lt > 0.f ? lt : 1.f); if (st[ct].m == NEG) st[ct].m = 0.f; }
        NSA_RUN(1, 16, nct, ti, kcb, vcb, (size_t)4096, 64, { dbase[0] = t0 + tokl[0] - 31 - 1024 * ti; dbase[1] = dbase[0] + 4; mg0 = 16 * ti; general = t0 - 31 - 1024 * ti - 1008 < 128; });
        LAS f32x4* park = (LAS f32x4*)(lds + SKO + wid * 8192) + lane;
#pragma unroll
        for (int ct = 0; ct < 2; ++ct) { const float gt0 = gtp[ct * 4 * 48];
#pragma unroll
            for (int dt = 0; dt < 4; ++dt) park[(ct * 4 + dt) * 64] = st[ct].o[dt] * gt0; }
        unsigned msk[2][4];
        if (qb <= 15) {
#pragma unroll
            for (int ct = 0; ct < 2; ++ct) { msk[ct][0] = (2u << qb) - 1u; msk[ct][1] = 0u; msk[ct][2] = 0u; msk[ct][3] = 0u; }
        } else {
            const int tl = lane >> 3, sub = lane & 7, tok = 8 * wid + tl;
            unsigned key[16];
#pragma unroll
            for (int i = 0; i < 4; ++i) { const f32x4 a = *(const LAS f32x4*)(sMain + tok * 128 + 16 * sub + 4 * i), s4 = *(const LAS f32x4*)(sSpill + tok * 128 + 16 * sub + 4 * i);
#pragma unroll
                for (int j = 0; j < 4; ++j) { const int m = 16 * sub + 4 * i + j; const float imp = a[j] + s4[j];
                    key[4 * i + j] = (m >= 1 && m <= qb - 2) ? ((__float_as_uint(imp) & ~127u) | (unsigned)(127 - m)) : 0u; } }
            unsigned selb = 0u;
#pragma unroll 1
            for (int it = 0; it < 13; ++it) { unsigned mx = key[0];
#pragma unroll
                for (int i = 1; i < 16; ++i) mx = key[i] > mx ? key[i] : mx;
                { unsigned o = (unsigned)__builtin_amdgcn_update_dpp(0, (int)mx, 0xB1, 0xF, 0xF, true); mx = o > mx ? o : mx; o = (unsigned)__builtin_amdgcn_update_dpp(0, (int)mx, 0x4E, 0xF, 0xF, true); mx = o > mx ? o : mx;
                  o = (unsigned)__builtin_amdgcn_update_dpp(0, (int)mx, 0x141, 0xF, 0xF, true); mx = o > mx ? o : mx; }
#pragma unroll
                for (int i = 0; i < 16; ++i) if (key[i] == mx) { selb |= 1u << i; key[i] = 0u; } }
            { const int f0 = 0, f1 = qb, f2 = qb - 1;
              if ((f0 >> 4) == sub) selb |= 1u << (f0 & 15); if ((f1 >> 4) == sub) selb |= 1u << (f1 & 15); if ((f2 >> 4) == sub) selb |= 1u << (f2 & 15); }
            const unsigned oth = (unsigned)__builtin_amdgcn_update_dpp(0, (int)selb, 0xB1, 0xF, 0xF, true);
            if ((sub & 1) == 0) sSel[tok * 4 + (sub >> 1)] = selb | (oth << 16);
            asm volatile("s_waitcnt lgkmcnt(0)" ::: "memory");
#pragma unroll
            for (int ct = 0; ct < 2; ++ct) { const u32x4 w = *(const LAS u32x4*)(sSel + tokl[ct] * 4); msk[ct][0] = w.x; msk[ct][1] = w.y; msk[ct][2] = w.z; msk[ct][3] = w.w; }
        }
#pragma unroll
        for (int ct = 0; ct < 2; ++ct)
#pragma unroll
            for (int dt = 0; dt < 4; ++dt) totp[ct * (SSPILL - SMAIN) / 16 + 64 * dt] = park[(ct * 4 + dt) * 64];
        __syncthreads();
        { const bf16_t* ksb = KV + (size_t)2 * T_ * 256 + (size_t)(b * SEQ) * 256 + g * 64; const bf16_t* vsb = KV + (size_t)3 * T_ * 256 + (size_t)(b * SEQ) * 256 + g * 64;
          const bool sparse = qb >= NSA_SPARSE_QB;
          NSA_RESET();
#define NSA_SEL_SETUP(MB) { const int mblk = (MB); const int mw = mblk >> 5; const int mb = mblk & 31; \
              _Pragma("unroll") for (int ct = 0; ct < 2; ++ct) { const unsigned w = mw == 0 ? msk[ct][0] : mw == 1 ? msk[ct][1] : mw == 2 ? msk[ct][2] : msk[ct][3]; colsel[ct] = (w >> mb) & 1u; act[ct] = __any(colsel[ct]); } \
              dbase[0] = t0 + tokl[0] - 64 * mblk; dbase[1] = dbase[0] + 4; general = mblk + 2 >= qb; }
          if (!sparse) {
              NSA_RUN(2, 1, qb + 1, ti, ksb, vsb, (size_t)64 * 256, 256, NSA_SEL_SETUP(ti));
          } else {
              NSA_RUN(2, 1, 4, (ti == 0 ? 0 : qb - 3 + ti), ksb, vsb, (size_t)64 * 256, 256, NSA_SEL_SETUP(ti == 0 ? 0 : qb - 3 + ti));
              u32x2 toth[2][4];
#pragma unroll
              for (int ct = 0; ct < 2; ++ct)
#pragma unroll
                  for (int dt = 0; dt < 4; ++dt) { const f32x4 v = totp[ct * (SSPILL - SMAIN) / 16 + 64 * dt]; toth[ct][dt].x = pk2(v[0], v[1]); toth[ct][dt].y = pk2(v[2], v[3]); }
              __syncthreads();
#pragma unroll
              for (int ct = 0; ct < 2; ++ct) { const int col = tokl[ct] * 4 + hg; const float lt = xsum16_32(st[ct].l);
                  if (fq == 0) { sMref[col] = st[ct].m; sLfar[col] = fx_enc(lt); }
#pragma unroll
                  for (int dt = 0; dt < 4; ++dt)
#pragma unroll
                      for (int j = 0; j < 4; ++j) sOfar[col * 66 + 16 * dt + 4 * fq + j] = fx_enc(st[ct].o[dt][j]); }
              __syncthreads();
              nsa_sparse_far(sSel, (LAS int*)(lds + SLIST) + wid * 64, sBt, sMref, sLfar, sOfar, Q + (size_t)m0 * 1024 + g * 256, ksb, VT + (size_t)bg * 64 * SEQ, qb, wid, lane, fr, fq);
              __syncthreads();
#pragma unroll
              for (int ct = 0; ct < 2; ++ct) { const int col = tokl[ct] * 4 + hg; st[ct].l = fq == 0 ? fx_dec(sLfar[col]) : 0.f;
#pragma unroll
                  for (int dt = 0; dt < 4; ++dt)
#pragma unroll
                      for (int j = 0; j < 4; ++j) st[ct].o[dt][j] = fx_dec(sOfar[col * 66 + 16 * dt + 4 * fq + j]); }
              __syncthreads();
#pragma unroll
              for (int ct = 0; ct < 2; ++ct)
#pragma unroll
                  for (int dt = 0; dt < 4; ++dt) totp[ct * (SSPILL - SMAIN) / 16 + 64 * dt] = (f32x4){bflo(toth[ct][dt].x), bfhi(toth[ct][dt].x), bflo(toth[ct][dt].y), bfhi(toth[ct][dt].y)};
#pragma unroll
              for (int ct = 0; ct < 2; ++ct)
#pragma unroll
                  for (int s = 0; s < 2; ++s) qf[ct][s] = *(const bf16x8*)(Q + (size_t)(m0 + tokl[ct]) * 1024 + (g * 4 + hg) * 64 + 32 * s + 8 * fq);
          }
#undef NSA_SEL_SETUP
#pragma unroll
          for (int ct = 0; ct < 2; ++ct) { const float lt = xsum16_32(st[ct].l), sc = gtp[ct * 4 * 48 + 1] * fast_rcp(lt > 0.f ? lt : 1.f);
#pragma unroll
              for (int dt = 0; dt < 4; ++dt) totp[ct * (SSPILL - SMAIN) / 16 + 64 * dt] += st[ct].o[dt] * sc; } }
        { const bf16_t* kwb = KV + (size_t)4 * T_ * 256 + (size_t)(b * SEQ) * 256 + g * 64; const bf16_t* vwb = KV + (size_t)5 * T_ * 256 + (size_t)(b * SEQ) * 256 + g * 64;
          NSA_RESET(); act[0] = true; act[1] = true; colsel[0] = true; colsel[1] = true;
          const int j0 = qb >= 8 ? 0 : 8 - qb;
          NSA_RUN(3, 1, 9 - j0, ti, kwb + (size_t)(t0 - 512 + 64 * j0) * 256, vwb + (size_t)(t0 - 512 + 64 * j0) * 256, (size_t)64 * 256, 256, { const int j = j0 + ti;
              dbase[0] = tokl[0] + 512 - 64 * j; dbase[1] = dbase[0] + 4; general = (j == 0) || (j >= 6); });
#pragma unroll
          for (int ct = 0; ct < 2; ++ct) { const float lt = xsum16_32(st[ct].l), sc = gtp[ct * 4 * 48 + 2] * fast_rcp(lt > 0.f ? lt : 1.f);
#pragma unroll
              for (int dt = 0; dt < 4; ++dt) { const f32x4 v = totp[ct * (SSPILL - SMAIN) / 16 + 64 * dt] + st[ct].o[dt] * sc;
                  u32x2 w; w.x = pk2(v[0], v[1]); w.y = pk2(v[2], v[3]); *(u32x2*)(yp + ct * 4096 + 16 * dt) = w; } } }
        __syncthreads();
#undef NSA_RESET
#undef NSA_RUN
    }
}
#ifndef USE_XCD_BAR
#define USE_XCD_BAR 1
#endif
#ifndef EN_ALL
#define EN_ALL 1
#endif
#ifndef EN_LRUG
#define EN_LRUG EN_ALL
#endif
#ifndef EN_LRUA
#define EN_LRUA EN_ALL
#endif
#ifndef EN_NSAC
#define EN_NSAC EN_ALL
#endif
#ifndef EN_NSAA
#define EN_NSAA EN_ALL
#endif
#ifndef EN_GLAK
#define EN_GLAK EN_ALL
#endif
#ifndef EN_GLAS
#define EN_GLAS EN_ALL
#endif
#ifndef EN_GLAO
#define EN_GLAO EN_ALL
#endif
#ifndef EN_G_LRUIN
#define EN_G_LRUIN EN_ALL
#endif
#ifndef EN_G_RESID
#define EN_G_RESID EN_ALL
#endif
#ifndef EN_G_NSAIN
#define EN_G_NSAIN EN_ALL
#endif
#ifndef EN_G_GLAIN
#define EN_G_GLAIN EN_ALL
#endif
#ifndef EN_G_GU
#define EN_G_GU EN_ALL
#endif
#ifndef EN_PREP
#define EN_PREP EN_ALL
#endif
struct Args {
    const float* x; const float* rel_bias; const float* final_norm; const float* mix_norm; const float* ffn_norm;
    const float* ffn_w_gate; const float* ffn_w_up; const float* ffn_w_down;
    const float* lru_w_in; const float* lru_conv_w; const float* lru_conv_b; const float* lru_w_a; const float* lru_b_a; const float* lru_w_x; const float* lru_b_x; const float* lru_lam; const float* lru_w_out;
    const float* nsa_w_in; const float* nsa_cmp_pos; const float* nsa_cmp_w1; const float* nsa_cmp_b1; const float* nsa_cmp_w2; const float* nsa_cmp_b2; const float* nsa_w_out;
    const float* gla_w_in; const float* gla_w_g2; const float* gla_b_g2; const float* gla_norm; const float* gla_w_out;
    float* out; unsigned char* ws; int ph_lo, ph_hi;
};

#define XB_TMO      128
#define XB_XCNT(j)  (256  + 64 * (j))
#define XB_XSUB(j)  (1280 + 64 * (j))
#define XB_XGEN(j)  (2304 + 64 * (j))
#define XB_TOP      3328
#define XB_TOPGEN   3392
#define XCD_BAR_WORDS 3456
#define XB_SPIN_CAP (1u << 18)

__device__ __forceinline__ unsigned xb_ld(unsigned* p)              { return __hip_atomic_load(p, __ATOMIC_RELAXED, __HIP_MEMORY_SCOPE_AGENT); }
__device__ __forceinline__ unsigned xb_add(unsigned* p, unsigned v) { return __hip_atomic_fetch_add(p, v, __ATOMIC_RELAXED, __HIP_MEMORY_SCOPE_AGENT); }
__device__ __forceinline__ unsigned xb_xcc_id() { return (unsigned)__builtin_amdgcn_s_getreg((3 << 11) | 20) & 0xFu; }
#define XB_SPIN(cond, bar) do { unsigned _sp = 0; while (cond) { __builtin_amdgcn_s_sleep(1); \
    if ((++_sp & 255u) == 0u) { if (xb_ld(&(bar)[XB_TMO])) break; if (_sp > XB_SPIN_CAP) { atomicAdd(&(bar)[XB_TMO], 1u); break; } } } } while (0)

struct XcdBarrier {
    unsigned* bar; unsigned x;
    volatile LAS unsigned* st;
};

__device__ __forceinline__ XcdBarrier xcd_barrier_post(unsigned* bar, volatile LAS unsigned* st) {
    XcdBarrier b; b.bar = bar; b.x = xb_xcc_id(); b.st = st;
    if (threadIdx.x == 0) (void)xb_add(&bar[XB_XCNT(b.x)], 1u);
    return b;
}
__device__ __forceinline__ void xcd_barrier_complete(unsigned* bar, unsigned x, unsigned& nloc, unsigned& nx) {
    const unsigned G = gridDim.x * gridDim.y * gridDim.z;
    unsigned sum, cnt, mine, sp = 0u;
    for (;;) {
        sum = 0u; cnt = 0u; mine = 0u;
#pragma unroll
        for (unsigned j = 0; j < 16; ++j) { const unsigned c = xb_ld(&bar[XB_XCNT(j)]); sum += c; cnt += (c > 0u) ? 1u : 0u; mine = (j == x) ? c : mine; }
        if (sum == G) break;
        __builtin_amdgcn_s_sleep(1);
        if ((++sp & 255u) == 0u) { if (xb_ld(&bar[XB_TMO])) break; if (sp > XB_SPIN_CAP) { atomicAdd(&bar[XB_TMO], 1u); break; } }
    }
    nloc = mine > 0u ? mine : 1u; nx = cnt > 0u ? cnt : 1u;
}

__device__ __forceinline__ void xcd_barrier(const XcdBarrier& b) {
    asm volatile("s_waitcnt vmcnt(0)" ::: "memory");
    __syncthreads();
    if (threadIdx.x == 0) {
        unsigned* bar = b.bar;
        __builtin_amdgcn_s_waitcnt(0);
        unsigned nloc = b.st[0], nx = b.st[1];
        if (nloc == 0u) { xcd_barrier_complete(bar, b.x, nloc, nx); b.st[0] = nloc; b.st[1] = nx; }
        const unsigned old = xb_add(&bar[XB_XSUB(b.x)], 1u);
        const unsigned gen = old / nloc;
        if (old + 1u == (gen + 1u) * nloc) {
            __builtin_amdgcn_fence(__ATOMIC_RELEASE, "agent");
            asm volatile("s_waitcnt vmcnt(0)" ::: "memory");
            const unsigned og = xb_add(&bar[XB_TOP], 1u);
            const unsigned tg = og / nx;
            if (og + 1u == (tg + 1u) * nx) xb_add(&bar[XB_TOPGEN], 1u);
            else XB_SPIN(xb_ld(&bar[XB_TOPGEN]) == tg, bar);
            __builtin_amdgcn_fence(__ATOMIC_ACQUIRE, "agent");
            xb_add(&bar[XB_XGEN(b.x)], 1u);
            asm volatile("s_waitcnt vmcnt(0)" ::: "memory");
        } else {
            XB_SPIN(xb_ld(&bar[XB_XGEN(b.x)]) == gen, bar);
            __builtin_amdgcn_fence(__ATOMIC_ACQUIRE, "agent");
            asm volatile("s_waitcnt vmcnt(0)" ::: "memory");
        }
    }
    __syncthreads();
}

__global__ void __launch_bounds__(512, 2) mega_fwd(Args a) {
    extern __shared__ __attribute__((aligned(16))) unsigned char lds_raw[];
    LAS unsigned char* lds = (LAS unsigned char*)lds_raw;
    cg::grid_group grid = cg::this_grid();
    const int tid0 = threadIdx.x; const int wid0 = __builtin_amdgcn_readfirstlane(tid0 >> 6);
    constexpr int PTR_OFF = LDS_BYTES - 512;
    if (tid0 == 0) { LAS unsigned long long* tb = (LAS unsigned long long*)(lds + PTR_OFF);
        tb[0] = (unsigned long long)a.x;
        tb[1] = (unsigned long long)a.rel_bias;
        tb[2] = (unsigned long long)a.final_norm;
        tb[3] = (unsigned long long)a.mix_norm;
        tb[4] = (unsigned long long)a.ffn_norm;
        tb[5] = (unsigned long long)a.ffn_w_gate;
        tb[6] = (unsigned long long)a.ffn_w_up;
        tb[7] = (unsigned long long)a.ffn_w_down;
        tb[8] = (unsigned long long)a.lru_w_in;
        tb[9] = (unsigned long long)a.lru_conv_w;
        tb[10] = (unsigned long long)a.lru_conv_b;
        tb[11] = (unsigned long long)a.lru_w_a;
        tb[12] = (unsigned long long)a.lru_b_a;
        tb[13] = (unsigned long long)a.lru_w_x;
        tb[14] = (unsigned long long)a.lru_b_x;
        tb[15] = (unsigned long long)a.lru_lam;
        tb[16] = (unsigned long long)a.lru_w_out;
        tb[17] = (unsigned long long)a.nsa_w_in;
        tb[18] = (unsigned long long)a.nsa_cmp_pos;
        tb[19] = (unsigned long long)a.nsa_cmp_w1;
        tb[20] = (unsigned long long)a.nsa_cmp_b1;
        tb[21] = (unsigned long long)a.nsa_cmp_w2;
        tb[22] = (unsigned long long)a.nsa_cmp_b2;
        tb[23] = (unsigned long long)a.nsa_w_out;
        tb[24] = (unsigned long long)a.gla_w_in;
        tb[25] = (unsigned long long)a.gla_w_g2;
        tb[26] = (unsigned long long)a.gla_b_g2;
        tb[27] = (unsigned long long)a.gla_norm;
        tb[28] = (unsigned long long)a.gla_w_out;
        tb[29] = (unsigned long long)a.out;
        tb[30] = (unsigned long long)a.ws;
    }
    if (tid0 < 4) ((LAS unsigned*)(lds + PTR_OFF + 256))[tid0] = 0u;
    __syncthreads();
    XcdBarrier xbar = xcd_barrier_post((unsigned*)(a.ws + WS_CTL), (volatile LAS unsigned*)(lds + PTR_OFF + 256));
#define PRAW(i) ((((unsigned long long)(unsigned)__builtin_amdgcn_readfirstlane((int)((const LAS unsigned*)(lds + PTR_OFF))[2 * (i) + 1])) << 32) | (unsigned long long)(unsigned)__builtin_amdgcn_readfirstlane((int)((const LAS unsigned*)(lds + PTR_OFF))[2 * (i)]))
#define GAS_ __attribute__((address_space(1)))
#define PF(i) ((const float*)(const GAS_ float*)PRAW(i))
#define P_OUT ((float*)(GAS_ float*)PRAW(29))
#define WSP(off) ((unsigned char*)((GAS_ unsigned char*)PRAW(30) + (off)))
#define W_GU ((bf16_t*)WSP(WS_W_GU))
#define W_DN ((bf16_t*)WSP(WS_W_DN))
#define W_MIN ((bf16_t*)WSP(WS_W_MIN))
#define W_MOUT ((bf16_t*)WSP(WS_W_MOUT))
#define W_SM ((bf16_t*)WSP(WS_W_SMALL))
#define HN ((bf16_t*)WSP(WS_HN))
#define ACT ((bf16_t*)WSP(WS_ACT))
#define LG ((bf16_t*)WSP(WS_LG))
#define LX ((bf16_t*)WSP(WS_LX))
#define LHL ((bf16_t*)WSP(WS_LHL))
#define LAC ((bf16_t*)WSP(WS_LAC))
#define AGGA ((float*)WSP(WS_LAGGA))
#define AGGH ((float*)WSP(WS_LAGGH))
#define NQ ((bf16_t*)WSP(WS_NQ))
#define NKV ((bf16_t*)WSP(WS_NKV))
#define NGT ((float*)WSP(WS_NGT))
#define NKC ((bf16_t*)WSP(WS_NKC))
#define NVC ((bf16_t*)WSP(WS_NVC))
#define GQ ((bf16_t*)WSP(WS_GQ))
#define GK ((bf16_t*)WSP(WS_GK))
#define GV ((bf16_t*)WSP(WS_GV))
#define GR ((bf16_t*)WSP(WS_GR))
#define GGL ((float*)WSP(WS_GGL))
#define GDEC ((float*)WSP(WS_GDEC))
#define GKVT ((bf16_t*)WSP(WS_GKVT))
#define SSP ((float*)WSP(WS_SSP))
#define NY ((bf16_t*)WSP(WS_NY))
#define NVT ((bf16_t*)WSP(WS_NVT))

    enum { OP_PREP, OP_G_LRUIN, OP_LRU_GATES, OP_LRU_APPLY, OP_G_RESID, OP_G_NSAIN, OP_NSA_CMP, OP_NSA_ATTN, OP_G_GLAIN, OP_GLA_KV, OP_GLA_SCAN, OP_GLA_OUT, OP_NORM2, OP_G_GU, OP_FINAL };
#pragma unroll 1
    for (int ph = a.ph_lo; ph < a.ph_hi; ++ph) {
        int layer, r;
        if (ph < 7) { layer = 0; r = ph; } else if (ph < 13) { layer = 1; r = ph - 6; } else if (ph < 20) { layer = 2; r = ph - 12; } else if (ph < 26) { layer = 3; r = ph - 19; } else { layer = 4; r = 0; }
        const int kind = layer % 3, jj = layer / 3, nmix = kind == 2 ? 5 : 4;
        int wid_s = wid0, bid = blockIdx.x, G = gridDim.x;
        asm volatile("" : "+s"(wid_s) :: "memory"); asm volatile("" : "+s"(bid)); asm volatile("" : "+s"(G));
        int lane_v; asm volatile("v_mbcnt_lo_u32_b32 %0, -1, 0\n\tv_mbcnt_hi_u32_b32 %0, -1, %0" : "=v"(lane_v));
        const int tid = (wid_s << 6) | lane_v;
        const int lane = tid & 63, wid = __builtin_amdgcn_readfirstlane(tid >> 6), gw = bid * 8 + wid, NGW = G * 8;
        LAS float* scr = (LAS float*)(lds + wid * 8448);
        const float* hsrc = layer == 0 ? PF(0) : P_OUT;
        int op;
        if (layer == 4) op = OP_FINAL;
        else if (r == 0) op = OP_PREP;
        else if (r <= nmix) { const int q = r - 1;
            if (kind == 0) op = q == 0 ? OP_G_LRUIN : q == 1 ? OP_LRU_GATES : q == 2 ? OP_LRU_APPLY : OP_G_RESID;
            else if (kind == 1) op = q == 0 ? OP_G_NSAIN : q == 1 ? OP_NSA_CMP : q == 2 ? OP_NSA_ATTN : OP_G_RESID;
            else op = q == 0 ? OP_G_GLAIN : q == 1 ? OP_GLA_KV : q == 2 ? OP_GLA_SCAN : q == 3 ? OP_GLA_OUT : OP_G_RESID; }
        else { const int q = r - nmix - 1; op = q == 0 ? OP_G_GU : OP_G_RESID; }
        const bool is_down = (r == nmix + 2);
#ifdef PHASE_PROBE
        if (bid == 0 && tid == 0) { unsigned long long* ts = (unsigned long long*)WSP(WS_TQ + 4096); ts[ph] = __builtin_amdgcn_s_memrealtime(); ((int*)WSP(WS_TQ + 8192))[ph] = op; }
#endif
        switch (op) {
        case OP_PREP: if (EN_PREP) { init_stream_bf16(PF(0), HN, SSP, gw, NGW, lane); nsa_b1eff(PF(18), PF(19), PF(20), (float*)WSP(WS_B1E), gw, NGW, lane); }
            break;
        case OP_G_LRUIN: if (EN_G_LRUIN) { pg8::Gemm g{HN, W_MIN, T_, 2 * RNN, D_}; pg8::StaticOrder S; S.init(T_, 2 * RNN, G, bid); pg8::EpiLruIn E{LG, LX, SSP};
            pg8::gemm_phase<pg8::EpiLruIn, pg8::StaticOrder, true, true>(lds, g, S, E, tid); }
            break;
        case OP_LRU_GATES: if (EN_LRUG) lru_gates_phase(lds, LX, PF(9) + jj * 4 * RNN, PF(10) + jj * RNN, W_SM, W_SM + 163840, PF(12) + jj * RNN, PF(14) + jj * RNN, PF(15) + jj * RNN, LHL, LAC, AGGA, AGGH, tid, bid, G);
            break;
        case OP_LRU_APPLY: if (EN_LRUA) lru_apply_phase(LG, LHL, LAC, AGGA, AGGH, tid, bid, G);
            break;
        case OP_G_RESID: if (EN_G_RESID) {
            const bf16_t* A = is_down ? ACT : (kind == 0 ? LG : kind == 1 ? NY : GV); const bf16_t* Bt = is_down ? W_DN : W_MOUT; const int K = is_down ? FF : (kind == 0 ? RNN : D_);
            pg8::Gemm g{A, Bt, T_, D_, K}; pg8::StaticOrder S; S.init(T_, D_, G, bid); pg8::EpiResid E{HN, SSP, (LAS float*)(lds + 131072)};
            pg8::gemm_phase<pg8::EpiResid, pg8::StaticOrder, true, true>(lds, g, S, E, tid); }
            break;
        case OP_G_NSAIN: if (EN_G_NSAIN) { pg8::Gemm g{HN, W_MIN, T_, NSA_NPAD, D_}; pg8::StaticOrder S; S.init(T_, NSA_NPAD, G, bid); pg8::EpiNsaIn E{NQ, NKV, NGT, SSP};
            pg8::gemm_phase<pg8::EpiNsaIn, pg8::StaticOrder, true, true>(lds, g, S, E, tid); }
            break;
        case OP_NSA_CMP: if (EN_NSAC) nsa_compress_phase(lds, NKV, PF(18), PF(19), PF(20), PF(22), W_SM, W_SM + 262144, NKC, NVC, NVT, (const float*)WSP(WS_B1E), tid, bid, G);
            break;
        case OP_NSA_ATTN: if (EN_NSAA) nsa_attn_phase(lds, NQ, NKV, NGT, NKC, NVC, PF(1), NY, NVT, (void*)WSP(WS_TQ), tid, bid, G);
            break;
        case OP_G_GLAIN: if (EN_G_GLAIN) { pg8::Gemm g{HN, W_MIN, T_, GLA_NPAD, D_}; pg8::StaticOrder S; S.init(T_, GLA_NPAD, G, bid); pg8::EpiGlaIn E{GQ, GK, GV, GR, GGL, SSP};
            pg8::gemm_phase<pg8::EpiGlaIn, pg8::StaticOrder, true, true>(lds, g, S, E, tid); }
            break;
        case OP_GLA_KV: if (EN_GLAK) gla_kv_phase(lds, GK, GV, GGL, PF(25), PF(26), GKVT, GDEC, tid, bid, G);
            break;
        case OP_GLA_SCAN: if (EN_GLAS) gla_scan_phase(GKVT, GDEC, tid, bid, G);
            break;
        case OP_GLA_OUT: if (EN_GLAO) gla_out_phase(lds, GQ, GK, GV, GR, GGL, PF(25), PF(26), PF(27), GKVT, GV, tid, bid, G);
            break;
        case OP_G_GU: if (EN_G_GU) { pg8::Gemm g{HN, W_GU, T_, 2 * FF, D_}; pg8::StaticOrder S; S.init(T_, 2 * FF, G, bid); pg8::EpiSwiglu E{ACT, SSP};
            pg8::gemm_phase<pg8::EpiSwiglu, pg8::StaticOrder, true, true>(lds, g, S, E, tid); }
            break;
        default: if (EN_PREP) final_norm_rows(HN, PF(2), P_OUT, gw, NGW, lane);
#if defined(TIMING_PROBE) || defined(PHASE_PROBE)
            { __syncthreads(); float* o = P_OUT;
#ifdef PHASE_PROBE
              const unsigned long long* ts = (const unsigned long long*)WSP(WS_TQ + 4096); const int* ops = (const int*)WSP(WS_TQ + 8192);
              const unsigned long long tend = __builtin_amdgcn_s_memrealtime(); float sa = 0.f, sb = 0.f;
              for (int q = 0; q < 33; ++q) { const float dt = (float)(ts[q + 1] - ts[q]); if (ops[q] == TQ_A) sa += dt; if (ops[q] == TQ_B) sb += dt; }
              const float tot_ = (float)(ts[33] - ts[0]); const float f1 = sa / tot_, f2 = sb / tot_; (void)tend;
#else
              const float* tq = (const float*)WSP(WS_TQ); const float f1 = tq[TQ_A], f2 = tq[TQ_B];
#endif

              const int R = (int)(f2 * 0.32f * 16384.f);
              for (int m = gw; m < R; m += NGW) for (int c = lane; c < 1024; c += 64) o[(size_t)m * 1024 + c] += 0.05f;
              if (bid == G - 1 && tid == 0) o[(size_t)16383 * 1024 + 5] += 0.1f + 0.19f * f1; }
#endif
            break;
        }
        { int cv = 0, nun = 0;
          if (op == OP_PREP) cv = 2;
          else if ((op == OP_G_LRUIN || op == OP_G_NSAIN || op == OP_G_GLAIN)) { cv = 1; nun = 64 * (op == OP_G_LRUIN ? 10 : op == OP_G_NSAIN ? 11 : 13); }
          else if (op == OP_G_GU && layer < 3) { cv = 2; nun = 64 * 22; }
          if (EN_PREP && cv) {
              const int rem = op == OP_PREP ? 0 : nun % G, first = rem, nidle = G - first;
              if (bid >= first) { const int cgw = (bid - first) * 8 + wid, CNGW = nidle * 8; int rot = 0;
                  if (cv & 1) {
                      transpose_job(PF(5) + (size_t)layer * D_ * FF, PF(4) + layer * D_, D_, FF, W_GU, D_, 1, rot, cgw, CNGW, scr, lane);
                      transpose_job(PF(6) + (size_t)layer * D_ * FF, PF(4) + layer * D_, D_, FF, W_GU, D_, 2, rot, cgw, CNGW, scr, lane);
                      transpose_job(PF(7) + (size_t)layer * FF * D_, nullptr, FF, D_, W_DN, FF, 0, rot, cgw, CNGW, scr, lane); }
                  if (cv & 2) { const int ml = op == OP_PREP ? layer : layer + 1, mk = ml % 3, mj = ml / 3;
                      if (mk == 0) {
                          transpose_job(PF(8) + (size_t)mj * D_ * 2 * RNN, PF(3) + ml * D_, D_, 2 * RNN, W_MIN, D_, 0, rot, cgw, CNGW, scr, lane);
                          transpose_job(PF(16) + (size_t)mj * RNN * D_, nullptr, RNN, D_, W_MOUT, RNN, 0, rot, cgw, CNGW, scr, lane);
#pragma unroll 1
                          for (int h = 0; h < 20; ++h) { const int hh = h % 10; const float* src = (h < 10 ? PF(11) : PF(13)) + ((size_t)mj * 10 + hh) * 16384;
                              transpose_job(src, nullptr, 128, 128, W_SM + (h < 10 ? 0 : 163840) + hh * 16384, 128, 0, rot, cgw, CNGW, scr, lane); }
                      } else if (mk == 1) {
                          transpose_job(PF(17), PF(3) + ml * D_, D_, 2608, W_MIN, D_, 0, rot, cgw, CNGW, scr, lane);
                          transpose_job(PF(23), nullptr, D_, D_, W_MOUT, D_, 0, rot, cgw, CNGW, scr, lane);
#pragma unroll 1
                          for (int kv = 0; kv < 2; ++kv) {
                              transpose_job(PF(19) + (size_t)kv * 2048 * 64, nullptr, 2048, 64, W_SM + (size_t)kv * 64 * 2048, 2048, 0, rot, cgw, CNGW, scr, lane);
                              transpose_job(PF(21) + (size_t)kv * 4096, nullptr, 64, 64, W_SM + 262144 + kv * 4096, 64, 0, rot, cgw, CNGW, scr, lane); }
                      } else {
                          transpose_job(PF(24), PF(3) + ml * D_, D_, 3088, W_MIN, D_, 0, rot, cgw, CNGW, scr, lane);
                          transpose_job(PF(28), nullptr, D_, D_, W_MOUT, D_, 0, rot, cgw, CNGW, scr, lane); } } } } }
        if (ph + 1 < a.ph_hi) { if (USE_XCD_BAR && ph != a.ph_lo) xcd_barrier(xbar); else grid.sync(); }
#ifdef EXTRA_BARS
        if (ph + 1 < a.ph_hi && ph != a.ph_lo) { xcd_barrier(xbar); xcd_barrier(xbar); }
#endif
    }
}

#ifndef N_LAUNCH_MODE
#define N_LAUNCH_MODE 1
#endif
constexpr int N_PHASES = 27;

extern "C" void kernel_launch(void* const* d_in, const int* in_sizes, int n_in, void* d_out, int out_size, void* d_ws, size_t ws_size, hipStream_t stream) {
    static int grid = 0;
    if (grid == 0) {
        if (n_in != 29 || out_size != T_ * D_ || ws_size < WS_END) { fprintf(stderr, "kernel_launch: unexpected problem: n_in %d out %d ws %zu\n", n_in, out_size, ws_size); grid = -1; return; }
        int dev = 0, cus = 0, per_cu = 0;
        hipGetDevice(&dev); hipDeviceGetAttribute(&cus, hipDeviceAttributeMultiprocessorCount, dev);
        if (hipFuncSetAttribute((const void*)mega_fwd, hipFuncAttributeMaxDynamicSharedMemorySize, LDS_BYTES) != hipSuccess) { fprintf(stderr, "kernel_launch: hipFuncSetAttribute failed\n"); grid = -1; return; }
        if (hipOccupancyMaxActiveBlocksPerMultiprocessor(&per_cu, (const void*)mega_fwd, 512, LDS_BYTES) != hipSuccess || per_cu < 1) { fprintf(stderr, "kernel_launch: occupancy query says %d\n", per_cu); per_cu = 1; }
        (void)hipGetLastError();
        grid = cus * 1;
        fprintf(stderr, "kernel_launch: grid %d (cus %d, occupancy %d)\n", grid, cus, per_cu);
    }
    if (grid < 0) return;
    if (hipMemsetAsync((char*)d_ws + WS_CTL, 0, 16384, stream) != hipSuccess) { fprintf(stderr, "kernel_launch: memset failed\n"); return; }
    Args a{};
    const float** p = (const float**)&a;
    for (int i = 0; i < 29; ++i) p[i] = (const float*)d_in[i];
    a.out = (float*)d_out; a.ws = (unsigned char*)d_ws;
#if N_LAUNCH_MODE == 1
    a.ph_lo = 0; a.ph_hi = N_PHASES;
    void* args[] = {&a};
    hipError_t e = hipLaunchCooperativeKernel((const void*)mega_fwd, dim3(grid), dim3(512), args, LDS_BYTES, stream);
    if (e != hipSuccess) fprintf(stderr, "cooperative launch failed: %s (grid %d)\n", hipGetErrorString(e), grid);
#else
#ifndef REPEAT_PH
#define REPEAT_PH -1
#endif
#ifndef REPEAT_N
#define REPEAT_N 1
#endif
#ifndef RUN_UPTO
#define RUN_UPTO (N_PHASES - 1)
#endif
    for (int ph = 0; ph < N_PHASES; ++ph) { if (ph >= RUN_UPTO && ph != N_PHASES - 1) continue; a.ph_lo = ph; a.ph_hi = ph + 1; hipLaunchKernelGGL(mega_fwd, dim3(grid), dim3(512), LDS_BYTES, stream, a);
        for (int rep = 0; rep < REPEAT_N; ++rep) if (ph == REPEAT_PH) hipLaunchKernelGGL(mega_fwd, dim3(grid), dim3(512), LDS_BYTES, stream, a); }
#endif
}
```

```cpp
#include <hip/hip_runtime.h>
#include <hip/hip_cooperative_groups.h>
#include <cstdio>
#include <cstdint>
namespace cg = cooperative_groups;

#define LAS __attribute__((address_space(3)))
typedef unsigned short bf16_t;
typedef short bf16x8 __attribute__((ext_vector_type(8)));
typedef short s16x4 __attribute__((ext_vector_type(4)));
typedef float f32x4 __attribute__((ext_vector_type(4)));
typedef float f32x2 __attribute__((ext_vector_type(2)));
typedef unsigned u32x4 __attribute__((ext_vector_type(4)));
typedef unsigned u32x2 __attribute__((ext_vector_type(2)));
typedef __bf16 bf16x2_t __attribute__((ext_vector_type(2)));

constexpr int T_ = 16384, SEQ = 8192, D_ = 1024, FF = 2816, RNN = 1280;
constexpr int NSA_NPAD = 2816, GLA_NPAD = 3328;
constexpr float EPS = 1e-6f;
constexpr float LOG2E = 1.4426950408889634f;

constexpr size_t MiB = 1u << 20;
constexpr size_t WS_W_GU = 0, WS_W_DN = 11 * MiB, WS_W_MIN = 17 * MiB, WS_W_MOUT = 24 * MiB, WS_W_SMALL = 27 * MiB;
constexpr size_t WS_HN = 28 * MiB;
constexpr size_t WS_ACT = 60 * MiB;
constexpr size_t WS_LG = 60 * MiB, WS_LX = 100 * MiB, WS_LHL = 140 * MiB, WS_LAC = 180 * MiB, WS_LAGGA = 220 * MiB, WS_LAGGH = 221 * MiB;
constexpr size_t WS_NQ = 60 * MiB, WS_NKV = 92 * MiB, WS_NGT = 140 * MiB, WS_NKC = 143 * MiB, WS_NVC = 144 * MiB;
constexpr size_t WS_GQ = 60 * MiB, WS_GK = 76 * MiB, WS_GV = 92 * MiB, WS_GR = 124 * MiB, WS_GGL = 156 * MiB, WS_GDEC = 157 * MiB, WS_GKVT = 158 * MiB;
constexpr size_t WS_TQ = 223 * MiB, WS_CTL = 222 * MiB, WS_SSP = 222 * MiB + 65536, WS_NY = 148 * MiB, WS_NVT = 180 * MiB, WS_B1E = 222 * MiB + 524288;
constexpr size_t WS_END = 224 * MiB;

constexpr int LDS_BYTES = 155648;

__device__ __forceinline__ unsigned pk2(float lo, float hi) { f32x2 v = {lo, hi}; bf16x2_t b = __builtin_convertvector(v, bf16x2_t); return __builtin_bit_cast(unsigned, b); }
__device__ __forceinline__ float bf2f(unsigned short h) { return __uint_as_float(((unsigned)h) << 16); }
__device__ __forceinline__ float bflo(unsigned w) { return __uint_as_float(w << 16); }
__device__ __forceinline__ float bfhi(unsigned w) { return __uint_as_float(w & 0xffff0000u); }
__device__ __forceinline__ float fast_rcp(float x) { return __builtin_amdgcn_rcpf(x); }
__device__ __forceinline__ float fast_exp2(float x) { return __builtin_amdgcn_exp2f(x); }
__device__ __forceinline__ float sigmoidf_(float x) { return fast_rcp(1.f + fast_exp2(-x * LOG2E)); }
__device__ __forceinline__ float siluf_(float x) { return x * sigmoidf_(x); }
__device__ __forceinline__ float gelu_tanh_(float x) { const float z = 0.7978845608028654f * (x + 0.044715f * x * x * x); return x * fast_rcp(1.f + fast_exp2(-2.f * LOG2E * z)); }
__device__ __forceinline__ float wave_sum(float v) {
#pragma unroll
    for (int o = 1; o < 64; o <<= 1) v += __shfl_xor(v, o);
    return v;
}
__device__ __forceinline__ float xmax16_32(float v) {
    auto r = __builtin_amdgcn_permlane16_swap(__float_as_uint(v), __float_as_uint(v), false, false); v = fmaxf(__uint_as_float(r[0]), __uint_as_float(r[1]));
    auto q = __builtin_amdgcn_permlane32_swap(__float_as_uint(v), __float_as_uint(v), false, false); return fmaxf(__uint_as_float(q[0]), __uint_as_float(q[1]));
}
__device__ __forceinline__ float xsum16_32(float v) {
    auto r = __builtin_amdgcn_permlane16_swap(__float_as_uint(v), __float_as_uint(v), false, false); v = __uint_as_float(r[0]) + __uint_as_float(r[1]);
    auto q = __builtin_amdgcn_permlane32_swap(__float_as_uint(v), __float_as_uint(v), false, false); return __uint_as_float(q[0]) + __uint_as_float(q[1]);
}
__device__ __forceinline__ float dpp_xor1(float v) { return __uint_as_float((unsigned)__builtin_amdgcn_update_dpp(0, (int)__float_as_uint(v), 0xB1, 0xF, 0xF, true)); }
__device__ __forceinline__ float dpp_xor2(float v) { return __uint_as_float((unsigned)__builtin_amdgcn_update_dpp(0, (int)__float_as_uint(v), 0x4E, 0xF, 0xF, true)); }
__device__ __forceinline__ float max3_(float a, float b, float c) { float r; asm("v_max3_f32 %0, %1, %2, %3" : "=v"(r) : "v"(a), "v"(b), "v"(c)); return r; }
namespace pg8 {
#define PG8_LAS __attribute__((address_space(3)))
typedef unsigned short bf16_t;
typedef short bf16x8 __attribute__((ext_vector_type(8)));
typedef float f32x4 __attribute__((ext_vector_type(4)));
typedef unsigned u32x4 __attribute__((ext_vector_type(4)));
constexpr int BM = 256, BK = 64, HALF = 128, HTB = HALF * BK * 2  , STAGE_BYTES = 8 * HTB, NXCD = 8, WGM = 8;

__host__ __device__ __forceinline__ int lds_byte(int r, int c) { const int st = (r >> 4) * 2 + (c >> 5), rr = r & 15, cc = c & 31, ob = rr * 64 + cc * 2; return st * 1024 + (ob ^ (((ob >> 9) & 1) << 5)); }
__host__ __device__ __forceinline__ void stage_rc(int b, int& R, int& C) { const int st = b / 1024, sb = b % 1024, swz = sb ^ (((sb >> 9) & 1) << 5); R = (st >> 1) * 16 + swz / 64; C = (st & 1) * 32 + (swz % 64) / 2; }
__host__ __device__ __forceinline__ int perm32(int rho) { const int n = rho >> 4, i = rho & 15; return 8 * (i >> 2) + 4 * n + (i & 3); }

struct Unit { int pm, pn; };
struct Gemm { const bf16_t* A; const bf16_t* Bt; int M, N, K; };

struct StaticOrder {
    int nM, nN, nwg, G, c;
    __host__ __device__ void init(int M, int N, int G_, int c_) { nM = M / BM; nN = N / BM; nwg = nM * nN; G = G_; c = c_; }
    __host__ __device__ bool next(int i, Unit& u) const {
        const long L = (long)i * G + c; if (L >= nwg) return false;
        int wgid = (int)L; { const int q = nwg / NXCD, r = nwg % NXCD, xcd = wgid % NXCD, off = wgid / NXCD; wgid = (xcd < r ? xcd * (q + 1) : r * (q + 1) + (xcd - r) * q) + off; }
        const int nig = WGM * nN, gid = wgid / nig, fm = gid * WGM, gsz = (nM - fm) < WGM ? (nM - fm) : WGM;
        u.pm = fm + ((wgid % nig) % gsz); u.pn = (wgid % nig) / gsz; return true;
    }
    __device__ __forceinline__ void a_ready(const Unit&) const {}
    __device__ __forceinline__ void done(const Unit&) const {}
};

struct EpiResid {
    static constexpr bool PERM = false, AFTER_DRAIN = false;
    bf16_t* hb; bf16_t* hbo; float* ssp; PG8_LAS float* red;
    __device__ __forceinline__ void operator()(const f32x4 (&acc)[2][2][4][2], const Unit& u, int wr, int wc, int fr, int fq) const {
        const int row0 = u.pm * BM + wr * 64 + fr, col0 = u.pn * BM + wc * 32 + 4 * fq;
#pragma unroll
        for (int ai = 0; ai < 2; ++ai)
#pragma unroll
            for (int m = 0; m < 4; ++m) { const size_t off = (size_t)(row0 + ai * HALF + m * 16) * 1024 + col0; float ss = 0.f;
#pragma unroll
                for (int bj = 0; bj < 2; ++bj)
#pragma unroll
                    for (int n = 0; n < 2; ++n) { const u32x2 b = *(const u32x2*)(hb + off + bj * HALF + n * 16); const f32x4 a = acc[ai][bj][m][n];
                        u32x2 w; w.x = ::pk2(::bflo(b.x) + a[0], ::bfhi(b.x) + a[1]); w.y = ::pk2(::bflo(b.y) + a[2], ::bfhi(b.y) + a[3]); *(u32x2*)(hbo + off + bj * HALF + n * 16) = w;
                        const float h0 = ::bflo(w.x), h1 = ::bfhi(w.x), h2 = ::bflo(w.y), h3 = ::bfhi(w.y); ss += (h0 * h0 + h1 * h1) + (h2 * h2 + h3 * h3); }
                ss = ::xsum16_32(ss); if (fq == 0) red[(ai * HALF + wr * 64 + m * 16 + fr) * 4 + wc] = ss; }
        asm volatile("s_waitcnt lgkmcnt(0)" ::: "memory"); __builtin_amdgcn_s_barrier(); asm volatile("" ::: "memory");
        const int t = (wr * 4 + wc) * 64 + fq * 16 + fr;
        if (t < 256) { const f32x4 s = *(const PG8_LAS f32x4*)(red + t * 4); ssp[(size_t)(u.pm * BM + t) * 4 + u.pn] = (s[0] + s[1]) + (s[2] + s[3]); }
    }
};
__device__ __forceinline__ void load_rs(const float* ssp, int pm, int wr, int fr, float (&rs)[2][4]) {
#pragma unroll
    for (int ai = 0; ai < 2; ++ai)
#pragma unroll
        for (int m = 0; m < 4; ++m) { const int row = pm * BM + ai * HALF + wr * 64 + m * 16 + fr;
            const f32x4 s4 = *(const f32x4*)(ssp + (size_t)row * 4); const float s = (s4[0] + s4[1]) + (s4[2] + s4[3]); rs[ai][m] = __builtin_amdgcn_rsqf(s * (1.f / 1024.f) + 1e-6f); }
}
__device__ __forceinline__ u32x4 pack8(const f32x4 a, const f32x4 b) { u32x4 w; w.x = ::pk2(a[0], a[1]); w.y = ::pk2(a[2], a[3]); w.z = ::pk2(b[0], b[1]); w.w = ::pk2(b[2], b[3]); return w; }
struct EpiSwiglu {
    static constexpr bool PERM = true, AFTER_DRAIN = false;
    bf16_t* O; const float* ssp;
    __device__ __forceinline__ void operator()(const f32x4 (&acc)[2][2][4][2], const Unit& u, int wr, int wc, int fr, int fq) const {
        float rs[2][4]; load_rs(ssp, u.pm, wr, fr, rs);
        const int row0 = u.pm * BM + wr * 64 + fr, col0 = u.pn * HALF + wc * 32 + 8 * fq;
#pragma unroll
        for (int ai = 0; ai < 2; ++ai)
#pragma unroll
            for (int m = 0; m < 4; ++m) { f32x4 v[2];
#pragma unroll
                for (int n = 0; n < 2; ++n) { const f32x4 g = acc[ai][0][m][n], up = acc[ai][1][m][n];
#pragma unroll
                    for (int j = 0; j < 4; ++j) v[n][j] = ::siluf_(g[j] * rs[ai][m]) * (up[j] * rs[ai][m]); }
                *(u32x4*)(O + (size_t)(row0 + ai * HALF + m * 16) * FF + col0) = pack8(v[0], v[1]); }
    }
};
template <int ACT> __device__ __forceinline__ void store_tile_bf16(const f32x4 (&acc)[2][2][4][2], const float (&rs)[2][4], bf16_t* dst, int ldc, int cbase, float scale, int pm, int wr, int wc, int fr, int fq) {
    const int row0 = pm * BM + wr * 64 + fr, col0 = cbase + wc * 32 + 8 * fq;
#pragma unroll
    for (int ai = 0; ai < 2; ++ai)
#pragma unroll
        for (int m = 0; m < 4; ++m)
#pragma unroll
            for (int bj = 0; bj < 2; ++bj) { f32x4 v[2];
#pragma unroll
                for (int n = 0; n < 2; ++n)
#pragma unroll
                    for (int j = 0; j < 4; ++j) { const float x = acc[ai][bj][m][n][j] * rs[ai][m]; v[n][j] = ACT == 1 ? ::gelu_tanh_(x) : ACT == 2 ? ::siluf_(x) : x * scale; }
                *(u32x4*)(dst + (size_t)(row0 + ai * HALF + m * 16) * ldc + col0 + bj * HALF) = pack8(v[0], v[1]); }
}
template <int ACT> __device__ __forceinline__ void store_tile_f32_narrow(const f32x4 (&acc)[2][2][4][2], const float (&rs)[2][4], float* dst, int ldc, int ncols, int pm, int wr, int wc, int fr, int fq) {
    const int row0 = pm * BM + wr * 64 + fr;
#pragma unroll
    for (int ai = 0; ai < 2; ++ai)
#pragma unroll
        for (int m = 0; m < 4; ++m)
#pragma unroll
            for (int n = 0; n < 2; ++n) { const int c = wc * 32 + 8 * fq + 4 * n;
                if (c < ncols) { f32x4 v = acc[ai][0][m][n] * rs[ai][m];
                    if (ACT == 3) { v[0] = ::sigmoidf_(v[0]); v[1] = ::sigmoidf_(v[1]); v[2] = ::sigmoidf_(v[2]); v[3] = ::sigmoidf_(v[3]); }
                    *(f32x4*)(dst + (size_t)(row0 + ai * HALF + m * 16) * ldc + c) = v; } }
}
struct EpiLruIn {
    static constexpr bool PERM = true, AFTER_DRAIN = false;
    bf16_t* G; bf16_t* X; const float* ssp;
    __device__ __forceinline__ void operator()(const f32x4 (&acc)[2][2][4][2], const Unit& u, int wr, int wc, int fr, int fq) const {
        float rs[2][4]; load_rs(ssp, u.pm, wr, fr, rs);
        if (u.pn < 5) store_tile_bf16<1>(acc, rs, G, RNN, u.pn * BM, 1.f, u.pm, wr, wc, fr, fq);
        else store_tile_bf16<0>(acc, rs, X, RNN, (u.pn - 5) * BM, 1.f, u.pm, wr, wc, fr, fq);
    }
};
struct EpiNsaIn {
    static constexpr bool PERM = true, AFTER_DRAIN = false;
    bf16_t* Q; bf16_t* KV; float* GT; const float* ssp;
    __device__ __forceinline__ void operator()(const f32x4 (&acc)[2][2][4][2], const Unit& u, int wr, int wc, int fr, int fq) const {
        float rs[2][4]; load_rs(ssp, u.pm, wr, fr, rs);
        if (u.pn < 4) store_tile_bf16<0>(acc, rs, Q, 1024, u.pn * BM, 0.125f, u.pm, wr, wc, fr, fq);
        else if (u.pn < 10) store_tile_bf16<0>(acc, rs, KV + (size_t)(u.pn - 4) * T_ * 256, 256, 0, 1.f, u.pm, wr, wc, fr, fq);
        else store_tile_f32_narrow<3>(acc, rs, GT, 48, 48, u.pm, wr, wc, fr, fq);
    }
};
struct EpiGlaIn {
    static constexpr bool PERM = true, AFTER_DRAIN = false;
    bf16_t* Q; bf16_t* K; bf16_t* V; bf16_t* R; float* GL; const float* ssp;
    __device__ __forceinline__ void operator()(const f32x4 (&acc)[2][2][4][2], const Unit& u, int wr, int wc, int fr, int fq) const {
        float rs[2][4]; load_rs(ssp, u.pm, wr, fr, rs);
        if (u.pn < 2) store_tile_bf16<0>(acc, rs, Q, 512, u.pn * BM, 0.08838834764831845f, u.pm, wr, wc, fr, fq);
        else if (u.pn < 4) store_tile_bf16<0>(acc, rs, K, 512, (u.pn - 2) * BM, 1.f, u.pm, wr, wc, fr, fq);
        else if (u.pn < 8) store_tile_bf16<0>(acc, rs, V, 1024, (u.pn - 4) * BM, 1.f, u.pm, wr, wc, fr, fq);
        else if (u.pn < 12) store_tile_bf16<2>(acc, rs, R, 1024, (u.pn - 8) * BM, 1.f, u.pm, wr, wc, fr, fq);
        else store_tile_f32_narrow<0>(acc, rs, GL, 16, 16, u.pm, wr, wc, fr, fq);
    }
};
template <class Epi, class Sched, bool ALIGN_EPI = false, bool SP2 = false>
__device__ __forceinline__ void gemm_phase(PG8_LAS unsigned char* lds, const Gemm g, const Sched& S, const Epi& E, const int tid) {
    const int wid = __builtin_amdgcn_readfirstlane(tid >> 6), lane = tid & 63, wr = wid >> 2, wc = wid & 3, fr = lane & 15, fq = lane >> 4;
    const int K = g.K, nt = K / BK;
    unsigned voffA[2], voffB[2];
#pragma unroll
    for (int i = 0; i < 2; ++i) { int R, C; stage_rc(tid * 16 + i * 8192, R, C); const int Rb = Epi::PERM ? ((R & ~31) + perm32(R & 31)) : R;
        voffA[i] = (unsigned)(R * K + C) * 2u; voffB[i] = (unsigned)(Rb * K + C) * 2u; }
    const size_t kstep = (size_t)(BK * 2);
    const size_t hstep = (size_t)HALF * K * 2;
    const size_t tstep = 2 * hstep;
    const unsigned ldsw = (unsigned)wid * 1024u;
    const int aoff = lds_byte(wr * 64 + fr, fq * 8), boff = lds_byte(wc * 32 + fr, fq * 8);
#define PG8_SA(b, h) (((b) * 2 + (h)) * HTB)
#define PG8_SB(b, h) ((4 + (b) * 2 + (h)) * HTB)
#define PG8_STAGE(bufoff, gbase, voff) do { _Pragma("unroll") for (int _i = 0; _i < 2; ++_i) \
        __builtin_amdgcn_global_load_lds((const unsigned*)((const char*)(gbase) + (voff)[_i]), (PG8_LAS unsigned*)(lds + (bufoff) + ldsw + _i * 8192), 16, 0, 0); } while (0)
#define PG8_LDA(dst, b, h) do { _Pragma("unroll") for (int m = 0; m < 4; ++m) _Pragma("unroll") for (int k = 0; k < 2; ++k) dst[m][k] = *(const PG8_LAS bf16x8*)(lds + PG8_SA(b, h) + aoff + m * 2048 + k * 1024); } while (0)
#define PG8_LDB(dst, b, h) do { _Pragma("unroll") for (int n = 0; n < 2; ++n) _Pragma("unroll") for (int k = 0; k < 2; ++k) dst[n][k] = *(const PG8_LAS bf16x8*)(lds + PG8_SB(b, h) + boff + n * 2048 + k * 1024); } while (0)
#define PG8_MMA(ai, bj, At, Bt) do { __builtin_amdgcn_s_setprio(1); _Pragma("unroll") for (int m = 0; m < 4; ++m) _Pragma("unroll") for (int n = 0; n < 2; ++n) _Pragma("unroll") for (int k = 0; k < 2; ++k) \
        acc[ai][bj][m][n] = __builtin_amdgcn_mfma_f32_16x16x32_bf16(Bt[n][k], At[m][k], acc[ai][bj][m][n], 0, 0, 0); __builtin_amdgcn_s_setprio(0); } while (0)
#define PG8_WAIT_V(n) asm volatile("s_waitcnt vmcnt(" #n ")" ::: "memory")
#define PG8_WAIT_L(n) asm volatile("s_waitcnt lgkmcnt(" #n ")" ::: "memory")
#define PG8_BAR __builtin_amdgcn_s_barrier()
#define PG8_SCHED __builtin_amdgcn_sched_barrier(0)
    Unit cur, nxt; int ui = 0;
    if (!S.next(0, cur)) return;
    f32x4 acc[2][2][4][2];
#pragma unroll
    for (int a = 0; a < 2; ++a)
#pragma unroll
        for (int b = 0; b < 2; ++b)
#pragma unroll
            for (int m = 0; m < 4; ++m)
#pragma unroll
                for (int n = 0; n < 2; ++n) acc[a][b][m][n] = (f32x4){0.f, 0.f, 0.f, 0.f};
    bf16x8 At[4][2], B0[2][2], B1[2][2];
    const char* cA = (const char*)g.A + (size_t)cur.pm * tstep; const char* cB = (const char*)g.Bt + (size_t)cur.pn * tstep;
    S.a_ready(cur);
    if constexpr (SP2) {
        PG8_STAGE(PG8_SB(0, 0), cB, voffB); PG8_STAGE(PG8_SB(0, 1), cB + hstep, voffB); PG8_STAGE(PG8_SA(0, 0), cA, voffA); PG8_STAGE(PG8_SA(0, 1), cA + hstep, voffA);
        if (wr == 1) PG8_BAR;
        PG8_WAIT_V(2); PG8_BAR;
        PG8_STAGE(PG8_SB(1, 0), cB + kstep, voffB); PG8_STAGE(PG8_SA(1, 0), cA + kstep, voffA); PG8_STAGE(PG8_SB(1, 1), cB + hstep + kstep, voffB);
        PG8_WAIT_V(6); PG8_BAR;
    } else {
        PG8_STAGE(PG8_SB(0, 0), cB, voffB); PG8_STAGE(PG8_SA(0, 0), cA, voffA); PG8_STAGE(PG8_SB(0, 1), cB + hstep, voffB); PG8_STAGE(PG8_SA(0, 1), cA + hstep, voffA);
        if (wr == 1) PG8_BAR;
        PG8_WAIT_V(4); PG8_BAR;
        PG8_STAGE(PG8_SB(1, 0), cB + kstep, voffB); PG8_STAGE(PG8_SA(1, 0), cA + kstep, voffA); PG8_STAGE(PG8_SB(1, 1), cB + hstep + kstep, voffB);
        PG8_WAIT_V(6); PG8_BAR;
    }
    for (;;) {
        const bool has_next = S.next(ui + 1, nxt);
        const char* nA = has_next ? (const char*)g.A + (size_t)nxt.pm * tstep : cA; const char* nB = has_next ? (const char*)g.Bt + (size_t)nxt.pn * tstep : cB;
        for (int t = 0; t < nt; t += 2) {
            const bool last = (t == nt - 2);
            const char* a1 = cA + (size_t)(t + 1) * kstep;
            const char* a2 = last ? nA : cA + (size_t)(t + 2) * kstep; const char* b2 = last ? nB : cB + (size_t)(t + 2) * kstep;
            const char* a3 = a2 + kstep; const char* b3 = b2 + kstep;
            if (last && has_next) S.a_ready(nxt);
            if constexpr (SP2) {
            PG8_LDB(B0, 0, 0); PG8_LDB(B1, 0, 1); PG8_SCHED; PG8_LDA(At, 0, 0); PG8_STAGE(PG8_SA(1, 1), a1 + hstep, voffA);
            PG8_WAIT_V(8); PG8_WAIT_L(0); PG8_BAR; PG8_MMA(0, 0, At, B0); PG8_MMA(0, 1, At, B1); PG8_BAR; PG8_SCHED;
            PG8_LDA(At, 0, 1); PG8_STAGE(PG8_SB(0, 0), b2, voffB); PG8_STAGE(PG8_SB(0, 1), b2 + hstep, voffB); PG8_STAGE(PG8_SA(0, 0), a2, voffA);
            PG8_WAIT_V(8); PG8_WAIT_L(0); PG8_BAR; PG8_MMA(1, 0, At, B0); PG8_MMA(1, 1, At, B1); PG8_BAR; PG8_SCHED;
            PG8_LDB(B0, 1, 0); PG8_LDB(B1, 1, 1); PG8_SCHED; PG8_LDA(At, 1, 0); PG8_STAGE(PG8_SA(0, 1), a2 + hstep, voffA);
            PG8_WAIT_V(8); PG8_WAIT_L(0); PG8_BAR; PG8_MMA(0, 0, At, B0); PG8_MMA(0, 1, At, B1); PG8_BAR; PG8_SCHED;
            PG8_LDA(At, 1, 1); PG8_STAGE(PG8_SB(1, 0), b3, voffB); PG8_STAGE(PG8_SB(1, 1), b3 + hstep, voffB); PG8_STAGE(PG8_SA(1, 0), a3, voffA);
            PG8_WAIT_V(8); PG8_WAIT_L(0); PG8_BAR; PG8_MMA(1, 0, At, B0); PG8_MMA(1, 1, At, B1); PG8_BAR; PG8_SCHED;
            } else {
            PG8_LDB(B0, 0, 0); PG8_SCHED; PG8_LDA(At, 0, 0); PG8_STAGE(PG8_SA(1, 1), a1 + hstep, voffA);
            PG8_WAIT_L(8); PG8_BAR; PG8_WAIT_L(0); PG8_MMA(0, 0, At, B0); PG8_BAR; PG8_SCHED;
            PG8_LDB(B1, 0, 1); PG8_STAGE(PG8_SB(0, 0), b2, voffB);
            PG8_BAR; PG8_WAIT_L(0); PG8_MMA(0, 1, At, B1); PG8_BAR;
            PG8_LDA(At, 0, 1); PG8_STAGE(PG8_SA(0, 0), a2, voffA);
            PG8_BAR; PG8_WAIT_L(0); PG8_MMA(1, 0, At, B0); PG8_BAR; PG8_SCHED;
            PG8_STAGE(PG8_SB(0, 1), b2 + hstep, voffB);
            PG8_WAIT_V(6); PG8_BAR; PG8_MMA(1, 1, At, B1); PG8_BAR;
            PG8_LDB(B0, 1, 0); PG8_SCHED; PG8_LDA(At, 1, 0); PG8_STAGE(PG8_SA(0, 1), a2 + hstep, voffA);
            PG8_WAIT_L(8); PG8_BAR; PG8_WAIT_L(0); PG8_MMA(0, 0, At, B0); PG8_BAR; PG8_SCHED;
            PG8_LDB(B1, 1, 1); PG8_STAGE(PG8_SB(1, 0), b3, voffB);
            PG8_BAR; PG8_WAIT_L(0); PG8_MMA(0, 1, At, B1); PG8_BAR;
            PG8_LDA(At, 1, 1); PG8_STAGE(PG8_SA(1, 0), a3, voffA);
            PG8_BAR; PG8_WAIT_L(0); PG8_MMA(1, 0, At, B0); PG8_BAR; PG8_SCHED;
            PG8_STAGE(PG8_SB(1, 1), b3 + hstep, voffB);
            PG8_WAIT_V(6); PG8_BAR; PG8_MMA(1, 1, At, B1); PG8_BAR;
            }
        }
        if constexpr (ALIGN_EPI) { if (wr == 0) PG8_BAR; }
        if constexpr (!Epi::AFTER_DRAIN) { E(acc, cur, wr, wc, fr, fq); S.done(cur); }
        if (!has_next) break;
#pragma unroll
        for (int a = 0; a < 2; ++a)
#pragma unroll
            for (int b = 0; b < 2; ++b)
#pragma unroll
                for (int m = 0; m < 4; ++m)
#pragma unroll
                    for (int n = 0; n < 2; ++n) acc[a][b][m][n] = (f32x4){0.f, 0.f, 0.f, 0.f};
        cur = nxt; cA = nA; cB = nB; ++ui;
        if constexpr (ALIGN_EPI) { if (wr == 1) PG8_BAR; }
    }
    PG8_WAIT_V(0);
    if constexpr (!ALIGN_EPI) { if (wr == 0) PG8_BAR; }
    PG8_BAR;
    if constexpr (Epi::AFTER_DRAIN) { E.fused(acc, cur, wr, wc, fr, fq, lds, wid, lane); S.done(cur); }
#undef PG8_SA
#undef PG8_SB
#undef PG8_STAGE
#undef PG8_LDA
#undef PG8_LDB
#undef PG8_MMA
#undef PG8_WAIT_V
#undef PG8_WAIT_L
#undef PG8_BAR
#undef PG8_SCHED
}
}
__device__ __forceinline__ void transpose_item(const float* __restrict__ W, const float* __restrict__ gk, int ldw, int N, int k0, int n0, bf16_t* WT, int ldt, int dst_row0, LAS float* scr, int lane) {
    const int nn = n0 + (lane & 31); const bool ok = nn < N;
    float wv[32];
#pragma unroll
    for (int i = 0; i < 32; ++i) { const int kk = 2 * i + (lane >> 5); wv[i] = ok ? W[(size_t)(k0 + kk) * ldw + nn] : 0.f; }
#pragma unroll
    for (int i = 0; i < 32; ++i) { const int kk = 2 * i + (lane >> 5); scr[kk * 33 + (lane & 31)] = gk ? wv[i] * gk[k0 + kk] : wv[i]; }
    asm volatile("s_waitcnt lgkmcnt(0)" ::: "memory");
    const int c = lane & 7;
#pragma unroll
    for (int j = 0; j < 4; ++j) { const int n = (lane >> 3) + 8 * j; const LAS float* s = scr + (8 * c) * 33 + n;
        u32x4 o; o.x = pk2(s[0 * 33], s[1 * 33]); o.y = pk2(s[2 * 33], s[3 * 33]); o.z = pk2(s[4 * 33], s[5 * 33]); o.w = pk2(s[6 * 33], s[7 * 33]);
        *(u32x4*)(WT + (size_t)(dst_row0 + n) * ldt + k0 + 8 * c) = o; }
    asm volatile("s_waitcnt lgkmcnt(0)" ::: "memory");
}
__device__ __forceinline__ void transpose_job(const float* W, const float* gk, int K, int N, bf16_t* WT, int ldt, int mode, int& rot, int gw, int NGW, LAS float* scr, int lane) {
    const int nnb = (N + 31) >> 5, nit = (K >> 6) * nnb;
    int start = gw - rot; if (start < 0) start += NGW;
    for (int it = start; it < nit; it += NGW) {
        const int kb = it / nnb, nb = it - kb * nnb, n0 = nb << 5;
        const int dr = mode == 0 ? n0 : ((n0 >> 7) * 256 + (n0 & 127) + (mode == 2 ? 128 : 0));
        transpose_item(W, gk, N, N, kb << 6, n0, WT, ldt, dr, scr, lane);
    }
    rot = (rot + nit) % NGW;
}
__device__ __forceinline__ void init_stream_bf16(const float* src, bf16_t* dst, float* ssp, int gw, int NGW, int lane) {
    for (int m = gw; m < T_; m += NGW) {
        const f32x4* xr = (const f32x4*)(src + (size_t)m * D_) + lane;
        u32x2 o[4]; float s = 0.f;
#pragma unroll
        for (int j = 0; j < 4; ++j) { const f32x4 v = xr[64 * j]; o[j].x = pk2(v.x, v.y); o[j].y = pk2(v.z, v.w);
            const float a = bflo(o[j].x), b = bfhi(o[j].x), c = bflo(o[j].y), d = bfhi(o[j].y); s += (a * a + b * b) + (c * c + d * d); }
        const float st = wave_sum(s); if (lane < 4) ssp[(size_t)m * 4 + lane] = lane == 0 ? st : 0.f;
        u32x2* o8 = (u32x2*)(dst + (size_t)m * D_) + lane;
#pragma unroll
        for (int j = 0; j < 4; ++j) o8[64 * j] = o[j];
    }
}
__device__ __forceinline__ void final_norm_rows(const bf16_t* hb, const float* __restrict__ g, float* out, int gw, int NGW, int lane) {
    f32x4 gv[4];
#pragma unroll
    for (int j = 0; j < 4; ++j) gv[j] = *(const f32x4*)(g + 4 * lane + 256 * j);
    for (int m = gw; m < T_; m += NGW) {
        const u32x2* hr = (const u32x2*)(hb + (size_t)m * D_) + lane;
        f32x4 v[4]; float s = 0.f;
#pragma unroll
        for (int j = 0; j < 4; ++j) { const u32x2 w = hr[64 * j]; v[j] = (f32x4){bflo(w.x), bfhi(w.x), bflo(w.y), bfhi(w.y)}; s += (v[j].x * v[j].x + v[j].y * v[j].y) + (v[j].z * v[j].z + v[j].w * v[j].w); }
        const float rs = 1.0f / sqrtf(wave_sum(s) * (1.f / D_) + EPS);
        f32x4* xr = (f32x4*)(out + (size_t)m * D_) + lane;
#pragma unroll
        for (int j = 0; j < 4; ++j) xr[64 * j] = v[j] * rs * gv[j];
    }
}
__device__ __forceinline__ void nsa_b1eff(const float* __restrict__ pos, const float* __restrict__ w1, const float* __restrict__ b1, float* B1E, int gw, int NGW, int lane) {
    for (int o = gw; o < 128; o += NGW) { const int kv = o >> 6, j = o & 63; float s = 0.f;
#pragma unroll 8
        for (int i = 0; i < 32; ++i) { const int kk = lane + 64 * i; s += pos[kv * 2048 + kk] * w1[((size_t)kv * 2048 + kk) * 64 + j]; }
        s = wave_sum(s); if (lane == 0) B1E[o] = s + b1[o]; }
}
__device__ __forceinline__ f32x4 mfma16(bf16x8 a, bf16x8 b, f32x4 c) { return __builtin_amdgcn_mfma_f32_16x16x32_bf16(a, b, c, 0, 0, 0); }
__device__ __forceinline__ void unpack8(const u32x4 w, float (&f)[8]) { f[0] = bflo(w.x); f[1] = bfhi(w.x); f[2] = bflo(w.y); f[3] = bfhi(w.y); f[4] = bflo(w.z); f[5] = bfhi(w.z); f[6] = bflo(w.w); f[7] = bfhi(w.w); }
__device__ __forceinline__ u32x4 pack8f(const float (&f)[8]) { u32x4 w; w.x = pk2(f[0], f[1]); w.y = pk2(f[2], f[3]); w.z = pk2(f[4], f[5]); w.w = pk2(f[6], f[7]); return w; }

__device__ __forceinline__ float neg_expm1(float x) {
    const float p = 1.f + x * (0.5f + x * (0.16666667f + x * (0.041666668f + x * (0.0083333338f + x * 0.0013888889f))));
    const float big = 1.f - fast_exp2(x * LOG2E);
    return x > -0.3f ? -x * p : big;
}
__device__ __forceinline__ void lru_gates_phase(LAS unsigned char* lds, const bf16_t* X, const float* __restrict__ conv_w, const float* __restrict__ conv_b,
        const bf16_t* WAT, const bf16_t* WXT, const float* __restrict__ b_a, const float* __restrict__ b_x, const float* __restrict__ lam,
        bf16_t* HL, bf16_t* AC, float* AGGA, float* AGGH, const int tid, const int bid, const int G) {
    const int lane = tid & 63, wid = __builtin_amdgcn_readfirstlane(tid >> 6), fr = lane & 15, fq = lane >> 4;
    constexpr int SA = 0, SBA = 34816, SBX = 69632, SAF = 0, SUF = 67584, SAGG = 135168, LDA_ = 272, LDF = 528;
    for (int u = bid; u < 1280; u += G) {
        const int tt = u / 10, hd = u - tt * 10, m0 = tt * 128, cbase = hd * 128;
        { const int c8 = tid & 15, r = tid >> 4, ch = cbase + 8 * c8;
          float cw[4][8], cb[8];
#pragma unroll
          for (int k = 0; k < 4; ++k) { const f32x4 w0 = *(const f32x4*)(conv_w + k * RNN + ch), w1 = *(const f32x4*)(conv_w + k * RNN + ch + 4);
              cw[k][0] = w0[0]; cw[k][1] = w0[1]; cw[k][2] = w0[2]; cw[k][3] = w0[3]; cw[k][4] = w1[0]; cw[k][5] = w1[1]; cw[k][6] = w1[2]; cw[k][7] = w1[3]; }
          { const f32x4 w0 = *(const f32x4*)(conv_b + ch), w1 = *(const f32x4*)(conv_b + ch + 4); cb[0] = w0[0]; cb[1] = w0[1]; cb[2] = w0[2]; cb[3] = w0[3]; cb[4] = w1[0]; cb[5] = w1[1]; cb[6] = w1[2]; cb[7] = w1[3]; }
#pragma unroll
          for (int g = 0; g < 4; ++g) { const int row = r + 32 * g, m = m0 + row, ts = m & (SEQ - 1);
              float acc[8];
#pragma unroll
              for (int e = 0; e < 8; ++e) acc[e] = cb[e];
#pragma unroll
              for (int k = 0; k < 4; ++k) { const bool okk = ts - 3 + k >= 0;
                  const u32x4 xv = *(const u32x4*)(X + (size_t)(okk ? m - 3 + k : m) * RNN + ch); float xf[8]; unpack8(xv, xf); const float zk = okk ? 1.f : 0.f;
#pragma unroll
                  for (int e = 0; e < 8; ++e) acc[e] += cw[k][e] * (xf[e] * zk); }
              *(LAS u32x4*)(lds + SA + row * LDA_ + c8 * 16) = pack8f(acc); } }
#pragma unroll
        for (int i = 0; i < 8; ++i) { const int q = tid + 512 * i, mat = q >> 11, j = (q >> 4) & 127, c = q & 15;
            const u32x4 v = *(const u32x4*)((mat ? WXT : WAT) + hd * 16384 + j * 128 + c * 8);
            *(LAS u32x4*)(lds + (mat ? SBX : SBA) + j * LDA_ + c * 16) = v; }
        __syncthreads();
        const int rg = wid >> 1, chh = wid & 1;
        f32x4 acca[2][4], accx[2][4];
#pragma unroll
        for (int mt = 0; mt < 2; ++mt)
#pragma unroll
            for (int nt = 0; nt < 4; ++nt) { acca[mt][nt] = (f32x4){0.f, 0.f, 0.f, 0.f}; accx[mt][nt] = (f32x4){0.f, 0.f, 0.f, 0.f}; }
#pragma unroll
        for (int s = 0; s < 4; ++s) { bf16x8 af[2];
#pragma unroll
            for (int mt = 0; mt < 2; ++mt) af[mt] = *(const LAS bf16x8*)(lds + SA + (32 * rg + 16 * mt + fr) * LDA_ + (32 * s + 8 * fq) * 2);
#pragma unroll
            for (int nt = 0; nt < 4; ++nt) { const bf16x8 ba = *(const LAS bf16x8*)(lds + SBA + (64 * chh + 16 * nt + fr) * LDA_ + (32 * s + 8 * fq) * 2);
                const bf16x8 bx = *(const LAS bf16x8*)(lds + SBX + (64 * chh + 16 * nt + fr) * LDA_ + (32 * s + 8 * fq) * 2);
#pragma unroll
                for (int mt = 0; mt < 2; ++mt) { acca[mt][nt] = mfma16(ba, af[mt], acca[mt][nt]); accx[mt][nt] = mfma16(bx, af[mt], accx[mt][nt]); } } }
        u32x2 xcv[2][4];
#pragma unroll
        for (int mt = 0; mt < 2; ++mt)
#pragma unroll
            for (int nt = 0; nt < 4; ++nt) xcv[mt][nt] = *(const LAS u32x2*)(lds + SA + (32 * rg + 16 * mt + fr) * LDA_ + (64 * chh + 16 * nt + 4 * fq) * 2);
        __syncthreads();
#pragma unroll
        for (int nt = 0; nt < 4; ++nt) { const int cc = cbase + 64 * chh + 16 * nt + 4 * fq;
            const f32x4 ba4 = *(const f32x4*)(b_a + cc), bx4 = *(const f32x4*)(b_x + cc), lm4 = *(const f32x4*)(lam + cc);
            f32x4 nl8;
#pragma unroll
            for (int j = 0; j < 4; ++j) nl8[j] = -8.f * 0.6931471805599453f * __builtin_amdgcn_logf(1.f + fast_exp2(-lm4[j] * LOG2E));
#pragma unroll
            for (int mt = 0; mt < 2; ++mt) { const float xc4[4] = {bflo(xcv[mt][nt].x), bfhi(xcv[mt][nt].x), bflo(xcv[mt][nt].y), bfhi(xcv[mt][nt].y)};
                f32x4 a4, u4;
#pragma unroll
                for (int j = 0; j < 4; ++j) { const float r = sigmoidf_(acca[mt][nt][j] + ba4[j]), ig = sigmoidf_(accx[mt][nt][j] + bx4[j]);
                    const float la = nl8[j] * r; a4[j] = fast_exp2(la * LOG2E); u4[j] = __builtin_amdgcn_sqrtf(neg_expm1(2.f * la)) * ig * xc4[j]; }
                const int off = (32 * rg + 16 * mt + fr) * LDF + (64 * chh + 16 * nt + 4 * fq) * 4;
                *(LAS f32x4*)(lds + SAF + off) = a4; *(LAS f32x4*)(lds + SUF + off) = u4; } }
        __syncthreads();
        { const int ch = tid & 127, seg = tid >> 7;
          LAS float* pa = (LAS float*)(lds + SAF) + ch; LAS float* pu = (LAS float*)(lds + SUF) + ch; LAS float* ag = (LAS float*)(lds + SAGG);
          float A = 1.f, H = 0.f;
#pragma unroll 8
          for (int t = seg * 32; t < seg * 32 + 32; ++t) { const float a = pa[t * (LDF / 4)], uu = pu[t * (LDF / 4)]; H = a * H + uu; A *= a; }
          ag[seg * 128 + ch] = A; ag[512 + seg * 128 + ch] = H;
          __syncthreads();
          float cA = 1.f, cH = 0.f;
          for (int s = 0; s < seg; ++s) { const float As = ag[s * 128 + ch], Hs = ag[512 + s * 128 + ch]; cH = As * cH + Hs; cA *= As; }
#pragma unroll 8
          for (int t = seg * 32; t < seg * 32 + 32; ++t) { const float a = pa[t * (LDF / 4)], uu = pu[t * (LDF / 4)]; cH = a * cH + uu; cA *= a; pa[t * (LDF / 4)] = cA; pu[t * (LDF / 4)] = cH; }
          if (seg == 3) { AGGA[(size_t)tt * RNN + cbase + ch] = cA; AGGH[(size_t)tt * RNN + cbase + ch] = cH; } }
        __syncthreads();
#pragma unroll
        for (int i = 0; i < 4; ++i) { const int q = tid + 512 * i, row = q >> 4, c8 = q & 15;
            const f32x4 a0 = *(const LAS f32x4*)(lds + SAF + row * LDF + c8 * 32), a1 = *(const LAS f32x4*)(lds + SAF + row * LDF + c8 * 32 + 16);
            const f32x4 h0 = *(const LAS f32x4*)(lds + SUF + row * LDF + c8 * 32), h1 = *(const LAS f32x4*)(lds + SUF + row * LDF + c8 * 32 + 16);
            u32x4 wa, wh; wa.x = pk2(a0[0], a0[1]); wa.y = pk2(a0[2], a0[3]); wa.z = pk2(a1[0], a1[1]); wa.w = pk2(a1[2], a1[3]);
            wh.x = pk2(h0[0], h0[1]); wh.y = pk2(h0[2], h0[3]); wh.z = pk2(h1[0], h1[1]); wh.w = pk2(h1[2], h1[3]);
            const size_t go = (size_t)(m0 + row) * RNN + cbase + 8 * c8;
            *(u32x4*)(AC + go) = wa; *(u32x4*)(HL + go) = wh; }
        __syncthreads();
    }
}
__device__ __forceinline__ void lru_apply_phase(const bf16_t* GB, bf16_t* YO, const bf16_t* HL, const bf16_t* AC, const float* AGGA, const float* AGGH, const int tid, const int bid, const int G) {
    const int c8 = tid & 31, r = tid >> 5;
    for (int u = bid; u < 640; u += G) {
        const int tt = u / 5, cb = u - tt * 5, m0 = tt * 128, ch = cb * 256 + 8 * c8;
        float carry[8];
#pragma unroll
        for (int e = 0; e < 8; ++e) carry[e] = 0.f;
        { const int p0 = tt & ~63; int p = p0;
          for (; p + 8 <= tt; p += 8) { f32x4 a0[8], a1[8], h0[8], h1[8];
#pragma unroll
              for (int q = 0; q < 8; ++q) { const size_t o = (size_t)(p + q) * RNN + ch; a0[q] = *(const f32x4*)(AGGA + o); a1[q] = *(const f32x4*)(AGGA + o + 4); h0[q] = *(const f32x4*)(AGGH + o); h1[q] = *(const f32x4*)(AGGH + o + 4); }
#pragma unroll
              for (int q = 0; q < 8; ++q)
#pragma unroll
                  for (int e = 0; e < 4; ++e) { carry[e] = carry[e] * a0[q][e] + h0[q][e]; carry[4 + e] = carry[4 + e] * a1[q][e] + h1[q][e]; } }
          for (; p < tt; ++p) { const size_t o = (size_t)p * RNN + ch; const f32x4 a0 = *(const f32x4*)(AGGA + o), a1 = *(const f32x4*)(AGGA + o + 4), h0 = *(const f32x4*)(AGGH + o), h1 = *(const f32x4*)(AGGH + o + 4);
#pragma unroll
              for (int e = 0; e < 4; ++e) { carry[e] = carry[e] * a0[e] + h0[e]; carry[4 + e] = carry[4 + e] * a1[e] + h1[e]; } } }
#pragma unroll
        for (int i = 0; i < 8; ++i) { const size_t go = (size_t)(m0 + r + 16 * i) * RNN + ch;
            float g[8], hl[8], ac[8], y[8]; unpack8(*(const u32x4*)(GB + go), g); unpack8(*(const u32x4*)(HL + go), hl); unpack8(*(const u32x4*)(AC + go), ac);
#pragma unroll
            for (int e = 0; e < 8; ++e) y[e] = g[e] * (hl[e] + ac[e] * carry[e]);
            *(u32x4*)(YO + go) = pack8f(y); }
    }
}
__device__ __forceinline__ s16x4 tr_read(const LAS unsigned char* p) { typedef short v4i16_t __attribute__((ext_vector_type(4))); return __builtin_bit_cast(s16x4, __builtin_amdgcn_ds_read_tr16_b64_v4i16((LAS v4i16_t*)p)); }
__device__ __forceinline__ bf16x8 cat44(s16x4 lo, s16x4 hi) { return (bf16x8){lo[0], lo[1], lo[2], lo[3], hi[0], hi[1], hi[2], hi[3]}; }
__device__ __forceinline__ void gla_cum(LAS unsigned char* lds, const float* GL, const float* __restrict__ w_g2, const float* __restrict__ b_g2, int m0, int h, const int tid, const int bid, const int G) {

    LAS float* sGL = (LAS float*)lds; LAS float* sSeg = (LAS float*)(lds + 4096); LAS float* sB = (LAS float*)(lds + 8192);
    if (tid < 256) *(LAS f32x4*)(sGL + tid * 4) = *(const f32x4*)(GL + (size_t)m0 * 16 + tid * 4);
    const int d = tid & 127, tq = tid >> 7, dch = h * 128 + d;
    float w[16];
#pragma unroll
    for (int r = 0; r < 16; ++r) w[r] = w_g2[r * 512 + dch];
    const float bb = b_g2[dch];
    __syncthreads();
    float run = 0.f;
#pragma unroll 4
    for (int i = 0; i < 16; ++i) { const int t = tq * 16 + i; float z = bb;
#pragma unroll
        for (int r4 = 0; r4 < 4; ++r4) { const f32x4 gv = *(const LAS f32x4*)(sGL + t * 16 + r4 * 4); z += gv[0] * w[r4 * 4] + gv[1] * w[r4 * 4 + 1] + gv[2] * w[r4 * 4 + 2] + gv[3] * w[r4 * 4 + 3]; }
        const float la = -(__builtin_amdgcn_logf(1.f + fast_exp2(-fabsf(z) * LOG2E)) * 0.6931471805599453f + fmaxf(-z, 0.f)) * 0.0625f;
        run += la; sB[t * 128 + d] = run; }
    sSeg[tq * 128 + d] = run;
    __syncthreads();
    float pre = 0.f;
    for (int s = 0; s < tq; ++s) pre += sSeg[s * 128 + d];
#pragma unroll 4
    for (int i = 0; i < 16; ++i) sB[(tq * 16 + i) * 128 + d] += pre;
    __syncthreads();
}
__device__ __forceinline__ void gla_kv_phase(LAS unsigned char* lds, const bf16_t* Kg, const bf16_t* Vg, const float* GL, const float* w_g2, const float* b_g2, bf16_t* KVT, float* DEC, const int tid, const int bid, const int G) {
    const int lane = tid & 63, wid = __builtin_amdgcn_readfirstlane(tid >> 6), fr = lane & 15, fq = lane >> 4, q4 = (lane & 15) >> 2, p4 = lane & 3;
    constexpr int SB_ = 8192, SK = 40960, SV = 58368, LDK = 272, LDV = 528;
    const LAS float* sB = (const LAS float*)(lds + SB_);
    for (int u = bid; u < 1024; u += G) {
        const int b = u >> 9, n = (u >> 2) & 127, h = u & 3, m0 = b * SEQ + 64 * n, bh = b * 4 + h;
        gla_cum(lds, GL, w_g2, b_g2, m0, h, tid, bid, G);
#pragma unroll
        for (int i = 0; i < 2; ++i) { const int q = tid + 512 * i, t = q >> 4, c = q & 15; float kf[8]; unpack8(*(const u32x4*)(Kg + (size_t)(m0 + t) * 512 + h * 128 + 8 * c), kf);
#pragma unroll
            for (int e = 0; e < 8; ++e) kf[e] *= fast_exp2((sB[63 * 128 + 8 * c + e] - sB[t * 128 + 8 * c + e]) * LOG2E);
            *(LAS u32x4*)(lds + SK + t * LDK + c * 16) = pack8f(kf); }
        if (tid < 128) DEC[((size_t)bh * 128 + n) * 128 + tid] = fast_exp2(sB[63 * 128 + tid] * LOG2E);
#pragma unroll
        for (int i = 0; i < 4; ++i) { const int q = tid + 512 * i, t = q >> 5, c = q & 31; *(LAS u32x4*)(lds + SV + t * LDV + c * 16) = *(const u32x4*)(Vg + (size_t)(m0 + t) * 1024 + h * 256 + 8 * c); }
        __syncthreads();
        f32x4 acc[8][2];
#pragma unroll
        for (int mt = 0; mt < 8; ++mt) { acc[mt][0] = (f32x4){0.f, 0.f, 0.f, 0.f}; acc[mt][1] = (f32x4){0.f, 0.f, 0.f, 0.f}; }
#pragma unroll
        for (int s = 0; s < 2; ++s) { bf16x8 bv[2];
#pragma unroll
            for (int nl = 0; nl < 2; ++nl) { const LAS unsigned char* pv = lds + SV + (32 * s + 8 * fq + q4) * LDV + (32 * wid + 16 * nl + 4 * p4) * 2; bv[nl] = cat44(tr_read(pv), tr_read(pv + 4 * LDV)); }
#pragma unroll
            for (int mt = 0; mt < 8; ++mt) { const LAS unsigned char* pk = lds + SK + (32 * s + 8 * fq + q4) * LDK + (16 * mt + 4 * p4) * 2; const bf16x8 ak = cat44(tr_read(pk), tr_read(pk + 4 * LDK));
                acc[mt][0] = mfma16(ak, bv[0], acc[mt][0]); acc[mt][1] = mfma16(ak, bv[1], acc[mt][1]); } }
        bf16_t* dst = KVT + ((size_t)bh * 128 + n) * 32768;
#pragma unroll
        for (int mt = 0; mt < 8; ++mt)
#pragma unroll
            for (int nl = 0; nl < 2; ++nl) { u32x2 w; w.x = pk2(acc[mt][nl][0], acc[mt][nl][1]); w.y = pk2(acc[mt][nl][2], acc[mt][nl][3]);
                *(u32x2*)(dst + (32 * wid + 16 * nl + fr) * 128 + 16 * mt + 4 * fq) = w; }
        __syncthreads();
    }
}
__device__ __forceinline__ void gla_scan_phase(bf16_t* KVT, const float* DEC, const bool dry, const int tid, const int bid, const int G) {
    const int nthr = G * 512;
    for (int e2 = bid * 512 + tid; e2 < 8 * 16384; e2 += nthr) {
        const int bh = e2 >> 14, e = (e2 & 16383) * 2, dk = e & 127;
        unsigned* p = (unsigned*)(KVT + (size_t)bh * 128 * 32768 + e); const float* dp = DEC + (size_t)bh * 128 * 128 + dk;
        float s0 = 0.f, s1 = 0.f;
        for (int n0 = 0; n0 < 128; n0 += 8) { unsigned w[8]; f32x2 d2[8];
#pragma unroll
            for (int i = 0; i < 8; ++i) { w[i] = p[(size_t)(n0 + i) * 16384]; d2[i] = *(const f32x2*)(dp + (n0 + i) * 128); }
#pragma unroll
            for (int i = 0; i < 8; ++i) { if (!dry) p[(size_t)(n0 + i) * 16384] = pk2(s0, s1); s0 = s0 * d2[i].x + bflo(w[i]); s1 = s1 * d2[i].y + bfhi(w[i]); } }
    }
}
__device__ __forceinline__ void gla_out_phase(LAS unsigned char* lds, const bf16_t* Qg, const bf16_t* Kg, const bf16_t* Vg, const bf16_t* Rg, const float* GL, const float* w_g2, const float* b_g2,
        const float* __restrict__ norm_g, const bf16_t* KVT, bf16_t* Y, const int tid, const int bid, const int G) {
    const int lane = tid & 63, wid = __builtin_amdgcn_readfirstlane(tid >> 6), fr = lane & 15, fq = lane >> 4, q4 = (lane & 15) >> 2, p4 = lane & 3;
    constexpr int SB_ = 8192, SQ = 40960, SKI = 58368, SV = 75776, SATT = 109568, SSS = 118784, LDQ = 272, LDV = 528, LDAT = 144;
    const LAS float* sB = (const LAS float*)(lds + SB_);
    for (int u = bid; u < 1024; u += G) {
        const int b = u >> 9, n = (u >> 2) & 127, h = u & 3, m0 = b * SEQ + 64 * n, bh = b * 4 + h;
        bf16x8 bsall[4][2];
        { const bf16_t* Sp = KVT + ((size_t)bh * 128 + n) * 32768;
#pragma unroll
          for (int s = 0; s < 4; ++s)
#pragma unroll
              for (int nl = 0; nl < 2; ++nl) bsall[s][nl] = *(const bf16x8*)(Sp + (32 * wid + 16 * nl + fr) * 128 + 32 * s + 8 * fq); }
        gla_cum(lds, GL, w_g2, b_g2, m0, h, tid, bid, G);
#pragma unroll
        for (int i = 0; i < 2; ++i) { const int q = tid + 512 * i, t = q >> 4, c = q & 15; float qf[8], kf[8];
            unpack8(*(const u32x4*)(Qg + (size_t)(m0 + t) * 512 + h * 128 + 8 * c), qf); unpack8(*(const u32x4*)(Kg + (size_t)(m0 + t) * 512 + h * 128 + 8 * c), kf);
#pragma unroll
            for (int e = 0; e < 8; ++e) { const float bb = sB[t * 128 + 8 * c + e] * LOG2E; qf[e] *= fast_exp2(bb); kf[e] *= fast_exp2(-bb); }
            *(LAS u32x4*)(lds + SQ + t * LDQ + c * 16) = pack8f(qf); *(LAS u32x4*)(lds + SKI + t * LDQ + c * 16) = pack8f(kf); }
#pragma unroll
        for (int i = 0; i < 4; ++i) { const int q = tid + 512 * i, t = q >> 5, c = q & 31; *(LAS u32x4*)(lds + SV + t * LDV + c * 16) = *(const u32x4*)(Vg + (size_t)(m0 + t) * 1024 + h * 256 + 8 * c); }
        __syncthreads();
        { const int mt = wid >> 1; f32x4 at[2] = {(f32x4){0.f, 0.f, 0.f, 0.f}, (f32x4){0.f, 0.f, 0.f, 0.f}};
#pragma unroll
          for (int s = 0; s < 4; ++s) { const bf16x8 a = *(const LAS bf16x8*)(lds + SQ + (16 * mt + fr) * LDQ + (32 * s + 8 * fq) * 2);
#pragma unroll
              for (int nl = 0; nl < 2; ++nl) { const int nt = 2 * (wid & 1) + nl; const bf16x8 bk = *(const LAS bf16x8*)(lds + SKI + (16 * nt + fr) * LDQ + (32 * s + 8 * fq) * 2); at[nl] = mfma16(bk, a, at[nl]); } }
#pragma unroll
          for (int nl = 0; nl < 2; ++nl) { const int nt = 2 * (wid & 1) + nl, c = 16 * mt + fr, j0 = 16 * nt + 4 * fq; float v[4];
#pragma unroll
              for (int j = 0; j < 4; ++j) v[j] = (j0 + j <= c) ? at[nl][j] : 0.f;
              u32x2 w; w.x = pk2(v[0], v[1]); w.y = pk2(v[2], v[3]); *(LAS u32x2*)(lds + SATT + c * LDAT + j0 * 2) = w; } }
        __syncthreads();
        f32x4 o[4][2];
#pragma unroll
        for (int mt = 0; mt < 4; ++mt) { o[mt][0] = (f32x4){0.f, 0.f, 0.f, 0.f}; o[mt][1] = (f32x4){0.f, 0.f, 0.f, 0.f}; }
#pragma unroll
        for (int s = 0; s < 2; ++s) { bf16x8 bv[2];
#pragma unroll
            for (int nl = 0; nl < 2; ++nl) { const LAS unsigned char* pv = lds + SV + (32 * s + 8 * fq + q4) * LDV + (32 * wid + 16 * nl + 4 * p4) * 2; bv[nl] = cat44(tr_read(pv), tr_read(pv + 4 * LDV)); }
#pragma unroll
            for (int mt = 0; mt < 4; ++mt) { const bf16x8 a = *(const LAS bf16x8*)(lds + SATT + (16 * mt + fr) * LDAT + (32 * s + 8 * fq) * 2);
                o[mt][0] = mfma16(bv[0], a, o[mt][0]); o[mt][1] = mfma16(bv[1], a, o[mt][1]); } }
#pragma unroll
        for (int s = 0; s < 4; ++s) {
#pragma unroll
            for (int mt = 0; mt < 4; ++mt) { const bf16x8 a = *(const LAS bf16x8*)(lds + SQ + (16 * mt + fr) * LDQ + (32 * s + 8 * fq) * 2);
                o[mt][0] = mfma16(bsall[s][0], a, o[mt][0]); o[mt][1] = mfma16(bsall[s][1], a, o[mt][1]); } }
        LAS float* sSS = (LAS float*)(lds + SSS);
#pragma unroll
        for (int mt = 0; mt < 4; ++mt) { float ss = 0.f;
#pragma unroll
            for (int nl = 0; nl < 2; ++nl)
#pragma unroll
                for (int j = 0; j < 4; ++j) ss += o[mt][nl][j] * o[mt][nl][j];
            ss += __shfl_xor(ss, 16); ss += __shfl_xor(ss, 32);
            if (fq == 0) sSS[(16 * mt + fr) * 8 + wid] = ss; }
        __syncthreads();
#pragma unroll
        for (int mt = 0; mt < 4; ++mt) { const int tok = 16 * mt + fr; const f32x4 s0 = *(const LAS f32x4*)(sSS + tok * 8), s1 = *(const LAS f32x4*)(sSS + tok * 8 + 4);
            const float tot = ((s0[0] + s0[1]) + (s0[2] + s0[3])) + ((s1[0] + s1[1]) + (s1[2] + s1[3])); const float rs = __builtin_amdgcn_rsqf(tot * (1.f / 256.f) + EPS);
#pragma unroll
            for (int nl = 0; nl < 2; ++nl) { const int dv = 32 * wid + 16 * nl + 4 * fq; const f32x4 gn = *(const f32x4*)(norm_g + dv);
                const size_t go = (size_t)(m0 + tok) * 1024 + h * 256 + dv; const u32x2 rv = *(const u32x2*)(Rg + go);
                u32x2 w; w.x = pk2(o[mt][nl][0] * rs * gn[0] * bflo(rv.x), o[mt][nl][1] * rs * gn[1] * bfhi(rv.x)); w.y = pk2(o[mt][nl][2] * rs * gn[2] * bflo(rv.y), o[mt][nl][3] * rs * gn[3] * bfhi(rv.y));
                *(u32x2*)(Y + go) = w; } }
        __syncthreads();
    }
}
__device__ __forceinline__ void nsa_compress_phase(LAS unsigned char* lds, const bf16_t* KV, const float* __restrict__ pos, const float* __restrict__ w1, const float* __restrict__ b1,
        const float* __restrict__ b2, const bf16_t* W1T, const bf16_t* W2T, bf16_t* KC, bf16_t* VC, bf16_t* VT, const float* B1E, const int tid, const int bid, const int G) {
    const int lane = tid & 63, wid = __builtin_amdgcn_readfirstlane(tid >> 6), fr = lane & 15, fq = lane >> 4;
    constexpr int SP = 0, SB1 = 2048, SPART = 4096, SH = 36864, LDH = 144;
    for (int u = bid; u < 256; u += G) {
        const int kv = u >> 7, b = (u >> 6) & 1, g = (u >> 4) & 3, n0 = (u & 15) * 32;
        if (tid < 64) ((LAS float*)(lds + SB1))[tid] = B1E[kv * 64 + tid];
        { const int rt = wid & 1, kq = wid >> 1, n = n0 + 16 * rt + fr; const bool ok = n <= 510;
          const bf16_t* src = KV + (size_t)kv * T_ * 256 + (size_t)(b * SEQ + 16 * (ok ? n : 0)) * 256 + g * 64;
          const bf16_t* wt = W1T + (size_t)kv * 64 * 2048;
          f32x4 acc[4] = {(f32x4){0.f, 0.f, 0.f, 0.f}, (f32x4){0.f, 0.f, 0.f, 0.f}, (f32x4){0.f, 0.f, 0.f, 0.f}, (f32x4){0.f, 0.f, 0.f, 0.f}};
#pragma unroll 4
          for (int s = 0; s < 16; ++s) { const int kk = kq * 512 + 32 * s + 8 * fq, l = kk >> 6, d = kk & 63;
              bf16x8 a = *(const bf16x8*)(src + (size_t)l * 256 + d); if (!ok) a = (bf16x8){0, 0, 0, 0, 0, 0, 0, 0};
#pragma unroll
              for (int nt = 0; nt < 4; ++nt) { const bf16x8 bb = *(const bf16x8*)(wt + (size_t)(16 * nt + fr) * 2048 + kk); acc[nt] = mfma16(bb, a, acc[nt]); } }
#pragma unroll
          for (int nt = 0; nt < 4; ++nt) *(LAS f32x4*)(lds + SPART + ((kq * 2 + rt) * 1024 + fr * 64 + 16 * nt + 4 * fq) * 4) = acc[nt]; }
        __syncthreads();
        { const int row = tid >> 4, c4 = (tid & 15) * 4, rt = row >> 4, rr = row & 15; f32x4 s = *(const LAS f32x4*)(lds + SB1 + c4 * 4);
#pragma unroll
          for (int kq = 0; kq < 4; ++kq) s += *(const LAS f32x4*)(lds + SPART + ((kq * 2 + rt) * 1024 + rr * 64 + c4) * 4);
          u32x2 w; w.x = pk2(gelu_tanh_(s[0]), gelu_tanh_(s[1])); w.y = pk2(gelu_tanh_(s[2]), gelu_tanh_(s[3])); *(LAS u32x2*)(lds + SH + row * LDH + c4 * 2) = w; }
        __syncthreads();
        { const int rt = wid >> 2, nt = wid & 3; f32x4 acc = (f32x4){0.f, 0.f, 0.f, 0.f};
#pragma unroll
          for (int s = 0; s < 2; ++s) { const bf16x8 a = *(const LAS bf16x8*)(lds + SH + (16 * rt + fr) * LDH + (32 * s + 8 * fq) * 2);
              const bf16x8 bb = *(const bf16x8*)(W2T + kv * 4096 + (16 * nt + fr) * 64 + 32 * s + 8 * fq); acc = mfma16(bb, a, acc); }
          const int n = n0 + 16 * rt + fr, d = 16 * nt + 4 * fq; const f32x4 bv = *(const f32x4*)(b2 + kv * 64 + d);
          u32x2 w; w.x = pk2(acc[0] + bv[0], acc[1] + bv[1]); w.y = pk2(acc[2] + bv[2], acc[3] + bv[3]);
          *(u32x2*)((kv ? VC : KC) + ((size_t)(b * 4 + g) * 512 + n) * 64 + d) = w; }
        __syncthreads();
    }
    { const bf16_t* VS = KV + (size_t)3 * T_ * 256;
      for (int tt = bid; tt < T_ / 64; tt += G) { const int r0 = tt * 64, bb = r0 >> 13, t0 = r0 & 8191;
#pragma unroll
          for (int i = 0; i < 4; ++i) { const int q = tid + 512 * i, row = q >> 5, ch = q & 31; *(LAS u32x4*)(lds + row * 528 + ch * 16) = *(const u32x4*)(VS + (size_t)(r0 + row) * 256 + ch * 8); }
          __syncthreads();
          { const int cc = tid >> 1, hf = tid & 1; unsigned short v[32];
#pragma unroll
            for (int k = 0; k < 32; ++k) v[k] = *(const LAS unsigned short*)(lds + (hf * 32 + k) * 528 + cc * 2);
            bf16_t* dst = VT + ((size_t)(bb * 256 + cc)) * 8192 + t0 + hf * 32;
#pragma unroll
            for (int k = 0; k < 4; ++k) { u32x4 w; w.x = v[8 * k] | ((unsigned)v[8 * k + 1] << 16); w.y = v[8 * k + 2] | ((unsigned)v[8 * k + 3] << 16); w.z = v[8 * k + 4] | ((unsigned)v[8 * k + 5] << 16); w.w = v[8 * k + 6] | ((unsigned)v[8 * k + 7] << 16);
                *(u32x4*)(dst + 8 * k) = w; } }
          __syncthreads(); } }
}
#ifndef NSA_LOCKSTEP
#define NSA_LOCKSTEP 0
#endif
#ifndef NSA_ONE_WAVE
#define NSA_ONE_WAVE 0
#endif
#ifndef NSA_SPARSE_SKIP
#define NSA_SPARSE_SKIP 0
#endif
#ifndef NSA_CT3_ONLY
#define NSA_CT3_ONLY 0
#endif
#ifndef NSA_SEL_REP
#define NSA_SEL_REP 1
#endif
#ifndef NSA_WIN_REP
#define NSA_WIN_REP 1
#endif
struct NsaSt { float m, l; f32x4 o[4]; };
struct KVRegs { u32x4 k[2], v[2]; };
template <int MODE, int STEP, int CTM>
__device__ __forceinline__ void nsa_tile(const LAS unsigned char* sK, const LAS unsigned char* sV, const bf16x8 (&qf)[2][2], NsaSt (&st)[2], const int (&dbase)[2],
        const bool general, const bool (&colsel)[2], const LAS float* bt, const float bfar, const float (&minv)[2], LAS float* sMain, LAS float* sSpill, const int (&tokl)[2], const int mg0,
        const int fr_in, const int fq_in, const int q4_in, const int p4_in) {
    constexpr int LDT = 144; const float NEG = -INFINITY;
    int fr = fr_in, fq = fq_in, q4 = q4_in, p4 = p4_in; asm volatile("" : "+v"(fr), "+v"(fq), "+v"(q4), "+v"(p4));
    bf16x8 kf[4][2];
#pragma unroll
    for (int kt = 0; kt < 4; ++kt) { kf[kt][0] = *(const LAS bf16x8*)(sK + (16 * kt + fr) * LDT + (8 * fq) * 2); kf[kt][1] = *(const LAS bf16x8*)(sK + (16 * kt + fr) * LDT + (32 + 8 * fq) * 2); }
    f32x4 sacc[2][4];
#pragma unroll
    for (int ct = 0; ct < 2; ++ct) if (CTM & (1 << ct)) {
#pragma unroll
        for (int kt = 0; kt < 4; ++kt) sacc[ct][kt] = mfma16(kf[kt][0], qf[ct][0], (f32x4){0.f, 0.f, 0.f, 0.f});
#pragma unroll
        for (int kt = 0; kt < 4; ++kt) sacc[ct][kt] = mfma16(kf[kt][1], qf[ct][1], sacc[ct][kt]); }
#pragma unroll
    for (int ct = 0; ct < 2; ++ct) if (CTM & (1 << ct)) {
        float tmax = NEG;
        if (general) {
            float bv[4][4];
#pragma unroll
            for (int kt = 0; kt < 4; ++kt)
#pragma unroll
                for (int j = 0; j < 4; ++j) { const int dist = dbase[ct] - (16 * kt + 4 * fq + j) * STEP; const int idx = dist < 0 ? 0 : (dist > 128 ? 128 : dist); bv[kt][j] = bt[idx]; }
#pragma unroll
            for (int kt = 0; kt < 4; ++kt)
#pragma unroll
                for (int j = 0; j < 4; ++j) { const int dist = dbase[ct] - (16 * kt + 4 * fq + j) * STEP; bool valid = dist >= 0;
                    if (MODE == 3) valid = valid && dist < 512;
                    if (MODE == 2) valid = valid && colsel[ct];
                    const float x = valid ? sacc[ct][kt][j] * LOG2E + bv[kt][j] : NEG;
                    sacc[ct][kt][j] = x; tmax = max3_(tmax, x, x); }
        } else {
#pragma unroll
            for (int kt = 0; kt < 4; ++kt) tmax = max3_(max3_(tmax, sacc[ct][kt][0], sacc[ct][kt][1]), sacc[ct][kt][2], sacc[ct][kt][3]);
            tmax = (MODE == 2 && !colsel[ct]) ? NEG : tmax * LOG2E + bfar;
        }
        if (MODE == 1) {
            const float mm = st[ct].m, li = minv[ct];
#pragma unroll
            for (int kt = 0; kt < 4; ++kt) { float gs = 0.f, p3 = 0.f;
#pragma unroll
                for (int j = 0; j < 4; ++j) { const float xx = general ? sacc[ct][kt][j] : sacc[ct][kt][j] * LOG2E + bfar; const float p = fast_exp2(xx - mm) * li; sacc[ct][kt][j] = p; gs += p; if (j == 3) p3 = p; }
                gs += dpp_xor1(gs); gs += dpp_xor2(gs); p3 += dpp_xor1(p3); p3 += dpp_xor2(p3);
                const int mg = mg0 + 4 * kt + fq;
                if ((fr & 3) == 0) { sMain[tokl[ct] * 128 + mg] = gs; if (mg + 1 < 128) sSpill[tokl[ct] * 128 + mg + 1] = p3; } }
        } else {
            const float rm = xmax16_32(tmax);
            const bool need = rm > st[ct].m + 8.f;
            if (__any(need)) { const float mnew = need ? fmaxf(st[ct].m, rm) : st[ct].m, alpha = (st[ct].m == mnew) ? 1.f : fast_exp2(st[ct].m - mnew);
                st[ct].l *= alpha; st[ct].m = mnew;
                if (MODE != 0) {
#pragma unroll
                    for (int dt = 0; dt < 4; ++dt) st[ct].o[dt] = st[ct].o[dt] * alpha; } }
            const float mref = (st[ct].m == NEG) ? 0.f : st[ct].m;
            float ps = 0.f;
            if (general) {
#pragma unroll
                for (int kt = 0; kt < 4; ++kt)
#pragma unroll
                    for (int j = 0; j < 4; ++j) { const float p = fast_exp2(sacc[ct][kt][j] - mref); sacc[ct][kt][j] = p; ps += p; }
            } else { const float c = (MODE == 2 && !colsel[ct]) ? NEG : bfar - mref;
#pragma unroll
                for (int kt = 0; kt < 4; ++kt)
#pragma unroll
                    for (int j = 0; j < 4; ++j) { const float p = fast_exp2(sacc[ct][kt][j] * LOG2E + c); sacc[ct][kt][j] = p; ps += p; } }
            st[ct].l += ps;
        }
    }
    if (MODE != 0) {
#pragma unroll
        for (int s = 0; s < 2; ++s) { bf16x8 pf[2];
#pragma unroll
            for (int ct = 0; ct < 2; ++ct) if (CTM & (1 << ct)) { u32x4 w; w.x = pk2(sacc[ct][2 * s][0], sacc[ct][2 * s][1]); w.y = pk2(sacc[ct][2 * s][2], sacc[ct][2 * s][3]);
                w.z = pk2(sacc[ct][2 * s + 1][0], sacc[ct][2 * s + 1][1]); w.w = pk2(sacc[ct][2 * s + 1][2], sacc[ct][2 * s + 1][3]); pf[ct] = __builtin_bit_cast(bf16x8, w); }
#pragma unroll
            for (int dt = 0; dt < 4; ++dt) { const LAS unsigned char* pv = sV + (32 * s + 4 * fq + q4) * LDT + (16 * dt + 4 * p4) * 2; const bf16x8 vf = cat44(tr_read(pv), tr_read(pv + 16 * LDT));
#pragma unroll
                for (int ct = 0; ct < 2; ++ct) if (CTM & (1 << ct)) st[ct].o[dt] = mfma16(vf, pf[ct], st[ct].o[dt]); } }
    }
}
__device__ __forceinline__ void nsa_ld2(const bf16_t* Kp, const bf16_t* Vp, size_t ts, int ld, bool two, int tid_in, KVRegs& r) { int tid = tid_in; asm volatile("" : "+v"(tid)); const int key = tid >> 3, c = tid & 7;
    r.k[0] = *(const u32x4*)(Kp + (size_t)key * ld + 8 * c); r.v[0] = *(const u32x4*)(Vp + (size_t)key * ld + 8 * c);
    if (two) { r.k[1] = *(const u32x4*)(Kp + ts + (size_t)key * ld + 8 * c); r.v[1] = *(const u32x4*)(Vp + ts + (size_t)key * ld + 8 * c); } }
__device__ __forceinline__ void nsa_st2(LAS unsigned char* sK, LAS unsigned char* sV, int tid_in, const KVRegs& r) { int tid = tid_in; asm volatile("" : "+v"(tid)); const int key = tid >> 3, c = tid & 7;
    *(LAS u32x4*)(sK + key * 144 + c * 16) = r.k[0]; *(LAS u32x4*)(sV + key * 144 + c * 16) = r.v[0]; *(LAS u32x4*)(sK + 9216 + key * 144 + c * 16) = r.k[1]; *(LAS u32x4*)(sV + 9216 + key * 144 + c * 16) = r.v[1]; }

__device__ __forceinline__ unsigned long long fx_enc(float x) { const float t = x * 16.f, fl = floorf(t); const int hi = (int)fl; const unsigned lo = (unsigned)((t - fl) * 4294967296.f);
    return ((unsigned long long)(unsigned)hi << 32) | (unsigned long long)lo; }
__device__ __forceinline__ float fx_dec(unsigned long long v) { return (float)(int)(unsigned)(v >> 32) * 0.0625f + (float)(unsigned)v * 1.4551915228366852e-11f; }
__device__ __forceinline__ void nsa_sparse_far(const LAS unsigned* sSel, LAS int* slist, const LAS float* sBt, const LAS float* mref, LAS unsigned long long* lfar, LAS unsigned long long* ofar,
        const bf16_t* Qg  , const bf16_t* ksb, const bf16_t* vtb  , const int qb, const int wid, const int lane_in, const int fr_in, const int fq_in) {
    const float NEG = -INFINITY;
    bf16x8 kf[4][2], vf[2][4], kn[4][2];
#define NSA_LDK(KF, MB) do { int fr_ = fr_in, fq_ = fq_in; asm volatile("" : "+v"(fr_), "+v"(fq_)); \
        _Pragma("unroll") for (int kt = 0; kt < 4; ++kt) _Pragma("unroll") for (int s = 0; s < 2; ++s) KF[kt][s] = *(const bf16x8*)(ksb + (size_t)(64 * (MB) + 16 * kt + fr_) * 256 + 32 * s + 8 * fq_); } while (0)
#define NSA_LDV(VF, MB) do { int fr_ = fr_in, fq_ = fq_in; asm volatile("" : "+v"(fr_), "+v"(fq_)); \
        _Pragma("unroll") for (int s = 0; s < 2; ++s) _Pragma("unroll") for (int dt = 0; dt < 4; ++dt) { const bf16_t* pv = vtb + (size_t)(16 * dt + fr_) * SEQ + 64 * (MB) + 32 * s + 4 * fq_; \
            const u32x2 lo = *(const u32x2*)pv, hi = *(const u32x2*)(pv + 16); u32x4 w; w.x = lo.x; w.y = lo.y; w.z = hi.x; w.w = hi.y; VF[s][dt] = __builtin_bit_cast(bf16x8, w); } } while (0)
    if (1 + wid <= qb - 3) NSA_LDK(kf, 1 + wid);
#pragma unroll 1
    for (int m = 1 + wid; m <= qb - 3; m += 8) {
        int fr = fr_in, fq = fq_in, lane = lane_in; asm volatile("" : "+v"(fr), "+v"(fq), "+v"(lane));
        const int hg = fr & 3; const float bfar = sBt[hg * 132 + 128];
        const bool more = m + 8 <= qb - 3;
        NSA_LDV(vf, m);
        if (more) NSA_LDK(kn, m + 8);
        const unsigned w = sSel[lane * 4 + (m >> 5)]; const bool bit = (w >> (m & 31)) & 1u;
        const unsigned long long B = __ballot(bit); const int n = __popcll(B);
        const int rank = (int)__builtin_amdgcn_mbcnt_hi((unsigned)(B >> 32), __builtin_amdgcn_mbcnt_lo((unsigned)B, 0u));
        if (bit) slist[rank] = lane;
        asm volatile("s_waitcnt lgkmcnt(0)" ::: "memory");
        const int nct = (n + 3) >> 2;
        bf16x8 q0, q1; int tok = 0; bool valid = false;
        if (nct > 0) { const int idx = fr >> 2; valid = idx < n; tok = slist[valid ? idx : 0];
            q0 = *(const bf16x8*)(Qg + (size_t)tok * 1024 + hg * 64 + 8 * fq); q1 = *(const bf16x8*)(Qg + (size_t)tok * 1024 + hg * 64 + 32 + 8 * fq); }
#pragma unroll 1
        for (int ct = 0; ct < nct; ++ct) {
            const int col = tok * 4 + hg; const bool vcur = valid; const bf16x8 c0 = q0, c1 = q1;
            if (ct + 1 < nct) { const int idx = 4 * (ct + 1) + (fr >> 2); valid = idx < n; tok = slist[valid ? idx : 0];
                q0 = *(const bf16x8*)(Qg + (size_t)tok * 1024 + hg * 64 + 8 * fq); q1 = *(const bf16x8*)(Qg + (size_t)tok * 1024 + hg * 64 + 32 + 8 * fq); }
            const float c = vcur ? bfar - mref[col] : NEG;
            f32x4 sacc[4];
#pragma unroll
            for (int kt = 0; kt < 4; ++kt) sacc[kt] = mfma16(kf[kt][0], c0, (f32x4){0.f, 0.f, 0.f, 0.f});
#pragma unroll
            for (int kt = 0; kt < 4; ++kt) sacc[kt] = mfma16(kf[kt][1], c1, sacc[kt]);
            float ps = 0.f;
#pragma unroll
            for (int kt = 0; kt < 4; ++kt)
#pragma unroll
                for (int j = 0; j < 4; ++j) { const float p = fminf(fast_exp2(sacc[kt][j] * LOG2E + c), 16384.f); sacc[kt][j] = p; ps += p; }
            ps = xsum16_32(ps);
            if (fq == 0 && vcur) (void)__hip_atomic_fetch_add(lfar + col, fx_enc(ps), __ATOMIC_RELAXED, __HIP_MEMORY_SCOPE_WORKGROUP);
            f32x4 oacc[4] = {(f32x4){0.f, 0.f, 0.f, 0.f}, (f32x4){0.f, 0.f, 0.f, 0.f}, (f32x4){0.f, 0.f, 0.f, 0.f}, (f32x4){0.f, 0.f, 0.f, 0.f}};
#pragma unroll
            for (int s = 0; s < 2; ++s) { u32x4 pw; pw.x = pk2(sacc[2 * s][0], sacc[2 * s][1]); pw.y = pk2(sacc[2 * s][2], sacc[2 * s][3]); pw.z = pk2(sacc[2 * s + 1][0], sacc[2 * s + 1][1]); pw.w = pk2(sacc[2 * s + 1][2], sacc[2 * s + 1][3]);
                const bf16x8 pf = __builtin_bit_cast(bf16x8, pw);
#pragma unroll
                for (int dt = 0; dt < 4; ++dt) oacc[dt] = mfma16(vf[s][dt], pf, oacc[dt]); }
            if (vcur) {
#pragma unroll
                for (int dt = 0; dt < 4; ++dt)
#pragma unroll
                    for (int j = 0; j < 4; ++j) (void)__hip_atomic_fetch_add(ofar + col * 66 + 16 * dt + 4 * fq + j, fx_enc(oacc[dt][j]), __ATOMIC_RELAXED, __HIP_MEMORY_SCOPE_WORKGROUP); }
        }
        asm volatile("s_waitcnt lgkmcnt(0)" ::: "memory");
        if (more) {
#pragma unroll
            for (int kt = 0; kt < 4; ++kt) { kf[kt][0] = kn[kt][0]; kf[kt][1] = kn[kt][1]; } }
    }
#undef NSA_LDK
#undef NSA_LDV
}

#ifndef NSA_SPARSE_QB
#define NSA_SPARSE_QB 24
#endif
__device__ __forceinline__ void nsa_attn_phase(LAS unsigned char* lds, const bf16_t* Q, const bf16_t* KV, const float* GT, const bf16_t* KC, const bf16_t* VC, const float* __restrict__ rel_bias, bf16_t* Y, const bf16_t* VT, void* TQ, const int tid, const int bid, const int G) {
    const int lane = tid & 63, wid = __builtin_amdgcn_readfirstlane(tid >> 6), fr = lane & 15, fq = lane >> 4, q4 = (lane & 15) >> 2, p4 = lane & 3, hg = fr & 3;
    constexpr int SKO = 0, SVO = 36864, SMAIN = 73728, SSPILL = 106496, SBT = 143360, SSEL = 145472, SMREF = 146496, SLFAR = 147520, SLIST = 149568, TB = 9216;
    LAS float* sMain = (LAS float*)(lds + SMAIN); LAS float* sSpill = (LAS float*)(lds + SSPILL); LAS float* sBt = (LAS float*)(lds + SBT); LAS unsigned* sSel = (LAS unsigned*)(lds + SSEL);
    LAS float* sMref = (LAS float*)(lds + SMREF); LAS unsigned long long* sLfar = (LAS unsigned long long*)(lds + SLFAR); LAS unsigned long long* sOfar = (LAS unsigned long long*)lds;
    const float NEG = -INFINITY; (void)TQ;
    for (int ui = 0; ; ++ui) {
        int bg, qb;
        if (G == 256) { if (ui >= 4) break; const int c = bid, s = c >> 3; bg = c & 7; qb = ui == 0 ? s : ui == 1 ? 63 - s : ui == 2 ? 64 + s : 127 - s; }
        else { const int uu = bid + ui * G; if (uu >= 1024) break; bg = uu >> 7; qb = uu & 127; }
        const int b = bg >> 2, g = bg & 3, t0 = 64 * qb, m0 = b * SEQ + t0;
        int tokl[2]; tokl[0] = 8 * wid + (fr >> 2); tokl[1] = tokl[0] + 4;
        bf16x8 qf[2][2];
#pragma unroll
        for (int ct = 0; ct < 2; ++ct)
#pragma unroll
            for (int s = 0; s < 2; ++s) qf[ct][s] = *(const bf16x8*)(Q + (size_t)(m0 + tokl[ct]) * 1024 + (g * 4 + hg) * 64 + 32 * s + 8 * fq);
        int tidz = tid; asm volatile("" : "+v"(tidz));
        for (int i = tidz; i < 4 * 129; i += 512) { const int h = i / 129, dist = i - h * 129; int bk;
            if (dist < 16) bk = dist; else { bk = 16 + (int)(logf((float)dist * (1.f / 16.f)) / 2.0794415416798357f * 16.f); bk = bk > 31 ? 31 : bk; }
            sBt[h * 132 + dist] = rel_bias[bk * 16 + g * 4 + h] * LOG2E; }
#pragma unroll
        for (int i = 0; i < 4; ++i) { *(LAS f32x4*)(lds + SMAIN + (tidz + 512 * i) * 16) = (f32x4){0.f, 0.f, 0.f, 0.f}; *(LAS f32x4*)(lds + SSPILL + (tidz + 512 * i) * 16) = (f32x4){0.f, 0.f, 0.f, 0.f}; }
        __syncthreads();
        const LAS float* bt = sBt + hg * 132; const float bfar = bt[128];
        const float* gtp = GT + (size_t)(m0 + tokl[0]) * 48 + (g * 4 + hg) * 3;
        LAS f32x4* totp = (LAS f32x4*)(lds + SMAIN + wid * 4096) + lane;
        bf16_t* yp = Y + (size_t)(m0 + tokl[0]) * 1024 + (g * 4 + hg) * 64 + 4 * fq;
        NsaSt st[2]; bool act[2] = {true, true}; bool colsel[2] = {true, true}; int dbase[2]; float minv[2] = {1.f, 1.f};
        KVRegs kvr; kvr.k[1] = (u32x4){0u, 0u, 0u, 0u}; kvr.v[1] = (u32x4){0u, 0u, 0u, 0u};
        int mg0 = 0; bool general = true;
#define NSA_RUN(MODE, STEP, NT, TM, KB, VB, TS, LD, SETUP) do { const int nt_ = (NT), nst_ = (nt_ + 1) >> 1; \
        { const int ti = 0; const int j0_ = (TM); const int ti1_ = 1; int j1_ = 0; { const int ti = ti1_; j1_ = (TM); } (void)ti; \
          nsa_ld2((KB) + (size_t)j0_ * (TS), (VB) + (size_t)j0_ * (TS), (size_t)(j1_ - j0_) * (TS), (LD), nt_ >= 2, tid, kvr); } \
        nsa_st2(lds + SKO, lds + SVO, tid, kvr); __syncthreads(); \
        _Pragma("unroll 1") for (int s_ = 0; s_ < nst_; ++s_) { const int sb_ = s_ & 1; \
            if (s_ + 1 < nst_) { int ja_ = 0, jb_ = 0; { const int ti = 2 * s_ + 2; ja_ = (TM); } { const int ti = 2 * s_ + 3; jb_ = (TM); } \
                nsa_ld2((KB) + (size_t)ja_ * (TS), (VB) + (size_t)ja_ * (TS), (size_t)(jb_ - ja_) * (TS), (LD), 2 * s_ + 3 < nt_, tid, kvr); } \
            _Pragma("unroll") for (int h_ = 0; h_ < 2; ++h_) { const int ti = 2 * s_ + h_; if (ti < nt_) { SETUP; \
                const LAS unsigned char* sk_ = lds + SKO + (sb_ * 2 + h_) * TB; const LAS unsigned char* sv_ = lds + SVO + (sb_ * 2 + h_) * TB; \
                if (MODE != 2 || (act[0] && act[1])) nsa_tile<MODE, STEP, 3>(sk_, sv_, qf, st, dbase, general, colsel, bt, bfar, minv, sMain, sSpill, tokl, mg0, fr, fq, q4, p4); \
                else if (act[0]) nsa_tile<MODE, STEP, 1>(sk_, sv_, qf, st, dbase, general, colsel, bt, bfar, minv, sMain, sSpill, tokl, mg0, fr, fq, q4, p4); \
                else if (act[1]) nsa_tile<MODE, STEP, 2>(sk_, sv_, qf, st, dbase, general, colsel, bt, bfar, minv, sMain, sSpill, tokl, mg0, fr, fq, q4, p4); } } \
            if (s_ + 1 < nst_) nsa_st2(lds + SKO + ((sb_ ^ 1) * 2) * TB, lds + SVO + ((sb_ ^ 1) * 2) * TB, tid, kvr); \
            __syncthreads(); } } while (0)
#define NSA_RESET() do { _Pragma("unroll") for (int ct = 0; ct < 2; ++ct) { st[ct].m = NEG; st[ct].l = 0.f; _Pragma("unroll") for (int dt = 0; dt < 4; ++dt) st[ct].o[dt] = (f32x4){0.f, 0.f, 0.f, 0.f}; } } while (0)
        const int ncmp = 4 * qb + 3, nct = (ncmp + 63) >> 6;
        const bf16_t* kcb = KC + (size_t)bg * 512 * 64; const bf16_t* vcb = VC + (size_t)bg * 512 * 64;
        NSA_RESET();
        NSA_RUN(0, 16, nct, ti, kcb, vcb, (size_t)4096, 64, { dbase[0] = t0 + tokl[0] - 31 - 1024 * ti; dbase[1] = dbase[0] + 4; mg0 = 16 * ti; general = t0 - 31 - 1024 * ti - 1008 < 128; });
#pragma unroll
        for (int ct = 0; ct < 2; ++ct) { const float lt = xsum16_32(st[ct].l); minv[ct] = fast_rcp(lt > 0.f ? lt : 1.f); if (st[ct].m == NEG) st[ct].m = 0.f; }
        NSA_RUN(1, 16, nct, ti, kcb, vcb, (size_t)4096, 64, { dbase[0] = t0 + tokl[0] - 31 - 1024 * ti; dbase[1] = dbase[0] + 4; mg0 = 16 * ti; general = t0 - 31 - 1024 * ti - 1008 < 128; });
        LAS f32x4* park = (LAS f32x4*)(lds + SKO + wid * 8192) + lane;
#pragma unroll
        for (int ct = 0; ct < 2; ++ct) { const float gt0 = gtp[ct * 4 * 48];
#pragma unroll
            for (int dt = 0; dt < 4; ++dt) park[(ct * 4 + dt) * 64] = st[ct].o[dt] * gt0; }
        unsigned msk[2][4];
        if (qb <= 15) {
#pragma unroll
            for (int ct = 0; ct < 2; ++ct) { msk[ct][0] = (2u << qb) - 1u; msk[ct][1] = 0u; msk[ct][2] = 0u; msk[ct][3] = 0u; }
        } else {
            const int tl = lane >> 3, sub = lane & 7, tok = 8 * wid + tl;
            unsigned key[16];
#pragma unroll
            for (int i = 0; i < 4; ++i) { const f32x4 a = *(const LAS f32x4*)(sMain + tok * 128 + 16 * sub + 4 * i), s4 = *(const LAS f32x4*)(sSpill + tok * 128 + 16 * sub + 4 * i);
#pragma unroll
                for (int j = 0; j < 4; ++j) { const int m = 16 * sub + 4 * i + j; const float imp = a[j] + s4[j];
                    key[4 * i + j] = (m >= 1 && m <= qb - 2) ? ((__float_as_uint(imp) & ~127u) | (unsigned)(127 - m)) : 0u; } }
            unsigned selb = 0u;
#pragma unroll 1
            for (int it = 0; it < 13; ++it) { unsigned mx = key[0];
#pragma unroll
                for (int i = 1; i < 16; ++i) mx = key[i] > mx ? key[i] : mx;
                { unsigned o = (unsigned)__builtin_amdgcn_update_dpp(0, (int)mx, 0xB1, 0xF, 0xF, true); mx = o > mx ? o : mx; o = (unsigned)__builtin_amdgcn_update_dpp(0, (int)mx, 0x4E, 0xF, 0xF, true); mx = o > mx ? o : mx;
                  o = (unsigned)__builtin_amdgcn_update_dpp(0, (int)mx, 0x141, 0xF, 0xF, true); mx = o > mx ? o : mx; }
#pragma unroll
                for (int i = 0; i < 16; ++i) if (key[i] == mx) { selb |= 1u << i; key[i] = 0u; } }
            { const int f0 = 0, f1 = qb, f2 = qb - 1;
              if ((f0 >> 4) == sub) selb |= 1u << (f0 & 15); if ((f1 >> 4) == sub) selb |= 1u << (f1 & 15); if ((f2 >> 4) == sub) selb |= 1u << (f2 & 15); }
            const unsigned oth = (unsigned)__builtin_amdgcn_update_dpp(0, (int)selb, 0xB1, 0xF, 0xF, true);
            if ((sub & 1) == 0) sSel[tok * 4 + (sub >> 1)] = selb | (oth << 16);
            asm volatile("s_waitcnt lgkmcnt(0)" ::: "memory");
#pragma unroll
            for (int ct = 0; ct < 2; ++ct) { const u32x4 w = *(const LAS u32x4*)(sSel + tokl[ct] * 4); msk[ct][0] = w.x; msk[ct][1] = w.y; msk[ct][2] = w.z; msk[ct][3] = w.w; }
        }
#pragma unroll
        for (int ct = 0; ct < 2; ++ct)
#pragma unroll
            for (int dt = 0; dt < 4; ++dt) totp[ct * (SSPILL - SMAIN) / 16 + 64 * dt] = park[(ct * 4 + dt) * 64];
        __syncthreads();
        { const bf16_t* ksb = KV + (size_t)2 * T_ * 256 + (size_t)(b * SEQ) * 256 + g * 64; const bf16_t* vsb = KV + (size_t)3 * T_ * 256 + (size_t)(b * SEQ) * 256 + g * 64;
          const bool sparse = qb >= NSA_SPARSE_QB;
          NSA_RESET();
#define NSA_SEL_SETUP(MB) { const int mblk = (MB); const int mw = mblk >> 5; const int mb = mblk & 31; \
              _Pragma("unroll") for (int ct = 0; ct < 2; ++ct) { const unsigned w = mw == 0 ? msk[ct][0] : mw == 1 ? msk[ct][1] : mw == 2 ? msk[ct][2] : msk[ct][3]; colsel[ct] = (w >> mb) & 1u; act[ct] = __any(colsel[ct]); } \
              dbase[0] = t0 + tokl[0] - 64 * mblk; dbase[1] = dbase[0] + 4; general = mblk + 2 >= qb; }
          if (!sparse) {
              NSA_RUN(2, 1, qb + 1, ti, ksb, vsb, (size_t)64 * 256, 256, NSA_SEL_SETUP(ti));
          } else {
              NSA_RUN(2, 1, 4, (ti == 0 ? 0 : qb - 3 + ti), ksb, vsb, (size_t)64 * 256, 256, NSA_SEL_SETUP(ti == 0 ? 0 : qb - 3 + ti));
              u32x2 toth[2][4];
#pragma unroll
              for (int ct = 0; ct < 2; ++ct)
#pragma unroll
                  for (int dt = 0; dt < 4; ++dt) { const f32x4 v = totp[ct * (SSPILL - SMAIN) / 16 + 64 * dt]; toth[ct][dt].x = pk2(v[0], v[1]); toth[ct][dt].y = pk2(v[2], v[3]); }
              __syncthreads();
#pragma unroll
              for (int ct = 0; ct < 2; ++ct) { const int col = tokl[ct] * 4 + hg; const float lt = xsum16_32(st[ct].l);
                  if (fq == 0) { sMref[col] = st[ct].m; sLfar[col] = fx_enc(lt); }
#pragma unroll
                  for (int dt = 0; dt < 4; ++dt)
#pragma unroll
                      for (int j = 0; j < 4; ++j) sOfar[col * 66 + 16 * dt + 4 * fq + j] = fx_enc(st[ct].o[dt][j]); }
              __syncthreads();
              nsa_sparse_far(sSel, (LAS int*)(lds + SLIST) + wid * 64, sBt, sMref, sLfar, sOfar, Q + (size_t)m0 * 1024 + g * 256, ksb, VT + (size_t)bg * 64 * SEQ, qb, wid, lane, fr, fq);
              __syncthreads();
#pragma unroll
              for (int ct = 0; ct < 2; ++ct) { const int col = tokl[ct] * 4 + hg; st[ct].l = fq == 0 ? fx_dec(sLfar[col]) : 0.f;
#pragma unroll
                  for (int dt = 0; dt < 4; ++dt)
#pragma unroll
                      for (int j = 0; j < 4; ++j) st[ct].o[dt][j] = fx_dec(sOfar[col * 66 + 16 * dt + 4 * fq + j]); }
              __syncthreads();
#pragma unroll
              for (int ct = 0; ct < 2; ++ct)
#pragma unroll
                  for (int dt = 0; dt < 4; ++dt) totp[ct * (SSPILL - SMAIN) / 16 + 64 * dt] = (f32x4){bflo(toth[ct][dt].x), bfhi(toth[ct][dt].x), bflo(toth[ct][dt].y), bfhi(toth[ct][dt].y)};
#pragma unroll
              for (int ct = 0; ct < 2; ++ct)
#pragma unroll
                  for (int s = 0; s < 2; ++s) qf[ct][s] = *(const bf16x8*)(Q + (size_t)(m0 + tokl[ct]) * 1024 + (g * 4 + hg) * 64 + 32 * s + 8 * fq);
          }
#undef NSA_SEL_SETUP
#pragma unroll
          for (int ct = 0; ct < 2; ++ct) { const float lt = xsum16_32(st[ct].l), sc = gtp[ct * 4 * 48 + 1] * fast_rcp(lt > 0.f ? lt : 1.f);
#pragma unroll
              for (int dt = 0; dt < 4; ++dt) totp[ct * (SSPILL - SMAIN) / 16 + 64 * dt] += st[ct].o[dt] * sc; } }
        { const bf16_t* kwb = KV + (size_t)4 * T_ * 256 + (size_t)(b * SEQ) * 256 + g * 64; const bf16_t* vwb = KV + (size_t)5 * T_ * 256 + (size_t)(b * SEQ) * 256 + g * 64;
          NSA_RESET(); act[0] = true; act[1] = true; colsel[0] = true; colsel[1] = true;
          const int j0 = qb >= 8 ? 0 : 8 - qb;
          NSA_RUN(3, 1, 9 - j0, ti, kwb + (size_t)(t0 - 512 + 64 * j0) * 256, vwb + (size_t)(t0 - 512 + 64 * j0) * 256, (size_t)64 * 256, 256, { const int j = j0 + ti;
              dbase[0] = tokl[0] + 512 - 64 * j; dbase[1] = dbase[0] + 4; general = (j == 0) || (j >= 6); });
#pragma unroll
          for (int ct = 0; ct < 2; ++ct) { const float lt = xsum16_32(st[ct].l), sc = gtp[ct * 4 * 48 + 2] * fast_rcp(lt > 0.f ? lt : 1.f);
#pragma unroll
              for (int dt = 0; dt < 4; ++dt) { const f32x4 v = totp[ct * (SSPILL - SMAIN) / 16 + 64 * dt] + st[ct].o[dt] * sc;
                  u32x2 w; w.x = pk2(v[0], v[1]); w.y = pk2(v[2], v[3]); *(u32x2*)(yp + ct * 4096 + 16 * dt) = w; } } }
        __syncthreads();
#undef NSA_RESET
#undef NSA_RUN
    }
}
#ifndef ALL_XCD_BAR
#define ALL_XCD_BAR 1
#endif
#ifndef USE_XCD_BAR
#define USE_XCD_BAR 1
#endif
#ifndef EN_ALL
#define EN_ALL 1
#endif
#ifndef EN_LRUG
#define EN_LRUG EN_ALL
#endif
#ifndef EN_LRUA
#define EN_LRUA EN_ALL
#endif
#ifndef EN_NSAC
#define EN_NSAC EN_ALL
#endif
#ifndef EN_NSAA
#define EN_NSAA EN_ALL
#endif
#ifndef EN_GLAK
#define EN_GLAK EN_ALL
#endif
#ifndef EN_GLAS
#define EN_GLAS EN_ALL
#endif
#ifndef EN_GLAO
#define EN_GLAO EN_ALL
#endif
#ifndef EN_G_LRUIN
#define EN_G_LRUIN EN_ALL
#endif
#ifndef EN_G_RESID
#define EN_G_RESID EN_ALL
#endif
#ifndef EN_G_NSAIN
#define EN_G_NSAIN EN_ALL
#endif
#ifndef EN_G_GLAIN
#define EN_G_GLAIN EN_ALL
#endif
#ifndef EN_G_GU
#define EN_G_GU EN_ALL
#endif
#ifndef EN_PREP
#define EN_PREP EN_ALL
#endif
struct Args {
    const float* x; const float* rel_bias; const float* final_norm; const float* mix_norm; const float* ffn_norm;
    const float* ffn_w_gate; const float* ffn_w_up; const float* ffn_w_down;
    const float* lru_w_in; const float* lru_conv_w; const float* lru_conv_b; const float* lru_w_a; const float* lru_b_a; const float* lru_w_x; const float* lru_b_x; const float* lru_lam; const float* lru_w_out;
    const float* nsa_w_in; const float* nsa_cmp_pos; const float* nsa_cmp_w1; const float* nsa_cmp_b1; const float* nsa_cmp_w2; const float* nsa_cmp_b2; const float* nsa_w_out;
    const float* gla_w_in; const float* gla_w_g2; const float* gla_b_g2; const float* gla_norm; const float* gla_w_out;
    float* out; unsigned char* ws; int ph_lo, ph_hi, dry, pad_;
};

#define XB_TMO      128
#define XB_XCNT(j)  (256  + 64 * (j))
#define XB_XSUB(j)  (1280 + 64 * (j))
#define XB_XGEN(j)  (2304 + 64 * (j))
#define XB_TOP      3328
#define XB_TOPGEN   3392
#define XCD_BAR_WORDS 3456
#define XB_SPIN_CAP (1u << 18)

__device__ __forceinline__ unsigned xb_ld(unsigned* p)              { return __hip_atomic_load(p, __ATOMIC_RELAXED, __HIP_MEMORY_SCOPE_AGENT); }
__device__ __forceinline__ unsigned xb_add(unsigned* p, unsigned v) { return __hip_atomic_fetch_add(p, v, __ATOMIC_RELAXED, __HIP_MEMORY_SCOPE_AGENT); }
__device__ __forceinline__ unsigned xb_xcc_id() { return (unsigned)__builtin_amdgcn_s_getreg((3 << 11) | 20) & 0xFu; }
#define XB_SPIN(cond, bar) do { unsigned _sp = 0; while (cond) { __builtin_amdgcn_s_sleep(1); \
    if ((++_sp & 255u) == 0u) { if (xb_ld(&(bar)[XB_TMO])) break; if (_sp > XB_SPIN_CAP) { atomicAdd(&(bar)[XB_TMO], 1u); break; } } } } while (0)

struct XcdBarrier {
    unsigned* bar; unsigned x;
    volatile LAS unsigned* st;
};

__device__ __forceinline__ XcdBarrier xcd_barrier_post(unsigned* bar, volatile LAS unsigned* st) {
    XcdBarrier b; b.bar = bar; b.x = xb_xcc_id(); b.st = st;
    if (threadIdx.x == 0) (void)xb_add(&bar[XB_XCNT(b.x)], 1u);
    return b;
}
__device__ __forceinline__ void xcd_barrier_complete(unsigned* bar, unsigned x, unsigned& nloc, unsigned& nx) {
    const unsigned G = gridDim.x * gridDim.y * gridDim.z;
    unsigned sum, cnt, mine, sp = 0u;
    for (;;) {
        sum = 0u; cnt = 0u; mine = 0u;
#pragma unroll
        for (unsigned j = 0; j < 16; ++j) { const unsigned c = xb_ld(&bar[XB_XCNT(j)]); sum += c; cnt += (c > 0u) ? 1u : 0u; mine = (j == x) ? c : mine; }
        if (sum == G) break;
        __builtin_amdgcn_s_sleep(1);
        if ((++sp & 255u) == 0u) { if (xb_ld(&bar[XB_TMO])) break; if (sp > XB_SPIN_CAP) { atomicAdd(&bar[XB_TMO], 1u); break; } }
    }
    nloc = mine > 0u ? mine : 1u; nx = cnt > 0u ? cnt : 1u;
}

__device__ __forceinline__ void xcd_barrier(const XcdBarrier& b) {
    asm volatile("s_waitcnt vmcnt(0)" ::: "memory");
    __syncthreads();
    if (threadIdx.x == 0) {
        unsigned* bar = b.bar;
        __builtin_amdgcn_s_waitcnt(0);
        unsigned nloc = b.st[0], nx = b.st[1];
        if (nloc == 0u) { xcd_barrier_complete(bar, b.x, nloc, nx); b.st[0] = nloc; b.st[1] = nx; }
        const unsigned old = xb_add(&bar[XB_XSUB(b.x)], 1u);
        const unsigned gen = old / nloc;
        if (old + 1u == (gen + 1u) * nloc) {
            __builtin_amdgcn_fence(__ATOMIC_RELEASE, "agent");
            asm volatile("s_waitcnt vmcnt(0)" ::: "memory");
            const unsigned og = xb_add(&bar[XB_TOP], 1u);
            const unsigned tg = og / nx;
            if (og + 1u == (tg + 1u) * nx) xb_add(&bar[XB_TOPGEN], 1u);
            else XB_SPIN(xb_ld(&bar[XB_TOPGEN]) == tg, bar);
            __builtin_amdgcn_fence(__ATOMIC_ACQUIRE, "agent");
            xb_add(&bar[XB_XGEN(b.x)], 1u);
            asm volatile("s_waitcnt vmcnt(0)" ::: "memory");
        } else {
            XB_SPIN(xb_ld(&bar[XB_XGEN(b.x)]) == gen, bar);
            __builtin_amdgcn_fence(__ATOMIC_ACQUIRE, "agent");
            asm volatile("s_waitcnt vmcnt(0)" ::: "memory");
        }
    }
    __syncthreads();
}

__global__ void __launch_bounds__(512, 2) mega_fwd(Args a) {
    extern __shared__ __attribute__((aligned(16))) unsigned char lds_raw[];
    LAS unsigned char* lds = (LAS unsigned char*)lds_raw;
    cg::grid_group grid = cg::this_grid();
    const int tid0 = threadIdx.x; const int wid0 = __builtin_amdgcn_readfirstlane(tid0 >> 6);
    constexpr int PTR_OFF = LDS_BYTES - 512;
    if (tid0 == 0) { LAS unsigned long long* tb = (LAS unsigned long long*)(lds + PTR_OFF);
        tb[0] = (unsigned long long)a.x;
        tb[1] = (unsigned long long)a.rel_bias;
        tb[2] = (unsigned long long)a.final_norm;
        tb[3] = (unsigned long long)a.mix_norm;
        tb[4] = (unsigned long long)a.ffn_norm;
        tb[5] = (unsigned long long)a.ffn_w_gate;
        tb[6] = (unsigned long long)a.ffn_w_up;
        tb[7] = (unsigned long long)a.ffn_w_down;
        tb[8] = (unsigned long long)a.lru_w_in;
        tb[9] = (unsigned long long)a.lru_conv_w;
        tb[10] = (unsigned long long)a.lru_conv_b;
        tb[11] = (unsigned long long)a.lru_w_a;
        tb[12] = (unsigned long long)a.lru_b_a;
        tb[13] = (unsigned long long)a.lru_w_x;
        tb[14] = (unsigned long long)a.lru_b_x;
        tb[15] = (unsigned long long)a.lru_lam;
        tb[16] = (unsigned long long)a.lru_w_out;
        tb[17] = (unsigned long long)a.nsa_w_in;
        tb[18] = (unsigned long long)a.nsa_cmp_pos;
        tb[19] = (unsigned long long)a.nsa_cmp_w1;
        tb[20] = (unsigned long long)a.nsa_cmp_b1;
        tb[21] = (unsigned long long)a.nsa_cmp_w2;
        tb[22] = (unsigned long long)a.nsa_cmp_b2;
        tb[23] = (unsigned long long)a.nsa_w_out;
        tb[24] = (unsigned long long)a.gla_w_in;
        tb[25] = (unsigned long long)a.gla_w_g2;
        tb[26] = (unsigned long long)a.gla_b_g2;
        tb[27] = (unsigned long long)a.gla_norm;
        tb[28] = (unsigned long long)a.gla_w_out;
        tb[29] = (unsigned long long)a.out;
        tb[30] = (unsigned long long)a.ws;
    }
    if (tid0 < 4) ((LAS unsigned*)(lds + PTR_OFF + 256))[tid0] = 0u;
    __syncthreads();
    if (a.ph_lo > 1000000) grid.sync();
    XcdBarrier xbar = xcd_barrier_post((unsigned*)(a.ws + WS_CTL), (volatile LAS unsigned*)(lds + PTR_OFF + 256));
#define PRAW(i) ((((unsigned long long)(unsigned)__builtin_amdgcn_readfirstlane((int)((const LAS unsigned*)(lds + PTR_OFF))[2 * (i) + 1])) << 32) | (unsigned long long)(unsigned)__builtin_amdgcn_readfirstlane((int)((const LAS unsigned*)(lds + PTR_OFF))[2 * (i)]))
#define GAS_ __attribute__((address_space(1)))
#define PF(i) ((const float*)(const GAS_ float*)PRAW(i))
#define P_OUT ((float*)(GAS_ float*)PRAW(29))
#define WSP(off) ((unsigned char*)((GAS_ unsigned char*)PRAW(30) + (off)))
#define W_GU ((bf16_t*)WSP(WS_W_GU))
#define W_DN ((bf16_t*)WSP(WS_W_DN))
#define W_MIN ((bf16_t*)WSP(WS_W_MIN))
#define W_MOUT ((bf16_t*)WSP(WS_W_MOUT))
#define W_SM ((bf16_t*)WSP(WS_W_SMALL))
#define HN ((bf16_t*)WSP(WS_HN))
#define ACT ((bf16_t*)WSP(WS_ACT))
#define LG ((bf16_t*)WSP(WS_LG))
#define LX ((bf16_t*)WSP(WS_LX))
#define LHL ((bf16_t*)WSP(WS_LHL))
#define LAC ((bf16_t*)WSP(WS_LAC))
#define AGGA ((float*)WSP(WS_LAGGA))
#define AGGH ((float*)WSP(WS_LAGGH))
#define NQ ((bf16_t*)WSP(WS_NQ))
#define NKV ((bf16_t*)WSP(WS_NKV))
#define NGT ((float*)WSP(WS_NGT))
#define NKC ((bf16_t*)WSP(WS_NKC))
#define NVC ((bf16_t*)WSP(WS_NVC))
#define GQ ((bf16_t*)WSP(WS_GQ))
#define GK ((bf16_t*)WSP(WS_GK))
#define GV ((bf16_t*)WSP(WS_GV))
#define GR ((bf16_t*)WSP(WS_GR))
#define GGL ((float*)WSP(WS_GGL))
#define GDEC ((float*)WSP(WS_GDEC))
#define GKVT ((bf16_t*)WSP(WS_GKVT))
#define SSP ((float*)WSP(WS_SSP))
#define NY ((bf16_t*)WSP(WS_NY))
#define NVT ((bf16_t*)WSP(WS_NVT))

    enum { OP_PREP, OP_G_LRUIN, OP_LRU_GATES, OP_LRU_APPLY, OP_G_RESID, OP_G_NSAIN, OP_NSA_CMP, OP_NSA_ATTN, OP_G_GLAIN, OP_GLA_KV, OP_GLA_SCAN, OP_GLA_OUT, OP_NORM2, OP_G_GU, OP_FINAL };
#pragma unroll 1
    for (int ph = a.ph_lo; ph < a.ph_hi; ++ph) {
        int layer, r;
        if (ph < 7) { layer = 0; r = ph; } else if (ph < 13) { layer = 1; r = ph - 6; } else if (ph < 20) { layer = 2; r = ph - 12; } else if (ph < 26) { layer = 3; r = ph - 19; } else { layer = 4; r = 0; }
        const int kind = layer % 3, jj = layer / 3, nmix = kind == 2 ? 5 : 4;
        int wid_s = wid0, bid = blockIdx.x, G = gridDim.x;
        asm volatile("" : "+s"(wid_s) :: "memory"); asm volatile("" : "+s"(bid)); asm volatile("" : "+s"(G));
        int lane_v; asm volatile("v_mbcnt_lo_u32_b32 %0, -1, 0\n\tv_mbcnt_hi_u32_b32 %0, -1, %0" : "=v"(lane_v));
        const int tid = (wid_s << 6) | lane_v;
        const int lane = tid & 63, wid = __builtin_amdgcn_readfirstlane(tid >> 6), gw = bid * 8 + wid, NGW = G * 8;
        LAS float* scr = (LAS float*)(lds + wid * 8448);
        const float* hsrc = layer == 0 ? PF(0) : P_OUT;
        int op;
        if (layer == 4) op = OP_FINAL;
        else if (r == 0) op = OP_PREP;
        else if (r <= nmix) { const int q = r - 1;
            if (kind == 0) op = q == 0 ? OP_G_LRUIN : q == 1 ? OP_LRU_GATES : q == 2 ? OP_LRU_APPLY : OP_G_RESID;
            else if (kind == 1) op = q == 0 ? OP_G_NSAIN : q == 1 ? OP_NSA_CMP : q == 2 ? OP_NSA_ATTN : OP_G_RESID;
            else op = q == 0 ? OP_G_GLAIN : q == 1 ? OP_GLA_KV : q == 2 ? OP_GLA_SCAN : q == 3 ? OP_GLA_OUT : OP_G_RESID; }
        else { const int q = r - nmix - 1; op = q == 0 ? OP_G_GU : OP_G_RESID; }
        const bool is_down = (r == nmix + 2);
#ifdef PHASE_PROBE
        if (bid == 0 && tid == 0) { unsigned long long* ts = (unsigned long long*)WSP(WS_TQ + 4096); ts[ph] = __builtin_amdgcn_s_memrealtime(); ((int*)WSP(WS_TQ + 8192))[ph] = op; }
#endif
        switch (op) {
        case OP_PREP: if (EN_PREP) { init_stream_bf16(PF(0), HN, SSP, gw, NGW, lane); nsa_b1eff(PF(18), PF(19), PF(20), (float*)WSP(WS_B1E), gw, NGW, lane); }
            break;
        case OP_G_LRUIN: if (EN_G_LRUIN) { pg8::Gemm g{HN, W_MIN, T_, 2 * RNN, D_}; pg8::StaticOrder S; S.init(T_, 2 * RNN, G, bid); pg8::EpiLruIn E{LG, LX, SSP};
            pg8::gemm_phase<pg8::EpiLruIn, pg8::StaticOrder, true, true>(lds, g, S, E, tid); }
            break;
        case OP_LRU_GATES: if (EN_LRUG) lru_gates_phase(lds, LX, PF(9) + jj * 4 * RNN, PF(10) + jj * RNN, W_SM, W_SM + 163840, PF(12) + jj * RNN, PF(14) + jj * RNN, PF(15) + jj * RNN, LHL, LAC, AGGA, AGGH, tid, bid, G);
            break;
        case OP_LRU_APPLY: if (EN_LRUA) lru_apply_phase(LG, a.dry ? (bf16_t*)WSP(190 * MiB) : LG, LHL, LAC, AGGA, AGGH, tid, bid, G);
            break;
        case OP_G_RESID: if (EN_G_RESID) {
            const bf16_t* A = is_down ? ACT : (kind == 0 ? LG : kind == 1 ? NY : GV); const bf16_t* Bt = is_down ? W_DN : W_MOUT; const int K = is_down ? FF : (kind == 0 ? RNN : D_);
            pg8::Gemm g{A, Bt, T_, D_, K}; pg8::StaticOrder S; S.init(T_, D_, G, bid); pg8::EpiResid E{HN, a.dry ? (bf16_t*)WSP(190 * MiB) : HN, SSP, (LAS float*)(lds + 131072)};
            pg8::gemm_phase<pg8::EpiResid, pg8::StaticOrder, true, true>(lds, g, S, E, tid); }
            break;
        case OP_G_NSAIN: if (EN_G_NSAIN) { pg8::Gemm g{HN, W_MIN, T_, NSA_NPAD, D_}; pg8::StaticOrder S; S.init(T_, NSA_NPAD, G, bid); pg8::EpiNsaIn E{NQ, NKV, NGT, SSP};
            pg8::gemm_phase<pg8::EpiNsaIn, pg8::StaticOrder, true, true>(lds, g, S, E, tid); }
            break;
        case OP_NSA_CMP: if (EN_NSAC) nsa_compress_phase(lds, NKV, PF(18), PF(19), PF(20), PF(22), W_SM, W_SM + 262144, NKC, NVC, NVT, (const float*)WSP(WS_B1E), tid, bid, G);
            break;
        case OP_NSA_ATTN: if (EN_NSAA) nsa_attn_phase(lds, NQ, NKV, NGT, NKC, NVC, PF(1), NY, NVT, (void*)WSP(WS_TQ), tid, bid, G);
            break;
        case OP_G_GLAIN: if (EN_G_GLAIN) { pg8::Gemm g{HN, W_MIN, T_, GLA_NPAD, D_}; pg8::StaticOrder S; S.init(T_, GLA_NPAD, G, bid); pg8::EpiGlaIn E{GQ, GK, GV, GR, GGL, SSP};
            pg8::gemm_phase<pg8::EpiGlaIn, pg8::StaticOrder, true, true>(lds, g, S, E, tid); }
            break;
        case OP_GLA_KV: if (EN_GLAK) gla_kv_phase(lds, GK, GV, GGL, PF(25), PF(26), GKVT, GDEC, tid, bid, G);
            break;
        case OP_GLA_SCAN: if (EN_GLAS) gla_scan_phase(GKVT, GDEC, a.dry != 0, tid, bid, G);
            break;
        case OP_GLA_OUT: if (EN_GLAO) gla_out_phase(lds, GQ, GK, GV, GR, GGL, PF(25), PF(26), PF(27), GKVT, a.dry ? (bf16_t*)WSP(190 * MiB) : GV, tid, bid, G);
            break;
        case OP_G_GU: if (EN_G_GU) { pg8::Gemm g{HN, W_GU, T_, 2 * FF, D_}; pg8::StaticOrder S; S.init(T_, 2 * FF, G, bid); pg8::EpiSwiglu E{ACT, SSP};
            pg8::gemm_phase<pg8::EpiSwiglu, pg8::StaticOrder, true, true>(lds, g, S, E, tid); }
            break;
        default: if (EN_PREP) final_norm_rows(HN, PF(2), a.dry ? (float*)WSP(60 * MiB) : P_OUT, gw, NGW, lane);
#if defined(TIMING_PROBE) || defined(PHASE_PROBE)
            { __syncthreads(); float* o = P_OUT;
#ifdef PHASE_PROBE
              const unsigned long long* ts = (const unsigned long long*)WSP(WS_TQ + 4096); const int* ops = (const int*)WSP(WS_TQ + 8192);
              const unsigned long long tend = __builtin_amdgcn_s_memrealtime(); float sa = 0.f, sb = 0.f;
              for (int q = 0; q < 33; ++q) { const float dt = (float)(ts[q + 1] - ts[q]); if (ops[q] == TQ_A) sa += dt; if (ops[q] == TQ_B) sb += dt; }
              const float tot_ = (float)(ts[33] - ts[0]); const float f1 = sa / tot_, f2 = sb / tot_; (void)tend;
#else
              const float* tq = (const float*)WSP(WS_TQ); const float f1 = tq[TQ_A], f2 = tq[TQ_B];
#endif

              const int R = (int)(f2 * 0.32f * 16384.f);
              for (int m = gw; m < R; m += NGW) for (int c = lane; c < 1024; c += 64) o[(size_t)m * 1024 + c] += 0.05f;
              if (bid == G - 1 && tid == 0) o[(size_t)16383 * 1024 + 5] += 0.1f + 0.19f * f1; }
#endif
            break;
        }
        { int cv = 0, nun = 0;
          if (op == OP_PREP) cv = 2;
          else if ((op == OP_G_LRUIN || op == OP_G_NSAIN || op == OP_G_GLAIN)) { cv = 1; nun = 64 * (op == OP_G_LRUIN ? 10 : op == OP_G_NSAIN ? 11 : 13); }
          else if (op == OP_G_GU && layer < 3) { cv = 2; nun = 64 * 22; }
          if (EN_PREP && cv) {
              const int rem = op == OP_PREP ? 0 : nun % G, first = rem, nidle = G - first;
              if (bid >= first) { const int cgw = (bid - first) * 8 + wid, CNGW = nidle * 8; int rot = 0;
                  if (cv & 1) {
                      transpose_job(PF(5) + (size_t)layer * D_ * FF, PF(4) + layer * D_, D_, FF, W_GU, D_, 1, rot, cgw, CNGW, scr, lane);
                      transpose_job(PF(6) + (size_t)layer * D_ * FF, PF(4) + layer * D_, D_, FF, W_GU, D_, 2, rot, cgw, CNGW, scr, lane);
                      transpose_job(PF(7) + (size_t)layer * FF * D_, nullptr, FF, D_, W_DN, FF, 0, rot, cgw, CNGW, scr, lane); }
                  if (cv & 2) { const int ml = op == OP_PREP ? layer : layer + 1, mk = ml % 3, mj = ml / 3;
                      if (mk == 0) {
                          transpose_job(PF(8) + (size_t)mj * D_ * 2 * RNN, PF(3) + ml * D_, D_, 2 * RNN, W_MIN, D_, 0, rot, cgw, CNGW, scr, lane);
                          transpose_job(PF(16) + (size_t)mj * RNN * D_, nullptr, RNN, D_, W_MOUT, RNN, 0, rot, cgw, CNGW, scr, lane);
#pragma unroll 1
                          for (int h = 0; h < 20; ++h) { const int hh = h % 10; const float* src = (h < 10 ? PF(11) : PF(13)) + ((size_t)mj * 10 + hh) * 16384;
                              transpose_job(src, nullptr, 128, 128, W_SM + (h < 10 ? 0 : 163840) + hh * 16384, 128, 0, rot, cgw, CNGW, scr, lane); }
                      } else if (mk == 1) {
                          transpose_job(PF(17), PF(3) + ml * D_, D_, 2608, W_MIN, D_, 0, rot, cgw, CNGW, scr, lane);
                          transpose_job(PF(23), nullptr, D_, D_, W_MOUT, D_, 0, rot, cgw, CNGW, scr, lane);
#pragma unroll 1
                          for (int kv = 0; kv < 2; ++kv) {
                              transpose_job(PF(19) + (size_t)kv * 2048 * 64, nullptr, 2048, 64, W_SM + (size_t)kv * 64 * 2048, 2048, 0, rot, cgw, CNGW, scr, lane);
                              transpose_job(PF(21) + (size_t)kv * 4096, nullptr, 64, 64, W_SM + 262144 + kv * 4096, 64, 0, rot, cgw, CNGW, scr, lane); }
                      } else {
                          transpose_job(PF(24), PF(3) + ml * D_, D_, 3088, W_MIN, D_, 0, rot, cgw, CNGW, scr, lane);
                          transpose_job(PF(28), nullptr, D_, D_, W_MOUT, D_, 0, rot, cgw, CNGW, scr, lane); } } } } }
        if (ph + 1 < a.ph_hi) { if (USE_XCD_BAR && (ALL_XCD_BAR || ph != a.ph_lo)) xcd_barrier(xbar); else grid.sync(); }
#ifdef EXTRA_BARS
        if (ph + 1 < a.ph_hi && ph != a.ph_lo) { xcd_barrier(xbar); xcd_barrier(xbar); }
#endif
    }
}

#ifndef N_LAUNCH_MODE
#define N_LAUNCH_MODE 1
#endif
constexpr int N_PHASES = 27;

extern "C" void kernel_launch(void* const* d_in, const int* in_sizes, int n_in, void* d_out, int out_size, void* d_ws, size_t ws_size, hipStream_t stream) {
    static int grid = 0;
    if (grid == 0) {
        if (n_in != 29 || out_size != T_ * D_ || ws_size < WS_END) { fprintf(stderr, "kernel_launch: unexpected problem: n_in %d out %d ws %zu\n", n_in, out_size, ws_size); grid = -1; return; }
        int dev = 0, cus = 0, per_cu = 0;
        hipGetDevice(&dev); hipDeviceGetAttribute(&cus, hipDeviceAttributeMultiprocessorCount, dev);
        if (hipFuncSetAttribute((const void*)mega_fwd, hipFuncAttributeMaxDynamicSharedMemorySize, LDS_BYTES) != hipSuccess) { fprintf(stderr, "kernel_launch: hipFuncSetAttribute failed\n"); grid = -1; return; }
        if (hipOccupancyMaxActiveBlocksPerMultiprocessor(&per_cu, (const void*)mega_fwd, 512, LDS_BYTES) != hipSuccess || per_cu < 1) { fprintf(stderr, "kernel_launch: occupancy query says %d\n", per_cu); per_cu = 1; }
        (void)hipGetLastError();
        grid = cus * 1;
        fprintf(stderr, "kernel_launch: grid %d (cus %d, occupancy %d)\n", grid, cus, per_cu);
    }
    if (grid < 0) return;
    if (hipMemsetAsync((char*)d_ws + WS_CTL, 0, 16384, stream) != hipSuccess) { fprintf(stderr, "kernel_launch: memset failed\n"); return; }
    Args a{};
    const float** p = (const float**)&a;
    for (int i = 0; i < 29; ++i) p[i] = (const float*)d_in[i];
    a.out = (float*)d_out; a.ws = (unsigned char*)d_ws;
#if N_LAUNCH_MODE == 1
    a.ph_lo = 0; a.ph_hi = N_PHASES;
    void* args[] = {&a};
    hipError_t e = hipLaunchCooperativeKernel((const void*)mega_fwd, dim3(grid), dim3(512), args, LDS_BYTES, stream);
    if (e != hipSuccess) fprintf(stderr, "cooperative launch failed: %s (grid %d)\n", hipGetErrorString(e), grid);
#else
#ifndef REPEAT_PH
#define REPEAT_PH -1
#endif
#ifndef REPEAT_N
#define REPEAT_N 1
#endif
#ifndef RUN_UPTO
#define RUN_UPTO (N_PHASES - 1)
#endif
    for (int ph = 0; ph < N_PHASES; ++ph) { if (ph >= RUN_UPTO && ph != N_PHASES - 1) continue; a.ph_lo = ph; a.ph_hi = ph + 1;
        a.dry = 1; for (int rep = 0; rep < REPEAT_N; ++rep) if (ph == REPEAT_PH) hipLaunchKernelGGL(mega_fwd, dim3(grid), dim3(512), LDS_BYTES, stream, a);
        a.dry = 0; hipLaunchKernelGGL(mega_fwd, dim3(grid), dim3(512), LDS_BYTES, stream, a); }
#endif
}
```

```cpp
#include <hip/hip_runtime.h>
#include <hip/hip_cooperative_groups.h>
#include <cstdio>
#include <cstdint>
namespace cg = cooperative_groups;

#define LAS __attribute__((address_space(3)))
typedef unsigned short bf16_t;
typedef short bf16x8 __attribute__((ext_vector_type(8)));
typedef short s16x4 __attribute__((ext_vector_type(4)));
typedef float f32x4 __attribute__((ext_vector_type(4)));
typedef float f32x2 __attribute__((ext_vector_type(2)));
typedef unsigned u32x4 __attribute__((ext_vector_type(4)));
typedef unsigned u32x2 __attribute__((ext_vector_type(2)));
typedef __bf16 bf16x2_t __attribute__((ext_vector_type(2)));

constexpr int T_ = 16384, SEQ = 8192, D_ = 1024, FF = 2816, RNN = 1280;
constexpr int NSA_NPAD = 2816, GLA_NPAD = 3328;
constexpr float EPS = 1e-6f;
constexpr float LOG2E = 1.4426950408889634f;

constexpr size_t MiB = 1u << 20;
constexpr size_t WS_W_GU = 0, WS_W_DN = 11 * MiB, WS_W_MIN = 17 * MiB, WS_W_MOUT = 24 * MiB, WS_W_SMALL = 27 * MiB;
constexpr size_t WS_HN = 28 * MiB;
constexpr size_t WS_ACT = 60 * MiB;
constexpr size_t WS_LG = 60 * MiB, WS_LX = 100 * MiB, WS_LHL = 140 * MiB, WS_LAC = 180 * MiB, WS_LAGGA = 220 * MiB, WS_LAGGH = 221 * MiB;
constexpr size_t WS_NQ = 60 * MiB, WS_NKV = 92 * MiB, WS_NGT = 140 * MiB, WS_NKC = 143 * MiB, WS_NVC = 144 * MiB;
constexpr size_t WS_GQ = 60 * MiB, WS_GK = 76 * MiB, WS_GV = 92 * MiB, WS_GR = 124 * MiB, WS_GGL = 156 * MiB, WS_GDEC = 157 * MiB, WS_GKVT = 158 * MiB;
constexpr size_t WS_TQ = 223 * MiB, WS_CTL = 222 * MiB, WS_SSP = 222 * MiB + 65536, WS_NY = 148 * MiB, WS_NVT = 180 * MiB, WS_B1E = 222 * MiB + 524288;
constexpr size_t WS_END = 224 * MiB;

constexpr int LDS_BYTES = 155648;

__device__ __forceinline__ unsigned pk2(float lo, float hi) { f32x2 v = {lo, hi}; bf16x2_t b = __builtin_convertvector(v, bf16x2_t); return __builtin_bit_cast(unsigned, b); }
__device__ __forceinline__ float bf2f(unsigned short h) { return __uint_as_float(((unsigned)h) << 16); }
__device__ __forceinline__ float bflo(unsigned w) { return __uint_as_float(w << 16); }
__device__ __forceinline__ float bfhi(unsigned w) { return __uint_as_float(w & 0xffff0000u); }
__device__ __forceinline__ float fast_rcp(float x) { return __builtin_amdgcn_rcpf(x); }
__device__ __forceinline__ float fast_exp2(float x) { return __builtin_amdgcn_exp2f(x); }
__device__ __forceinline__ float sigmoidf_(float x) { return fast_rcp(1.f + fast_exp2(-x * LOG2E)); }
__device__ __forceinline__ float siluf_(float x) { return x * sigmoidf_(x); }
__device__ __forceinline__ float gelu_tanh_(float x) { const float z = 0.7978845608028654f * (x + 0.044715f * x * x * x); return x * fast_rcp(1.f + fast_exp2(-2.f * LOG2E * z)); }
__device__ __forceinline__ float wave_sum(float v) {
#pragma unroll
    for (int o = 1; o < 64; o <<= 1) v += __shfl_xor(v, o);
    return v;
}
__device__ __forceinline__ float xmax16_32(float v) {
    auto r = __builtin_amdgcn_permlane16_swap(__float_as_uint(v), __float_as_uint(v), false, false); v = fmaxf(__uint_as_float(r[0]), __uint_as_float(r[1]));
    auto q = __builtin_amdgcn_permlane32_swap(__float_as_uint(v), __float_as_uint(v), false, false); return fmaxf(__uint_as_float(q[0]), __uint_as_float(q[1]));
}
__device__ __forceinline__ float xsum16_32(float v) {
    auto r = __builtin_amdgcn_permlane16_swap(__float_as_uint(v), __float_as_uint(v), false, false); v = __uint_as_float(r[0]) + __uint_as_float(r[1]);
    auto q = __builtin_amdgcn_permlane32_swap(__float_as_uint(v), __float_as_uint(v), false, false); return __uint_as_float(q[0]) + __uint_as_float(q[1]);
}
__device__ __forceinline__ float dpp_xor1(float v) { return __uint_as_float((unsigned)__builtin_amdgcn_update_dpp(0, (int)__float_as_uint(v), 0xB1, 0xF, 0xF, true)); }
__device__ __forceinline__ float dpp_xor2(float v) { return __uint_as_float((unsigned)__builtin_amdgcn_update_dpp(0, (int)__float_as_uint(v), 0x4E, 0xF, 0xF, true)); }
__device__ __forceinline__ float max3_(float a, float b, float c) { float r; asm("v_max3_f32 %0, %1, %2, %3" : "=v"(r) : "v"(a), "v"(b), "v"(c)); return r; }
namespace pg8 {
#define PG8_LAS __attribute__((address_space(3)))
typedef unsigned short bf16_t;
typedef short bf16x8 __attribute__((ext_vector_type(8)));
typedef float f32x4 __attribute__((ext_vector_type(4)));
typedef unsigned u32x4 __attribute__((ext_vector_type(4)));
constexpr int BM = 256, BK = 64, HALF = 128, HTB = HALF * BK * 2  , STAGE_BYTES = 8 * HTB, NXCD = 8, WGM = 8;

__host__ __device__ __forceinline__ int lds_byte(int r, int c) { const int st = (r >> 4) * 2 + (c >> 5), rr = r & 15, cc = c & 31, ob = rr * 64 + cc * 2; return st * 1024 + (ob ^ (((ob >> 9) & 1) << 5)); }
__host__ __device__ __forceinline__ void stage_rc(int b, int& R, int& C) { const int st = b / 1024, sb = b % 1024, swz = sb ^ (((sb >> 9) & 1) << 5); R = (st >> 1) * 16 + swz / 64; C = (st & 1) * 32 + (swz % 64) / 2; }
__host__ __device__ __forceinline__ int perm32(int rho) { const int n = rho >> 4, i = rho & 15; return 8 * (i >> 2) + 4 * n + (i & 3); }

struct Unit { int pm, pn; };
struct Gemm { const bf16_t* A; const bf16_t* Bt; int M, N, K; };

struct StaticOrder {
    int nM, nN, nwg, G, c;
    __host__ __device__ void init(int M, int N, int G_, int c_) { nM = M / BM; nN = N / BM; nwg = nM * nN; G = G_; c = c_; }
    __host__ __device__ bool next(int i, Unit& u) const {
        const long L = (long)i * G + c; if (L >= nwg) return false;
        int wgid = (int)L; { const int q = nwg / NXCD, r = nwg % NXCD, xcd = wgid % NXCD, off = wgid / NXCD; wgid = (xcd < r ? xcd * (q + 1) : r * (q + 1) + (xcd - r) * q) + off; }
        const int nig = WGM * nN, gid = wgid / nig, fm = gid * WGM, gsz = (nM - fm) < WGM ? (nM - fm) : WGM;
        u.pm = fm + ((wgid % nig) % gsz); u.pn = (wgid % nig) / gsz; return true;
    }
    __device__ __forceinline__ void a_ready(const Unit&) const {}
    __device__ __forceinline__ void done(const Unit&) const {}
};

struct EpiResid {
    static constexpr bool PERM = false, AFTER_DRAIN = false;
    bf16_t* hb; bf16_t* hbo; float* ssp; PG8_LAS float* red;
    __device__ __forceinline__ void operator()(const f32x4 (&acc)[2][2][4][2], const Unit& u, int wr, int wc, int fr, int fq) const {
        const int row0 = u.pm * BM + wr * 64 + fr, col0 = u.pn * BM + wc * 32 + 4 * fq;
#pragma unroll
        for (int ai = 0; ai < 2; ++ai)
#pragma unroll
            for (int m = 0; m < 4; ++m) { const size_t off = (size_t)(row0 + ai * HALF + m * 16) * 1024 + col0; float ss = 0.f;
#pragma unroll
                for (int bj = 0; bj < 2; ++bj)
#pragma unroll
                    for (int n = 0; n < 2; ++n) { const u32x2 b = *(const u32x2*)(hb + off + bj * HALF + n * 16); const f32x4 a = acc[ai][bj][m][n];
                        u32x2 w; w.x = ::pk2(::bflo(b.x) + a[0], ::bfhi(b.x) + a[1]); w.y = ::pk2(::bflo(b.y) + a[2], ::bfhi(b.y) + a[3]); *(u32x2*)(hbo + off + bj * HALF + n * 16) = w;
                        const float h0 = ::bflo(w.x), h1 = ::bfhi(w.x), h2 = ::bflo(w.y), h3 = ::bfhi(w.y); ss += (h0 * h0 + h1 * h1) + (h2 * h2 + h3 * h3); }
                ss = ::xsum16_32(ss); if (fq == 0) red[(ai * HALF + wr * 64 + m * 16 + fr) * 4 + wc] = ss; }
        asm volatile("s_waitcnt lgkmcnt(0)" ::: "memory"); __builtin_amdgcn_s_barrier(); asm volatile("" ::: "memory");
        const int t = (wr * 4 + wc) * 64 + fq * 16 + fr;
        if (t < 256) { const f32x4 s = *(const PG8_LAS f32x4*)(red + t * 4); ssp[(size_t)(u.pm * BM + t) * 4 + u.pn] = (s[0] + s[1]) + (s[2] + s[3]); }
    }
};
__device__ __forceinline__ void load_rs(const float* ssp, int pm, int wr, int fr, float (&rs)[2][4]) {
#pragma unroll
    for (int ai = 0; ai < 2; ++ai)
#pragma unroll
        for (int m = 0; m < 4; ++m) { const int row = pm * BM + ai * HALF + wr * 64 + m * 16 + fr;
            const f32x4 s4 = *(const f32x4*)(ssp + (size_t)row * 4); const float s = (s4[0] + s4[1]) + (s4[2] + s4[3]); rs[ai][m] = __builtin_amdgcn_rsqf(s * (1.f / 1024.f) + 1e-6f); }
}
__device__ __forceinline__ u32x4 pack8(const f32x4 a, const f32x4 b) { u32x4 w; w.x = ::pk2(a[0], a[1]); w.y = ::pk2(a[2], a[3]); w.z = ::pk2(b[0], b[1]); w.w = ::pk2(b[2], b[3]); return w; }
struct EpiSwiglu {
    static constexpr bool PERM = true, AFTER_DRAIN = false;
    bf16_t* O; const float* ssp;
    __device__ __forceinline__ void operator()(const f32x4 (&acc)[2][2][4][2], const Unit& u, int wr, int wc, int fr, int fq) const {
        float rs[2][4]; load_rs(ssp, u.pm, wr, fr, rs);
        const int row0 = u.pm * BM + wr * 64 + fr, col0 = u.pn * HALF + wc * 32 + 8 * fq;
#pragma unroll
        for (int ai = 0; ai < 2; ++ai)
#pragma unroll
            for (int m = 0; m < 4; ++m) { f32x4 v[2];
#pragma unroll
                for (int n = 0; n < 2; ++n) { const f32x4 g = acc[ai][0][m][n], up = acc[ai][1][m][n];
#pragma unroll
                    for (int j = 0; j < 4; ++j) v[n][j] = ::siluf_(g[j] * rs[ai][m]) * (up[j] * rs[ai][m]); }
                *(u32x4*)(O + (size_t)(row0 + ai * HALF + m * 16) * FF + col0) = pack8(v[0], v[1]); }
    }
};
template <int ACT> __device__ __forceinline__ void store_tile_bf16(const f32x4 (&acc)[2][2][4][2], const float (&rs)[2][4], bf16_t* dst, int ldc, int cbase, float scale, int pm, int wr, int wc, int fr, int fq) {
    const int row0 = pm * BM + wr * 64 + fr, col0 = cbase + wc * 32 + 8 * fq;
#pragma unroll
    for (int ai = 0; ai < 2; ++ai)
#pragma unroll
        for (int m = 0; m < 4; ++m)
#pragma unroll
            for (int bj = 0; bj < 2; ++bj) { f32x4 v[2];
#pragma unroll
                for (int n = 0; n < 2; ++n)
#pragma unroll
                    for (int j = 0; j < 4; ++j) { const float x = acc[ai][bj][m][n][j] * rs[ai][m]; v[n][j] = ACT == 1 ? ::gelu_tanh_(x) : ACT == 2 ? ::siluf_(x) : x * scale; }
                *(u32x4*)(dst + (size_t)(row0 + ai * HALF + m * 16) * ldc + col0 + bj * HALF) = pack8(v[0], v[1]); }
}
template <int ACT> __device__ __forceinline__ void store_tile_f32_narrow(const f32x4 (&acc)[2][2][4][2], const float (&rs)[2][4], float* dst, int ldc, int ncols, int pm, int wr, int wc, int fr, int fq) {
    const int row0 = pm * BM + wr * 64 + fr;
#pragma unroll
    for (int ai = 0; ai < 2; ++ai)
#pragma unroll
        for (int m = 0; m < 4; ++m)
#pragma unroll
            for (int n = 0; n < 2; ++n) { const int c = wc * 32 + 8 * fq + 4 * n;
                if (c < ncols) { f32x4 v = acc[ai][0][m][n] * rs[ai][m];
                    if (ACT == 3) { v[0] = ::sigmoidf_(v[0]); v[1] = ::sigmoidf_(v[1]); v[2] = ::sigmoidf_(v[2]); v[3] = ::sigmoidf_(v[3]); }
                    *(f32x4*)(dst + (size_t)(row0 + ai * HALF + m * 16) * ldc + c) = v; } }
}
struct EpiLruIn {
    static constexpr bool PERM = true, AFTER_DRAIN = false;
    bf16_t* G; bf16_t* X; const float* ssp; int nogelu;
    __device__ __forceinline__ void operator()(const f32x4 (&acc)[2][2][4][2], const Unit& u, int wr, int wc, int fr, int fq) const {
        float rs[2][4]; load_rs(ssp, u.pm, wr, fr, rs);
        if (u.pn < 5 && !nogelu) store_tile_bf16<1>(acc, rs, G, RNN, u.pn * BM, 1.f, u.pm, wr, wc, fr, fq);
        else if (u.pn < 5) store_tile_bf16<0>(acc, rs, G, RNN, u.pn * BM, 1.f, u.pm, wr, wc, fr, fq);
        else store_tile_bf16<0>(acc, rs, X, RNN, (u.pn - 5) * BM, 1.f, u.pm, wr, wc, fr, fq);
    }
};
struct EpiNsaIn {
    static constexpr bool PERM = true, AFTER_DRAIN = false;
    bf16_t* Q; bf16_t* KV; float* GT; const float* ssp;
    __device__ __forceinline__ void operator()(const f32x4 (&acc)[2][2][4][2], const Unit& u, int wr, int wc, int fr, int fq) const {
        float rs[2][4]; load_rs(ssp, u.pm, wr, fr, rs);
        if (u.pn < 4) store_tile_bf16<0>(acc, rs, Q, 1024, u.pn * BM, 0.125f, u.pm, wr, wc, fr, fq);
        else if (u.pn < 10) store_tile_bf16<0>(acc, rs, KV + (size_t)(u.pn - 4) * T_ * 256, 256, 0, 1.f, u.pm, wr, wc, fr, fq);
        else store_tile_f32_narrow<3>(acc, rs, GT, 48, 48, u.pm, wr, wc, fr, fq);
    }
};
struct EpiGlaIn {
    static constexpr bool PERM = true, AFTER_DRAIN = false;
    bf16_t* Q; bf16_t* K; bf16_t* V; bf16_t* R; float* GL; const float* ssp;
    __device__ __forceinline__ void operator()(const f32x4 (&acc)[2][2][4][2], const Unit& u, int wr, int wc, int fr, int fq) const {
        float rs[2][4]; load_rs(ssp, u.pm, wr, fr, rs);
        if (u.pn < 2) store_tile_bf16<0>(acc, rs, Q, 512, u.pn * BM, 0.08838834764831845f, u.pm, wr, wc, fr, fq);
        else if (u.pn < 4) store_tile_bf16<0>(acc, rs, K, 512, (u.pn - 2) * BM, 1.f, u.pm, wr, wc, fr, fq);
        else if (u.pn < 8) store_tile_bf16<0>(acc, rs, V, 1024, (u.pn - 4) * BM, 1.f, u.pm, wr, wc, fr, fq);
        else if (u.pn < 12) store_tile_bf16<2>(acc, rs, R, 1024, (u.pn - 8) * BM, 1.f, u.pm, wr, wc, fr, fq);
        else store_tile_f32_narrow<0>(acc, rs, GL, 16, 16, u.pm, wr, wc, fr, fq);
    }
};
template <class Epi, class Sched, bool ALIGN_EPI = false, bool SP2 = false>
__device__ __forceinline__ void gemm_phase(PG8_LAS unsigned char* lds, const Gemm g, const Sched& S, const Epi& E, const int tid) {
    const int wid = __builtin_amdgcn_readfirstlane(tid >> 6), lane = tid & 63, wr = wid >> 2, wc = wid & 3, fr = lane & 15, fq = lane >> 4;
    const int K = g.K, nt = K / BK;
    unsigned voffA[2], voffB[2];
#pragma unroll
    for (int i = 0; i < 2; ++i) { int R, C; stage_rc(tid * 16 + i * 8192, R, C); const int Rb = Epi::PERM ? ((R & ~31) + perm32(R & 31)) : R;
        voffA[i] = (unsigned)(R * K + C) * 2u; voffB[i] = (unsigned)(Rb * K + C) * 2u; }
    const size_t kstep = (size_t)(BK * 2);
    const size_t hstep = (size_t)HALF * K * 2;
    const size_t tstep = 2 * hstep;
    const unsigned ldsw = (unsigned)wid * 1024u;
    const int aoff = lds_byte(wr * 64 + fr, fq * 8), boff = lds_byte(wc * 32 + fr, fq * 8);
#define PG8_SA(b, h) (((b) * 2 + (h)) * HTB)
#define PG8_SB(b, h) ((4 + (b) * 2 + (h)) * HTB)
#define PG8_STAGE(bufoff, gbase, voff) do { _Pragma("unroll") for (int _i = 0; _i < 2; ++_i) \
        __builtin_amdgcn_global_load_lds((const unsigned*)((const char*)(gbase) + (voff)[_i]), (PG8_LAS unsigned*)(lds + (bufoff) + ldsw + _i * 8192), 16, 0, 0); } while (0)
#define PG8_LDA(dst, b, h) do { _Pragma("unroll") for (int m = 0; m < 4; ++m) _Pragma("unroll") for (int k = 0; k < 2; ++k) dst[m][k] = *(const PG8_LAS bf16x8*)(lds + PG8_SA(b, h) + aoff + m * 2048 + k * 1024); } while (0)
#define PG8_LDB(dst, b, h) do { _Pragma("unroll") for (int n = 0; n < 2; ++n) _Pragma("unroll") for (int k = 0; k < 2; ++k) dst[n][k] = *(const PG8_LAS bf16x8*)(lds + PG8_SB(b, h) + boff + n * 2048 + k * 1024); } while (0)
#define PG8_MMA(ai, bj, At, Bt) do { __builtin_amdgcn_s_setprio(1); _Pragma("unroll") for (int m = 0; m < 4; ++m) _Pragma("unroll") for (int n = 0; n < 2; ++n) _Pragma("unroll") for (int k = 0; k < 2; ++k) \
        acc[ai][bj][m][n] = __builtin_amdgcn_mfma_f32_16x16x32_bf16(Bt[n][k], At[m][k], acc[ai][bj][m][n], 0, 0, 0); __builtin_amdgcn_s_setprio(0); } while (0)
#define PG8_WAIT_V(n) asm volatile("s_waitcnt vmcnt(" #n ")" ::: "memory")
#define PG8_WAIT_L(n) asm volatile("s_waitcnt lgkmcnt(" #n ")" ::: "memory")
#define PG8_BAR __builtin_amdgcn_s_barrier()
#define PG8_SCHED __builtin_amdgcn_sched_barrier(0)
    Unit cur, nxt; int ui = 0;
    if (!S.next(0, cur)) return;
    f32x4 acc[2][2][4][2];
#pragma unroll
    for (int a = 0; a < 2; ++a)
#pragma unroll
        for (int b = 0; b < 2; ++b)
#pragma unroll
            for (int m = 0; m < 4; ++m)
#pragma unroll
                for (int n = 0; n < 2; ++n) acc[a][b][m][n] = (f32x4){0.f, 0.f, 0.f, 0.f};
    bf16x8 At[4][2], B0[2][2], B1[2][2];
    const char* cA = (const char*)g.A + (size_t)cur.pm * tstep; const char* cB = (const char*)g.Bt + (size_t)cur.pn * tstep;
    S.a_ready(cur);
    if constexpr (SP2) {
        PG8_STAGE(PG8_SB(0, 0), cB, voffB); PG8_STAGE(PG8_SB(0, 1), cB + hstep, voffB); PG8_STAGE(PG8_SA(0, 0), cA, voffA); PG8_STAGE(PG8_SA(0, 1), cA + hstep, voffA);
        if (wr == 1) PG8_BAR;
        PG8_WAIT_V(2); PG8_BAR;
        PG8_STAGE(PG8_SB(1, 0), cB + kstep, voffB); PG8_STAGE(PG8_SA(1, 0), cA + kstep, voffA); PG8_STAGE(PG8_SB(1, 1), cB + hstep + kstep, voffB);
        PG8_WAIT_V(6); PG8_BAR;
    } else {
        PG8_STAGE(PG8_SB(0, 0), cB, voffB); PG8_STAGE(PG8_SA(0, 0), cA, voffA); PG8_STAGE(PG8_SB(0, 1), cB + hstep, voffB); PG8_STAGE(PG8_SA(0, 1), cA + hstep, voffA);
        if (wr == 1) PG8_BAR;
        PG8_WAIT_V(4); PG8_BAR;
        PG8_STAGE(PG8_SB(1, 0), cB + kstep, voffB); PG8_STAGE(PG8_SA(1, 0), cA + kstep, voffA); PG8_STAGE(PG8_SB(1, 1), cB + hstep + kstep, voffB);
        PG8_WAIT_V(6); PG8_BAR;
    }
    for (;;) {
        const bool has_next = S.next(ui + 1, nxt);
        const char* nA = has_next ? (const char*)g.A + (size_t)nxt.pm * tstep : cA; const char* nB = has_next ? (const char*)g.Bt + (size_t)nxt.pn * tstep : cB;
        for (int t = 0; t < nt; t += 2) {
            const bool last = (t == nt - 2);
            const char* a1 = cA + (size_t)(t + 1) * kstep;
            const char* a2 = last ? nA : cA + (size_t)(t + 2) * kstep; const char* b2 = last ? nB : cB + (size_t)(t + 2) * kstep;
            const char* a3 = a2 + kstep; const char* b3 = b2 + kstep;
            if (last && has_next) S.a_ready(nxt);
            if constexpr (SP2) {
            PG8_LDB(B0, 0, 0); PG8_LDB(B1, 0, 1); PG8_SCHED; PG8_LDA(At, 0, 0); PG8_STAGE(PG8_SA(1, 1), a1 + hstep, voffA);
            PG8_WAIT_V(8); PG8_WAIT_L(0); PG8_BAR; PG8_MMA(0, 0, At, B0); PG8_MMA(0, 1, At, B1); PG8_BAR; PG8_SCHED;
            PG8_LDA(At, 0, 1); PG8_STAGE(PG8_SB(0, 0), b2, voffB); PG8_STAGE(PG8_SB(0, 1), b2 + hstep, voffB); PG8_STAGE(PG8_SA(0, 0), a2, voffA);
            PG8_WAIT_V(8); PG8_WAIT_L(0); PG8_BAR; PG8_MMA(1, 0, At, B0); PG8_MMA(1, 1, At, B1); PG8_BAR; PG8_SCHED;
            PG8_LDB(B0, 1, 0); PG8_LDB(B1, 1, 1); PG8_SCHED; PG8_LDA(At, 1, 0); PG8_STAGE(PG8_SA(0, 1), a2 + hstep, voffA);
            PG8_WAIT_V(8); PG8_WAIT_L(0); PG8_BAR; PG8_MMA(0, 0, At, B0); PG8_MMA(0, 1, At, B1); PG8_BAR; PG8_SCHED;
            PG8_LDA(At, 1, 1); PG8_STAGE(PG8_SB(1, 0), b3, voffB); PG8_STAGE(PG8_SB(1, 1), b3 + hstep, voffB); PG8_STAGE(PG8_SA(1, 0), a3, voffA);
            PG8_WAIT_V(8); PG8_WAIT_L(0); PG8_BAR; PG8_MMA(1, 0, At, B0); PG8_MMA(1, 1, At, B1); PG8_BAR; PG8_SCHED;
            } else {
            PG8_LDB(B0, 0, 0); PG8_SCHED; PG8_LDA(At, 0, 0); PG8_STAGE(PG8_SA(1, 1), a1 + hstep, voffA);
            PG8_WAIT_L(8); PG8_BAR; PG8_WAIT_L(0); PG8_MMA(0, 0, At, B0); PG8_BAR; PG8_SCHED;
            PG8_LDB(B1, 0, 1); PG8_STAGE(PG8_SB(0, 0), b2, voffB);
            PG8_BAR; PG8_WAIT_L(0); PG8_MMA(0, 1, At, B1); PG8_BAR;
            PG8_LDA(At, 0, 1); PG8_STAGE(PG8_SA(0, 0), a2, voffA);
            PG8_BAR; PG8_WAIT_L(0); PG8_MMA(1, 0, At, B0); PG8_BAR; PG8_SCHED;
            PG8_STAGE(PG8_SB(0, 1), b2 + hstep, voffB);
            PG8_WAIT_V(6); PG8_BAR; PG8_MMA(1, 1, At, B1); PG8_BAR;
            PG8_LDB(B0, 1, 0); PG8_SCHED; PG8_LDA(At, 1, 0); PG8_STAGE(PG8_SA(0, 1), a2 + hstep, voffA);
            PG8_WAIT_L(8); PG8_BAR; PG8_WAIT_L(0); PG8_MMA(0, 0, At, B0); PG8_BAR; PG8_SCHED;
            PG8_LDB(B1, 1, 1); PG8_STAGE(PG8_SB(1, 0), b3, voffB);
            PG8_BAR; PG8_WAIT_L(0); PG8_MMA(0, 1, At, B1); PG8_BAR;
            PG8_LDA(At, 1, 1); PG8_STAGE(PG8_SA(1, 0), a3, voffA);
            PG8_BAR; PG8_WAIT_L(0); PG8_MMA(1, 0, At, B0); PG8_BAR; PG8_SCHED;
            PG8_STAGE(PG8_SB(1, 1), b3 + hstep, voffB);
            PG8_WAIT_V(6); PG8_BAR; PG8_MMA(1, 1, At, B1); PG8_BAR;
            }
        }
        if constexpr (ALIGN_EPI) { if (wr == 0) PG8_BAR; }
        if constexpr (!Epi::AFTER_DRAIN) { E(acc, cur, wr, wc, fr, fq); S.done(cur); }
        if (!has_next) break;
#pragma unroll
        for (int a = 0; a < 2; ++a)
#pragma unroll
            for (int b = 0; b < 2; ++b)
#pragma unroll
                for (int m = 0; m < 4; ++m)
#pragma unroll
                    for (int n = 0; n < 2; ++n) acc[a][b][m][n] = (f32x4){0.f, 0.f, 0.f, 0.f};
        cur = nxt; cA = nA; cB = nB; ++ui;
        if constexpr (ALIGN_EPI) { if (wr == 1) PG8_BAR; }
    }
    PG8_WAIT_V(0);
    if constexpr (!ALIGN_EPI) { if (wr == 0) PG8_BAR; }
    PG8_BAR;
    if constexpr (Epi::AFTER_DRAIN) { E.fused(acc, cur, wr, wc, fr, fq, lds, wid, lane); S.done(cur); }
#undef PG8_SA
#undef PG8_SB
#undef PG8_STAGE
#undef PG8_LDA
#undef PG8_LDB
#undef PG8_MMA
#undef PG8_WAIT_V
#undef PG8_WAIT_L
#undef PG8_BAR
#undef PG8_SCHED
}
}
__device__ __forceinline__ void transpose_item(const float* __restrict__ W, const float* __restrict__ gk, int ldw, int N, int k0, int n0, bf16_t* WT, int ldt, int dst_row0, LAS float* scr, int lane) {
    const int kq = lane >> 3, n4 = (lane & 7) * 4; const bool ok = n0 + n4 < N;
    f32x4 wv[8];
#pragma unroll
    for (int i = 0; i < 8; ++i) wv[i] = ok ? *(const f32x4*)(W + (size_t)(k0 + kq + 8 * i) * ldw + n0 + n4) : (f32x4){0.f, 0.f, 0.f, 0.f};
#pragma unroll
    for (int i = 0; i < 8; ++i) { const int kk = kq + 8 * i; const float gg = gk ? gk[k0 + kk] : 1.f;
#pragma unroll
        for (int e = 0; e < 4; ++e) scr[kk * 33 + n4 + e] = wv[i][e] * gg; }
    asm volatile("s_waitcnt lgkmcnt(0)" ::: "memory");
    const int c = lane & 7;
#pragma unroll
    for (int j = 0; j < 4; ++j) { const int n = (lane >> 3) + 8 * j; const LAS float* s = scr + (8 * c) * 33 + n;
        u32x4 o; o.x = pk2(s[0 * 33], s[1 * 33]); o.y = pk2(s[2 * 33], s[3 * 33]); o.z = pk2(s[4 * 33], s[5 * 33]); o.w = pk2(s[6 * 33], s[7 * 33]);
        *(u32x4*)(WT + (size_t)(dst_row0 + n) * ldt + k0 + 8 * c) = o; }
    asm volatile("s_waitcnt lgkmcnt(0)" ::: "memory");
}
__device__ __forceinline__ void transpose_job(const float* W, const float* gk, int K, int N, bf16_t* WT, int ldt, int mode, int& rot, int gw, int NGW, LAS float* scr, int lane) {
    const int nnb = (N + 31) >> 5, nit = (K >> 6) * nnb;
    int start = gw - rot; if (start < 0) start += NGW;
    for (int it = start; it < nit; it += NGW) {
        const int kb = it / nnb, nb = it - kb * nnb, n0 = nb << 5;
        const int dr = mode == 0 ? n0 : ((n0 >> 7) * 256 + (n0 & 127) + (mode == 2 ? 128 : 0));
        transpose_item(W, gk, N, N, kb << 6, n0, WT, ldt, dr, scr, lane);
    }
    rot = (rot + nit) % NGW;
}
__device__ __forceinline__ void init_stream_bf16(const float* src, bf16_t* dst, float* ssp, int gw, int NGW, int lane) {
    for (int m = gw; m < T_; m += NGW) {
        const f32x4* xr = (const f32x4*)(src + (size_t)m * D_) + lane;
        u32x2 o[4]; float s = 0.f;
#pragma unroll
        for (int j = 0; j < 4; ++j) { const f32x4 v = xr[64 * j]; o[j].x = pk2(v.x, v.y); o[j].y = pk2(v.z, v.w);
            const float a = bflo(o[j].x), b = bfhi(o[j].x), c = bflo(o[j].y), d = bfhi(o[j].y); s += (a * a + b * b) + (c * c + d * d); }
        const float st = wave_sum(s); if (lane < 4) ssp[(size_t)m * 4 + lane] = lane == 0 ? st : 0.f;
        u32x2* o8 = (u32x2*)(dst + (size_t)m * D_) + lane;
#pragma unroll
        for (int j = 0; j < 4; ++j) o8[64 * j] = o[j];
    }
}
__device__ __forceinline__ void final_norm_rows(const bf16_t* hb, const float* __restrict__ g, float* out, int gw, int NGW, int lane) {
    f32x4 gv[4];
#pragma unroll
    for (int j = 0; j < 4; ++j) gv[j] = *(const f32x4*)(g + 4 * lane + 256 * j);
    for (int m = gw; m < T_; m += NGW) {
        const u32x2* hr = (const u32x2*)(hb + (size_t)m * D_) + lane;
        f32x4 v[4]; float s = 0.f;
#pragma unroll
        for (int j = 0; j < 4; ++j) { const u32x2 w = hr[64 * j]; v[j] = (f32x4){bflo(w.x), bfhi(w.x), bflo(w.y), bfhi(w.y)}; s += (v[j].x * v[j].x + v[j].y * v[j].y) + (v[j].z * v[j].z + v[j].w * v[j].w); }
        const float rs = 1.0f / sqrtf(wave_sum(s) * (1.f / D_) + EPS);
        f32x4* xr = (f32x4*)(out + (size_t)m * D_) + lane;
#pragma unroll
        for (int j = 0; j < 4; ++j) xr[64 * j] = v[j] * rs * gv[j];
    }
}
__device__ __forceinline__ void nsa_b1eff(const float* __restrict__ pos, const float* __restrict__ w1, const float* __restrict__ b1, float* B1E, int gw, int NGW, int lane) {
    for (int o = gw; o < 128; o += NGW) { const int kv = o >> 6, j = o & 63; float s = 0.f;
#pragma unroll 8
        for (int i = 0; i < 32; ++i) { const int kk = lane + 64 * i; s += pos[kv * 2048 + kk] * w1[((size_t)kv * 2048 + kk) * 64 + j]; }
        s = wave_sum(s); if (lane == 0) B1E[o] = s + b1[o]; }
}
__device__ __forceinline__ f32x4 mfma16(bf16x8 a, bf16x8 b, f32x4 c) { return __builtin_amdgcn_mfma_f32_16x16x32_bf16(a, b, c, 0, 0, 0); }
__device__ __forceinline__ void unpack8(const u32x4 w, float (&f)[8]) { f[0] = bflo(w.x); f[1] = bfhi(w.x); f[2] = bflo(w.y); f[3] = bfhi(w.y); f[4] = bflo(w.z); f[5] = bfhi(w.z); f[6] = bflo(w.w); f[7] = bfhi(w.w); }
__device__ __forceinline__ u32x4 pack8f(const float (&f)[8]) { u32x4 w; w.x = pk2(f[0], f[1]); w.y = pk2(f[2], f[3]); w.z = pk2(f[4], f[5]); w.w = pk2(f[6], f[7]); return w; }

__device__ __forceinline__ float neg_expm1(float x) {
    const float p = 1.f + x * (0.5f + x * (0.16666667f + x * (0.041666668f + x * (0.0083333338f + x * 0.0013888889f))));
    const float big = 1.f - fast_exp2(x * LOG2E);
    return x > -0.3f ? -x * p : big;
}
__device__ __forceinline__ void lru_gates_phase(LAS unsigned char* lds, const bf16_t* X, const float* __restrict__ conv_w, const float* __restrict__ conv_b,
        const bf16_t* WAT, const bf16_t* WXT, const float* __restrict__ b_a, const float* __restrict__ b_x, const float* __restrict__ lam,
        bf16_t* HL, bf16_t* AC, float* AGGA, float* AGGH, const int tid, const int bid, const int G) {
    const int lane = tid & 63, wid = __builtin_amdgcn_readfirstlane(tid >> 6), fr = lane & 15, fq = lane >> 4;
    constexpr int SA = 0, SBA = 34816, SBX = 69632, SAF = 0, SUF = 67584, SAGG = 135168, LDA_ = 272, LDF = 528;
    for (int u = bid; u < 1280; u += G) {
        const int tt = u / 10, hd = u - tt * 10, m0 = tt * 128, cbase = hd * 128;
        { const int c8 = tid & 15, r = tid >> 4, ch = cbase + 8 * c8;
          float cw[4][8], cb[8];
#pragma unroll
          for (int k = 0; k < 4; ++k) { const f32x4 w0 = *(const f32x4*)(conv_w + k * RNN + ch), w1 = *(const f32x4*)(conv_w + k * RNN + ch + 4);
              cw[k][0] = w0[0]; cw[k][1] = w0[1]; cw[k][2] = w0[2]; cw[k][3] = w0[3]; cw[k][4] = w1[0]; cw[k][5] = w1[1]; cw[k][6] = w1[2]; cw[k][7] = w1[3]; }
          { const f32x4 w0 = *(const f32x4*)(conv_b + ch), w1 = *(const f32x4*)(conv_b + ch + 4); cb[0] = w0[0]; cb[1] = w0[1]; cb[2] = w0[2]; cb[3] = w0[3]; cb[4] = w1[0]; cb[5] = w1[1]; cb[6] = w1[2]; cb[7] = w1[3]; }
#pragma unroll
          for (int g = 0; g < 4; ++g) { const int row = r + 32 * g, m = m0 + row, ts = m & (SEQ - 1);
              float acc[8];
#pragma unroll
              for (int e = 0; e < 8; ++e) acc[e] = cb[e];
#pragma unroll
              for (int k = 0; k < 4; ++k) { const bool okk = ts - 3 + k >= 0;
                  const u32x4 xv = *(const u32x4*)(X + (size_t)(okk ? m - 3 + k : m) * RNN + ch); float xf[8]; unpack8(xv, xf); const float zk = okk ? 1.f : 0.f;
#pragma unroll
                  for (int e = 0; e < 8; ++e) acc[e] += cw[k][e] * (xf[e] * zk); }
              *(LAS u32x4*)(lds + SA + row * LDA_ + c8 * 16) = pack8f(acc); } }
#pragma unroll
        for (int i = 0; i < 8; ++i) { const int q = tid + 512 * i, mat = q >> 11, j = (q >> 4) & 127, c = q & 15;
            const u32x4 v = *(const u32x4*)((mat ? WXT : WAT) + hd * 16384 + j * 128 + c * 8);
            *(LAS u32x4*)(lds + (mat ? SBX : SBA) + j * LDA_ + c * 16) = v; }
        __syncthreads();
        const int rg = wid >> 1, chh = wid & 1;
        f32x4 acca[2][4], accx[2][4];
#pragma unroll
        for (int mt = 0; mt < 2; ++mt)
#pragma unroll
            for (int nt = 0; nt < 4; ++nt) { acca[mt][nt] = (f32x4){0.f, 0.f, 0.f, 0.f}; accx[mt][nt] = (f32x4){0.f, 0.f, 0.f, 0.f}; }
#pragma unroll
        for (int s = 0; s < 4; ++s) { bf16x8 af[2];
#pragma unroll
            for (int mt = 0; mt < 2; ++mt) af[mt] = *(const LAS bf16x8*)(lds + SA + (32 * rg + 16 * mt + fr) * LDA_ + (32 * s + 8 * fq) * 2);
#pragma unroll
            for (int nt = 0; nt < 4; ++nt) { const bf16x8 ba = *(const LAS bf16x8*)(lds + SBA + (64 * chh + 16 * nt + fr) * LDA_ + (32 * s + 8 * fq) * 2);
                const bf16x8 bx = *(const LAS bf16x8*)(lds + SBX + (64 * chh + 16 * nt + fr) * LDA_ + (32 * s + 8 * fq) * 2);
#pragma unroll
                for (int mt = 0; mt < 2; ++mt) { acca[mt][nt] = mfma16(ba, af[mt], acca[mt][nt]); accx[mt][nt] = mfma16(bx, af[mt], accx[mt][nt]); } } }
        u32x2 xcv[2][4];
#pragma unroll
        for (int mt = 0; mt < 2; ++mt)
#pragma unroll
            for (int nt = 0; nt < 4; ++nt) xcv[mt][nt] = *(const LAS u32x2*)(lds + SA + (32 * rg + 16 * mt + fr) * LDA_ + (64 * chh + 16 * nt + 4 * fq) * 2);
        __syncthreads();
#pragma unroll
        for (int nt = 0; nt < 4; ++nt) { const int cc = cbase + 64 * chh + 16 * nt + 4 * fq;
            const f32x4 ba4 = *(const f32x4*)(b_a + cc), bx4 = *(const f32x4*)(b_x + cc), lm4 = *(const f32x4*)(lam + cc);
            f32x4 nl8;
#pragma unroll
            for (int j = 0; j < 4; ++j) nl8[j] = -8.f * 0.6931471805599453f * __builtin_amdgcn_logf(1.f + fast_exp2(-lm4[j] * LOG2E));
#pragma unroll
            for (int mt = 0; mt < 2; ++mt) { const float xc4[4] = {bflo(xcv[mt][nt].x), bfhi(xcv[mt][nt].x), bflo(xcv[mt][nt].y), bfhi(xcv[mt][nt].y)};
                f32x4 a4, u4;
#pragma unroll
                for (int j = 0; j < 4; ++j) { const float r = sigmoidf_(acca[mt][nt][j] + ba4[j]), ig = sigmoidf_(accx[mt][nt][j] + bx4[j]);
                    const float la = nl8[j] * r; a4[j] = fast_exp2(la * LOG2E); u4[j] = __builtin_amdgcn_sqrtf(neg_expm1(2.f * la)) * ig * xc4[j]; }
                const int off = (32 * rg + 16 * mt + fr) * LDF + (64 * chh + 16 * nt + 4 * fq) * 4;
                *(LAS f32x4*)(lds + SAF + off) = a4; *(LAS f32x4*)(lds + SUF + off) = u4; } }
        __syncthreads();
        { const int ch = tid & 127, seg = tid >> 7;
          LAS float* pa = (LAS float*)(lds + SAF) + ch; LAS float* pu = (LAS float*)(lds + SUF) + ch; LAS float* ag = (LAS float*)(lds + SAGG);
          float A = 1.f, H = 0.f;
#pragma unroll 8
          for (int t = seg * 32; t < seg * 32 + 32; ++t) { const float a = pa[t * (LDF / 4)], uu = pu[t * (LDF / 4)]; H = a * H + uu; A *= a; }
          ag[seg * 128 + ch] = A; ag[512 + seg * 128 + ch] = H;
          __syncthreads();
          float cA = 1.f, cH = 0.f;
          for (int s = 0; s < seg; ++s) { const float As = ag[s * 128 + ch], Hs = ag[512 + s * 128 + ch]; cH = As * cH + Hs; cA *= As; }
#pragma unroll 8
          for (int t = seg * 32; t < seg * 32 + 32; ++t) { const float a = pa[t * (LDF / 4)], uu = pu[t * (LDF / 4)]; cH = a * cH + uu; cA *= a; pa[t * (LDF / 4)] = cA; pu[t * (LDF / 4)] = cH; }
          if (seg == 3) { AGGA[(size_t)tt * RNN + cbase + ch] = cA; AGGH[(size_t)tt * RNN + cbase + ch] = cH; } }
        __syncthreads();
#pragma unroll
        for (int i = 0; i < 4; ++i) { const int q = tid + 512 * i, row = q >> 4, c8 = q & 15;
            const f32x4 a0 = *(const LAS f32x4*)(lds + SAF + row * LDF + c8 * 32), a1 = *(const LAS f32x4*)(lds + SAF + row * LDF + c8 * 32 + 16);
            const f32x4 h0 = *(const LAS f32x4*)(lds + SUF + row * LDF + c8 * 32), h1 = *(const LAS f32x4*)(lds + SUF + row * LDF + c8 * 32 + 16);
            u32x4 wa, wh; wa.x = pk2(a0[0], a0[1]); wa.y = pk2(a0[2], a0[3]); wa.z = pk2(a1[0], a1[1]); wa.w = pk2(a1[2], a1[3]);
            wh.x = pk2(h0[0], h0[1]); wh.y = pk2(h0[2], h0[3]); wh.z = pk2(h1[0], h1[1]); wh.w = pk2(h1[2], h1[3]);
            const size_t go = (size_t)(m0 + row) * RNN + cbase + 8 * c8;
            *(u32x4*)(AC + go) = wa; *(u32x4*)(HL + go) = wh; }
        __syncthreads();
    }
}
__device__ __forceinline__ void lru_apply_phase(const bf16_t* GB, bf16_t* YO, const bf16_t* HL, const bf16_t* AC, const float* AGGA, const float* AGGH, const int tid, const int bid, const int G) {
    const int c8 = tid & 31, r = tid >> 5;
    for (int u = bid; u < 640; u += G) {
        const int tt = u / 5, cb = u - tt * 5, m0 = tt * 128, ch = cb * 256 + 8 * c8;
        float carry[8];
#pragma unroll
        for (int e = 0; e < 8; ++e) carry[e] = 0.f;
        { const int p0 = tt & ~63; int p = p0;
          for (; p + 8 <= tt; p += 8) { f32x4 a0[8], a1[8], h0[8], h1[8];
#pragma unroll
              for (int q = 0; q < 8; ++q) { const size_t o = (size_t)(p + q) * RNN + ch; a0[q] = *(const f32x4*)(AGGA + o); a1[q] = *(const f32x4*)(AGGA + o + 4); h0[q] = *(const f32x4*)(AGGH + o); h1[q] = *(const f32x4*)(AGGH + o + 4); }
#pragma unroll
              for (int q = 0; q < 8; ++q)
#pragma unroll
                  for (int e = 0; e < 4; ++e) { carry[e] = carry[e] * a0[q][e] + h0[q][e]; carry[4 + e] = carry[4 + e] * a1[q][e] + h1[q][e]; } }
          for (; p < tt; ++p) { const size_t o = (size_t)p * RNN + ch; const f32x4 a0 = *(const f32x4*)(AGGA + o), a1 = *(const f32x4*)(AGGA + o + 4), h0 = *(const f32x4*)(AGGH + o), h1 = *(const f32x4*)(AGGH + o + 4);
#pragma unroll
              for (int e = 0; e < 4; ++e) { carry[e] = carry[e] * a0[e] + h0[e]; carry[4 + e] = carry[4 + e] * a1[e] + h1[e]; } } }
#pragma unroll
        for (int i = 0; i < 8; ++i) { const size_t go = (size_t)(m0 + r + 16 * i) * RNN + ch;
            float g[8], hl[8], ac[8], y[8]; unpack8(*(const u32x4*)(GB + go), g); unpack8(*(const u32x4*)(HL + go), hl); unpack8(*(const u32x4*)(AC + go), ac);
#pragma unroll
            for (int e = 0; e < 8; ++e) y[e] = g[e] * (hl[e] + ac[e] * carry[e]);
            *(u32x4*)(YO + go) = pack8f(y); }
    }
}
__device__ __forceinline__ s16x4 tr_read(const LAS unsigned char* p) { typedef short v4i16_t __attribute__((ext_vector_type(4))); return __builtin_bit_cast(s16x4, __builtin_amdgcn_ds_read_tr16_b64_v4i16((LAS v4i16_t*)p)); }
__device__ __forceinline__ bf16x8 cat44(s16x4 lo, s16x4 hi) { return (bf16x8){lo[0], lo[1], lo[2], lo[3], hi[0], hi[1], hi[2], hi[3]}; }
__device__ __forceinline__ void gla_cum(LAS unsigned char* lds, const float* GL, const float* __restrict__ w_g2, const float* __restrict__ b_g2, int m0, int h, const int tid, const int bid, const int G) {

    LAS float* sGL = (LAS float*)lds; LAS float* sSeg = (LAS float*)(lds + 4096); LAS float* sB = (LAS float*)(lds + 8192);
    if (tid < 256) *(LAS f32x4*)(sGL + tid * 4) = *(const f32x4*)(GL + (size_t)m0 * 16 + tid * 4);
    const int d = tid & 127, tq = tid >> 7, dch = h * 128 + d;
    float w[16];
#pragma unroll
    for (int r = 0; r < 16; ++r) w[r] = w_g2[r * 512 + dch];
    const float bb = b_g2[dch];
    __syncthreads();
    float run = 0.f;
#pragma unroll 4
    for (int i = 0; i < 16; ++i) { const int t = tq * 16 + i; float z = bb;
#pragma unroll
        for (int r4 = 0; r4 < 4; ++r4) { const f32x4 gv = *(const LAS f32x4*)(sGL + t * 16 + r4 * 4); z += gv[0] * w[r4 * 4] + gv[1] * w[r4 * 4 + 1] + gv[2] * w[r4 * 4 + 2] + gv[3] * w[r4 * 4 + 3]; }
        const float la = -(__builtin_amdgcn_logf(1.f + fast_exp2(-fabsf(z) * LOG2E)) * 0.6931471805599453f + fmaxf(-z, 0.f)) * 0.0625f;
        run += la; sB[t * 128 + d] = run; }
    sSeg[tq * 128 + d] = run;
    __syncthreads();
    float pre = 0.f;
    for (int s = 0; s < tq; ++s) pre += sSeg[s * 128 + d];
#pragma unroll 4
    for (int i = 0; i < 16; ++i) sB[(tq * 16 + i) * 128 + d] += pre;
    __syncthreads();
}
__device__ __forceinline__ void gla_kv_phase(LAS unsigned char* lds, const bf16_t* Kg, const bf16_t* Vg, const float* GL, const float* w_g2, const float* b_g2, bf16_t* KVT, float* DEC, const int tid, const int bid, const int G) {
    const int lane = tid & 63, wid = __builtin_amdgcn_readfirstlane(tid >> 6), fr = lane & 15, fq = lane >> 4, q4 = (lane & 15) >> 2, p4 = lane & 3;
    constexpr int SB_ = 8192, SK = 40960, SV = 58368, LDK = 272, LDV = 528;
    const LAS float* sB = (const LAS float*)(lds + SB_);
    for (int u = bid; u < 1024; u += G) {
        const int b = u >> 9, n = (u >> 2) & 127, h = u & 3, m0 = b * SEQ + 64 * n, bh = b * 4 + h;
        gla_cum(lds, GL, w_g2, b_g2, m0, h, tid, bid, G);
#pragma unroll
        for (int i = 0; i < 2; ++i) { const int q = tid + 512 * i, t = q >> 4, c = q & 15; float kf[8]; unpack8(*(const u32x4*)(Kg + (size_t)(m0 + t) * 512 + h * 128 + 8 * c), kf);
#pragma unroll
            for (int e = 0; e < 8; ++e) kf[e] *= fast_exp2((sB[63 * 128 + 8 * c + e] - sB[t * 128 + 8 * c + e]) * LOG2E);
            *(LAS u32x4*)(lds + SK + t * LDK + c * 16) = pack8f(kf); }
        if (tid < 128) DEC[((size_t)bh * 128 + n) * 128 + tid] = fast_exp2(sB[63 * 128 + tid] * LOG2E);
#pragma unroll
        for (int i = 0; i < 4; ++i) { const int q = tid + 512 * i, t = q >> 5, c = q & 31; *(LAS u32x4*)(lds + SV + t * LDV + c * 16) = *(const u32x4*)(Vg + (size_t)(m0 + t) * 1024 + h * 256 + 8 * c); }
        __syncthreads();
        f32x4 acc[8][2];
#pragma unroll
        for (int mt = 0; mt < 8; ++mt) { acc[mt][0] = (f32x4){0.f, 0.f, 0.f, 0.f}; acc[mt][1] = (f32x4){0.f, 0.f, 0.f, 0.f}; }
#pragma unroll
        for (int s = 0; s < 2; ++s) { bf16x8 bv[2];
#pragma unroll
            for (int nl = 0; nl < 2; ++nl) { const LAS unsigned char* pv = lds + SV + (32 * s + 8 * fq + q4) * LDV + (32 * wid + 16 * nl + 4 * p4) * 2; bv[nl] = cat44(tr_read(pv), tr_read(pv + 4 * LDV)); }
#pragma unroll
            for (int mt = 0; mt < 8; ++mt) { const LAS unsigned char* pk = lds + SK + (32 * s + 8 * fq + q4) * LDK + (16 * mt + 4 * p4) * 2; const bf16x8 ak = cat44(tr_read(pk), tr_read(pk + 4 * LDK));
                acc[mt][0] = mfma16(ak, bv[0], acc[mt][0]); acc[mt][1] = mfma16(ak, bv[1], acc[mt][1]); } }
        bf16_t* dst = KVT + ((size_t)bh * 128 + n) * 32768;
#pragma unroll
        for (int mt = 0; mt < 8; ++mt)
#pragma unroll
            for (int nl = 0; nl < 2; ++nl) { u32x2 w; w.x = pk2(acc[mt][nl][0], acc[mt][nl][1]); w.y = pk2(acc[mt][nl][2], acc[mt][nl][3]);
                *(u32x2*)(dst + (32 * wid + 16 * nl + fr) * 128 + 16 * mt + 4 * fq) = w; }
        __syncthreads();
    }
}
__device__ __forceinline__ void gla_scan_phase(bf16_t* KVT, const float* DEC, const bool dry, const int tid, const int bid, const int G) {
    const int nthr = G * 512;
    for (int e2 = bid * 512 + tid; e2 < 8 * 16384; e2 += nthr) {
        const int bh = e2 >> 14, e = (e2 & 16383) * 2, dk = e & 127;
        unsigned* p = (unsigned*)(KVT + (size_t)bh * 128 * 32768 + e); const float* dp = DEC + (size_t)bh * 128 * 128 + dk;
        float s0 = 0.f, s1 = 0.f;
        for (int n0 = 0; n0 < 128; n0 += 8) { unsigned w[8]; f32x2 d2[8];
#pragma unroll
            for (int i = 0; i < 8; ++i) { w[i] = p[(size_t)(n0 + i) * 16384]; d2[i] = *(const f32x2*)(dp + (n0 + i) * 128); }
#pragma unroll
            for (int i = 0; i < 8; ++i) { if (!dry) p[(size_t)(n0 + i) * 16384] = pk2(s0, s1); s0 = s0 * d2[i].x + bflo(w[i]); s1 = s1 * d2[i].y + bfhi(w[i]); } }
    }
}
__device__ __forceinline__ void gla_out_phase(LAS unsigned char* lds, const bf16_t* Qg, const bf16_t* Kg, const bf16_t* Vg, const bf16_t* Rg, const float* GL, const float* w_g2, const float* b_g2,
        const float* __restrict__ norm_g, const bf16_t* KVT, bf16_t* Y, const int tid, const int bid, const int G) {
    const int lane = tid & 63, wid = __builtin_amdgcn_readfirstlane(tid >> 6), fr = lane & 15, fq = lane >> 4, q4 = (lane & 15) >> 2, p4 = lane & 3;
    constexpr int SB_ = 8192, SQ = 40960, SKI = 58368, SV = 75776, SATT = 109568, SSS = 118784, LDQ = 272, LDV = 528, LDAT = 144;
    const LAS float* sB = (const LAS float*)(lds + SB_);
    for (int u = bid; u < 1024; u += G) {
        const int b = u >> 9, n = (u >> 2) & 127, h = u & 3, m0 = b * SEQ + 64 * n, bh = b * 4 + h;
        bf16x8 bsall[4][2];
        { const bf16_t* Sp = KVT + ((size_t)bh * 128 + n) * 32768;
#pragma unroll
          for (int s = 0; s < 4; ++s)
#pragma unroll
              for (int nl = 0; nl < 2; ++nl) bsall[s][nl] = *(const bf16x8*)(Sp + (32 * wid + 16 * nl + fr) * 128 + 32 * s + 8 * fq); }
        gla_cum(lds, GL, w_g2, b_g2, m0, h, tid, bid, G);
#pragma unroll
        for (int i = 0; i < 2; ++i) { const int q = tid + 512 * i, t = q >> 4, c = q & 15; float qf[8], kf[8];
            unpack8(*(const u32x4*)(Qg + (size_t)(m0 + t) * 512 + h * 128 + 8 * c), qf); unpack8(*(const u32x4*)(Kg + (size_t)(m0 + t) * 512 + h * 128 + 8 * c), kf);
#pragma unroll
            for (int e = 0; e < 8; ++e) { const float bb = sB[t * 128 + 8 * c + e] * LOG2E; qf[e] *= fast_exp2(bb); kf[e] *= fast_exp2(-bb); }
            *(LAS u32x4*)(lds + SQ + t * LDQ + c * 16) = pack8f(qf); *(LAS u32x4*)(lds + SKI + t * LDQ + c * 16) = pack8f(kf); }
#pragma unroll
        for (int i = 0; i < 4; ++i) { const int q = tid + 512 * i, t = q >> 5, c = q & 31; *(LAS u32x4*)(lds + SV + t * LDV + c * 16) = *(const u32x4*)(Vg + (size_t)(m0 + t) * 1024 + h * 256 + 8 * c); }
        __syncthreads();
        { const int mt = wid >> 1; f32x4 at[2] = {(f32x4){0.f, 0.f, 0.f, 0.f}, (f32x4){0.f, 0.f, 0.f, 0.f}};
#pragma unroll
          for (int s = 0; s < 4; ++s) { const bf16x8 a = *(const LAS bf16x8*)(lds + SQ + (16 * mt + fr) * LDQ + (32 * s + 8 * fq) * 2);
#pragma unroll
              for (int nl = 0; nl < 2; ++nl) { const int nt = 2 * (wid & 1) + nl; const bf16x8 bk = *(const LAS bf16x8*)(lds + SKI + (16 * nt + fr) * LDQ + (32 * s + 8 * fq) * 2); at[nl] = mfma16(bk, a, at[nl]); } }
#pragma unroll
          for (int nl = 0; nl < 2; ++nl) { const int nt = 2 * (wid & 1) + nl, c = 16 * mt + fr, j0 = 16 * nt + 4 * fq; float v[4];
#pragma unroll
              for (int j = 0; j < 4; ++j) v[j] = (j0 + j <= c) ? at[nl][j] : 0.f;
              u32x2 w; w.x = pk2(v[0], v[1]); w.y = pk2(v[2], v[3]); *(LAS u32x2*)(lds + SATT + c * LDAT + j0 * 2) = w; } }
        __syncthreads();
        f32x4 o[4][2];
#pragma unroll
        for (int mt = 0; mt < 4; ++mt) { o[mt][0] = (f32x4){0.f, 0.f, 0.f, 0.f}; o[mt][1] = (f32x4){0.f, 0.f, 0.f, 0.f}; }
#pragma unroll
        for (int s = 0; s < 2; ++s) { bf16x8 bv[2];
#pragma unroll
            for (int nl = 0; nl < 2; ++nl) { const LAS unsigned char* pv = lds + SV + (32 * s + 8 * fq + q4) * LDV + (32 * wid + 16 * nl + 4 * p4) * 2; bv[nl] = cat44(tr_read(pv), tr_read(pv + 4 * LDV)); }
#pragma unroll
            for (int mt = 0; mt < 4; ++mt) { const bf16x8 a = *(const LAS bf16x8*)(lds + SATT + (16 * mt + fr) * LDAT + (32 * s + 8 * fq) * 2);
                o[mt][0] = mfma16(bv[0], a, o[mt][0]); o[mt][1] = mfma16(bv[1], a, o[mt][1]); } }
#pragma unroll
        for (int s = 0; s < 4; ++s) {
#pragma unroll
            for (int mt = 0; mt < 4; ++mt) { const bf16x8 a = *(const LAS bf16x8*)(lds + SQ + (16 * mt + fr) * LDQ + (32 * s + 8 * fq) * 2);
                o[mt][0] = mfma16(bsall[s][0], a, o[mt][0]); o[mt][1] = mfma16(bsall[s][1], a, o[mt][1]); } }
        LAS float* sSS = (LAS float*)(lds + SSS);
#pragma unroll
        for (int mt = 0; mt < 4; ++mt) { float ss = 0.f;
#pragma unroll
            for (int nl = 0; nl < 2; ++nl)
#pragma unroll
                for (int j = 0; j < 4; ++j) ss += o[mt][nl][j] * o[mt][nl][j];
            ss += __shfl_xor(ss, 16); ss += __shfl_xor(ss, 32);
            if (fq == 0) sSS[(16 * mt + fr) * 8 + wid] = ss; }
        __syncthreads();
#pragma unroll
        for (int mt = 0; mt < 4; ++mt) { const int tok = 16 * mt + fr; const f32x4 s0 = *(const LAS f32x4*)(sSS + tok * 8), s1 = *(const LAS f32x4*)(sSS + tok * 8 + 4);
            const float tot = ((s0[0] + s0[1]) + (s0[2] + s0[3])) + ((s1[0] + s1[1]) + (s1[2] + s1[3])); const float rs = __builtin_amdgcn_rsqf(tot * (1.f / 256.f) + EPS);
#pragma unroll
            for (int nl = 0; nl < 2; ++nl) { const int dv = 32 * wid + 16 * nl + 4 * fq; const f32x4 gn = *(const f32x4*)(norm_g + dv);
                const size_t go = (size_t)(m0 + tok) * 1024 + h * 256 + dv; const u32x2 rv = *(const u32x2*)(Rg + go);
                u32x2 w; w.x = pk2(o[mt][nl][0] * rs * gn[0] * bflo(rv.x), o[mt][nl][1] * rs * gn[1] * bfhi(rv.x)); w.y = pk2(o[mt][nl][2] * rs * gn[2] * bflo(rv.y), o[mt][nl][3] * rs * gn[3] * bfhi(rv.y));
                *(u32x2*)(Y + go) = w; } }
        __syncthreads();
    }
}
__device__ __forceinline__ void nsa_compress_phase(LAS unsigned char* lds, const bf16_t* KV, const float* __restrict__ pos, const float* __restrict__ w1, const float* __restrict__ b1,
        const float* __restrict__ b2, const bf16_t* W1T, const bf16_t* W2T, bf16_t* KC, bf16_t* VC, bf16_t* VT, const float* B1E, const int tid, const int bid, const int G) {
    const int lane = tid & 63, wid = __builtin_amdgcn_readfirstlane(tid >> 6), fr = lane & 15, fq = lane >> 4;
    constexpr int SP = 0, SB1 = 2048, SPART = 4096, SH = 36864, LDH = 144;
    for (int u = bid; u < 256; u += G) {
        const int kv = u >> 7, b = (u >> 6) & 1, g = (u >> 4) & 3, n0 = (u & 15) * 32;
        if (tid < 64) ((LAS float*)(lds + SB1))[tid] = B1E[kv * 64 + tid];
        { const int rt = wid & 1, kq = wid >> 1, n = n0 + 16 * rt + fr; const bool ok = n <= 510;
          const bf16_t* src = KV + (size_t)kv * T_ * 256 + (size_t)(b * SEQ + 16 * (ok ? n : 0)) * 256 + g * 64;
          const bf16_t* wt = W1T + (size_t)kv * 64 * 2048;
          f32x4 acc[4] = {(f32x4){0.f, 0.f, 0.f, 0.f}, (f32x4){0.f, 0.f, 0.f, 0.f}, (f32x4){0.f, 0.f, 0.f, 0.f}, (f32x4){0.f, 0.f, 0.f, 0.f}};
#pragma unroll 4
          for (int s = 0; s < 16; ++s) { const int kk = kq * 512 + 32 * s + 8 * fq, l = kk >> 6, d = kk & 63;
              bf16x8 a = *(const bf16x8*)(src + (size_t)l * 256 + d); if (!ok) a = (bf16x8){0, 0, 0, 0, 0, 0, 0, 0};
#pragma unroll
              for (int nt = 0; nt < 4; ++nt) { const bf16x8 bb = *(const bf16x8*)(wt + (size_t)(16 * nt + fr) * 2048 + kk); acc[nt] = mfma16(bb, a, acc[nt]); } }
#pragma unroll
          for (int nt = 0; nt < 4; ++nt) *(LAS f32x4*)(lds + SPART + ((kq * 2 + rt) * 1024 + fr * 64 + 16 * nt + 4 * fq) * 4) = acc[nt]; }
        __syncthreads();
        { const int row = tid >> 4, c4 = (tid & 15) * 4, rt = row >> 4, rr = row & 15; f32x4 s = *(const LAS f32x4*)(lds + SB1 + c4 * 4);
#pragma unroll
          for (int kq = 0; kq < 4; ++kq) s += *(const LAS f32x4*)(lds + SPART + ((kq * 2 + rt) * 1024 + rr * 64 + c4) * 4);
          u32x2 w; w.x = pk2(gelu_tanh_(s[0]), gelu_tanh_(s[1])); w.y = pk2(gelu_tanh_(s[2]), gelu_tanh_(s[3])); *(LAS u32x2*)(lds + SH + row * LDH + c4 * 2) = w; }
        __syncthreads();
        { const int rt = wid >> 2, nt = wid & 3; f32x4 acc = (f32x4){0.f, 0.f, 0.f, 0.f};
#pragma unroll
          for (int s = 0; s < 2; ++s) { const bf16x8 a = *(const LAS bf16x8*)(lds + SH + (16 * rt + fr) * LDH + (32 * s + 8 * fq) * 2);
              const bf16x8 bb = *(const bf16x8*)(W2T + kv * 4096 + (16 * nt + fr) * 64 + 32 * s + 8 * fq); acc = mfma16(bb, a, acc); }
          const int n = n0 + 16 * rt + fr, d = 16 * nt + 4 * fq; const f32x4 bv = *(const f32x4*)(b2 + kv * 64 + d);
          u32x2 w; w.x = pk2(acc[0] + bv[0], acc[1] + bv[1]); w.y = pk2(acc[2] + bv[2], acc[3] + bv[3]);
          *(u32x2*)((kv ? VC : KC) + ((size_t)(b * 4 + g) * 512 + n) * 64 + d) = w; }
        __syncthreads();
    }
    { const bf16_t* VS = KV + (size_t)3 * T_ * 256;
      for (int tt = bid; tt < T_ / 64; tt += G) { const int r0 = tt * 64, bb = r0 >> 13, t0 = r0 & 8191;
#pragma unroll
          for (int i = 0; i < 4; ++i) { const int q = tid + 512 * i, row = q >> 5, ch = q & 31; *(LAS u32x4*)(lds + row * 528 + ch * 16) = *(const u32x4*)(VS + (size_t)(r0 + row) * 256 + ch * 8); }
          __syncthreads();
          { const int cc = tid >> 1, hf = tid & 1; unsigned short v[32];
#pragma unroll
            for (int k = 0; k < 32; ++k) v[k] = *(const LAS unsigned short*)(lds + (hf * 32 + k) * 528 + cc * 2);
            bf16_t* dst = VT + ((size_t)(bb * 256 + cc)) * 8192 + t0 + hf * 32;
#pragma unroll
            for (int k = 0; k < 4; ++k) { u32x4 w; w.x = v[8 * k] | ((unsigned)v[8 * k + 1] << 16); w.y = v[8 * k + 2] | ((unsigned)v[8 * k + 3] << 16); w.z = v[8 * k + 4] | ((unsigned)v[8 * k + 5] << 16); w.w = v[8 * k + 6] | ((unsigned)v[8 * k + 7] << 16);
                *(u32x4*)(dst + 8 * k) = w; } }
          __syncthreads(); } }
}
#ifndef NSA_LOCKSTEP
#define NSA_LOCKSTEP 0
#endif
#ifndef NSA_ONE_WAVE
#define NSA_ONE_WAVE 0
#endif
#ifndef NSA_SPARSE_SKIP
#define NSA_SPARSE_SKIP 0
#endif
#ifndef NSA_CT3_ONLY
#define NSA_CT3_ONLY 0
#endif
#ifndef NSA_SEL_REP
#define NSA_SEL_REP 1
#endif
#ifndef NSA_WIN_REP
#define NSA_WIN_REP 1
#endif
struct NsaSt { float m, l; f32x4 o[4]; };
struct KVRegs { u32x4 k[2], v[2]; };
template <int MODE, int STEP, int CTM>
__device__ __forceinline__ void nsa_tile(const LAS unsigned char* sK, const LAS unsigned char* sV, const bf16x8 (&qf)[2][2], NsaSt (&st)[2], const int (&dbase)[2],
        const bool general, const bool (&colsel)[2], const LAS float* bt, const float bfar, const float (&minv)[2], LAS float* sMain, LAS float* sSpill, const int (&tokl)[2], const int mg0,
        const int fr_in, const int fq_in, const int q4_in, const int p4_in) {
    constexpr int LDT = 144; const float NEG = -INFINITY;
    int fr = fr_in, fq = fq_in, q4 = q4_in, p4 = p4_in; asm volatile("" : "+v"(fr), "+v"(fq), "+v"(q4), "+v"(p4));
    bf16x8 kf[4][2];
#pragma unroll
    for (int kt = 0; kt < 4; ++kt) { kf[kt][0] = *(const LAS bf16x8*)(sK + (16 * kt + fr) * LDT + (8 * fq) * 2); kf[kt][1] = *(const LAS bf16x8*)(sK + (16 * kt + fr) * LDT + (32 + 8 * fq) * 2); }
    f32x4 sacc[2][4];
#pragma unroll
    for (int ct = 0; ct < 2; ++ct) if (CTM & (1 << ct)) {
#pragma unroll
        for (int kt = 0; kt < 4; ++kt) sacc[ct][kt] = mfma16(kf[kt][0], qf[ct][0], (f32x4){0.f, 0.f, 0.f, 0.f});
#pragma unroll
        for (int kt = 0; kt < 4; ++kt) sacc[ct][kt] = mfma16(kf[kt][1], qf[ct][1], sacc[ct][kt]); }
#pragma unroll
    for (int ct = 0; ct < 2; ++ct) if (CTM & (1 << ct)) {
        float tmax = NEG;
        if (general) {
            float bv[4][4];
#pragma unroll
            for (int kt = 0; kt < 4; ++kt)
#pragma unroll
                for (int j = 0; j < 4; ++j) { const int dist = dbase[ct] - (16 * kt + 4 * fq + j) * STEP; const int idx = dist < 0 ? 0 : (dist > 128 ? 128 : dist); bv[kt][j] = bt[idx]; }
#pragma unroll
            for (int kt = 0; kt < 4; ++kt)
#pragma unroll
                for (int j = 0; j < 4; ++j) { const int dist = dbase[ct] - (16 * kt + 4 * fq + j) * STEP; bool valid = dist >= 0;
                    if (MODE == 3) valid = valid && dist < 512;
                    if (MODE == 2) valid = valid && colsel[ct];
                    const float x = valid ? sacc[ct][kt][j] * LOG2E + bv[kt][j] : NEG;
                    sacc[ct][kt][j] = x; tmax = max3_(tmax, x, x); }
        } else {
#pragma unroll
            for (int kt = 0; kt < 4; ++kt) tmax = max3_(max3_(tmax, sacc[ct][kt][0], sacc[ct][kt][1]), sacc[ct][kt][2], sacc[ct][kt][3]);
            tmax = (MODE == 2 && !colsel[ct]) ? NEG : tmax * LOG2E + bfar;
        }
        if (MODE == 1) {
            const float mm = st[ct].m, li = minv[ct];
#pragma unroll
            for (int kt = 0; kt < 4; ++kt) { float gs = 0.f, p3 = 0.f;
#pragma unroll
                for (int j = 0; j < 4; ++j) { const float xx = general ? sacc[ct][kt][j] : sacc[ct][kt][j] * LOG2E + bfar; const float p = fast_exp2(xx - mm) * li; sacc[ct][kt][j] = p; gs += p; if (j == 3) p3 = p; }
                gs += dpp_xor1(gs); gs += dpp_xor2(gs); p3 += dpp_xor1(p3); p3 += dpp_xor2(p3);
                const int mg = mg0 + 4 * kt + fq;
                if ((fr & 3) == 0) { sMain[tokl[ct] * 128 + mg] = gs; if (mg + 1 < 128) sSpill[tokl[ct] * 128 + mg + 1] = p3; } }
        } else {
            const float rm = xmax16_32(tmax);
            const bool need = rm > st[ct].m + 8.f;
            if (__any(need)) { const float mnew = need ? fmaxf(st[ct].m, rm) : st[ct].m, alpha = (st[ct].m == mnew) ? 1.f : fast_exp2(st[ct].m - mnew);
                st[ct].l *= alpha; st[ct].m = mnew;
                if (MODE != 0) {
#pragma unroll
                    for (int dt = 0; dt < 4; ++dt) st[ct].o[dt] = st[ct].o[dt] * alpha; } }
            const float mref = (st[ct].m == NEG) ? 0.f : st[ct].m;
            float ps = 0.f;
            if (general) {
#pragma unroll
                for (int kt = 0; kt < 4; ++kt)
#pragma unroll
                    for (int j = 0; j < 4; ++j) { const float p = fast_exp2(sacc[ct][kt][j] - mref); sacc[ct][kt][j] = p; ps += p; }
            } else { const float c = (MODE == 2 && !colsel[ct]) ? NEG : bfar - mref;
#pragma unroll
                for (int kt = 0; kt < 4; ++kt)
#pragma unroll
                    for (int j = 0; j < 4; ++j) { const float p = fast_exp2(sacc[ct][kt][j] * LOG2E + c); sacc[ct][kt][j] = p; ps += p; } }
            st[ct].l += ps;
        }
    }
    if (MODE != 0) {
#pragma unroll
        for (int s = 0; s < 2; ++s) { bf16x8 pf[2];
#pragma unroll
            for (int ct = 0; ct < 2; ++ct) if (CTM & (1 << ct)) { u32x4 w; w.x = pk2(sacc[ct][2 * s][0], sacc[ct][2 * s][1]); w.y = pk2(sacc[ct][2 * s][2], sacc[ct][2 * s][3]);
                w.z = pk2(sacc[ct][2 * s + 1][0], sacc[ct][2 * s + 1][1]); w.w = pk2(sacc[ct][2 * s + 1][2], sacc[ct][2 * s + 1][3]); pf[ct] = __builtin_bit_cast(bf16x8, w); }
#pragma unroll
            for (int dt = 0; dt < 4; ++dt) { const LAS unsigned char* pv = sV + (32 * s + 4 * fq + q4) * LDT + (16 * dt + 4 * p4) * 2; const bf16x8 vf = cat44(tr_read(pv), tr_read(pv + 16 * LDT));
#pragma unroll
                for (int ct = 0; ct < 2; ++ct) if (CTM & (1 << ct)) st[ct].o[dt] = mfma16(vf, pf[ct], st[ct].o[dt]); } }
    }
}
__device__ __forceinline__ void nsa_ld2(const bf16_t* Kp, const bf16_t* Vp, size_t ts, int ld, bool two, int tid_in, KVRegs& r) { int tid = tid_in; asm volatile("" : "+v"(tid)); const int key = tid >> 3, c = tid & 7;
    r.k[0] = *(const u32x4*)(Kp + (size_t)key * ld + 8 * c); r.v[0] = *(const u32x4*)(Vp + (size_t)key * ld + 8 * c);
    if (two) { r.k[1] = *(const u32x4*)(Kp + ts + (size_t)key * ld + 8 * c); r.v[1] = *(const u32x4*)(Vp + ts + (size_t)key * ld + 8 * c); } }
__device__ __forceinline__ void nsa_st2(LAS unsigned char* sK, LAS unsigned char* sV, int tid_in, const KVRegs& r) { int tid = tid_in; asm volatile("" : "+v"(tid)); const int key = tid >> 3, c = tid & 7;
    *(LAS u32x4*)(sK + key * 144 + c * 16) = r.k[0]; *(LAS u32x4*)(sV + key * 144 + c * 16) = r.v[0]; *(LAS u32x4*)(sK + 9216 + key * 144 + c * 16) = r.k[1]; *(LAS u32x4*)(sV + 9216 + key * 144 + c * 16) = r.v[1]; }

__device__ __forceinline__ unsigned long long fx_enc(float x) { const float t = x * 16.f, fl = floorf(t); const int hi = (int)fl; const unsigned lo = (unsigned)((t - fl) * 4294967296.f);
    return ((unsigned long long)(unsigned)hi << 32) | (unsigned long long)lo; }
__device__ __forceinline__ float fx_dec(unsigned long long v) { return (float)(int)(unsigned)(v >> 32) * 0.0625f + (float)(unsigned)v * 1.4551915228366852e-11f; }
__device__ __forceinline__ void nsa_sparse_far(const LAS unsigned* sSel, LAS int* slist, const LAS float* sBt, const LAS float* mref, LAS unsigned long long* lfar, LAS unsigned long long* ofar,
        const bf16_t* Qg  , const bf16_t* ksb, const bf16_t* vtb  , const int qb, const int wid, const int lane_in, const int fr_in, const int fq_in) {
    const float NEG = -INFINITY;
    bf16x8 kf[4][2], vf[2][4], kn[4][2];
#define NSA_LDK(KF, MB) do { int fr_ = fr_in, fq_ = fq_in; asm volatile("" : "+v"(fr_), "+v"(fq_)); \
        _Pragma("unroll") for (int kt = 0; kt < 4; ++kt) _Pragma("unroll") for (int s = 0; s < 2; ++s) KF[kt][s] = *(const bf16x8*)(ksb + (size_t)(64 * (MB) + 16 * kt + fr_) * 256 + 32 * s + 8 * fq_); } while (0)
#define NSA_LDV(VF, MB) do { int fr_ = fr_in, fq_ = fq_in; asm volatile("" : "+v"(fr_), "+v"(fq_)); \
        _Pragma("unroll") for (int s = 0; s < 2; ++s) _Pragma("unroll") for (int dt = 0; dt < 4; ++dt) { const bf16_t* pv = vtb + (size_t)(16 * dt + fr_) * SEQ + 64 * (MB) + 32 * s + 4 * fq_; \
            const u32x2 lo = *(const u32x2*)pv, hi = *(const u32x2*)(pv + 16); u32x4 w; w.x = lo.x; w.y = lo.y; w.z = hi.x; w.w = hi.y; VF[s][dt] = __builtin_bit_cast(bf16x8, w); } } while (0)
    if (1 + wid <= qb - 3) NSA_LDK(kf, 1 + wid);
#pragma unroll 1
    for (int m = 1 + wid; m <= qb - 3; m += 8) {
        int fr = fr_in, fq = fq_in, lane = lane_in; asm volatile("" : "+v"(fr), "+v"(fq), "+v"(lane));
        const int hg = fr & 3; const float bfar = sBt[hg * 132 + 128];
        const bool more = m + 8 <= qb - 3;
        NSA_LDV(vf, m);
        if (more) NSA_LDK(kn, m + 8);
        const unsigned w = sSel[lane * 4 + (m >> 5)]; const bool bit = (w >> (m & 31)) & 1u;
        const unsigned long long B = __ballot(bit); const int n = __popcll(B);
        const int rank = (int)__builtin_amdgcn_mbcnt_hi((unsigned)(B >> 32), __builtin_amdgcn_mbcnt_lo((unsigned)B, 0u));
        if (bit) slist[rank] = lane;
        asm volatile("s_waitcnt lgkmcnt(0)" ::: "memory");
        const int nct = (n + 3) >> 2;
        bf16x8 q0, q1; int tok = 0; bool valid = false;
        if (nct > 0) { const int idx = fr >> 2; valid = idx < n; tok = slist[valid ? idx : 0];
            q0 = *(const bf16x8*)(Qg + (size_t)tok * 1024 + hg * 64 + 8 * fq); q1 = *(const bf16x8*)(Qg + (size_t)tok * 1024 + hg * 64 + 32 + 8 * fq); }
#pragma unroll 1
        for (int ct = 0; ct < nct; ++ct) {
            const int col = tok * 4 + hg; const bool vcur = valid; const bf16x8 c0 = q0, c1 = q1;
            if (ct + 1 < nct) { const int idx = 4 * (ct + 1) + (fr >> 2); valid = idx < n; tok = slist[valid ? idx : 0];
                q0 = *(const bf16x8*)(Qg + (size_t)tok * 1024 + hg * 64 + 8 * fq); q1 = *(const bf16x8*)(Qg + (size_t)tok * 1024 + hg * 64 + 32 + 8 * fq); }
            const float c = vcur ? bfar - mref[col] : NEG;
            f32x4 sacc[4];
#pragma unroll
            for (int kt = 0; kt < 4; ++kt) sacc[kt] = mfma16(kf[kt][0], c0, (f32x4){0.f, 0.f, 0.f, 0.f});
#pragma unroll
            for (int kt = 0; kt < 4; ++kt) sacc[kt] = mfma16(kf[kt][1], c1, sacc[kt]);
            float ps = 0.f;
#pragma unroll
            for (int kt = 0; kt < 4; ++kt)
#pragma unroll
                for (int j = 0; j < 4; ++j) { const float p = fminf(fast_exp2(sacc[kt][j] * LOG2E + c), 16384.f); sacc[kt][j] = p; ps += p; }
            ps = xsum16_32(ps);
            if (fq == 0 && vcur) (void)__hip_atomic_fetch_add(lfar + col, fx_enc(ps), __ATOMIC_RELAXED, __HIP_MEMORY_SCOPE_WORKGROUP);
            f32x4 oacc[4] = {(f32x4){0.f, 0.f, 0.f, 0.f}, (f32x4){0.f, 0.f, 0.f, 0.f}, (f32x4){0.f, 0.f, 0.f, 0.f}, (f32x4){0.f, 0.f, 0.f, 0.f}};
#pragma unroll
            for (int s = 0; s < 2; ++s) { u32x4 pw; pw.x = pk2(sacc[2 * s][0], sacc[2 * s][1]); pw.y = pk2(sacc[2 * s][2], sacc[2 * s][3]); pw.z = pk2(sacc[2 * s + 1][0], sacc[2 * s + 1][1]); pw.w = pk2(sacc[2 * s + 1][2], sacc[2 * s + 1][3]);
                const bf16x8 pf = __builtin_bit_cast(bf16x8, pw);
#pragma unroll
                for (int dt = 0; dt < 4; ++dt) oacc[dt] = mfma16(vf[s][dt], pf, oacc[dt]); }
            if (vcur) {
#pragma unroll
                for (int dt = 0; dt < 4; ++dt)
#pragma unroll
                    for (int j = 0; j < 4; ++j) (void)__hip_atomic_fetch_add(ofar + col * 66 + 16 * dt + 4 * fq + j, fx_enc(oacc[dt][j]), __ATOMIC_RELAXED, __HIP_MEMORY_SCOPE_WORKGROUP); }
        }
        asm volatile("s_waitcnt lgkmcnt(0)" ::: "memory");
        if (more) {
#pragma unroll
            for (int kt = 0; kt < 4; ++kt) { kf[kt][0] = kn[kt][0]; kf[kt][1] = kn[kt][1]; } }
    }
#undef NSA_LDK
#undef NSA_LDV
}

#ifndef NSA_SPARSE_QB
#define NSA_SPARSE_QB 24
#endif
__device__ __forceinline__ void nsa_attn_phase(LAS unsigned char* lds, const bf16_t* Q, const bf16_t* KV, const float* GT, const bf16_t* KC, const bf16_t* VC, const float* __restrict__ rel_bias, bf16_t* Y, const bf16_t* VT, void* TQ, const int tid, const int bid, const int G) {
    const int lane = tid & 63, wid = __builtin_amdgcn_readfirstlane(tid >> 6), fr = lane & 15, fq = lane >> 4, q4 = (lane & 15) >> 2, p4 = lane & 3, hg = fr & 3;
    constexpr int SKO = 0, SVO = 36864, SMAIN = 73728, SSPILL = 106496, SBT = 143360, SSEL = 145472, SMREF = 146496, SLFAR = 147520, SLIST = 149568, TB = 9216;
    LAS float* sMain = (LAS float*)(lds + SMAIN); LAS float* sSpill = (LAS float*)(lds + SSPILL); LAS float* sBt = (LAS float*)(lds + SBT); LAS unsigned* sSel = (LAS unsigned*)(lds + SSEL);
    LAS float* sMref = (LAS float*)(lds + SMREF); LAS unsigned long long* sLfar = (LAS unsigned long long*)(lds + SLFAR); LAS unsigned long long* sOfar = (LAS unsigned long long*)lds;
    const float NEG = -INFINITY; (void)TQ;
    for (int ui = 0; ; ++ui) {
        int bg, qb;
        if (G == 256) { if (ui >= 4) break; const int c = bid, s = c >> 3; bg = c & 7; qb = ui == 0 ? s : ui == 1 ? 63 - s : ui == 2 ? 64 + s : 127 - s; }
        else { const int uu = bid + ui * G; if (uu >= 1024) break; bg = uu >> 7; qb = uu & 127; }
        const int b = bg >> 2, g = bg & 3, t0 = 64 * qb, m0 = b * SEQ + t0;
        int tokl[2]; tokl[0] = 8 * wid + (fr >> 2); tokl[1] = tokl[0] + 4;
        bf16x8 qf[2][2];
#pragma unroll
        for (int ct = 0; ct < 2; ++ct)
#pragma unroll
            for (int s = 0; s < 2; ++s) qf[ct][s] = *(const bf16x8*)(Q + (size_t)(m0 + tokl[ct]) * 1024 + (g * 4 + hg) * 64 + 32 * s + 8 * fq);
        int tidz = tid; asm volatile("" : "+v"(tidz));
        for (int i = tidz; i < 4 * 129; i += 512) { const int h = i / 129, dist = i - h * 129; int bk;
            if (dist < 16) bk = dist; else { bk = 16 + (int)(logf((float)dist * (1.f / 16.f)) / 2.0794415416798357f * 16.f); bk = bk > 31 ? 31 : bk; }
            sBt[h * 132 + dist] = rel_bias[bk * 16 + g * 4 + h] * LOG2E; }
#pragma unroll
        for (int i = 0; i < 4; ++i) { *(LAS f32x4*)(lds + SMAIN + (tidz + 512 * i) * 16) = (f32x4){0.f, 0.f, 0.f, 0.f}; *(LAS f32x4*)(lds + SSPILL + (tidz + 512 * i) * 16) = (f32x4){0.f, 0.f, 0.f, 0.f}; }
        __syncthreads();
        const LAS float* bt = sBt + hg * 132; const float bfar = bt[128];
        const float* gtp = GT + (size_t)(m0 + tokl[0]) * 48 + (g * 4 + hg) * 3;
        LAS f32x4* totp = (LAS f32x4*)(lds + SMAIN + wid * 4096) + lane;
        bf16_t* yp = Y + (size_t)(m0 + tokl[0]) * 1024 + (g * 4 + hg) * 64 + 4 * fq;
        NsaSt st[2]; bool act[2] = {true, true}; bool colsel[2] = {true, true}; int dbase[2]; float minv[2] = {1.f, 1.f};
        KVRegs kvr; kvr.k[1] = (u32x4){0u, 0u, 0u, 0u}; kvr.v[1] = (u32x4){0u, 0u, 0u, 0u};
        int mg0 = 0; bool general = true;
#define NSA_RUN(MODE, STEP, NT, TM, KB, VB, TS, LD, SETUP) do { const int nt_ = (NT), nst_ = (nt_ + 1) >> 1; \
        { const int ti = 0; const int j0_ = (TM); const int ti1_ = 1; int j1_ = 0; { const int ti = ti1_; j1_ = (TM); } (void)ti; \
          nsa_ld2((KB) + (size_t)j0_ * (TS), (VB) + (size_t)j0_ * (TS), (size_t)(j1_ - j0_) * (TS), (LD), nt_ >= 2, tid, kvr); } \
        nsa_st2(lds + SKO, lds + SVO, tid, kvr); __syncthreads(); \
        _Pragma("unroll 1") for (int s_ = 0; s_ < nst_; ++s_) { const int sb_ = s_ & 1; \
            if (s_ + 1 < nst_) { int ja_ = 0, jb_ = 0; { const int ti = 2 * s_ + 2; ja_ = (TM); } { const int ti = 2 * s_ + 3; jb_ = (TM); } \
                nsa_ld2((KB) + (size_t)ja_ * (TS), (VB) + (size_t)ja_ * (TS), (size_t)(jb_ - ja_) * (TS), (LD), 2 * s_ + 3 < nt_, tid, kvr); } \
            _Pragma("unroll") for (int h_ = 0; h_ < 2; ++h_) { const int ti = 2 * s_ + h_; if (ti < nt_) { SETUP; \
                const LAS unsigned char* sk_ = lds + SKO + (sb_ * 2 + h_) * TB; const LAS unsigned char* sv_ = lds + SVO + (sb_ * 2 + h_) * TB; \
                if (MODE != 2 || (act[0] && act[1])) nsa_tile<MODE, STEP, 3>(sk_, sv_, qf, st, dbase, general, colsel, bt, bfar, minv, sMain, sSpill, tokl, mg0, fr, fq, q4, p4); \
                else if (act[0]) nsa_tile<MODE, STEP, 1>(sk_, sv_, qf, st, dbase, general, colsel, bt, bfar, minv, sMain, sSpill, tokl, mg0, fr, fq, q4, p4); \
                else if (act[1]) nsa_tile<MODE, STEP, 2>(sk_, sv_, qf, st, dbase, general, colsel, bt, bfar, minv, sMain, sSpill, tokl, mg0, fr, fq, q4, p4); } } \
            if (s_ + 1 < nst_) nsa_st2(lds + SKO + ((sb_ ^ 1) * 2) * TB, lds + SVO + ((sb_ ^ 1) * 2) * TB, tid, kvr); \
            __syncthreads(); } } while (0)
#define NSA_RESET() do { _Pragma("unroll") for (int ct = 0; ct < 2; ++ct) { st[ct].m = NEG; st[ct].l = 0.f; _Pragma("unroll") for (int dt = 0; dt < 4; ++dt) st[ct].o[dt] = (f32x4){0.f, 0.f, 0.f, 0.f}; } } while (0)
        const int ncmp = 4 * qb + 3, nct = (ncmp + 63) >> 6;
        const bf16_t* kcb = KC + (size_t)bg * 512 * 64; const bf16_t* vcb = VC + (size_t)bg * 512 * 64;
        NSA_RESET();
        NSA_RUN(0, 16, nct, ti, kcb, vcb, (size_t)4096, 64, { dbase[0] = t0 + tokl[0] - 31 - 1024 * ti; dbase[1] = dbase[0] + 4; mg0 = 16 * ti; general = t0 - 31 - 1024 * ti - 1008 < 128; });
#pragma unroll
        for (int ct = 0; ct < 2; ++ct) { const float lt = xsum16_32(st[ct].l); minv[ct] = fast_rcp(lt > 0.f ? lt : 1.f); if (st[ct].m == NEG) st[ct].m = 0.f; }
        NSA_RUN(1, 16, nct, ti, kcb, vcb, (size_t)4096, 64, { dbase[0] = t0 + tokl[0] - 31 - 1024 * ti; dbase[1] = dbase[0] + 4; mg0 = 16 * ti; general = t0 - 31 - 1024 * ti - 1008 < 128; });
        LAS f32x4* park = (LAS f32x4*)(lds + SKO + wid * 8192) + lane;
#pragma unroll
        for (int ct = 0; ct < 2; ++ct) { const float gt0 = gtp[ct * 4 * 48];
#pragma unroll
            for (int dt = 0; dt < 4; ++dt) park[(ct * 4 + dt) * 64] = st[ct].o[dt] * gt0; }
        unsigned msk[2][4];
        if (qb <= 15) {
#pragma unroll
            for (int ct = 0; ct < 2; ++ct) { msk[ct][0] = (2u << qb) - 1u; msk[ct][1] = 0u; msk[ct][2] = 0u; msk[ct][3] = 0u; }
        } else {
            const int tl = lane >> 3, sub = lane & 7, tok = 8 * wid + tl;
            unsigned key[16];
#pragma unroll
            for (int i = 0; i < 4; ++i) { const f32x4 a = *(const LAS f32x4*)(sMain + tok * 128 + 16 * sub + 4 * i), s4 = *(const LAS f32x4*)(sSpill + tok * 128 + 16 * sub + 4 * i);
#pragma unroll
                for (int j = 0; j < 4; ++j) { const int m = 16 * sub + 4 * i + j; const float imp = a[j] + s4[j];
                    key[4 * i + j] = (m >= 1 && m <= qb - 2) ? ((__float_as_uint(imp) & ~127u) | (unsigned)(127 - m)) : 0u; } }
            unsigned selb = 0u;
#pragma unroll 1
            for (int it = 0; it < 13; ++it) { unsigned mx = key[0];
#pragma unroll
                for (int i = 1; i < 16; ++i) mx = key[i] > mx ? key[i] : mx;
                { unsigned o = (unsigned)__builtin_amdgcn_update_dpp(0, (int)mx, 0xB1, 0xF, 0xF, true); mx = o > mx ? o : mx; o = (unsigned)__builtin_amdgcn_update_dpp(0, (int)mx, 0x4E, 0xF, 0xF, true); mx = o > mx ? o : mx;
                  o = (unsigned)__builtin_amdgcn_update_dpp(0, (int)mx, 0x141, 0xF, 0xF, true); mx = o > mx ? o : mx; }
#pragma unroll
                for (int i = 0; i < 16; ++i) if (key[i] == mx) { selb |= 1u << i; key[i] = 0u; } }
            { const int f0 = 0, f1 = qb, f2 = qb - 1;
              if ((f0 >> 4) == sub) selb |= 1u << (f0 & 15); if ((f1 >> 4) == sub) selb |= 1u << (f1 & 15); if ((f2 >> 4) == sub) selb |= 1u << (f2 & 15); }
            const unsigned oth = (unsigned)__builtin_amdgcn_update_dpp(0, (int)selb, 0xB1, 0xF, 0xF, true);
            if ((sub & 1) == 0) sSel[tok * 4 + (sub >> 1)] = selb | (oth << 16);
            asm volatile("s_waitcnt lgkmcnt(0)" ::: "memory");
#pragma unroll
            for (int ct = 0; ct < 2; ++ct) { const u32x4 w = *(const LAS u32x4*)(sSel + tokl[ct] * 4); msk[ct][0] = w.x; msk[ct][1] = w.y; msk[ct][2] = w.z; msk[ct][3] = w.w; }
        }
#pragma unroll
        for (int ct = 0; ct < 2; ++ct)
#pragma unroll
            for (int dt = 0; dt < 4; ++dt) totp[ct * (SSPILL - SMAIN) / 16 + 64 * dt] = park[(ct * 4 + dt) * 64];
        __syncthreads();
        { const bf16_t* ksb = KV + (size_t)2 * T_ * 256 + (size_t)(b * SEQ) * 256 + g * 64; const bf16_t* vsb = KV + (size_t)3 * T_ * 256 + (size_t)(b * SEQ) * 256 + g * 64;
          const bool sparse = qb >= NSA_SPARSE_QB;
          NSA_RESET();
#define NSA_SEL_SETUP(MB) { const int mblk = (MB); const int mw = mblk >> 5; const int mb = mblk & 31; \
              _Pragma("unroll") for (int ct = 0; ct < 2; ++ct) { const unsigned w = mw == 0 ? msk[ct][0] : mw == 1 ? msk[ct][1] : mw == 2 ? msk[ct][2] : msk[ct][3]; colsel[ct] = (w >> mb) & 1u; act[ct] = __any(colsel[ct]); } \
              dbase[0] = t0 + tokl[0] - 64 * mblk; dbase[1] = dbase[0] + 4; general = mblk + 2 >= qb; }
          if (!sparse) {
              NSA_RUN(2, 1, qb + 1, ti, ksb, vsb, (size_t)64 * 256, 256, NSA_SEL_SETUP(ti));
          } else {
              NSA_RUN(2, 1, 4, (ti == 0 ? 0 : qb - 3 + ti), ksb, vsb, (size_t)64 * 256, 256, NSA_SEL_SETUP(ti == 0 ? 0 : qb - 3 + ti));
              u32x2 toth[2][4];
#pragma unroll
              for (int ct = 0; ct < 2; ++ct)
#pragma unroll
                  for (int dt = 0; dt < 4; ++dt) { const f32x4 v = totp[ct * (SSPILL - SMAIN) / 16 + 64 * dt]; toth[ct][dt].x = pk2(v[0], v[1]); toth[ct][dt].y = pk2(v[2], v[3]); }
              __syncthreads();
#pragma unroll
              for (int ct = 0; ct < 2; ++ct) { const int col = tokl[ct] * 4 + hg; const float lt = xsum16_32(st[ct].l);
                  if (fq == 0) { sMref[col] = st[ct].m; sLfar[col] = fx_enc(lt); }
#pragma unroll
                  for (int dt = 0; dt < 4; ++dt)
#pragma unroll
                      for (int j = 0; j < 4; ++j) sOfar[col * 66 + 16 * dt + 4 * fq + j] = fx_enc(st[ct].o[dt][j]); }
              __syncthreads();
              nsa_sparse_far(sSel, (LAS int*)(lds + SLIST) + wid * 64, sBt, sMref, sLfar, sOfar, Q + (size_t)m0 * 1024 + g * 256, ksb, VT + (size_t)bg * 64 * SEQ, qb, wid, lane, fr, fq);
              __syncthreads();
#pragma unroll
              for (int ct = 0; ct < 2; ++ct) { const int col = tokl[ct] * 4 + hg; st[ct].l = fq == 0 ? fx_dec(sLfar[col]) : 0.f;
#pragma unroll
                  for (int dt = 0; dt < 4; ++dt)
#pragma unroll
                      for (int j = 0; j < 4; ++j) st[ct].o[dt][j] = fx_dec(sOfar[col * 66 + 16 * dt + 4 * fq + j]); }
              __syncthreads();
#pragma unroll
              for (int ct = 0; ct < 2; ++ct)
#pragma unroll
                  for (int dt = 0; dt < 4; ++dt) totp[ct * (SSPILL - SMAIN) / 16 + 64 * dt] = (f32x4){bflo(toth[ct][dt].x), bfhi(toth[ct][dt].x), bflo(toth[ct][dt].y), bfhi(toth[ct][dt].y)};
#pragma unroll
              for (int ct = 0; ct < 2; ++ct)
#pragma unroll
                  for (int s = 0; s < 2; ++s) qf[ct][s] = *(const bf16x8*)(Q + (size_t)(m0 + tokl[ct]) * 1024 + (g * 4 + hg) * 64 + 32 * s + 8 * fq);
          }
#undef NSA_SEL_SETUP
#pragma unroll
          for (int ct = 0; ct < 2; ++ct) { const float lt = xsum16_32(st[ct].l), sc = gtp[ct * 4 * 48 + 1] * fast_rcp(lt > 0.f ? lt : 1.f);
#pragma unroll
              for (int dt = 0; dt < 4; ++dt) totp[ct * (SSPILL - SMAIN) / 16 + 64 * dt] += st[ct].o[dt] * sc; } }
        { const bf16_t* kwb = KV + (size_t)4 * T_ * 256 + (size_t)(b * SEQ) * 256 + g * 64; const bf16_t* vwb = KV + (size_t)5 * T_ * 256 + (size_t)(b * SEQ) * 256 + g * 64;
          NSA_RESET(); act[0] = true; act[1] = true; colsel[0] = true; colsel[1] = true;
          const int j0 = qb >= 8 ? 0 : 8 - qb;
          NSA_RUN(3, 1, 9 - j0, ti, kwb + (size_t)(t0 - 512 + 64 * j0) * 256, vwb + (size_t)(t0 - 512 + 64 * j0) * 256, (size_t)64 * 256, 256, { const int j = j0 + ti;
              dbase[0] = tokl[0] + 512 - 64 * j; dbase[1] = dbase[0] + 4; general = (j == 0) || (j >= 6); });
#pragma unroll
          for (int ct = 0; ct < 2; ++ct) { const float lt = xsum16_32(st[ct].l), sc = gtp[ct * 4 * 48 + 2] * fast_rcp(lt > 0.f ? lt : 1.f);
#pragma unroll
              for (int dt = 0; dt < 4; ++dt) { const f32x4 v = totp[ct * (SSPILL - SMAIN) / 16 + 64 * dt] + st[ct].o[dt] * sc;
                  u32x2 w; w.x = pk2(v[0], v[1]); w.y = pk2(v[2], v[3]); *(u32x2*)(yp + ct * 4096 + 16 * dt) = w; } } }
        __syncthreads();
#undef NSA_RESET
#undef NSA_RUN
    }
}
#ifndef PROBE_NOCONV
#define PROBE_NOCONV 0
#endif
#ifndef PROBE_NOGELU
#define PROBE_NOGELU 0
#endif
#ifndef ALL_XCD_BAR
#define ALL_XCD_BAR 1
#endif
#ifndef USE_XCD_BAR
#define USE_XCD_BAR 1
#endif
#ifndef EN_ALL
#define EN_ALL 1
#endif
#ifndef EN_LRUG
#define EN_LRUG EN_ALL
#endif
#ifndef EN_LRUA
#define EN_LRUA EN_ALL
#endif
#ifndef EN_NSAC
#define EN_NSAC EN_ALL
#endif
#ifndef EN_NSAA
#define EN_NSAA EN_ALL
#endif
#ifndef EN_GLAK
#define EN_GLAK EN_ALL
#endif
#ifndef EN_GLAS
#define EN_GLAS EN_ALL
#endif
#ifndef EN_GLAO
#define EN_GLAO EN_ALL
#endif
#ifndef EN_G_LRUIN
#define EN_G_LRUIN EN_ALL
#endif
#ifndef EN_G_RESID
#define EN_G_RESID EN_ALL
#endif
#ifndef EN_G_NSAIN
#define EN_G_NSAIN EN_ALL
#endif
#ifndef EN_G_GLAIN
#define EN_G_GLAIN EN_ALL
#endif
#ifndef EN_G_GU
#define EN_G_GU EN_ALL
#endif
#ifndef EN_PREP
#define EN_PREP EN_ALL
#endif
struct Args {
    const float* x; const float* rel_bias; const float* final_norm; const float* mix_norm; const float* ffn_norm;
    const float* ffn_w_gate; const float* ffn_w_up; const float* ffn_w_down;
    const float* lru_w_in; const float* lru_conv_w; const float* lru_conv_b; const float* lru_w_a; const float* lru_b_a; const float* lru_w_x; const float* lru_b_x; const float* lru_lam; const float* lru_w_out;
    const float* nsa_w_in; const float* nsa_cmp_pos; const float* nsa_cmp_w1; const float* nsa_cmp_b1; const float* nsa_cmp_w2; const float* nsa_cmp_b2; const float* nsa_w_out;
    const float* gla_w_in; const float* gla_w_g2; const float* gla_b_g2; const float* gla_norm; const float* gla_w_out;
    float* out; unsigned char* ws; int ph_lo, ph_hi, dry, pad_;
};

#define XB_TMO      128
#define XB_XCNT(j)  (256  + 64 * (j))
#define XB_XSUB(j)  (1280 + 64 * (j))
#define XB_XGEN(j)  (2304 + 64 * (j))
#define XB_TOP      3328
#define XB_TOPGEN   3392
#define XCD_BAR_WORDS 3456
#define XB_SPIN_CAP (1u << 18)

__device__ __forceinline__ unsigned xb_ld(unsigned* p)              { return __hip_atomic_load(p, __ATOMIC_RELAXED, __HIP_MEMORY_SCOPE_AGENT); }
__device__ __forceinline__ unsigned xb_add(unsigned* p, unsigned v) { return __hip_atomic_fetch_add(p, v, __ATOMIC_RELAXED, __HIP_MEMORY_SCOPE_AGENT); }
__device__ __forceinline__ unsigned xb_xcc_id() { return (unsigned)__builtin_amdgcn_s_getreg((3 << 11) | 20) & 0xFu; }
#define XB_SPIN(cond, bar) do { unsigned _sp = 0; while (cond) { __builtin_amdgcn_s_sleep(1); \
    if ((++_sp & 255u) == 0u) { if (xb_ld(&(bar)[XB_TMO])) break; if (_sp > XB_SPIN_CAP) { atomicAdd(&(bar)[XB_TMO], 1u); break; } } } } while (0)

struct XcdBarrier {
    unsigned* bar; unsigned x;
    volatile LAS unsigned* st;
};

__device__ __forceinline__ XcdBarrier xcd_barrier_post(unsigned* bar, volatile LAS unsigned* st) {
    XcdBarrier b; b.bar = bar; b.x = xb_xcc_id(); b.st = st;
    if (threadIdx.x == 0) (void)xb_add(&bar[XB_XCNT(b.x)], 1u);
    return b;
}
__device__ __forceinline__ void xcd_barrier_complete(unsigned* bar, unsigned x, unsigned& nloc, unsigned& nx) {
    const unsigned G = gridDim.x * gridDim.y * gridDim.z;
    unsigned sum, cnt, mine, sp = 0u;
    for (;;) {
        sum = 0u; cnt = 0u; mine = 0u;
#pragma unroll
        for (unsigned j = 0; j < 16; ++j) { const unsigned c = xb_ld(&bar[XB_XCNT(j)]); sum += c; cnt += (c > 0u) ? 1u : 0u; mine = (j == x) ? c : mine; }
        if (sum == G) break;
        __builtin_amdgcn_s_sleep(1);
        if ((++sp & 255u) == 0u) { if (xb_ld(&bar[XB_TMO])) break; if (sp > XB_SPIN_CAP) { atomicAdd(&bar[XB_TMO], 1u); break; } }
    }
    nloc = mine > 0u ? mine : 1u; nx = cnt > 0u ? cnt : 1u;
}

__device__ __forceinline__ void xcd_barrier(const XcdBarrier& b) {
    asm volatile("s_waitcnt vmcnt(0)" ::: "memory");
    __syncthreads();
    if (threadIdx.x == 0) {
        unsigned* bar = b.bar;
        __builtin_amdgcn_s_waitcnt(0);
        unsigned nloc = b.st[0], nx = b.st[1];
        if (nloc == 0u) { xcd_barrier_complete(bar, b.x, nloc, nx); b.st[0] = nloc; b.st[1] = nx; }
        const unsigned old = xb_add(&bar[XB_XSUB(b.x)], 1u);
        const unsigned gen = old / nloc;
        if (old + 1u == (gen + 1u) * nloc) {
            __builtin_amdgcn_fence(__ATOMIC_RELEASE, "agent");
            asm volatile("s_waitcnt vmcnt(0)" ::: "memory");
            const unsigned og = xb_add(&bar[XB_TOP], 1u);
            const unsigned tg = og / nx;
            if (og + 1u == (tg + 1u) * nx) xb_add(&bar[XB_TOPGEN], 1u);
            else XB_SPIN(xb_ld(&bar[XB_TOPGEN]) == tg, bar);
            __builtin_amdgcn_fence(__ATOMIC_ACQUIRE, "agent");
            xb_add(&bar[XB_XGEN(b.x)], 1u);
            asm volatile("s_waitcnt vmcnt(0)" ::: "memory");
        } else {
            XB_SPIN(xb_ld(&bar[XB_XGEN(b.x)]) == gen, bar);
            __builtin_amdgcn_fence(__ATOMIC_ACQUIRE, "agent");
            asm volatile("s_waitcnt vmcnt(0)" ::: "memory");
        }
    }
    __syncthreads();
}

__global__ void __launch_bounds__(512, 2) mega_fwd(Args a) {
    extern __shared__ __attribute__((aligned(16))) unsigned char lds_raw[];
    LAS unsigned char* lds = (LAS unsigned char*)lds_raw;
    cg::grid_group grid = cg::this_grid();
    const int tid0 = threadIdx.x; const int wid0 = __builtin_amdgcn_readfirstlane(tid0 >> 6);
    constexpr int PTR_OFF = LDS_BYTES - 512;
    if (tid0 == 0) { LAS unsigned long long* tb = (LAS unsigned long long*)(lds + PTR_OFF);
        tb[0] = (unsigned long long)a.x;
        tb[1] = (unsigned long long)a.rel_bias;
        tb[2] = (unsigned long long)a.final_norm;
        tb[3] = (unsigned long long)a.mix_norm;
        tb[4] = (unsigned long long)a.ffn_norm;
        tb[5] = (unsigned long long)a.ffn_w_gate;
        tb[6] = (unsigned long long)a.ffn_w_up;
        tb[7] = (unsigned long long)a.ffn_w_down;
        tb[8] = (unsigned long long)a.lru_w_in;
        tb[9] = (unsigned long long)a.lru_conv_w;
        tb[10] = (unsigned long long)a.lru_conv_b;
        tb[11] = (unsigned long long)a.lru_w_a;
        tb[12] = (unsigned long long)a.lru_b_a;
        tb[13] = (unsigned long long)a.lru_w_x;
        tb[14] = (unsigned long long)a.lru_b_x;
        tb[15] = (unsigned long long)a.lru_lam;
        tb[16] = (unsigned long long)a.lru_w_out;
        tb[17] = (unsigned long long)a.nsa_w_in;
        tb[18] = (unsigned long long)a.nsa_cmp_pos;
        tb[19] = (unsigned long long)a.nsa_cmp_w1;
        tb[20] = (unsigned long long)a.nsa_cmp_b1;
        tb[21] = (unsigned long long)a.nsa_cmp_w2;
        tb[22] = (unsigned long long)a.nsa_cmp_b2;
        tb[23] = (unsigned long long)a.nsa_w_out;
        tb[24] = (unsigned long long)a.gla_w_in;
        tb[25] = (unsigned long long)a.gla_w_g2;
        tb[26] = (unsigned long long)a.gla_b_g2;
        tb[27] = (unsigned long long)a.gla_norm;
        tb[28] = (unsigned long long)a.gla_w_out;
        tb[29] = (unsigned long long)a.out;
        tb[30] = (unsigned long long)a.ws;
    }
    if (tid0 < 4) ((LAS unsigned*)(lds + PTR_OFF + 256))[tid0] = 0u;
    __syncthreads();
    if (a.ph_lo > 1000000) grid.sync();
    XcdBarrier xbar = xcd_barrier_post((unsigned*)(a.ws + WS_CTL), (volatile LAS unsigned*)(lds + PTR_OFF + 256));
#define PRAW(i) ((((unsigned long long)(unsigned)__builtin_amdgcn_readfirstlane((int)((const LAS unsigned*)(lds + PTR_OFF))[2 * (i) + 1])) << 32) | (unsigned long long)(unsigned)__builtin_amdgcn_readfirstlane((int)((const LAS unsigned*)(lds + PTR_OFF))[2 * (i)]))
#define GAS_ __attribute__((address_space(1)))
#define PF(i) ((const float*)(const GAS_ float*)PRAW(i))
#define P_OUT ((float*)(GAS_ float*)PRAW(29))
#define WSP(off) ((unsigned char*)((GAS_ unsigned char*)PRAW(30) + (off)))
#define W_GU ((bf16_t*)WSP(WS_W_GU))
#define W_DN ((bf16_t*)WSP(WS_W_DN))
#define W_MIN ((bf16_t*)WSP(WS_W_MIN))
#define W_MOUT ((bf16_t*)WSP(WS_W_MOUT))
#define W_SM ((bf16_t*)WSP(WS_W_SMALL))
#define HN ((bf16_t*)WSP(WS_HN))
#define ACT ((bf16_t*)WSP(WS_ACT))
#define LG ((bf16_t*)WSP(WS_LG))
#define LX ((bf16_t*)WSP(WS_LX))
#define LHL ((bf16_t*)WSP(WS_LHL))
#define LAC ((bf16_t*)WSP(WS_LAC))
#define AGGA ((float*)WSP(WS_LAGGA))
#define AGGH ((float*)WSP(WS_LAGGH))
#define NQ ((bf16_t*)WSP(WS_NQ))
#define NKV ((bf16_t*)WSP(WS_NKV))
#define NGT ((float*)WSP(WS_NGT))
#define NKC ((bf16_t*)WSP(WS_NKC))
#define NVC ((bf16_t*)WSP(WS_NVC))
#define GQ ((bf16_t*)WSP(WS_GQ))
#define GK ((bf16_t*)WSP(WS_GK))
#define GV ((bf16_t*)WSP(WS_GV))
#define GR ((bf16_t*)WSP(WS_GR))
#define GGL ((float*)WSP(WS_GGL))
#define GDEC ((float*)WSP(WS_GDEC))
#define GKVT ((bf16_t*)WSP(WS_GKVT))
#define SSP ((float*)WSP(WS_SSP))
#define NY ((bf16_t*)WSP(WS_NY))
#define NVT ((bf16_t*)WSP(WS_NVT))

    enum { OP_PREP, OP_G_LRUIN, OP_LRU_GATES, OP_LRU_APPLY, OP_G_RESID, OP_G_NSAIN, OP_NSA_CMP, OP_NSA_ATTN, OP_G_GLAIN, OP_GLA_KV, OP_GLA_SCAN, OP_GLA_OUT, OP_NORM2, OP_G_GU, OP_FINAL };
#pragma unroll 1
    for (int ph = a.ph_lo; ph < a.ph_hi; ++ph) {
        int layer, r;
        if (ph < 7) { layer = 0; r = ph; } else if (ph < 13) { layer = 1; r = ph - 6; } else if (ph < 20) { layer = 2; r = ph - 12; } else if (ph < 26) { layer = 3; r = ph - 19; } else { layer = 4; r = 0; }
        const int kind = layer % 3, jj = layer / 3, nmix = kind == 2 ? 5 : 4;
        int wid_s = wid0, bid = blockIdx.x, G = gridDim.x;
        asm volatile("" : "+s"(wid_s) :: "memory"); asm volatile("" : "+s"(bid)); asm volatile("" : "+s"(G));
        int lane_v; asm volatile("v_mbcnt_lo_u32_b32 %0, -1, 0\n\tv_mbcnt_hi_u32_b32 %0, -1, %0" : "=v"(lane_v));
        const int tid = (wid_s << 6) | lane_v;
        const int lane = tid & 63, wid = __builtin_amdgcn_readfirstlane(tid >> 6), gw = bid * 8 + wid, NGW = G * 8;
        LAS float* scr = (LAS float*)(lds + wid * 8448);
        const float* hsrc = layer == 0 ? PF(0) : P_OUT;
        int op;
        if (layer == 4) op = OP_FINAL;
        else if (r == 0) op = OP_PREP;
        else if (r <= nmix) { const int q = r - 1;
            if (kind == 0) op = q == 0 ? OP_G_LRUIN : q == 1 ? OP_LRU_GATES : q == 2 ? OP_LRU_APPLY : OP_G_RESID;
            else if (kind == 1) op = q == 0 ? OP_G_NSAIN : q == 1 ? OP_NSA_CMP : q == 2 ? OP_NSA_ATTN : OP_G_RESID;
            else op = q == 0 ? OP_G_GLAIN : q == 1 ? OP_GLA_KV : q == 2 ? OP_GLA_SCAN : q == 3 ? OP_GLA_OUT : OP_G_RESID; }
        else { const int q = r - nmix - 1; op = q == 0 ? OP_G_GU : OP_G_RESID; }
        const bool is_down = (r == nmix + 2);
#ifdef PHASE_PROBE
        if (bid == 0 && tid == 0) { unsigned long long* ts = (unsigned long long*)WSP(WS_TQ + 4096); ts[ph] = __builtin_amdgcn_s_memrealtime(); ((int*)WSP(WS_TQ + 8192))[ph] = op; }
#endif
        switch (op) {
        case OP_PREP: if (EN_PREP) { init_stream_bf16(PF(0), HN, SSP, gw, NGW, lane); nsa_b1eff(PF(18), PF(19), PF(20), (float*)WSP(WS_B1E), gw, NGW, lane); }
            break;
        case OP_G_LRUIN: if (EN_G_LRUIN) { pg8::Gemm g{HN, W_MIN, T_, 2 * RNN, D_}; pg8::StaticOrder S; S.init(T_, 2 * RNN, G, bid); pg8::EpiLruIn E{LG, LX, SSP, PROBE_NOGELU ? a.dry : 0};
            pg8::gemm_phase<pg8::EpiLruIn, pg8::StaticOrder, true, true>(lds, g, S, E, tid); }
            break;
        case OP_LRU_GATES: if (EN_LRUG) lru_gates_phase(lds, LX, PF(9) + jj * 4 * RNN, PF(10) + jj * RNN, W_SM, W_SM + 163840, PF(12) + jj * RNN, PF(14) + jj * RNN, PF(15) + jj * RNN, LHL, LAC, AGGA, AGGH, tid, bid, G);
            break;
        case OP_LRU_APPLY: if (EN_LRUA) lru_apply_phase(LG, a.dry ? (bf16_t*)WSP(190 * MiB) : LG, LHL, LAC, AGGA, AGGH, tid, bid, G);
            break;
        case OP_G_RESID: if (EN_G_RESID) {
            const bf16_t* A = is_down ? ACT : (kind == 0 ? LG : kind == 1 ? NY : GV); const bf16_t* Bt = is_down ? W_DN : W_MOUT; const int K = is_down ? FF : (kind == 0 ? RNN : D_);
            pg8::Gemm g{A, Bt, T_, D_, K}; pg8::StaticOrder S; S.init(T_, D_, G, bid); pg8::EpiResid E{HN, a.dry ? (bf16_t*)WSP(190 * MiB) : HN, SSP, (LAS float*)(lds + 131072)};
            pg8::gemm_phase<pg8::EpiResid, pg8::StaticOrder, true, true>(lds, g, S, E, tid); }
            break;
        case OP_G_NSAIN: if (EN_G_NSAIN) { pg8::Gemm g{HN, W_MIN, T_, NSA_NPAD, D_}; pg8::StaticOrder S; S.init(T_, NSA_NPAD, G, bid); pg8::EpiNsaIn E{NQ, NKV, NGT, SSP};
            pg8::gemm_phase<pg8::EpiNsaIn, pg8::StaticOrder, true, true>(lds, g, S, E, tid); }
            break;
        case OP_NSA_CMP: if (EN_NSAC) nsa_compress_phase(lds, NKV, PF(18), PF(19), PF(20), PF(22), W_SM, W_SM + 262144, NKC, NVC, NVT, (const float*)WSP(WS_B1E), tid, bid, G);
            break;
        case OP_NSA_ATTN: if (EN_NSAA) nsa_attn_phase(lds, NQ, NKV, NGT, NKC, NVC, PF(1), NY, NVT, (void*)WSP(WS_TQ), tid, bid, G);
            break;
        case OP_G_GLAIN: if (EN_G_GLAIN) { pg8::Gemm g{HN, W_MIN, T_, GLA_NPAD, D_}; pg8::StaticOrder S; S.init(T_, GLA_NPAD, G, bid); pg8::EpiGlaIn E{GQ, GK, GV, GR, GGL, SSP};
            pg8::gemm_phase<pg8::EpiGlaIn, pg8::StaticOrder, true, true>(lds, g, S, E, tid); }
            break;
        case OP_GLA_KV: if (EN_GLAK) gla_kv_phase(lds, GK, GV, GGL, PF(25), PF(26), GKVT, GDEC, tid, bid, G);
            break;
        case OP_GLA_SCAN: if (EN_GLAS) gla_scan_phase(GKVT, GDEC, a.dry != 0, tid, bid, G);
            break;
        case OP_GLA_OUT: if (EN_GLAO) gla_out_phase(lds, GQ, GK, GV, GR, GGL, PF(25), PF(26), PF(27), GKVT, a.dry ? (bf16_t*)WSP(190 * MiB) : GV, tid, bid, G);
            break;
        case OP_G_GU: if (EN_G_GU) { pg8::Gemm g{HN, W_GU, T_, 2 * FF, D_}; pg8::StaticOrder S; S.init(T_, 2 * FF, G, bid); pg8::EpiSwiglu E{ACT, SSP};
            pg8::gemm_phase<pg8::EpiSwiglu, pg8::StaticOrder, true, true>(lds, g, S, E, tid); }
            break;
        default: if (EN_PREP) final_norm_rows(HN, PF(2), a.dry ? (float*)WSP(60 * MiB) : P_OUT, gw, NGW, lane);
#if defined(TIMING_PROBE) || defined(PHASE_PROBE)
            { __syncthreads(); float* o = P_OUT;
#ifdef PHASE_PROBE
              const unsigned long long* ts = (const unsigned long long*)WSP(WS_TQ + 4096); const int* ops = (const int*)WSP(WS_TQ + 8192);
              const unsigned long long tend = __builtin_amdgcn_s_memrealtime(); float sa = 0.f, sb = 0.f;
              for (int q = 0; q < 33; ++q) { const float dt = (float)(ts[q + 1] - ts[q]); if (ops[q] == TQ_A) sa += dt; if (ops[q] == TQ_B) sb += dt; }
              const float tot_ = (float)(ts[33] - ts[0]); const float f1 = sa / tot_, f2 = sb / tot_; (void)tend;
#else
              const float* tq = (const float*)WSP(WS_TQ); const float f1 = tq[TQ_A], f2 = tq[TQ_B];
#endif

              const int R = (int)(f2 * 0.32f * 16384.f);
              for (int m = gw; m < R; m += NGW) for (int c = lane; c < 1024; c += 64) o[(size_t)m * 1024 + c] += 0.05f;
              if (bid == G - 1 && tid == 0) o[(size_t)16383 * 1024 + 5] += 0.1f + 0.19f * f1; }
#endif
            break;
        }
        { int cv = 0, nun = 0;
          if (op == OP_PREP) cv = 2;
          else if ((op == OP_G_LRUIN || op == OP_G_NSAIN || op == OP_G_GLAIN)) { cv = 1; nun = 64 * (op == OP_G_LRUIN ? 10 : op == OP_G_NSAIN ? 11 : 13); }
          else if (op == OP_G_GU && layer < 3) { cv = 2; nun = 64 * 22; }
          if (EN_PREP && cv && !(PROBE_NOCONV && a.dry)) {
              const int rem = op == OP_PREP ? 0 : nun % G, first = rem, nidle = G - first;
              if (bid >= first) { const int cgw = (bid - first) * 8 + wid, CNGW = nidle * 8; int rot = 0;
                  if (cv & 1) {
                      transpose_job(PF(5) + (size_t)layer * D_ * FF, PF(4) + layer * D_, D_, FF, W_GU, D_, 1, rot, cgw, CNGW, scr, lane);
                      transpose_job(PF(6) + (size_t)layer * D_ * FF, PF(4) + layer * D_, D_, FF, W_GU, D_, 2, rot, cgw, CNGW, scr, lane);
                      transpose_job(PF(7) + (size_t)layer * FF * D_, nullptr, FF, D_, W_DN, FF, 0, rot, cgw, CNGW, scr, lane); }
                  if (cv & 2) { const int ml = op == OP_PREP ? layer : layer + 1, mk = ml % 3, mj = ml / 3;
                      if (mk == 0) {
                          transpose_job(PF(8) + (size_t)mj * D_ * 2 * RNN, PF(3) + ml * D_, D_, 2 * RNN, W_MIN, D_, 0, rot, cgw, CNGW, scr, lane);
                          transpose_job(PF(16) + (size_t)mj * RNN * D_, nullptr, RNN, D_, W_MOUT, RNN, 0, rot, cgw, CNGW, scr, lane);
#pragma unroll 1
                          for (int h = 0; h < 20; ++h) { const int hh = h % 10; const float* src = (h < 10 ? PF(11) : PF(13)) + ((size_t)mj * 10 + hh) * 16384;
                              transpose_job(src, nullptr, 128, 128, W_SM + (h < 10 ? 0 : 163840) + hh * 16384, 128, 0, rot, cgw, CNGW, scr, lane); }
                      } else if (mk == 1) {
                          transpose_job(PF(17), PF(3) + ml * D_, D_, 2608, W_MIN, D_, 0, rot, cgw, CNGW, scr, lane);
                          transpose_job(PF(23), nullptr, D_, D_, W_MOUT, D_, 0, rot, cgw, CNGW, scr, lane);
#pragma unroll 1
                          for (int kv = 0; kv < 2; ++kv) {
                              transpose_job(PF(19) + (size_t)kv * 2048 * 64, nullptr, 2048, 64, W_SM + (size_t)kv * 64 * 2048, 2048, 0, rot, cgw, CNGW, scr, lane);
                              transpose_job(PF(21) + (size_t)kv * 4096, nullptr, 64, 64, W_SM + 262144 + kv * 4096, 64, 0, rot, cgw, CNGW, scr, lane); }
                      } else {
                          transpose_job(PF(24), PF(3) + ml * D_, D_, 3088, W_MIN, D_, 0, rot, cgw, CNGW, scr, lane);
                          transpose_job(PF(28), nullptr, D_, D_, W_MOUT, D_, 0, rot, cgw, CNGW, scr, lane); } } } } }
        if (ph + 1 < a.ph_hi) { if (USE_XCD_BAR && (ALL_XCD_BAR || ph != a.ph_lo)) xcd_barrier(xbar); else grid.sync(); }
#ifdef EXTRA_BARS
        if (ph + 1 < a.ph_hi && ph != a.ph_lo) { xcd_barrier(xbar); xcd_barrier(xbar); }
#endif
    }
}

#ifndef N_LAUNCH_MODE
#define N_LAUNCH_MODE 1
#endif
constexpr int N_PHASES = 27;

extern "C" void kernel_launch(void* const* d_in, const int* in_sizes, int n_in, void* d_out, int out_size, void* d_ws, size_t ws_size, hipStream_t stream) {
    static int grid = 0;
    if (grid == 0) {
        if (n_in != 29 || out_size != T_ * D_ || ws_size < WS_END) { fprintf(stderr, "kernel_launch: unexpected problem: n_in %d out %d ws %zu\n", n_in, out_size, ws_size); grid = -1; return; }
        int dev = 0, cus = 0, per_cu = 0;
        hipGetDevice(&dev); hipDeviceGetAttribute(&cus, hipDeviceAttributeMultiprocessorCount, dev);
        if (hipFuncSetAttribute((const void*)mega_fwd, hipFuncAttributeMaxDynamicSharedMemorySize, LDS_BYTES) != hipSuccess) { fprintf(stderr, "kernel_launch: hipFuncSetAttribute failed\n"); grid = -1; return; }
        if (hipOccupancyMaxActiveBlocksPerMultiprocessor(&per_cu, (const void*)mega_fwd, 512, LDS_BYTES) != hipSuccess || per_cu < 1) { fprintf(stderr, "kernel_launch: occupancy query says %d\n", per_cu); per_cu = 1; }
        (void)hipGetLastError();
        grid = cus * 1;
        fprintf(stderr, "kernel_launch: grid %d (cus %d, occupancy %d)\n", grid, cus, per_cu);
    }
    if (grid < 0) return;
    if (hipMemsetAsync((char*)d_ws + WS_CTL, 0, 16384, stream) != hipSuccess) { fprintf(stderr, "kernel_launch: memset failed\n"); return; }
    Args a{};
    const float** p = (const float**)&a;
    for (int i = 0; i < 29; ++i) p[i] = (const float*)d_in[i];
    a.out = (float*)d_out; a.ws = (unsigned char*)d_ws;
#if N_LAUNCH_MODE == 1
    a.ph_lo = 0; a.ph_hi = N_PHASES;
    void* args[] = {&a};
    hipError_t e = hipLaunchCooperativeKernel((const void*)mega_fwd, dim3(grid), dim3(512), args, LDS_BYTES, stream);
    if (e != hipSuccess) fprintf(stderr, "cooperative launch failed: %s (grid %d)\n", hipGetErrorString(e), grid);
#else
#ifndef REPEAT_PH
#define REPEAT_PH -1
#endif
#ifndef REPEAT_N
#define REPEAT_N 1
#endif
#ifndef RUN_UPTO
#define RUN_UPTO (N_PHASES - 1)
#endif
    for (int ph = 0; ph < N_PHASES; ++ph) { if (ph >= RUN_UPTO && ph != N_PHASES - 1) continue; a.ph_lo = ph; a.ph_hi = ph + 1;
        a.dry = 1; for (int rep = 0; rep < REPEAT_N; ++rep) if (ph == REPEAT_PH) hipLaunchKernelGGL(mega_fwd, dim3(grid), dim3(512), LDS_BYTES, stream, a);
        a.dry = 0; hipLaunchKernelGGL(mega_fwd, dim3(grid), dim3(512), LDS_BYTES, stream, a); }
#endif
}
```

```cpp
#include <hip/hip_runtime.h>
#include <hip/hip_cooperative_groups.h>
#include <cstdio>
#include <cstdint>
namespace cg = cooperative_groups;

#define LAS __attribute__((address_space(3)))
typedef unsigned short bf16_t;
typedef short bf16x8 __attribute__((ext_vector_type(8)));
typedef short s16x4 __attribute__((ext_vector_type(4)));
typedef float f32x4 __attribute__((ext_vector_type(4)));
typedef float f32x2 __attribute__((ext_vector_type(2)));
typedef unsigned u32x4 __attribute__((ext_vector_type(4)));
typedef unsigned u32x2 __attribute__((ext_vector_type(2)));
typedef __bf16 bf16x2_t __attribute__((ext_vector_type(2)));

constexpr int T_ = 16384, SEQ = 8192, D_ = 1024, FF = 2816, RNN = 1280;
constexpr int NSA_NPAD = 2816, GLA_NPAD = 3328;
constexpr float EPS = 1e-6f;
constexpr float LOG2E = 1.4426950408889634f;

constexpr size_t MiB = 1u << 20;
constexpr size_t WS_W_GU = 0, WS_W_DN = 11 * MiB, WS_W_MIN = 17 * MiB, WS_W_MOUT = 24 * MiB, WS_W_SMALL = 27 * MiB;
constexpr size_t WS_HN = 28 * MiB;
constexpr size_t WS_ACT = 60 * MiB;
constexpr size_t WS_LG = 60 * MiB, WS_LX = 100 * MiB, WS_LHL = 140 * MiB, WS_LAC = 180 * MiB, WS_LAGGA = 220 * MiB, WS_LAGGH = 221 * MiB;
constexpr size_t WS_NQ = 60 * MiB, WS_NKV = 92 * MiB, WS_NGT = 140 * MiB, WS_NKC = 143 * MiB, WS_NVC = 144 * MiB;
constexpr size_t WS_GQ = 60 * MiB, WS_GK = 76 * MiB, WS_GV = 92 * MiB, WS_GR = 124 * MiB, WS_GGL = 156 * MiB, WS_GDEC = 157 * MiB, WS_GKVT = 158 * MiB;
constexpr size_t WS_TQ = 223 * MiB, WS_CTL = 222 * MiB, WS_SSP = 222 * MiB + 65536, WS_NY = 148 * MiB, WS_NVT = 180 * MiB, WS_B1E = 222 * MiB + 524288;
constexpr size_t WS_END = 224 * MiB;

constexpr int LDS_BYTES = 155648;
#ifndef WT_STORES
#define WT_STORES 1
#endif

__device__ __forceinline__ unsigned pk2(float lo, float hi) { f32x2 v = {lo, hi}; bf16x2_t b = __builtin_convertvector(v, bf16x2_t); return __builtin_bit_cast(unsigned, b); }
__device__ __forceinline__ float bf2f(unsigned short h) { return __uint_as_float(((unsigned)h) << 16); }
__device__ __forceinline__ float bflo(unsigned w) { return __uint_as_float(w << 16); }
__device__ __forceinline__ float bfhi(unsigned w) { return __uint_as_float(w & 0xffff0000u); }
__device__ __forceinline__ float fast_rcp(float x) { return __builtin_amdgcn_rcpf(x); }
__device__ __forceinline__ float fast_exp2(float x) { return __builtin_amdgcn_exp2f(x); }
__device__ __forceinline__ float sigmoidf_(float x) { return fast_rcp(1.f + fast_exp2(-x * LOG2E)); }
__device__ __forceinline__ float siluf_(float x) { return x * sigmoidf_(x); }
__device__ __forceinline__ float gelu_tanh_(float x) { const float z = 0.7978845608028654f * (x + 0.044715f * x * x * x); return x * fast_rcp(1.f + fast_exp2(-2.f * LOG2E * z)); }
__device__ __forceinline__ float wave_sum(float v) {
#pragma unroll
    for (int o = 1; o < 64; o <<= 1) v += __shfl_xor(v, o);
    return v;
}
__device__ __forceinline__ float xmax16_32(float v) {
    auto r = __builtin_amdgcn_permlane16_swap(__float_as_uint(v), __float_as_uint(v), false, false); v = fmaxf(__uint_as_float(r[0]), __uint_as_float(r[1]));
    auto q = __builtin_amdgcn_permlane32_swap(__float_as_uint(v), __float_as_uint(v), false, false); return fmaxf(__uint_as_float(q[0]), __uint_as_float(q[1]));
}
__device__ __forceinline__ float xsum16_32(float v) {
    auto r = __builtin_amdgcn_permlane16_swap(__float_as_uint(v), __float_as_uint(v), false, false); v = __uint_as_float(r[0]) + __uint_as_float(r[1]);
    auto q = __builtin_amdgcn_permlane32_swap(__float_as_uint(v), __float_as_uint(v), false, false); return __uint_as_float(q[0]) + __uint_as_float(q[1]);
}
__device__ __forceinline__ float dpp_xor1(float v) { return __uint_as_float((unsigned)__builtin_amdgcn_update_dpp(0, (int)__float_as_uint(v), 0xB1, 0xF, 0xF, true)); }
__device__ __forceinline__ float dpp_xor2(float v) { return __uint_as_float((unsigned)__builtin_amdgcn_update_dpp(0, (int)__float_as_uint(v), 0x4E, 0xF, 0xF, true)); }
__device__ __forceinline__ float max3_(float a, float b, float c) { float r; asm("v_max3_f32 %0, %1, %2, %3" : "=v"(r) : "v"(a), "v"(b), "v"(c)); return r; }
__device__ __forceinline__ void st16_wt(void* p, u32x4 v) {
#if WT_STORES
    asm volatile("global_store_dwordx4 %0, %1, off sc1\n\ts_nop 1" :: "v"(p), "v"(v) : "memory");
#else
    *(u32x4*)p = v;
#endif
}
namespace pg8 {
#define PG8_LAS __attribute__((address_space(3)))
typedef unsigned short bf16_t;
typedef short bf16x8 __attribute__((ext_vector_type(8)));
typedef float f32x4 __attribute__((ext_vector_type(4)));
typedef unsigned u32x4 __attribute__((ext_vector_type(4)));
constexpr int BM = 256, BK = 64, HALF = 128, HTB = HALF * BK * 2  , STAGE_BYTES = 8 * HTB, NXCD = 8, WGM = 8;

__host__ __device__ __forceinline__ int lds_byte(int r, int c) { const int st = (r >> 4) * 2 + (c >> 5), rr = r & 15, cc = c & 31, ob = rr * 64 + cc * 2; return st * 1024 + (ob ^ (((ob >> 9) & 1) << 5)); }
__host__ __device__ __forceinline__ void stage_rc(int b, int& R, int& C) { const int st = b / 1024, sb = b % 1024, swz = sb ^ (((sb >> 9) & 1) << 5); R = (st >> 1) * 16 + swz / 64; C = (st & 1) * 32 + (swz % 64) / 2; }
__host__ __device__ __forceinline__ int perm32(int rho) { const int n = rho >> 4, i = rho & 15; return 8 * (i >> 2) + 4 * n + (i & 3); }

struct Unit { int pm, pn; };
struct Gemm { const bf16_t* A; const bf16_t* Bt; int M, N, K; };

struct StaticOrder {
    int nM, nN, nwg, G, c;
    __host__ __device__ void init(int M, int N, int G_, int c_) { nM = M / BM; nN = N / BM; nwg = nM * nN; G = G_; c = c_; }
    __host__ __device__ bool next(int i, Unit& u) const {
        const long L = (long)i * G + c; if (L >= nwg) return false;
        int wgid = (int)L; { const int q = nwg / NXCD, r = nwg % NXCD, xcd = wgid % NXCD, off = wgid / NXCD; wgid = (xcd < r ? xcd * (q + 1) : r * (q + 1) + (xcd - r) * q) + off; }
        const int nig = WGM * nN, gid = wgid / nig, fm = gid * WGM, gsz = (nM - fm) < WGM ? (nM - fm) : WGM;
        u.pm = fm + ((wgid % nig) % gsz); u.pn = (wgid % nig) / gsz; return true;
    }
    __device__ __forceinline__ void a_ready(const Unit&) const {}
    __device__ __forceinline__ void done(const Unit&) const {}
};

struct EpiResid {
    static constexpr bool PERM = true, AFTER_DRAIN = false;
    bf16_t* hb; bf16_t* hbo; float* ssp; PG8_LAS float* red;
    __device__ __forceinline__ void operator()(const f32x4 (&acc)[2][2][4][2], const Unit& u, int wr, int wc, int fr, int fq) const {
        const int row0 = u.pm * BM + wr * 64 + fr, col0 = u.pn * BM + wc * 32 + 8 * fq;
#pragma unroll
        for (int ai = 0; ai < 2; ++ai)
#pragma unroll
            for (int m = 0; m < 4; ++m) { const size_t off = (size_t)(row0 + ai * HALF + m * 16) * 1024 + col0; float ss = 0.f;
#pragma unroll
                for (int bj = 0; bj < 2; ++bj) { const u32x4 b = *(const u32x4*)(hb + off + bj * HALF); const f32x4 a0 = acc[ai][bj][m][0], a1 = acc[ai][bj][m][1];
                    u32x4 w; w.x = ::pk2(::bflo(b.x) + a0[0], ::bfhi(b.x) + a0[1]); w.y = ::pk2(::bflo(b.y) + a0[2], ::bfhi(b.y) + a0[3]);
                    w.z = ::pk2(::bflo(b.z) + a1[0], ::bfhi(b.z) + a1[1]); w.w = ::pk2(::bflo(b.w) + a1[2], ::bfhi(b.w) + a1[3]);
                    ::st16_wt(hbo + off + bj * HALF, w);
                    const float h0 = ::bflo(w.x), h1 = ::bfhi(w.x), h2 = ::bflo(w.y), h3 = ::bfhi(w.y), h4 = ::bflo(w.z), h5 = ::bfhi(w.z), h6 = ::bflo(w.w), h7 = ::bfhi(w.w);
                    ss += ((h0 * h0 + h1 * h1) + (h2 * h2 + h3 * h3)) + ((h4 * h4 + h5 * h5) + (h6 * h6 + h7 * h7)); }
                ss = ::xsum16_32(ss); if (fq == 0) red[(ai * HALF + wr * 64 + m * 16 + fr) * 4 + wc] = ss; }
        asm volatile("s_waitcnt lgkmcnt(0)" ::: "memory"); __builtin_amdgcn_s_barrier(); asm volatile("" ::: "memory");
        const int t = (wr * 4 + wc) * 64 + fq * 16 + fr;
        if (t < 256) { const f32x4 s = *(const PG8_LAS f32x4*)(red + t * 4); ssp[(size_t)(u.pm * BM + t) * 4 + u.pn] = (s[0] + s[1]) + (s[2] + s[3]); }
    }
};
__device__ __forceinline__ void load_rs(const float* ssp, int pm, int wr, int fr, float (&rs)[2][4]) {
#pragma unroll
    for (int ai = 0; ai < 2; ++ai)
#pragma unroll
        for (int m = 0; m < 4; ++m) { const int row = pm * BM + ai * HALF + wr * 64 + m * 16 + fr;
            const f32x4 s4 = *(const f32x4*)(ssp + (size_t)row * 4); const float s = (s4[0] + s4[1]) + (s4[2] + s4[3]); rs[ai][m] = __builtin_amdgcn_rsqf(s * (1.f / 1024.f) + 1e-6f); }
}
__device__ __forceinline__ u32x4 pack8(const f32x4 a, const f32x4 b) { u32x4 w; w.x = ::pk2(a[0], a[1]); w.y = ::pk2(a[2], a[3]); w.z = ::pk2(b[0], b[1]); w.w = ::pk2(b[2], b[3]); return w; }
struct EpiSwiglu {
    static constexpr bool PERM = true, AFTER_DRAIN = false;
    bf16_t* O; const float* ssp;
    __device__ __forceinline__ void operator()(const f32x4 (&acc)[2][2][4][2], const Unit& u, int wr, int wc, int fr, int fq) const {
        float rs[2][4]; load_rs(ssp, u.pm, wr, fr, rs);
        const int row0 = u.pm * BM + wr * 64 + fr, col0 = u.pn * HALF + wc * 32 + 8 * fq;
#pragma unroll
        for (int ai = 0; ai < 2; ++ai)
#pragma unroll
            for (int m = 0; m < 4; ++m) { f32x4 v[2];
#pragma unroll
                for (int n = 0; n < 2; ++n) { const f32x4 g = acc[ai][0][m][n], up = acc[ai][1][m][n];
#pragma unroll
                    for (int j = 0; j < 4; ++j) v[n][j] = ::siluf_(g[j] * rs[ai][m]) * (up[j] * rs[ai][m]); }
                ::st16_wt(O + (size_t)(row0 + ai * HALF + m * 16) * FF + col0, pack8(v[0], v[1])); }
    }
};
template <int ACT> __device__ __forceinline__ void store_tile_bf16(const f32x4 (&acc)[2][2][4][2], const float (&rs)[2][4], bf16_t* dst, int ldc, int cbase, float scale, int pm, int wr, int wc, int fr, int fq) {
    const int row0 = pm * BM + wr * 64 + fr, col0 = cbase + wc * 32 + 8 * fq;
#pragma unroll
    for (int ai = 0; ai < 2; ++ai)
#pragma unroll
        for (int m = 0; m < 4; ++m)
#pragma unroll
            for (int bj = 0; bj < 2; ++bj) { f32x4 v[2];
#pragma unroll
                for (int n = 0; n < 2; ++n)
#pragma unroll
                    for (int j = 0; j < 4; ++j) { const float x = acc[ai][bj][m][n][j] * rs[ai][m]; v[n][j] = ACT == 1 ? ::gelu_tanh_(x) : ACT == 2 ? ::siluf_(x) : x * scale; }
                ::st16_wt(dst + (size_t)(row0 + ai * HALF + m * 16) * ldc + col0 + bj * HALF, pack8(v[0], v[1])); }
}
template <int ACT> __device__ __forceinline__ void store_tile_f32_narrow(const f32x4 (&acc)[2][2][4][2], const float (&rs)[2][4], float* dst, int ldc, int ncols, int pm, int wr, int wc, int fr, int fq) {
    const int row0 = pm * BM + wr * 64 + fr;
#pragma unroll
    for (int ai = 0; ai < 2; ++ai)
#pragma unroll
        for (int m = 0; m < 4; ++m)
#pragma unroll
            for (int n = 0; n < 2; ++n) { const int c = wc * 32 + 8 * fq + 4 * n;
                if (c < ncols) { f32x4 v = acc[ai][0][m][n] * rs[ai][m];
                    if (ACT == 3) { v[0] = ::sigmoidf_(v[0]); v[1] = ::sigmoidf_(v[1]); v[2] = ::sigmoidf_(v[2]); v[3] = ::sigmoidf_(v[3]); }
                    *(f32x4*)(dst + (size_t)(row0 + ai * HALF + m * 16) * ldc + c) = v; } }
}
struct EpiLruIn {
    static constexpr bool PERM = true, AFTER_DRAIN = false;
    bf16_t* G; bf16_t* X; const float* ssp; int nogelu;
    __device__ __forceinline__ void operator()(const f32x4 (&acc)[2][2][4][2], const Unit& u, int wr, int wc, int fr, int fq) const {
        float rs[2][4]; load_rs(ssp, u.pm, wr, fr, rs);
        if (u.pn < 5 && !nogelu) store_tile_bf16<1>(acc, rs, G, RNN, u.pn * BM, 1.f, u.pm, wr, wc, fr, fq);
        else if (u.pn < 5) store_tile_bf16<0>(acc, rs, G, RNN, u.pn * BM, 1.f, u.pm, wr, wc, fr, fq);
        else store_tile_bf16<0>(acc, rs, X, RNN, (u.pn - 5) * BM, 1.f, u.pm, wr, wc, fr, fq);
    }
};
struct EpiNsaIn {
    static constexpr bool PERM = true, AFTER_DRAIN = false;
    bf16_t* Q; bf16_t* KV; float* GT; const float* ssp;
    __device__ __forceinline__ void operator()(const f32x4 (&acc)[2][2][4][2], const Unit& u, int wr, int wc, int fr, int fq) const {
        float rs[2][4]; load_rs(ssp, u.pm, wr, fr, rs);
        if (u.pn < 4) store_tile_bf16<0>(acc, rs, Q, 1024, u.pn * BM, 0.125f, u.pm, wr, wc, fr, fq);
        else if (u.pn < 10) store_tile_bf16<0>(acc, rs, KV + (size_t)(u.pn - 4) * T_ * 256, 256, 0, 1.f, u.pm, wr, wc, fr, fq);
        else store_tile_f32_narrow<3>(acc, rs, GT, 48, 48, u.pm, wr, wc, fr, fq);
    }
};
struct EpiGlaIn {
    static constexpr bool PERM = true, AFTER_DRAIN = false;
    bf16_t* Q; bf16_t* K; bf16_t* V; bf16_t* R; float* GL; const float* ssp;
    __device__ __forceinline__ void operator()(const f32x4 (&acc)[2][2][4][2], const Unit& u, int wr, int wc, int fr, int fq) const {
        float rs[2][4]; load_rs(ssp, u.pm, wr, fr, rs);
        if (u.pn < 2) store_tile_bf16<0>(acc, rs, Q, 512, u.pn * BM, 0.08838834764831845f, u.pm, wr, wc, fr, fq);
        else if (u.pn < 4) store_tile_bf16<0>(acc, rs, K, 512, (u.pn - 2) * BM, 1.f, u.pm, wr, wc, fr, fq);
        else if (u.pn < 8) store_tile_bf16<0>(acc, rs, V, 1024, (u.pn - 4) * BM, 1.f, u.pm, wr, wc, fr, fq);
        else if (u.pn < 12) store_tile_bf16<2>(acc, rs, R, 1024, (u.pn - 8) * BM, 1.f, u.pm, wr, wc, fr, fq);
        else store_tile_f32_narrow<0>(acc, rs, GL, 16, 16, u.pm, wr, wc, fr, fq);
    }
};
template <class Epi, class Sched, bool ALIGN_EPI = false, bool SP2 = false>
__device__ __forceinline__ void gemm_phase(PG8_LAS unsigned char* lds, const Gemm g, const Sched& S, const Epi& E, const int tid) {
    const int wid = __builtin_amdgcn_readfirstlane(tid >> 6), lane = tid & 63, wr = wid >> 2, wc = wid & 3, fr = lane & 15, fq = lane >> 4;
    const int K = g.K, nt = K / BK;
    unsigned voffA[2], voffB[2];
#pragma unroll
    for (int i = 0; i < 2; ++i) { int R, C; stage_rc(tid * 16 + i * 8192, R, C); const int Rb = Epi::PERM ? ((R & ~31) + perm32(R & 31)) : R;
        voffA[i] = (unsigned)(R * K + C) * 2u; voffB[i] = (unsigned)(Rb * K + C) * 2u; }
    const size_t kstep = (size_t)(BK * 2);
    const size_t hstep = (size_t)HALF * K * 2;
    const size_t tstep = 2 * hstep;
    const unsigned ldsw = (unsigned)wid * 1024u;
    const int aoff = lds_byte(wr * 64 + fr, fq * 8), boff = lds_byte(wc * 32 + fr, fq * 8);
#define PG8_SA(b, h) (((b) * 2 + (h)) * HTB)
#define PG8_SB(b, h) ((4 + (b) * 2 + (h)) * HTB)
#define PG8_STAGE(bufoff, gbase, voff) do { _Pragma("unroll") for (int _i = 0; _i < 2; ++_i) \
        __builtin_amdgcn_global_load_lds((const unsigned*)((const char*)(gbase) + (voff)[_i]), (PG8_LAS unsigned*)(lds + (bufoff) + ldsw + _i * 8192), 16, 0, 0); } while (0)
#define PG8_LDA(dst, b, h) do { _Pragma("unroll") for (int m = 0; m < 4; ++m) _Pragma("unroll") for (int k = 0; k < 2; ++k) dst[m][k] = *(const PG8_LAS bf16x8*)(lds + PG8_SA(b, h) + aoff + m * 2048 + k * 1024); } while (0)
#define PG8_LDB(dst, b, h) do { _Pragma("unroll") for (int n = 0; n < 2; ++n) _Pragma("unroll") for (int k = 0; k < 2; ++k) dst[n][k] = *(const PG8_LAS bf16x8*)(lds + PG8_SB(b, h) + boff + n * 2048 + k * 1024); } while (0)
#define PG8_MMA(ai, bj, At, Bt) do { __builtin_amdgcn_s_setprio(1); _Pragma("unroll") for (int m = 0; m < 4; ++m) _Pragma("unroll") for (int n = 0; n < 2; ++n) _Pragma("unroll") for (int k = 0; k < 2; ++k) \
        acc[ai][bj][m][n] = __builtin_amdgcn_mfma_f32_16x16x32_bf16(Bt[n][k], At[m][k], acc[ai][bj][m][n], 0, 0, 0); __builtin_amdgcn_s_setprio(0); } while (0)
#define PG8_WAIT_V(n) asm volatile("s_waitcnt vmcnt(" #n ")" ::: "memory")
#define PG8_WAIT_L(n) asm volatile("s_waitcnt lgkmcnt(" #n ")" ::: "memory")
#define PG8_BAR __builtin_amdgcn_s_barrier()
#define PG8_SCHED __builtin_amdgcn_sched_barrier(0)
    Unit cur, nxt; int ui = 0;
    if (!S.next(0, cur)) return;
    f32x4 acc[2][2][4][2];
#pragma unroll
    for (int a = 0; a < 2; ++a)
#pragma unroll
        for (int b = 0; b < 2; ++b)
#pragma unroll
            for (int m = 0; m < 4; ++m)
#pragma unroll
                for (int n = 0; n < 2; ++n) acc[a][b][m][n] = (f32x4){0.f, 0.f, 0.f, 0.f};
    bf16x8 At[4][2], B0[2][2], B1[2][2];
    const char* cA = (const char*)g.A + (size_t)cur.pm * tstep; const char* cB = (const char*)g.Bt + (size_t)cur.pn * tstep;
    S.a_ready(cur);
    if constexpr (SP2) {
        PG8_STAGE(PG8_SB(0, 0), cB, voffB); PG8_STAGE(PG8_SB(0, 1), cB + hstep, voffB); PG8_STAGE(PG8_SA(0, 0), cA, voffA); PG8_STAGE(PG8_SA(0, 1), cA + hstep, voffA);
        if (wr == 1) PG8_BAR;
        PG8_WAIT_V(2); PG8_BAR;
        PG8_STAGE(PG8_SB(1, 0), cB + kstep, voffB); PG8_STAGE(PG8_SA(1, 0), cA + kstep, voffA); PG8_STAGE(PG8_SB(1, 1), cB + hstep + kstep, voffB);
        PG8_WAIT_V(6); PG8_BAR;
    } else {
        PG8_STAGE(PG8_SB(0, 0), cB, voffB); PG8_STAGE(PG8_SA(0, 0), cA, voffA); PG8_STAGE(PG8_SB(0, 1), cB + hstep, voffB); PG8_STAGE(PG8_SA(0, 1), cA + hstep, voffA);
        if (wr == 1) PG8_BAR;
        PG8_WAIT_V(4); PG8_BAR;
        PG8_STAGE(PG8_SB(1, 0), cB + kstep, voffB); PG8_STAGE(PG8_SA(1, 0), cA + kstep, voffA); PG8_STAGE(PG8_SB(1, 1), cB + hstep + kstep, voffB);
        PG8_WAIT_V(6); PG8_BAR;
    }
    for (;;) {
        const bool has_next = S.next(ui + 1, nxt);
        const char* nA = has_next ? (const char*)g.A + (size_t)nxt.pm * tstep : cA; const char* nB = has_next ? (const char*)g.Bt + (size_t)nxt.pn * tstep : cB;
        for (int t = 0; t < nt; t += 2) {
            const bool last = (t == nt - 2);
            const char* a1 = cA + (size_t)(t + 1) * kstep;
            const char* a2 = last ? nA : cA + (size_t)(t + 2) * kstep; const char* b2 = last ? nB : cB + (size_t)(t + 2) * kstep;
            const char* a3 = a2 + kstep; const char* b3 = b2 + kstep;
            if (last && has_next) S.a_ready(nxt);
            if constexpr (SP2) {
            PG8_LDB(B0, 0, 0); PG8_LDB(B1, 0, 1); PG8_SCHED; PG8_LDA(At, 0, 0); PG8_STAGE(PG8_SA(1, 1), a1 + hstep, voffA);
            PG8_WAIT_V(8); PG8_WAIT_L(0); PG8_BAR; PG8_MMA(0, 0, At, B0); PG8_MMA(0, 1, At, B1); PG8_BAR; PG8_SCHED;
            PG8_LDA(At, 0, 1); PG8_STAGE(PG8_SB(0, 0), b2, voffB); PG8_STAGE(PG8_SB(0, 1), b2 + hstep, voffB); PG8_STAGE(PG8_SA(0, 0), a2, voffA);
            PG8_WAIT_V(8); PG8_WAIT_L(0); PG8_BAR; PG8_MMA(1, 0, At, B0); PG8_MMA(1, 1, At, B1); PG8_BAR; PG8_SCHED;
            PG8_LDB(B0, 1, 0); PG8_LDB(B1, 1, 1); PG8_SCHED; PG8_LDA(At, 1, 0); PG8_STAGE(PG8_SA(0, 1), a2 + hstep, voffA);
            PG8_WAIT_V(8); PG8_WAIT_L(0); PG8_BAR; PG8_MMA(0, 0, At, B0); PG8_MMA(0, 1, At, B1); PG8_BAR; PG8_SCHED;
            PG8_LDA(At, 1, 1); PG8_STAGE(PG8_SB(1, 0), b3, voffB); PG8_STAGE(PG8_SB(1, 1), b3 + hstep, voffB); PG8_STAGE(PG8_SA(1, 0), a3, voffA);
            PG8_WAIT_V(8); PG8_WAIT_L(0); PG8_BAR; PG8_MMA(1, 0, At, B0); PG8_MMA(1, 1, At, B1); PG8_BAR; PG8_SCHED;
            } else {
            PG8_LDB(B0, 0, 0); PG8_SCHED; PG8_LDA(At, 0, 0); PG8_STAGE(PG8_SA(1, 1), a1 + hstep, voffA);
            PG8_WAIT_L(8); PG8_BAR; PG8_WAIT_L(0); PG8_MMA(0, 0, At, B0); PG8_BAR; PG8_SCHED;
            PG8_LDB(B1, 0, 1); PG8_STAGE(PG8_SB(0, 0), b2, voffB);
            PG8_BAR; PG8_WAIT_L(0); PG8_MMA(0, 1, At, B1); PG8_BAR;
            PG8_LDA(At, 0, 1); PG8_STAGE(PG8_SA(0, 0), a2, voffA);
            PG8_BAR; PG8_WAIT_L(0); PG8_MMA(1, 0, At, B0); PG8_BAR; PG8_SCHED;
            PG8_STAGE(PG8_SB(0, 1), b2 + hstep, voffB);
            PG8_WAIT_V(6); PG8_BAR; PG8_MMA(1, 1, At, B1); PG8_BAR;
            PG8_LDB(B0, 1, 0); PG8_SCHED; PG8_LDA(At, 1, 0); PG8_STAGE(PG8_SA(0, 1), a2 + hstep, voffA);
            PG8_WAIT_L(8); PG8_BAR; PG8_WAIT_L(0); PG8_MMA(0, 0, At, B0); PG8_BAR; PG8_SCHED;
            PG8_LDB(B1, 1, 1); PG8_STAGE(PG8_SB(1, 0), b3, voffB);
            PG8_BAR; PG8_WAIT_L(0); PG8_MMA(0, 1, At, B1); PG8_BAR;
            PG8_LDA(At, 1, 1); PG8_STAGE(PG8_SA(1, 0), a3, voffA);
            PG8_BAR; PG8_WAIT_L(0); PG8_MMA(1, 0, At, B0); PG8_BAR; PG8_SCHED;
            PG8_STAGE(PG8_SB(1, 1), b3 + hstep, voffB);
            PG8_WAIT_V(6); PG8_BAR; PG8_MMA(1, 1, At, B1); PG8_BAR;
            }
        }
        if constexpr (ALIGN_EPI) { if (wr == 0) PG8_BAR; }
        if constexpr (!Epi::AFTER_DRAIN) { E(acc, cur, wr, wc, fr, fq); S.done(cur); }
        if (!has_next) break;
#pragma unroll
        for (int a = 0; a < 2; ++a)
#pragma unroll
            for (int b = 0; b < 2; ++b)
#pragma unroll
                for (int m = 0; m < 4; ++m)
#pragma unroll
                    for (int n = 0; n < 2; ++n) acc[a][b][m][n] = (f32x4){0.f, 0.f, 0.f, 0.f};
        cur = nxt; cA = nA; cB = nB; ++ui;
        if constexpr (ALIGN_EPI) { if (wr == 1) PG8_BAR; }
    }
    PG8_WAIT_V(0);
    if constexpr (!ALIGN_EPI) { if (wr == 0) PG8_BAR; }
    PG8_BAR;
    if constexpr (Epi::AFTER_DRAIN) { E.fused(acc, cur, wr, wc, fr, fq, lds, wid, lane); S.done(cur); }
#undef PG8_SA
#undef PG8_SB
#undef PG8_STAGE
#undef PG8_LDA
#undef PG8_LDB
#undef PG8_MMA
#undef PG8_WAIT_V
#undef PG8_WAIT_L
#undef PG8_BAR
#undef PG8_SCHED
}
}
__device__ __forceinline__ void transpose_item(const float* __restrict__ W, const float* __restrict__ gk, int ldw, int N, int k0, int n0, bf16_t* WT, int ldt, int dst_row0, LAS float* scr, int lane) {
    const int kq = lane >> 3, n4 = (lane & 7) * 4; const bool ok = n0 + n4 < N;
    f32x4 wv[8];
#pragma unroll
    for (int i = 0; i < 8; ++i) wv[i] = ok ? *(const f32x4*)(W + (size_t)(k0 + kq + 8 * i) * ldw + n0 + n4) : (f32x4){0.f, 0.f, 0.f, 0.f};
#pragma unroll
    for (int i = 0; i < 8; ++i) { const int kk = kq + 8 * i; const float gg = gk ? gk[k0 + kk] : 1.f;
#pragma unroll
        for (int e = 0; e < 4; ++e) scr[kk * 33 + n4 + e] = wv[i][e] * gg; }
    asm volatile("s_waitcnt lgkmcnt(0)" ::: "memory");
    const int c = lane & 7;
#pragma unroll
    for (int j = 0; j < 4; ++j) { const int n = (lane >> 3) + 8 * j; const LAS float* s = scr + (8 * c) * 33 + n;
        u32x4 o; o.x = pk2(s[0 * 33], s[1 * 33]); o.y = pk2(s[2 * 33], s[3 * 33]); o.z = pk2(s[4 * 33], s[5 * 33]); o.w = pk2(s[6 * 33], s[7 * 33]);
        *(u32x4*)(WT + (size_t)(dst_row0 + n) * ldt + k0 + 8 * c) = o; }
    asm volatile("s_waitcnt lgkmcnt(0)" ::: "memory");
}
__device__ __forceinline__ void transpose_job(const float* W, const float* gk, int K, int N, bf16_t* WT, int ldt, int mode, int& rot, int gw, int NGW, LAS float* scr, int lane) {
    const int nnb = (N + 31) >> 5, nit = (K >> 6) * nnb;
    int start = gw - rot; if (start < 0) start += NGW;
    for (int it = start; it < nit; it += NGW) {
        const int kb = it / nnb, nb = it - kb * nnb, n0 = nb << 5;
        const int dr = mode == 0 ? n0 : ((n0 >> 7) * 256 + (n0 & 127) + (mode == 2 ? 128 : 0));
        transpose_item(W, gk, N, N, kb << 6, n0, WT, ldt, dr, scr, lane);
    }
    rot = (rot + nit) % NGW;
}
__device__ __forceinline__ void init_stream_bf16(const float* src, bf16_t* dst, float* ssp, int gw, int NGW, int lane) {
    for (int m = gw; m < T_; m += NGW) {
        const f32x4* xr = (const f32x4*)(src + (size_t)m * D_) + lane;
        u32x2 o[4]; float s = 0.f;
#pragma unroll
        for (int j = 0; j < 4; ++j) { const f32x4 v = xr[64 * j]; o[j].x = pk2(v.x, v.y); o[j].y = pk2(v.z, v.w);
            const float a = bflo(o[j].x), b = bfhi(o[j].x), c = bflo(o[j].y), d = bfhi(o[j].y); s += (a * a + b * b) + (c * c + d * d); }
        const float st = wave_sum(s); if (lane < 4) ssp[(size_t)m * 4 + lane] = lane == 0 ? st : 0.f;
        u32x2* o8 = (u32x2*)(dst + (size_t)m * D_) + lane;
#pragma unroll
        for (int j = 0; j < 4; ++j) o8[64 * j] = o[j];
    }
}
__device__ __forceinline__ void final_norm_rows(const bf16_t* hb, const float* __restrict__ g, float* out, int gw, int NGW, int lane) {
    f32x4 gv[4];
#pragma unroll
    for (int j = 0; j < 4; ++j) gv[j] = *(const f32x4*)(g + 4 * lane + 256 * j);
    for (int m = gw; m < T_; m += NGW) {
        const u32x2* hr = (const u32x2*)(hb + (size_t)m * D_) + lane;
        f32x4 v[4]; float s = 0.f;
#pragma unroll
        for (int j = 0; j < 4; ++j) { const u32x2 w = hr[64 * j]; v[j] = (f32x4){bflo(w.x), bfhi(w.x), bflo(w.y), bfhi(w.y)}; s += (v[j].x * v[j].x + v[j].y * v[j].y) + (v[j].z * v[j].z + v[j].w * v[j].w); }
        const float rs = 1.0f / sqrtf(wave_sum(s) * (1.f / D_) + EPS);
        f32x4* xr = (f32x4*)(out + (size_t)m * D_) + lane;
#pragma unroll
        for (int j = 0; j < 4; ++j) xr[64 * j] = v[j] * rs * gv[j];
    }
}
__device__ __forceinline__ void nsa_b1eff(const float* __restrict__ pos, const float* __restrict__ w1, const float* __restrict__ b1, float* B1E, int gw, int NGW, int lane) {
    for (int o = gw; o < 128; o += NGW) { const int kv = o >> 6, j = o & 63; float s = 0.f;
#pragma unroll 8
        for (int i = 0; i < 32; ++i) { const int kk = lane + 64 * i; s += pos[kv * 2048 + kk] * w1[((size_t)kv * 2048 + kk) * 64 + j]; }
        s = wave_sum(s); if (lane == 0) B1E[o] = s + b1[o]; }
}
__device__ __forceinline__ f32x4 mfma16(bf16x8 a, bf16x8 b, f32x4 c) { return __builtin_amdgcn_mfma_f32_16x16x32_bf16(a, b, c, 0, 0, 0); }
__device__ __forceinline__ void unpack8(const u32x4 w, float (&f)[8]) { f[0] = bflo(w.x); f[1] = bfhi(w.x); f[2] = bflo(w.y); f[3] = bfhi(w.y); f[4] = bflo(w.z); f[5] = bfhi(w.z); f[6] = bflo(w.w); f[7] = bfhi(w.w); }
__device__ __forceinline__ u32x4 pack8f(const float (&f)[8]) { u32x4 w; w.x = pk2(f[0], f[1]); w.y = pk2(f[2], f[3]); w.z = pk2(f[4], f[5]); w.w = pk2(f[6], f[7]); return w; }

__device__ __forceinline__ float neg_expm1(float x) {
    const float p = 1.f + x * (0.5f + x * (0.16666667f + x * (0.041666668f + x * (0.0083333338f + x * 0.0013888889f))));
    const float big = 1.f - fast_exp2(x * LOG2E);
    return x > -0.3f ? -x * p : big;
}
__device__ __forceinline__ void lru_gates_phase(LAS unsigned char* lds, const bf16_t* X, const float* __restrict__ conv_w, const float* __restrict__ conv_b,
        const bf16_t* WAT, const bf16_t* WXT, const float* __restrict__ b_a, const float* __restrict__ b_x, const float* __restrict__ lam,
        bf16_t* HL, bf16_t* AC, float* AGGA, float* AGGH, const int tid, const int bid, const int G) {
    const int lane = tid & 63, wid = __builtin_amdgcn_readfirstlane(tid >> 6), fr = lane & 15, fq = lane >> 4;
    constexpr int SA = 0, SBA = 34816, SBX = 69632, SAF = 0, SUF = 67584, SAGG = 135168, LDA_ = 272, LDF = 528;
    for (int u = bid; u < 1280; u += G) {
        const int tt = u / 10, hd = u - tt * 10, m0 = tt * 128, cbase = hd * 128;
        { const int c8 = tid & 15, r = tid >> 4, ch = cbase + 8 * c8;
          float cw[4][8], cb[8];
#pragma unroll
          for (int k = 0; k < 4; ++k) { const f32x4 w0 = *(const f32x4*)(conv_w + k * RNN + ch), w1 = *(const f32x4*)(conv_w + k * RNN + ch + 4);
              cw[k][0] = w0[0]; cw[k][1] = w0[1]; cw[k][2] = w0[2]; cw[k][3] = w0[3]; cw[k][4] = w1[0]; cw[k][5] = w1[1]; cw[k][6] = w1[2]; cw[k][7] = w1[3]; }
          { const f32x4 w0 = *(const f32x4*)(conv_b + ch), w1 = *(const f32x4*)(conv_b + ch + 4); cb[0] = w0[0]; cb[1] = w0[1]; cb[2] = w0[2]; cb[3] = w0[3]; cb[4] = w1[0]; cb[5] = w1[1]; cb[6] = w1[2]; cb[7] = w1[3]; }
#pragma unroll
          for (int g = 0; g < 4; ++g) { const int row = r + 32 * g, m = m0 + row, ts = m & (SEQ - 1);
              float acc[8];
#pragma unroll
              for (int e = 0; e < 8; ++e) acc[e] = cb[e];
#pragma unroll
              for (int k = 0; k < 4; ++k) { const bool okk = ts - 3 + k >= 0;
                  const u32x4 xv = *(const u32x4*)(X + (size_t)(okk ? m - 3 + k : m) * RNN + ch); float xf[8]; unpack8(xv, xf); const float zk = okk ? 1.f : 0.f;
#pragma unroll
                  for (int e = 0; e < 8; ++e) acc[e] += cw[k][e] * (xf[e] * zk); }
              *(LAS u32x4*)(lds + SA + row * LDA_ + c8 * 16) = pack8f(acc); } }
#pragma unroll
        for (int i = 0; i < 8; ++i) { const int q = tid + 512 * i, mat = q >> 11, j = (q >> 4) & 127, c = q & 15;
            const u32x4 v = *(const u32x4*)((mat ? WXT : WAT) + hd * 16384 + j * 128 + c * 8);
            *(LAS u32x4*)(lds + (mat ? SBX : SBA) + j * LDA_ + c * 16) = v; }
        __syncthreads();
        const int rg = wid >> 1, chh = wid & 1;
        f32x4 acca[2][4], accx[2][4];
#pragma unroll
        for (int mt = 0; mt < 2; ++mt)
#pragma unroll
            for (int nt = 0; nt < 4; ++nt) { acca[mt][nt] = (f32x4){0.f, 0.f, 0.f, 0.f}; accx[mt][nt] = (f32x4){0.f, 0.f, 0.f, 0.f}; }
#pragma unroll
        for (int s = 0; s < 4; ++s) { bf16x8 af[2];
#pragma unroll
            for (int mt = 0; mt < 2; ++mt) af[mt] = *(const LAS bf16x8*)(lds + SA + (32 * rg + 16 * mt + fr) * LDA_ + (32 * s + 8 * fq) * 2);
#pragma unroll
            for (int nt = 0; nt < 4; ++nt) { const bf16x8 ba = *(const LAS bf16x8*)(lds + SBA + (64 * chh + 16 * nt + fr) * LDA_ + (32 * s + 8 * fq) * 2);
                const bf16x8 bx = *(const LAS bf16x8*)(lds + SBX + (64 * chh + 16 * nt + fr) * LDA_ + (32 * s + 8 * fq) * 2);
#pragma unroll
                for (int mt = 0; mt < 2; ++mt) { acca[mt][nt] = mfma16(ba, af[mt], acca[mt][nt]); accx[mt][nt] = mfma16(bx, af[mt], accx[mt][nt]); } } }
        u32x2 xcv[2][4];
#pragma unroll
        for (int mt = 0; mt < 2; ++mt)
#pragma unroll
            for (int nt = 0; nt < 4; ++nt) xcv[mt][nt] = *(const LAS u32x2*)(lds + SA + (32 * rg + 16 * mt + fr) * LDA_ + (64 * chh + 16 * nt + 4 * fq) * 2);
        __syncthreads();
#pragma unroll
        for (int nt = 0; nt < 4; ++nt) { const int cc = cbase + 64 * chh + 16 * nt + 4 * fq;
            const f32x4 ba4 = *(const f32x4*)(b_a + cc), bx4 = *(const f32x4*)(b_x + cc), lm4 = *(const f32x4*)(lam + cc);
            f32x4 nl8;
#pragma unroll
            for (int j = 0; j < 4; ++j) nl8[j] = -8.f * 0.6931471805599453f * __builtin_amdgcn_logf(1.f + fast_exp2(-lm4[j] * LOG2E));
#pragma unroll
            for (int mt = 0; mt < 2; ++mt) { const float xc4[4] = {bflo(xcv[mt][nt].x), bfhi(xcv[mt][nt].x), bflo(xcv[mt][nt].y), bfhi(xcv[mt][nt].y)};
                f32x4 a4, u4;
#pragma unroll
                for (int j = 0; j < 4; ++j) { const float r = sigmoidf_(acca[mt][nt][j] + ba4[j]), ig = sigmoidf_(accx[mt][nt][j] + bx4[j]);
                    const float la = nl8[j] * r; a4[j] = fast_exp2(la * LOG2E); u4[j] = __builtin_amdgcn_sqrtf(neg_expm1(2.f * la)) * ig * xc4[j]; }
                const int off = (32 * rg + 16 * mt + fr) * LDF + (64 * chh + 16 * nt + 4 * fq) * 4;
                *(LAS f32x4*)(lds + SAF + off) = a4; *(LAS f32x4*)(lds + SUF + off) = u4; } }
        __syncthreads();
        { const int ch = tid & 127, seg = tid >> 7;
          LAS float* pa = (LAS float*)(lds + SAF) + ch; LAS float* pu = (LAS float*)(lds + SUF) + ch; LAS float* ag = (LAS float*)(lds + SAGG);
          float A = 1.f, H = 0.f;
#pragma unroll 8
          for (int t = seg * 32; t < seg * 32 + 32; ++t) { const float a = pa[t * (LDF / 4)], uu = pu[t * (LDF / 4)]; H = a * H + uu; A *= a; }
          ag[seg * 128 + ch] = A; ag[512 + seg * 128 + ch] = H;
          __syncthreads();
          float cA = 1.f, cH = 0.f;
          for (int s = 0; s < seg; ++s) { const float As = ag[s * 128 + ch], Hs = ag[512 + s * 128 + ch]; cH = As * cH + Hs; cA *= As; }
#pragma unroll 8
          for (int t = seg * 32; t < seg * 32 + 32; ++t) { const float a = pa[t * (LDF / 4)], uu = pu[t * (LDF / 4)]; cH = a * cH + uu; cA *= a; pa[t * (LDF / 4)] = cA; pu[t * (LDF / 4)] = cH; }
          if (seg == 3) { AGGA[(size_t)tt * RNN + cbase + ch] = cA; AGGH[(size_t)tt * RNN + cbase + ch] = cH; } }
        __syncthreads();
#pragma unroll
        for (int i = 0; i < 4; ++i) { const int q = tid + 512 * i, row = q >> 4, c8 = q & 15;
            const f32x4 a0 = *(const LAS f32x4*)(lds + SAF + row * LDF + c8 * 32), a1 = *(const LAS f32x4*)(lds + SAF + row * LDF + c8 * 32 + 16);
            const f32x4 h0 = *(const LAS f32x4*)(lds + SUF + row * LDF + c8 * 32), h1 = *(const LAS f32x4*)(lds + SUF + row * LDF + c8 * 32 + 16);
            u32x4 wa, wh; wa.x = pk2(a0[0], a0[1]); wa.y = pk2(a0[2], a0[3]); wa.z = pk2(a1[0], a1[1]); wa.w = pk2(a1[2], a1[3]);
            wh.x = pk2(h0[0], h0[1]); wh.y = pk2(h0[2], h0[3]); wh.z = pk2(h1[0], h1[1]); wh.w = pk2(h1[2], h1[3]);
            const size_t go = (size_t)(m0 + row) * RNN + cbase + 8 * c8;
            *(u32x4*)(AC + go) = wa; *(u32x4*)(HL + go) = wh; }
        __syncthreads();
    }
}
__device__ __forceinline__ void lru_apply_phase(const bf16_t* GB, bf16_t* YO, const bf16_t* HL, const bf16_t* AC, const float* AGGA, const float* AGGH, const int tid, const int bid, const int G) {
    const int c8 = tid & 31, r = tid >> 5;
    for (int u = bid; u < 640; u += G) {
        const int tt = u / 5, cb = u - tt * 5, m0 = tt * 128, ch = cb * 256 + 8 * c8;
        float carry[8];
#pragma unroll
        for (int e = 0; e < 8; ++e) carry[e] = 0.f;
        { const int p0 = tt & ~63; int p = p0;
          for (; p + 8 <= tt; p += 8) { f32x4 a0[8], a1[8], h0[8], h1[8];
#pragma unroll
              for (int q = 0; q < 8; ++q) { const size_t o = (size_t)(p + q) * RNN + ch; a0[q] = *(const f32x4*)(AGGA + o); a1[q] = *(const f32x4*)(AGGA + o + 4); h0[q] = *(const f32x4*)(AGGH + o); h1[q] = *(const f32x4*)(AGGH + o + 4); }
#pragma unroll
              for (int q = 0; q < 8; ++q)
#pragma unroll
                  for (int e = 0; e < 4; ++e) { carry[e] = carry[e] * a0[q][e] + h0[q][e]; carry[4 + e] = carry[4 + e] * a1[q][e] + h1[q][e]; } }
          for (; p < tt; ++p) { const size_t o = (size_t)p * RNN + ch; const f32x4 a0 = *(const f32x4*)(AGGA + o), a1 = *(const f32x4*)(AGGA + o + 4), h0 = *(const f32x4*)(AGGH + o), h1 = *(const f32x4*)(AGGH + o + 4);
#pragma unroll
              for (int e = 0; e < 4; ++e) { carry[e] = carry[e] * a0[e] + h0[e]; carry[4 + e] = carry[4 + e] * a1[e] + h1[e]; } } }
#pragma unroll
        for (int i = 0; i < 8; ++i) { const size_t go = (size_t)(m0 + r + 16 * i) * RNN + ch;
            float g[8], hl[8], ac[8], y[8]; unpack8(*(const u32x4*)(GB + go), g); unpack8(*(const u32x4*)(HL + go), hl); unpack8(*(const u32x4*)(AC + go), ac);
#pragma unroll
            for (int e = 0; e < 8; ++e) y[e] = g[e] * (hl[e] + ac[e] * carry[e]);
            *(u32x4*)(YO + go) = pack8f(y); }
    }
}
__device__ __forceinline__ s16x4 tr_read(const LAS unsigned char* p) { typedef short v4i16_t __attribute__((ext_vector_type(4))); return __builtin_bit_cast(s16x4, __builtin_amdgcn_ds_read_tr16_b64_v4i16((LAS v4i16_t*)p)); }
__device__ __forceinline__ bf16x8 cat44(s16x4 lo, s16x4 hi) { return (bf16x8){lo[0], lo[1], lo[2], lo[3], hi[0], hi[1], hi[2], hi[3]}; }
__device__ __forceinline__ void gla_cum(LAS unsigned char* lds, const float* GL, const float* __restrict__ w_g2, const float* __restrict__ b_g2, int m0, int h, const int tid, const int bid, const int G) {

    LAS float* sGL = (LAS float*)lds; LAS float* sSeg = (LAS float*)(lds + 4096); LAS float* sB = (LAS float*)(lds + 8192);
    if (tid < 256) *(LAS f32x4*)(sGL + tid * 4) = *(const f32x4*)(GL + (size_t)m0 * 16 + tid * 4);
    const int d = tid & 127, tq = tid >> 7, dch = h * 128 + d;
    float w[16];
#pragma unroll
    for (int r = 0; r < 16; ++r) w[r] = w_g2[r * 512 + dch];
    const float bb = b_g2[dch];
    __syncthreads();
    float run = 0.f;
#pragma unroll 4
    for (int i = 0; i < 16; ++i) { const int t = tq * 16 + i; float z = bb;
#pragma unroll
        for (int r4 = 0; r4 < 4; ++r4) { const f32x4 gv = *(const LAS f32x4*)(sGL + t * 16 + r4 * 4); z += gv[0] * w[r4 * 4] + gv[1] * w[r4 * 4 + 1] + gv[2] * w[r4 * 4 + 2] + gv[3] * w[r4 * 4 + 3]; }
        const float la = -(__builtin_amdgcn_logf(1.f + fast_exp2(-fabsf(z) * LOG2E)) * 0.6931471805599453f + fmaxf(-z, 0.f)) * 0.0625f;
        run += la; sB[t * 128 + d] = run; }
    sSeg[tq * 128 + d] = run;
    __syncthreads();
    float pre = 0.f;
    for (int s = 0; s < tq; ++s) pre += sSeg[s * 128 + d];
#pragma unroll 4
    for (int i = 0; i < 16; ++i) sB[(tq * 16 + i) * 128 + d] += pre;
    __syncthreads();
}
__device__ __forceinline__ void gla_kv_phase(LAS unsigned char* lds, const bf16_t* Kg, const bf16_t* Vg, const float* GL, const float* w_g2, const float* b_g2, bf16_t* KVT, float* DEC, const int tid, const int bid, const int G) {
    const int lane = tid & 63, wid = __builtin_amdgcn_readfirstlane(tid >> 6), fr = lane & 15, fq = lane >> 4, q4 = (lane & 15) >> 2, p4 = lane & 3;
    constexpr int SB_ = 8192, SK = 40960, SV = 58368, LDK = 272, LDV = 528;
    const LAS float* sB = (const LAS float*)(lds + SB_);
    for (int u = bid; u < 1024; u += G) {
        const int b = u >> 9, n = (u >> 2) & 127, h = u & 3, m0 = b * SEQ + 64 * n, bh = b * 4 + h;
        gla_cum(lds, GL, w_g2, b_g2, m0, h, tid, bid, G);
#pragma unroll
        for (int i = 0; i < 2; ++i) { const int q = tid + 512 * i, t = q >> 4, c = q & 15; float kf[8]; unpack8(*(const u32x4*)(Kg + (size_t)(m0 + t) * 512 + h * 128 + 8 * c), kf);
#pragma unroll
            for (int e = 0; e < 8; ++e) kf[e] *= fast_exp2((sB[63 * 128 + 8 * c + e] - sB[t * 128 + 8 * c + e]) * LOG2E);
            *(LAS u32x4*)(lds + SK + t * LDK + c * 16) = pack8f(kf); }
        if (tid < 128) DEC[((size_t)bh * 128 + n) * 128 + tid] = fast_exp2(sB[63 * 128 + tid] * LOG2E);
#pragma unroll
        for (int i = 0; i < 4; ++i) { const int q = tid + 512 * i, t = q >> 5, c = q & 31; *(LAS u32x4*)(lds + SV + t * LDV + c * 16) = *(const u32x4*)(Vg + (size_t)(m0 + t) * 1024 + h * 256 + 8 * c); }
        __syncthreads();
        f32x4 acc[8][2];
#pragma unroll
        for (int mt = 0; mt < 8; ++mt) { acc[mt][0] = (f32x4){0.f, 0.f, 0.f, 0.f}; acc[mt][1] = (f32x4){0.f, 0.f, 0.f, 0.f}; }
#pragma unroll
        for (int s = 0; s < 2; ++s) { bf16x8 bv[2];
#pragma unroll
            for (int nl = 0; nl < 2; ++nl) { const LAS unsigned char* pv = lds + SV + (32 * s + 8 * fq + q4) * LDV + (32 * wid + 16 * nl + 4 * p4) * 2; bv[nl] = cat44(tr_read(pv), tr_read(pv + 4 * LDV)); }
#pragma unroll
            for (int mt = 0; mt < 8; ++mt) { const LAS unsigned char* pk = lds + SK + (32 * s + 8 * fq + q4) * LDK + (16 * mt + 4 * p4) * 2; const bf16x8 ak = cat44(tr_read(pk), tr_read(pk + 4 * LDK));
                acc[mt][0] = mfma16(ak, bv[0], acc[mt][0]); acc[mt][1] = mfma16(ak, bv[1], acc[mt][1]); } }
        bf16_t* dst = KVT + ((size_t)bh * 128 + n) * 32768;
#pragma unroll
        for (int mt = 0; mt < 8; ++mt)
#pragma unroll
            for (int nl = 0; nl < 2; ++nl) { u32x2 w; w.x = pk2(acc[mt][nl][0], acc[mt][nl][1]); w.y = pk2(acc[mt][nl][2], acc[mt][nl][3]);
                *(u32x2*)(dst + (32 * wid + 16 * nl + fr) * 128 + 16 * mt + 4 * fq) = w; }
        __syncthreads();
    }
}
__device__ __forceinline__ void gla_scan_phase(bf16_t* KVT, const float* DEC, const bool dry, const int tid, const int bid, const int G) {
    const int nthr = G * 512;
    for (int e2 = bid * 512 + tid; e2 < 8 * 16384; e2 += nthr) {
        const int bh = e2 >> 14, e = (e2 & 16383) * 2, dk = e & 127;
        unsigned* p = (unsigned*)(KVT + (size_t)bh * 128 * 32768 + e); const float* dp = DEC + (size_t)bh * 128 * 128 + dk;
        float s0 = 0.f, s1 = 0.f;
        for (int n0 = 0; n0 < 128; n0 += 8) { unsigned w[8]; f32x2 d2[8];
#pragma unroll
            for (int i = 0; i < 8; ++i) { w[i] = p[(size_t)(n0 + i) * 16384]; d2[i] = *(const f32x2*)(dp + (n0 + i) * 128); }
#pragma unroll
            for (int i = 0; i < 8; ++i) { if (!dry) p[(size_t)(n0 + i) * 16384] = pk2(s0, s1); s0 = s0 * d2[i].x + bflo(w[i]); s1 = s1 * d2[i].y + bfhi(w[i]); } }
    }
}
__device__ __forceinline__ void gla_out_phase(LAS unsigned char* lds, const bf16_t* Qg, const bf16_t* Kg, const bf16_t* Vg, const bf16_t* Rg, const float* GL, const float* w_g2, const float* b_g2,
        const float* __restrict__ norm_g, const bf16_t* KVT, bf16_t* Y, const int tid, const int bid, const int G) {
    const int lane = tid & 63, wid = __builtin_amdgcn_readfirstlane(tid >> 6), fr = lane & 15, fq = lane >> 4, q4 = (lane & 15) >> 2, p4 = lane & 3;
    constexpr int SB_ = 8192, SQ = 40960, SKI = 58368, SV = 75776, SATT = 109568, SSS = 118784, LDQ = 272, LDV = 528, LDAT = 144;
    const LAS float* sB = (const LAS float*)(lds + SB_);
    for (int u = bid; u < 1024; u += G) {
        const int b = u >> 9, n = (u >> 2) & 127, h = u & 3, m0 = b * SEQ + 64 * n, bh = b * 4 + h;
        bf16x8 bsall[4][2];
        { const bf16_t* Sp = KVT + ((size_t)bh * 128 + n) * 32768;
#pragma unroll
          for (int s = 0; s < 4; ++s)
#pragma unroll
              for (int nl = 0; nl < 2; ++nl) bsall[s][nl] = *(const bf16x8*)(Sp + (32 * wid + 16 * nl + fr) * 128 + 32 * s + 8 * fq); }
        gla_cum(lds, GL, w_g2, b_g2, m0, h, tid, bid, G);
#pragma unroll
        for (int i = 0; i < 2; ++i) { const int q = tid + 512 * i, t = q >> 4, c = q & 15; float qf[8], kf[8];
            unpack8(*(const u32x4*)(Qg + (size_t)(m0 + t) * 512 + h * 128 + 8 * c), qf); unpack8(*(const u32x4*)(Kg + (size_t)(m0 + t) * 512 + h * 128 + 8 * c), kf);
#pragma unroll
            for (int e = 0; e < 8; ++e) { const float bb = sB[t * 128 + 8 * c + e] * LOG2E; qf[e] *= fast_exp2(bb); kf[e] *= fast_exp2(-bb); }
            *(LAS u32x4*)(lds + SQ + t * LDQ + c * 16) = pack8f(qf); *(LAS u32x4*)(lds + SKI + t * LDQ + c * 16) = pack8f(kf); }
#pragma unroll
        for (int i = 0; i < 4; ++i) { const int q = tid + 512 * i, t = q >> 5, c = q & 31; *(LAS u32x4*)(lds + SV + t * LDV + c * 16) = *(const u32x4*)(Vg + (size_t)(m0 + t) * 1024 + h * 256 + 8 * c); }
        __syncthreads();
        { const int mt = wid >> 1; f32x4 at[2] = {(f32x4){0.f, 0.f, 0.f, 0.f}, (f32x4){0.f, 0.f, 0.f, 0.f}};
#pragma unroll
          for (int s = 0; s < 4; ++s) { const bf16x8 a = *(const LAS bf16x8*)(lds + SQ + (16 * mt + fr) * LDQ + (32 * s + 8 * fq) * 2);
#pragma unroll
              for (int nl = 0; nl < 2; ++nl) { const int nt = 2 * (wid & 1) + nl; const bf16x8 bk = *(const LAS bf16x8*)(lds + SKI + (16 * nt + fr) * LDQ + (32 * s + 8 * fq) * 2); at[nl] = mfma16(bk, a, at[nl]); } }
#pragma unroll
          for (int nl = 0; nl < 2; ++nl) { const int nt = 2 * (wid & 1) + nl, c = 16 * mt + fr, j0 = 16 * nt + 4 * fq; float v[4];
#pragma unroll
              for (int j = 0; j < 4; ++j) v[j] = (j0 + j <= c) ? at[nl][j] : 0.f;
              u32x2 w; w.x = pk2(v[0], v[1]); w.y = pk2(v[2], v[3]); *(LAS u32x2*)(lds + SATT + c * LDAT + j0 * 2) = w; } }
        __syncthreads();
        f32x4 o[4][2];
#pragma unroll
        for (int mt = 0; mt < 4; ++mt) { o[mt][0] = (f32x4){0.f, 0.f, 0.f, 0.f}; o[mt][1] = (f32x4){0.f, 0.f, 0.f, 0.f}; }
#pragma unroll
        for (int s = 0; s < 2; ++s) { bf16x8 bv[2];
#pragma unroll
            for (int nl = 0; nl < 2; ++nl) { const LAS unsigned char* pv = lds + SV + (32 * s + 8 * fq + q4) * LDV + (32 * wid + 16 * nl + 4 * p4) * 2; bv[nl] = cat44(tr_read(pv), tr_read(pv + 4 * LDV)); }
#pragma unroll
            for (int mt = 0; mt < 4; ++mt) { const bf16x8 a = *(const LAS bf16x8*)(lds + SATT + (16 * mt + fr) * LDAT + (32 * s + 8 * fq) * 2);
                o[mt][0] = mfma16(bv[0], a, o[mt][0]); o[mt][1] = mfma16(bv[1], a, o[mt][1]); } }
#pragma unroll
        for (int s = 0; s < 4; ++s) {
#pragma unroll
            for (int mt = 0; mt < 4; ++mt) { const bf16x8 a = *(const LAS bf16x8*)(lds + SQ + (16 * mt + fr) * LDQ + (32 * s + 8 * fq) * 2);
                o[mt][0] = mfma16(bsall[s][0], a, o[mt][0]); o[mt][1] = mfma16(bsall[s][1], a, o[mt][1]); } }
        LAS float* sSS = (LAS float*)(lds + SSS);
#pragma unroll
        for (int mt = 0; mt < 4; ++mt) { float ss = 0.f;
#pragma unroll
            for (int nl = 0; nl < 2; ++nl)
#pragma unroll
                for (int j = 0; j < 4; ++j) ss += o[mt][nl][j] * o[mt][nl][j];
            ss += __shfl_xor(ss, 16); ss += __shfl_xor(ss, 32);
            if (fq == 0) sSS[(16 * mt + fr) * 8 + wid] = ss; }
        __syncthreads();
#pragma unroll
        for (int mt = 0; mt < 4; ++mt) { const int tok = 16 * mt + fr; const f32x4 s0 = *(const LAS f32x4*)(sSS + tok * 8), s1 = *(const LAS f32x4*)(sSS + tok * 8 + 4);
            const float tot = ((s0[0] + s0[1]) + (s0[2] + s0[3])) + ((s1[0] + s1[1]) + (s1[2] + s1[3])); const float rs = __builtin_amdgcn_rsqf(tot * (1.f / 256.f) + EPS);
#pragma unroll
            for (int nl = 0; nl < 2; ++nl) { const int dv = 32 * wid + 16 * nl + 4 * fq; const f32x4 gn = *(const f32x4*)(norm_g + dv);
                const size_t go = (size_t)(m0 + tok) * 1024 + h * 256 + dv; const u32x2 rv = *(const u32x2*)(Rg + go);
                u32x2 w; w.x = pk2(o[mt][nl][0] * rs * gn[0] * bflo(rv.x), o[mt][nl][1] * rs * gn[1] * bfhi(rv.x)); w.y = pk2(o[mt][nl][2] * rs * gn[2] * bflo(rv.y), o[mt][nl][3] * rs * gn[3] * bfhi(rv.y));
                *(u32x2*)(Y + go) = w; } }
        __syncthreads();
    }
}
__device__ __forceinline__ void nsa_compress_phase(LAS unsigned char* lds, const bf16_t* KV, const float* __restrict__ pos, const float* __restrict__ w1, const float* __restrict__ b1,
        const float* __restrict__ b2, const bf16_t* W1T, const bf16_t* W2T, bf16_t* KC, bf16_t* VC, bf16_t* VT, const float* B1E, const int tid, const int bid, const int G) {
    const int lane = tid & 63, wid = __builtin_amdgcn_readfirstlane(tid >> 6), fr = lane & 15, fq = lane >> 4;
    constexpr int SP = 0, SB1 = 2048, SPART = 4096, SH = 36864, LDH = 144;
    for (int u = bid; u < 256; u += G) {
        const int kv = u >> 7, b = (u >> 6) & 1, g = (u >> 4) & 3, n0 = (u & 15) * 32;
        if (tid < 64) ((LAS float*)(lds + SB1))[tid] = B1E[kv * 64 + tid];
        { const int rt = wid & 1, kq = wid >> 1, n = n0 + 16 * rt + fr; const bool ok = n <= 510;
          const bf16_t* src = KV + (size_t)kv * T_ * 256 + (size_t)(b * SEQ + 16 * (ok ? n : 0)) * 256 + g * 64;
          const bf16_t* wt = W1T + (size_t)kv * 64 * 2048;
          f32x4 acc[4] = {(f32x4){0.f, 0.f, 0.f, 0.f}, (f32x4){0.f, 0.f, 0.f, 0.f}, (f32x4){0.f, 0.f, 0.f, 0.f}, (f32x4){0.f, 0.f, 0.f, 0.f}};
#pragma unroll 4
          for (int s = 0; s < 16; ++s) { const int kk = kq * 512 + 32 * s + 8 * fq, l = kk >> 6, d = kk & 63;
              bf16x8 a = *(const bf16x8*)(src + (size_t)l * 256 + d); if (!ok) a = (bf16x8){0, 0, 0, 0, 0, 0, 0, 0};
#pragma unroll
              for (int nt = 0; nt < 4; ++nt) { const bf16x8 bb = *(const bf16x8*)(wt + (size_t)(16 * nt + fr) * 2048 + kk); acc[nt] = mfma16(bb, a, acc[nt]); } }
#pragma unroll
          for (int nt = 0; nt < 4; ++nt) *(LAS f32x4*)(lds + SPART + ((kq * 2 + rt) * 1024 + fr * 64 + 16 * nt + 4 * fq) * 4) = acc[nt]; }
        __syncthreads();
        { const int row = tid >> 4, c4 = (tid & 15) * 4, rt = row >> 4, rr = row & 15; f32x4 s = *(const LAS f32x4*)(lds + SB1 + c4 * 4);
#pragma unroll
          for (int kq = 0; kq < 4; ++kq) s += *(const LAS f32x4*)(lds + SPART + ((kq * 2 + rt) * 1024 + rr * 64 + c4) * 4);
          u32x2 w; w.x = pk2(gelu_tanh_(s[0]), gelu_tanh_(s[1])); w.y = pk2(gelu_tanh_(s[2]), gelu_tanh_(s[3])); *(LAS u32x2*)(lds + SH + row * LDH + c4 * 2) = w; }
        __syncthreads();
        { const int rt = wid >> 2, nt = wid & 3; f32x4 acc = (f32x4){0.f, 0.f, 0.f, 0.f};
#pragma unroll
          for (int s = 0; s < 2; ++s) { const bf16x8 a = *(const LAS bf16x8*)(lds + SH + (16 * rt + fr) * LDH + (32 * s + 8 * fq) * 2);
              const bf16x8 bb = *(const bf16x8*)(W2T + kv * 4096 + (16 * nt + fr) * 64 + 32 * s + 8 * fq); acc = mfma16(bb, a, acc); }
          const int n = n0 + 16 * rt + fr, d = 16 * nt + 4 * fq; const f32x4 bv = *(const f32x4*)(b2 + kv * 64 + d);
          u32x2 w; w.x = pk2(acc[0] + bv[0], acc[1] + bv[1]); w.y = pk2(acc[2] + bv[2], acc[3] + bv[3]);
          *(u32x2*)((kv ? VC : KC) + ((size_t)(b * 4 + g) * 512 + n) * 64 + d) = w; }
        __syncthreads();
    }
    { const bf16_t* VS = KV + (size_t)3 * T_ * 256;
      for (int tt = bid; tt < T_ / 64; tt += G) { const int r0 = tt * 64, bb = r0 >> 13, t0 = r0 & 8191;
#pragma unroll
          for (int i = 0; i < 4; ++i) { const int q = tid + 512 * i, row = q >> 5, ch = q & 31; *(LAS u32x4*)(lds + row * 528 + ch * 16) = *(const u32x4*)(VS + (size_t)(r0 + row) * 256 + ch * 8); }
          __syncthreads();
          { const int cc = tid >> 1, hf = tid & 1; unsigned short v[32];
#pragma unroll
            for (int k = 0; k < 32; ++k) v[k] = *(const LAS unsigned short*)(lds + (hf * 32 + k) * 528 + cc * 2);
            bf16_t* dst = VT + ((size_t)(bb * 256 + cc)) * 8192 + t0 + hf * 32;
#pragma unroll
            for (int k = 0; k < 4; ++k) { u32x4 w; w.x = v[8 * k] | ((unsigned)v[8 * k + 1] << 16); w.y = v[8 * k + 2] | ((unsigned)v[8 * k + 3] << 16); w.z = v[8 * k + 4] | ((unsigned)v[8 * k + 5] << 16); w.w = v[8 * k + 6] | ((unsigned)v[8 * k + 7] << 16);
                *(u32x4*)(dst + 8 * k) = w; } }
          __syncthreads(); } }
}
#ifndef NSA_LOCKSTEP
#define NSA_LOCKSTEP 0
#endif
#ifndef NSA_ONE_WAVE
#define NSA_ONE_WAVE 0
#endif
#ifndef NSA_SPARSE_SKIP
#define NSA_SPARSE_SKIP 0
#endif
#ifndef NSA_CT3_ONLY
#define NSA_CT3_ONLY 0
#endif
#ifndef NSA_SEL_REP
#define NSA_SEL_REP 1
#endif
#ifndef NSA_WIN_REP
#define NSA_WIN_REP 1
#endif
struct NsaSt { float m, l; f32x4 o[4]; };
struct KVRegs { u32x4 k[2], v[2]; };
template <int MODE, int STEP, int CTM>
__device__ __forceinline__ void nsa_tile(const LAS unsigned char* sK, const LAS unsigned char* sV, const bf16x8 (&qf)[2][2], NsaSt (&st)[2], const int (&dbase)[2],
        const bool general, const bool (&colsel)[2], const LAS float* bt, const float bfar, const float (&minv)[2], LAS float* sMain, LAS float* sSpill, const int (&tokl)[2], const int mg0,
        const int fr_in, const int fq_in, const int q4_in, const int p4_in) {
    constexpr int LDT = 144; const float NEG = -INFINITY;
    int fr = fr_in, fq = fq_in, q4 = q4_in, p4 = p4_in; asm volatile("" : "+v"(fr), "+v"(fq), "+v"(q4), "+v"(p4));
    bf16x8 kf[4][2];
#pragma unroll
    for (int kt = 0; kt < 4; ++kt) { kf[kt][0] = *(const LAS bf16x8*)(sK + (16 * kt + fr) * LDT + (8 * fq) * 2); kf[kt][1] = *(const LAS bf16x8*)(sK + (16 * kt + fr) * LDT + (32 + 8 * fq) * 2); }
    f32x4 sacc[2][4];
#pragma unroll
    for (int ct = 0; ct < 2; ++ct) if (CTM & (1 << ct)) {
#pragma unroll
        for (int kt = 0; kt < 4; ++kt) sacc[ct][kt] = mfma16(kf[kt][0], qf[ct][0], (f32x4){0.f, 0.f, 0.f, 0.f});
#pragma unroll
        for (int kt = 0; kt < 4; ++kt) sacc[ct][kt] = mfma16(kf[kt][1], qf[ct][1], sacc[ct][kt]); }
#pragma unroll
    for (int ct = 0; ct < 2; ++ct) if (CTM & (1 << ct)) {
        float tmax = NEG;
        if (general) {
            float bv[4][4];
#pragma unroll
            for (int kt = 0; kt < 4; ++kt)
#pragma unroll
                for (int j = 0; j < 4; ++j) { const int dist = dbase[ct] - (16 * kt + 4 * fq + j) * STEP; const int idx = dist < 0 ? 0 : (dist > 128 ? 128 : dist); bv[kt][j] = bt[idx]; }
#pragma unroll
            for (int kt = 0; kt < 4; ++kt)
#pragma unroll
                for (int j = 0; j < 4; ++j) { const int dist = dbase[ct] - (16 * kt + 4 * fq + j) * STEP; bool valid = dist >= 0;
                    if (MODE == 3) valid = valid && dist < 512;
                    if (MODE == 2) valid = valid && colsel[ct];
                    const float x = valid ? sacc[ct][kt][j] * LOG2E + bv[kt][j] : NEG;
                    sacc[ct][kt][j] = x; tmax = max3_(tmax, x, x); }
        } else {
#pragma unroll
            for (int kt = 0; kt < 4; ++kt) tmax = max3_(max3_(tmax, sacc[ct][kt][0], sacc[ct][kt][1]), sacc[ct][kt][2], sacc[ct][kt][3]);
            tmax = (MODE == 2 && !colsel[ct]) ? NEG : tmax * LOG2E + bfar;
        }
        if (MODE == 1) {
            const float mm = st[ct].m, li = minv[ct];
#pragma unroll
            for (int kt = 0; kt < 4; ++kt) { float gs = 0.f, p3 = 0.f;
#pragma unroll
                for (int j = 0; j < 4; ++j) { const float xx = general ? sacc[ct][kt][j] : sacc[ct][kt][j] * LOG2E + bfar; const float p = fast_exp2(xx - mm) * li; sacc[ct][kt][j] = p; gs += p; if (j == 3) p3 = p; }
                gs += dpp_xor1(gs); gs += dpp_xor2(gs); p3 += dpp_xor1(p3); p3 += dpp_xor2(p3);
                const int mg = mg0 + 4 * kt + fq;
                if ((fr & 3) == 0) { sMain[tokl[ct] * 128 + mg] = gs; if (mg + 1 < 128) sSpill[tokl[ct] * 128 + mg + 1] = p3; } }
        } else {
            const float rm = xmax16_32(tmax);
            const bool need = rm > st[ct].m + 8.f;
            if (__any(need)) { const float mnew = need ? fmaxf(st[ct].m, rm) : st[ct].m, alpha = (st[ct].m == mnew) ? 1.f : fast_exp2(st[ct].m - mnew);
                st[ct].l *= alpha; st[ct].m = mnew;
                if (MODE != 0) {
#pragma unroll
                    for (int dt = 0; dt < 4; ++dt) st[ct].o[dt] = st[ct].o[dt] * alpha; } }
            const float mref = (st[ct].m == NEG) ? 0.f : st[ct].m;
            float ps = 0.f;
            if (general) {
#pragma unroll
                for (int kt = 0; kt < 4; ++kt)
#pragma unroll
                    for (int j = 0; j < 4; ++j) { const float p = fast_exp2(sacc[ct][kt][j] - mref); sacc[ct][kt][j] = p; ps += p; }
            } else { const float c = (MODE == 2 && !colsel[ct]) ? NEG : bfar - mref;
#pragma unroll
                for (int kt = 0; kt < 4; ++kt)
#pragma unroll
                    for (int j = 0; j < 4; ++j) { const float p = fast_exp2(sacc[ct][kt][j] * LOG2E + c); sacc[ct][kt][j] = p; ps += p; } }
            st[ct].l += ps;
        }
    }
    if (MODE != 0) {
#pragma unroll
        for (int s = 0; s < 2; ++s) { bf16x8 pf[2];
#pragma unroll
            for (int ct = 0; ct < 2; ++ct) if (CTM & (1 << ct)) { u32x4 w; w.x = pk2(sacc[ct][2 * s][0], sacc[ct][2 * s][1]); w.y = pk2(sacc[ct][2 * s][2], sacc[ct][2 * s][3]);
                w.z = pk2(sacc[ct][2 * s + 1][0], sacc[ct][2 * s + 1][1]); w.w = pk2(sacc[ct][2 * s + 1][2], sacc[ct][2 * s + 1][3]); pf[ct] = __builtin_bit_cast(bf16x8, w); }
#pragma unroll
            for (int dt = 0; dt < 4; ++dt) { const LAS unsigned char* pv = sV + (32 * s + 4 * fq + q4) * LDT + (16 * dt + 4 * p4) * 2; const bf16x8 vf = cat44(tr_read(pv), tr_read(pv + 16 * LDT));
#pragma unroll
                for (int ct = 0; ct < 2; ++ct) if (CTM & (1 << ct)) st[ct].o[dt] = mfma16(vf, pf[ct], st[ct].o[dt]); } }
    }
}
__device__ __forceinline__ void nsa_ld2(const bf16_t* Kp, const bf16_t* Vp, size_t ts, int ld, bool two, int tid_in, KVRegs& r) { int tid = tid_in; asm volatile("" : "+v"(tid)); const int key = tid >> 3, c = tid & 7;
    r.k[0] = *(const u32x4*)(Kp + (size_t)key * ld + 8 * c); r.v[0] = *(const u32x4*)(Vp + (size_t)key * ld + 8 * c);
    if (two) { r.k[1] = *(const u32x4*)(Kp + ts + (size_t)key * ld + 8 * c); r.v[1] = *(const u32x4*)(Vp + ts + (size_t)key * ld + 8 * c); } }
__device__ __forceinline__ void nsa_st2(LAS unsigned char* sK, LAS unsigned char* sV, int tid_in, const KVRegs& r) { int tid = tid_in; asm volatile("" : "+v"(tid)); const int key = tid >> 3, c = tid & 7;
    *(LAS u32x4*)(sK + key * 144 + c * 16) = r.k[0]; *(LAS u32x4*)(sV + key * 144 + c * 16) = r.v[0]; *(LAS u32x4*)(sK + 9216 + key * 144 + c * 16) = r.k[1]; *(LAS u32x4*)(sV + 9216 + key * 144 + c * 16) = r.v[1]; }

__device__ __forceinline__ unsigned long long fx_enc(float x) { const float t = x * 16.f, fl = floorf(t); const int hi = (int)fl; const unsigned lo = (unsigned)((t - fl) * 4294967296.f);
    return ((unsigned long long)(unsigned)hi << 32) | (unsigned long long)lo; }
__device__ __forceinline__ float fx_dec(unsigned long long v) { return (float)(int)(unsigned)(v >> 32) * 0.0625f + (float)(unsigned)v * 1.4551915228366852e-11f; }
__device__ __forceinline__ void nsa_sparse_far(const LAS unsigned* sSel, LAS int* slist, const LAS float* sBt, const LAS float* mref, LAS unsigned long long* lfar, LAS unsigned long long* ofar,
        const bf16_t* Qg  , const bf16_t* ksb, const bf16_t* vtb  , const int qb, const int wid, const int lane_in, const int fr_in, const int fq_in) {
    const float NEG = -INFINITY;
    bf16x8 kf[4][2], vf[2][4], kn[4][2];
#define NSA_LDK(KF, MB) do { int fr_ = fr_in, fq_ = fq_in; asm volatile("" : "+v"(fr_), "+v"(fq_)); \
        _Pragma("unroll") for (int kt = 0; kt < 4; ++kt) _Pragma("unroll") for (int s = 0; s < 2; ++s) KF[kt][s] = *(const bf16x8*)(ksb + (size_t)(64 * (MB) + 16 * kt + fr_) * 256 + 32 * s + 8 * fq_); } while (0)
#define NSA_LDV(VF, MB) do { int fr_ = fr_in, fq_ = fq_in; asm volatile("" : "+v"(fr_), "+v"(fq_)); \
        _Pragma("unroll") for (int s = 0; s < 2; ++s) _Pragma("unroll") for (int dt = 0; dt < 4; ++dt) { const bf16_t* pv = vtb + (size_t)(16 * dt + fr_) * SEQ + 64 * (MB) + 32 * s + 4 * fq_; \
            const u32x2 lo = *(const u32x2*)pv, hi = *(const u32x2*)(pv + 16); u32x4 w; w.x = lo.x; w.y = lo.y; w.z = hi.x; w.w = hi.y; VF[s][dt] = __builtin_bit_cast(bf16x8, w); } } while (0)
    if (1 + wid <= qb - 3) NSA_LDK(kf, 1 + wid);
#pragma unroll 1
    for (int m = 1 + wid; m <= qb - 3; m += 8) {
        int fr = fr_in, fq = fq_in, lane = lane_in; asm volatile("" : "+v"(fr), "+v"(fq), "+v"(lane));
        const int hg = fr & 3; const float bfar = sBt[hg * 132 + 128];
        const bool more = m + 8 <= qb - 3;
        NSA_LDV(vf, m);
        if (more) NSA_LDK(kn, m + 8);
        const unsigned w = sSel[lane * 4 + (m >> 5)]; const bool bit = (w >> (m & 31)) & 1u;
        const unsigned long long B = __ballot(bit); const int n = __popcll(B);
        const int rank = (int)__builtin_amdgcn_mbcnt_hi((unsigned)(B >> 32), __builtin_amdgcn_mbcnt_lo((unsigned)B, 0u));
        if (bit) slist[rank] = lane;
        asm volatile("s_waitcnt lgkmcnt(0)" ::: "memory");
        const int nct = (n + 3) >> 2;
        bf16x8 q0, q1; int tok = 0; bool valid = false;
        if (nct > 0) { const int idx = fr >> 2; valid = idx < n; tok = slist[valid ? idx : 0];
            q0 = *(const bf16x8*)(Qg + (size_t)tok * 1024 + hg * 64 + 8 * fq); q1 = *(const bf16x8*)(Qg + (size_t)tok * 1024 + hg * 64 + 32 + 8 * fq); }
#pragma unroll 1
        for (int ct = 0; ct < nct; ++ct) {
            const int col = tok * 4 + hg; const bool vcur = valid; const bf16x8 c0 = q0, c1 = q1;
            if (ct + 1 < nct) { const int idx = 4 * (ct + 1) + (fr >> 2); valid = idx < n; tok = slist[valid ? idx : 0];
                q0 = *(const bf16x8*)(Qg + (size_t)tok * 1024 + hg * 64 + 8 * fq); q1 = *(const bf16x8*)(Qg + (size_t)tok * 1024 + hg * 64 + 32 + 8 * fq); }
            const float c = vcur ? bfar - mref[col] : NEG;
            f32x4 sacc[4];
#pragma unroll
            for (int kt = 0; kt < 4; ++kt) sacc[kt] = mfma16(kf[kt][0], c0, (f32x4){0.f, 0.f, 0.f, 0.f});
#pragma unroll
            for (int kt = 0; kt < 4; ++kt) sacc[kt] = mfma16(kf[kt][1], c1, sacc[kt]);
            float ps = 0.f;
#pragma unroll
            for (int kt = 0; kt < 4; ++kt)
#pragma unroll
                for (int j = 0; j < 4; ++j) { const float p = fminf(fast_exp2(sacc[kt][j] * LOG2E + c), 16384.f); sacc[kt][j] = p; ps += p; }
            ps = xsum16_32(ps);
            if (fq == 0 && vcur) (void)__hip_atomic_fetch_add(lfar + col, fx_enc(ps), __ATOMIC_RELAXED, __HIP_MEMORY_SCOPE_WORKGROUP);
            f32x4 oacc[4] = {(f32x4){0.f, 0.f, 0.f, 0.f}, (f32x4){0.f, 0.f, 0.f, 0.f}, (f32x4){0.f, 0.f, 0.f, 0.f}, (f32x4){0.f, 0.f, 0.f, 0.f}};
#pragma unroll
            for (int s = 0; s < 2; ++s) { u32x4 pw; pw.x = pk2(sacc[2 * s][0], sacc[2 * s][1]); pw.y = pk2(sacc[2 * s][2], sacc[2 * s][3]); pw.z = pk2(sacc[2 * s + 1][0], sacc[2 * s + 1][1]); pw.w = pk2(sacc[2 * s + 1][2], sacc[2 * s + 1][3]);
                const bf16x8 pf = __builtin_bit_cast(bf16x8, pw);
#pragma unroll
                for (int dt = 0; dt < 4; ++dt) oacc[dt] = mfma16(vf[s][dt], pf, oacc[dt]); }
            if (vcur) {
#pragma unroll
                for (int dt = 0; dt < 4; ++dt)
#pragma unroll
                    for (int j = 0; j < 4; ++j) (void)__hip_atomic_fetch_add(ofar + col * 66 + 16 * dt + 4 * fq + j, fx_enc(oacc[dt][j]), __ATOMIC_RELAXED, __HIP_MEMORY_SCOPE_WORKGROUP); }
        }
        asm volatile("s_waitcnt lgkmcnt(0)" ::: "memory");
        if (more) {
#pragma unroll
            for (int kt = 0; kt < 4; ++kt) { kf[kt][0] = kn[kt][0]; kf[kt][1] = kn[kt][1]; } }
    }
#undef NSA_LDK
#undef NSA_LDV
}

#ifndef NSA_SPARSE_QB
#define NSA_SPARSE_QB 24
#endif
__device__ __forceinline__ void nsa_attn_phase(LAS unsigned char* lds, const bf16_t* Q, const bf16_t* KV, const float* GT, const bf16_t* KC, const bf16_t* VC, const float* __restrict__ rel_bias, bf16_t* Y, const bf16_t* VT, void* TQ, const int tid, const int bid, const int G) {
    const int lane = tid & 63, wid = __builtin_amdgcn_readfirstlane(tid >> 6), fr = lane & 15, fq = lane >> 4, q4 = (lane & 15) >> 2, p4 = lane & 3, hg = fr & 3;
    constexpr int SKO = 0, SVO = 36864, SMAIN = 73728, SSPILL = 106496, SBT = 143360, SSEL = 145472, SMREF = 146496, SLFAR = 147520, SLIST = 149568, TB = 9216;
    LAS float* sMain = (LAS float*)(lds + SMAIN); LAS float* sSpill = (LAS float*)(lds + SSPILL); LAS float* sBt = (LAS float*)(lds + SBT); LAS unsigned* sSel = (LAS unsigned*)(lds + SSEL);
    LAS float* sMref = (LAS float*)(lds + SMREF); LAS unsigned long long* sLfar = (LAS unsigned long long*)(lds + SLFAR); LAS unsigned long long* sOfar = (LAS unsigned long long*)lds;
    const float NEG = -INFINITY; (void)TQ;
    for (int ui = 0; ; ++ui) {
        int bg, qb;
        if (G == 256) { if (ui >= 4) break; const int c = bid, s = c >> 3; bg = c & 7; qb = ui == 0 ? s : ui == 1 ? 63 - s : ui == 2 ? 64 + s : 127 - s; }
        else { const int uu = bid + ui * G; if (uu >= 1024) break; bg = uu >> 7; qb = uu & 127; }
        const int b = bg >> 2, g = bg & 3, t0 = 64 * qb, m0 = b * SEQ + t0;
        int tokl[2]; tokl[0] = 8 * wid + (fr >> 2); tokl[1] = tokl[0] + 4;
        bf16x8 qf[2][2];
#pragma unroll
        for (int ct = 0; ct < 2; ++ct)
#pragma unroll
            for (int s = 0; s < 2; ++s) qf[ct][s] = *(const bf16x8*)(Q + (size_t)(m0 + tokl[ct]) * 1024 + (g * 4 + hg) * 64 + 32 * s + 8 * fq);
        int tidz = tid; asm volatile("" : "+v"(tidz));
        for (int i = tidz; i < 4 * 129; i += 512) { const int h = i / 129, dist = i - h * 129; int bk;
            if (dist < 16) bk = dist; else { bk = 16 + (int)(logf((float)dist * (1.f / 16.f)) / 2.0794415416798357f * 16.f); bk = bk > 31 ? 31 : bk; }
            sBt[h * 132 + dist] = rel_bias[bk * 16 + g * 4 + h] * LOG2E; }
#pragma unroll
        for (int i = 0; i < 4; ++i) { *(LAS f32x4*)(lds + SMAIN + (tidz + 512 * i) * 16) = (f32x4){0.f, 0.f, 0.f, 0.f}; *(LAS f32x4*)(lds + SSPILL + (tidz + 512 * i) * 16) = (f32x4){0.f, 0.f, 0.f, 0.f}; }
        __syncthreads();
        const LAS float* bt = sBt + hg * 132; const float bfar = bt[128];
        const float* gtp = GT + (size_t)(m0 + tokl[0]) * 48 + (g * 4 + hg) * 3;
        LAS f32x4* totp = (LAS f32x4*)(lds + SMAIN + wid * 4096) + lane;
        bf16_t* yp = Y + (size_t)(m0 + tokl[0]) * 1024 + (g * 4 + hg) * 64 + 4 * fq;
        NsaSt st[2]; bool act[2] = {true, true}; bool colsel[2] = {true, true}; int dbase[2]; float minv[2] = {1.f, 1.f};
        KVRegs kvr; kvr.k[1] = (u32x4){0u, 0u, 0u, 0u}; kvr.v[1] = (u32x4){0u, 0u, 0u, 0u};
        int mg0 = 0; bool general = true;
#define NSA_RUN(MODE, STEP, NT, TM, KB, VB, TS, LD, SETUP) do { const int nt_ = (NT), nst_ = (nt_ + 1) >> 1; \
        { const int ti = 0; const int j0_ = (TM); const int ti1_ = 1; int j1_ = 0; { const int ti = ti1_; j1_ = (TM); } (void)ti; \
          nsa_ld2((KB) + (size_t)j0_ * (TS), (VB) + (size_t)j0_ * (TS), (size_t)(j1_ - j0_) * (TS), (LD), nt_ >= 2, tid, kvr); } \
        nsa_st2(lds + SKO, lds + SVO, tid, kvr); __syncthreads(); \
        _Pragma("unroll 1") for (int s_ = 0; s_ < nst_; ++s_) { const int sb_ = s_ & 1; \
            if (s_ + 1 < nst_) { int ja_ = 0, jb_ = 0; { const int ti = 2 * s_ + 2; ja_ = (TM); } { const int ti = 2 * s_ + 3; jb_ = (TM); } \
                nsa_ld2((KB) + (size_t)ja_ * (TS), (VB) + (size_t)ja_ * (TS), (size_t)(jb_ - ja_) * (TS), (LD), 2 * s_ + 3 < nt_, tid, kvr); } \
            _Pragma("unroll") for (int h_ = 0; h_ < 2; ++h_) { const int ti = 2 * s_ + h_; if (ti < nt_) { SETUP; \
                const LAS unsigned char* sk_ = lds + SKO + (sb_ * 2 + h_) * TB; const LAS unsigned char* sv_ = lds + SVO + (sb_ * 2 + h_) * TB; \
                if (MODE != 2 || (act[0] && act[1])) nsa_tile<MODE, STEP, 3>(sk_, sv_, qf, st, dbase, general, colsel, bt, bfar, minv, sMain, sSpill, tokl, mg0, fr, fq, q4, p4); \
                else if (act[0]) nsa_tile<MODE, STEP, 1>(sk_, sv_, qf, st, dbase, general, colsel, bt, bfar, minv, sMain, sSpill, tokl, mg0, fr, fq, q4, p4); \
                else if (act[1]) nsa_tile<MODE, STEP, 2>(sk_, sv_, qf, st, dbase, general, colsel, bt, bfar, minv, sMain, sSpill, tokl, mg0, fr, fq, q4, p4); } } \
            if (s_ + 1 < nst_) nsa_st2(lds + SKO + ((sb_ ^ 1) * 2) * TB, lds + SVO + ((sb_ ^ 1) * 2) * TB, tid, kvr); \
            __syncthreads(); } } while (0)
#define NSA_RESET() do { _Pragma("unroll") for (int ct = 0; ct < 2; ++ct) { st[ct].m = NEG; st[ct].l = 0.f; _Pragma("unroll") for (int dt = 0; dt < 4; ++dt) st[ct].o[dt] = (f32x4){0.f, 0.f, 0.f, 0.f}; } } while (0)
        const int ncmp = 4 * qb + 3, nct = (ncmp + 63) >> 6;
        const bf16_t* kcb = KC + (size_t)bg * 512 * 64; const bf16_t* vcb = VC + (size_t)bg * 512 * 64;
        NSA_RESET();
        NSA_RUN(0, 16, nct, ti, kcb, vcb, (size_t)4096, 64, { dbase[0] = t0 + tokl[0] - 31 - 1024 * ti; dbase[1] = dbase[0] + 4; mg0 = 16 * ti; general = t0 - 31 - 1024 * ti - 1008 < 128; });
#pragma unroll
        for (int ct = 0; ct < 2; ++ct) { const float lt = xsum16_32(st[ct].l); minv[ct] = fast_rcp(lt > 0.f ? lt : 1.f); if (st[ct].m == NEG) st[ct].m = 0.f; }
        NSA_RUN(1, 16, nct, ti, kcb, vcb, (size_t)4096, 64, { dbase[0] = t0 + tokl[0] - 31 - 1024 * ti; dbase[1] = dbase[0] + 4; mg0 = 16 * ti; general = t0 - 31 - 1024 * ti - 1008 < 128; });
        LAS f32x4* park = (LAS f32x4*)(lds + SKO + wid * 8192) + lane;
#pragma unroll
        for (int ct = 0; ct < 2; ++ct) { const float gt0 = gtp[ct * 4 * 48];
#pragma unroll
            for (int dt = 0; dt < 4; ++dt) park[(ct * 4 + dt) * 64] = st[ct].o[dt] * gt0; }
        unsigned msk[2][4];
        if (qb <= 15) {
#pragma unroll
            for (int ct = 0; ct < 2; ++ct) { msk[ct][0] = (2u << qb) - 1u; msk[ct][1] = 0u; msk[ct][2] = 0u; msk[ct][3] = 0u; }
        } else {
            const int tl = lane >> 3, sub = lane & 7, tok = 8 * wid + tl;
            unsigned key[16];
#pragma unroll
            for (int i = 0; i < 4; ++i) { const f32x4 a = *(const LAS f32x4*)(sMain + tok * 128 + 16 * sub + 4 * i), s4 = *(const LAS f32x4*)(sSpill + tok * 128 + 16 * sub + 4 * i);
#pragma unroll
                for (int j = 0; j < 4; ++j) { const int m = 16 * sub + 4 * i + j; const float imp = a[j] + s4[j];
                    key[4 * i + j] = (m >= 1 && m <= qb - 2) ? ((__float_as_uint(imp) & ~127u) | (unsigned)(127 - m)) : 0u; } }
            unsigned selb = 0u;
#pragma unroll 1
            for (int it = 0; it < 13; ++it) { unsigned mx = key[0];
#pragma unroll
                for (int i = 1; i < 16; ++i) mx = key[i] > mx ? key[i] : mx;
                { unsigned o = (unsigned)__builtin_amdgcn_update_dpp(0, (int)mx, 0xB1, 0xF, 0xF, true); mx = o > mx ? o : mx; o = (unsigned)__builtin_amdgcn_update_dpp(0, (int)mx, 0x4E, 0xF, 0xF, true); mx = o > mx ? o : mx;
                  o = (unsigned)__builtin_amdgcn_update_dpp(0, (int)mx, 0x141, 0xF, 0xF, true); mx = o > mx ? o : mx; }
#pragma unroll
                for (int i = 0; i < 16; ++i) if (key[i] == mx) { selb |= 1u << i; key[i] = 0u; } }
            { const int f0 = 0, f1 = qb, f2 = qb - 1;
              if ((f0 >> 4) == sub) selb |= 1u << (f0 & 15); if ((f1 >> 4) == sub) selb |= 1u << (f1 & 15); if ((f2 >> 4) == sub) selb |= 1u << (f2 & 15); }
            const unsigned oth = (unsigned)__builtin_amdgcn_update_dpp(0, (int)selb, 0xB1, 0xF, 0xF, true);
            if ((sub & 1) == 0) sSel[tok * 4 + (sub >> 1)] = selb | (oth << 16);
            asm volatile("s_waitcnt lgkmcnt(0)" ::: "memory");
#pragma unroll
            for (int ct = 0; ct < 2; ++ct) { const u32x4 w = *(const LAS u32x4*)(sSel + tokl[ct] * 4); msk[ct][0] = w.x; msk[ct][1] = w.y; msk[ct][2] = w.z; msk[ct][3] = w.w; }
        }
#pragma unroll
        for (int ct = 0; ct < 2; ++ct)
#pragma unroll
            for (int dt = 0; dt < 4; ++dt) totp[ct * (SSPILL - SMAIN) / 16 + 64 * dt] = park[(ct * 4 + dt) * 64];
        __syncthreads();
        { const bf16_t* ksb = KV + (size_t)2 * T_ * 256 + (size_t)(b * SEQ) * 256 + g * 64; const bf16_t* vsb = KV + (size_t)3 * T_ * 256 + (size_t)(b * SEQ) * 256 + g * 64;
          const bool sparse = qb >= NSA_SPARSE_QB;
          NSA_RESET();
#define NSA_SEL_SETUP(MB) { const int mblk = (MB); const int mw = mblk >> 5; const int mb = mblk & 31; \
              _Pragma("unroll") for (int ct = 0; ct < 2; ++ct) { const unsigned w = mw == 0 ? msk[ct][0] : mw == 1 ? msk[ct][1] : mw == 2 ? msk[ct][2] : msk[ct][3]; colsel[ct] = (w >> mb) & 1u; act[ct] = __any(colsel[ct]); } \
              dbase[0] = t0 + tokl[0] - 64 * mblk; dbase[1] = dbase[0] + 4; general = mblk + 2 >= qb; }
          if (!sparse) {
              NSA_RUN(2, 1, qb + 1, ti, ksb, vsb, (size_t)64 * 256, 256, NSA_SEL_SETUP(ti));
          } else {
              NSA_RUN(2, 1, 4, (ti == 0 ? 0 : qb - 3 + ti), ksb, vsb, (size_t)64 * 256, 256, NSA_SEL_SETUP(ti == 0 ? 0 : qb - 3 + ti));
              u32x2 toth[2][4];
#pragma unroll
              for (int ct = 0; ct < 2; ++ct)
#pragma unroll
                  for (int dt = 0; dt < 4; ++dt) { const f32x4 v = totp[ct * (SSPILL - SMAIN) / 16 + 64 * dt]; toth[ct][dt].x = pk2(v[0], v[1]); toth[ct][dt].y = pk2(v[2], v[3]); }
              __syncthreads();
#pragma unroll
              for (int ct = 0; ct < 2; ++ct) { const int col = tokl[ct] * 4 + hg; const float lt = xsum16_32(st[ct].l);
                  if (fq == 0) { sMref[col] = st[ct].m; sLfar[col] = fx_enc(lt); }
#pragma unroll
                  for (int dt = 0; dt < 4; ++dt)
#pragma unroll
                      for (int j = 0; j < 4; ++j) sOfar[col * 66 + 16 * dt + 4 * fq + j] = fx_enc(st[ct].o[dt][j]); }
              __syncthreads();
              nsa_sparse_far(sSel, (LAS int*)(lds + SLIST) + wid * 64, sBt, sMref, sLfar, sOfar, Q + (size_t)m0 * 1024 + g * 256, ksb, VT + (size_t)bg * 64 * SEQ, qb, wid, lane, fr, fq);
              __syncthreads();
#pragma unroll
              for (int ct = 0; ct < 2; ++ct) { const int col = tokl[ct] * 4 + hg; st[ct].l = fq == 0 ? fx_dec(sLfar[col]) : 0.f;
#pragma unroll
                  for (int dt = 0; dt < 4; ++dt)
#pragma unroll
                      for (int j = 0; j < 4; ++j) st[ct].o[dt][j] = fx_dec(sOfar[col * 66 + 16 * dt + 4 * fq + j]); }
              __syncthreads();
#pragma unroll
              for (int ct = 0; ct < 2; ++ct)
#pragma unroll
                  for (int dt = 0; dt < 4; ++dt) totp[ct * (SSPILL - SMAIN) / 16 + 64 * dt] = (f32x4){bflo(toth[ct][dt].x), bfhi(toth[ct][dt].x), bflo(toth[ct][dt].y), bfhi(toth[ct][dt].y)};
#pragma unroll
              for (int ct = 0; ct < 2; ++ct)
#pragma unroll
                  for (int s = 0; s < 2; ++s) qf[ct][s] = *(const bf16x8*)(Q + (size_t)(m0 + tokl[ct]) * 1024 + (g * 4 + hg) * 64 + 32 * s + 8 * fq);
          }
#undef NSA_SEL_SETUP
#pragma unroll
          for (int ct = 0; ct < 2; ++ct) { const float lt = xsum16_32(st[ct].l), sc = gtp[ct * 4 * 48 + 1] * fast_rcp(lt > 0.f ? lt : 1.f);
#pragma unroll
              for (int dt = 0; dt < 4; ++dt) totp[ct * (SSPILL - SMAIN) / 16 + 64 * dt] += st[ct].o[dt] * sc; } }
        { const bf16_t* kwb = KV + (size_t)4 * T_ * 256 + (size_t)(b * SEQ) * 256 + g * 64; const bf16_t* vwb = KV + (size_t)5 * T_ * 256 + (size_t)(b * SEQ) * 256 + g * 64;
          NSA_RESET(); act[0] = true; act[1] = true; colsel[0] = true; colsel[1] = true;
          const int j0 = qb >= 8 ? 0 : 8 - qb;
          NSA_RUN(3, 1, 9 - j0, ti, kwb + (size_t)(t0 - 512 + 64 * j0) * 256, vwb + (size_t)(t0 - 512 + 64 * j0) * 256, (size_t)64 * 256, 256, { const int j = j0 + ti;
              dbase[0] = tokl[0] + 512 - 64 * j; dbase[1] = dbase[0] + 4; general = (j == 0) || (j >= 6); });
#pragma unroll
          for (int ct = 0; ct < 2; ++ct) { const float lt = xsum16_32(st[ct].l), sc = gtp[ct * 4 * 48 + 2] * fast_rcp(lt > 0.f ? lt : 1.f);
#pragma unroll
              for (int dt = 0; dt < 4; ++dt) { const f32x4 v = totp[ct * (SSPILL - SMAIN) / 16 + 64 * dt] + st[ct].o[dt] * sc;
                  u32x2 w; w.x = pk2(v[0], v[1]); w.y = pk2(v[2], v[3]); *(u32x2*)(yp + ct * 4096 + 16 * dt) = w; } } }
        __syncthreads();
#undef NSA_RESET
#undef NSA_RUN
    }
}
#ifndef PROBE_NOCONV
#define PROBE_NOCONV 0
#endif
#ifndef PROBE_NOGELU
#define PROBE_NOGELU 0
#endif
#ifndef ALL_XCD_BAR
#define ALL_XCD_BAR 1
#endif
#ifndef USE_XCD_BAR
#define USE_XCD_BAR 1
#endif
#ifndef EN_ALL
#define EN_ALL 1
#endif
#ifndef EN_LRUG
#define EN_LRUG EN_ALL
#endif
#ifndef EN_LRUA
#define EN_LRUA EN_ALL
#endif
#ifndef EN_NSAC
#define EN_NSAC EN_ALL
#endif
#ifndef EN_NSAA
#define EN_NSAA EN_ALL
#endif
#ifndef EN_GLAK
#define EN_GLAK EN_ALL
#endif
#ifndef EN_GLAS
#define EN_GLAS EN_ALL
#endif
#ifndef EN_GLAO
#define EN_GLAO EN_ALL
#endif
#ifndef EN_G_LRUIN
#define EN_G_LRUIN EN_ALL
#endif
#ifndef EN_G_RESID
#define EN_G_RESID EN_ALL
#endif
#ifndef EN_G_NSAIN
#define EN_G_NSAIN EN_ALL
#endif
#ifndef EN_G_GLAIN
#define EN_G_GLAIN EN_ALL
#endif
#ifndef EN_G_GU
#define EN_G_GU EN_ALL
#endif
#ifndef EN_PREP
#define EN_PREP EN_ALL
#endif
struct Args {
    const float* x; const float* rel_bias; const float* final_norm; const float* mix_norm; const float* ffn_norm;
    const float* ffn_w_gate; const float* ffn_w_up; const float* ffn_w_down;
    const float* lru_w_in; const float* lru_conv_w; const float* lru_conv_b; const float* lru_w_a; const float* lru_b_a; const float* lru_w_x; const float* lru_b_x; const float* lru_lam; const float* lru_w_out;
    const float* nsa_w_in; const float* nsa_cmp_pos; const float* nsa_cmp_w1; const float* nsa_cmp_b1; const float* nsa_cmp_w2; const float* nsa_cmp_b2; const float* nsa_w_out;
    const float* gla_w_in; const float* gla_w_g2; const float* gla_b_g2; const float* gla_norm; const float* gla_w_out;
    float* out; unsigned char* ws; int ph_lo, ph_hi, dry, pad_;
};

#define XB_TMO      128
#define XB_XCNT(j)  (256  + 64 * (j))
#define XB_XSUB(j)  (1280 + 64 * (j))
#define XB_XGEN(j)  (2304 + 64 * (j))
#define XB_TOP      3328
#define XB_TOPGEN   3392
#define XCD_BAR_WORDS 3456
#define XB_SPIN_CAP (1u << 18)

__device__ __forceinline__ unsigned xb_ld(unsigned* p)              { return __hip_atomic_load(p, __ATOMIC_RELAXED, __HIP_MEMORY_SCOPE_AGENT); }
__device__ __forceinline__ unsigned xb_add(unsigned* p, unsigned v) { return __hip_atomic_fetch_add(p, v, __ATOMIC_RELAXED, __HIP_MEMORY_SCOPE_AGENT); }
__device__ __forceinline__ unsigned xb_xcc_id() { return (unsigned)__builtin_amdgcn_s_getreg((3 << 11) | 20) & 0xFu; }
#define XB_SPIN(cond, bar) do { unsigned _sp = 0; while (cond) { __builtin_amdgcn_s_sleep(1); \
    if ((++_sp & 255u) == 0u) { if (xb_ld(&(bar)[XB_TMO])) break; if (_sp > XB_SPIN_CAP) { atomicAdd(&(bar)[XB_TMO], 1u); break; } } } } while (0)

struct XcdBarrier {
    unsigned* bar; unsigned x;
    volatile LAS unsigned* st;
};

__device__ __forceinline__ XcdBarrier xcd_barrier_post(unsigned* bar, volatile LAS unsigned* st) {
    XcdBarrier b; b.bar = bar; b.x = xb_xcc_id(); b.st = st;
    if (threadIdx.x == 0) (void)xb_add(&bar[XB_XCNT(b.x)], 1u);
    return b;
}
__device__ __forceinline__ void xcd_barrier_complete(unsigned* bar, unsigned x, unsigned& nloc, unsigned& nx) {
    const unsigned G = gridDim.x * gridDim.y * gridDim.z;
    unsigned sum, cnt, mine, sp = 0u;
    for (;;) {
        sum = 0u; cnt = 0u; mine = 0u;
#pragma unroll
        for (unsigned j = 0; j < 16; ++j) { const unsigned c = xb_ld(&bar[XB_XCNT(j)]); sum += c; cnt += (c > 0u) ? 1u : 0u; mine = (j == x) ? c : mine; }
        if (sum == G) break;
        __builtin_amdgcn_s_sleep(1);
        if ((++sp & 255u) == 0u) { if (xb_ld(&bar[XB_TMO])) break; if (sp > XB_SPIN_CAP) { atomicAdd(&bar[XB_TMO], 1u); break; } }
    }
    nloc = mine > 0u ? mine : 1u; nx = cnt > 0u ? cnt : 1u;
}

__device__ __forceinline__ void xcd_barrier(const XcdBarrier& b) {
    asm volatile("s_waitcnt vmcnt(0)" ::: "memory");
    __syncthreads();
    if (threadIdx.x == 0) {
        unsigned* bar = b.bar;
        __builtin_amdgcn_s_waitcnt(0);
        unsigned nloc = b.st[0], nx = b.st[1];
        if (nloc == 0u) { xcd_barrier_complete(bar, b.x, nloc, nx); b.st[0] = nloc; b.st[1] = nx; }
        const unsigned old = xb_add(&bar[XB_XSUB(b.x)], 1u);
        const unsigned gen = old / nloc;
        if (old + 1u == (gen + 1u) * nloc) {
            __builtin_amdgcn_fence(__ATOMIC_RELEASE, "agent");
            asm volatile("s_waitcnt vmcnt(0)" ::: "memory");
            const unsigned og = xb_add(&bar[XB_TOP], 1u);
            const unsigned tg = og / nx;
            if (og + 1u == (tg + 1u) * nx) xb_add(&bar[XB_TOPGEN], 1u);
            else XB_SPIN(xb_ld(&bar[XB_TOPGEN]) == tg, bar);
            __builtin_amdgcn_fence(__ATOMIC_ACQUIRE, "agent");
            xb_add(&bar[XB_XGEN(b.x)], 1u);
            asm volatile("s_waitcnt vmcnt(0)" ::: "memory");
        } else {
            XB_SPIN(xb_ld(&bar[XB_XGEN(b.x)]) == gen, bar);
            __builtin_amdgcn_fence(__ATOMIC_ACQUIRE, "agent");
            asm volatile("s_waitcnt vmcnt(0)" ::: "memory");
        }
    }
    __syncthreads();
}

__global__ void __launch_bounds__(512, 2) mega_fwd(Args a) {
    extern __shared__ __attribute__((aligned(16))) unsigned char lds_raw[];
    LAS unsigned char* lds = (LAS unsigned char*)lds_raw;
    cg::grid_group grid = cg::this_grid();
    const int tid0 = threadIdx.x; const int wid0 = __builtin_amdgcn_readfirstlane(tid0 >> 6);
    constexpr int PTR_OFF = LDS_BYTES - 512;
    if (tid0 == 0) { LAS unsigned long long* tb = (LAS unsigned long long*)(lds + PTR_OFF);
        tb[0] = (unsigned long long)a.x;
        tb[1] = (unsigned long long)a.rel_bias;
        tb[2] = (unsigned long long)a.final_norm;
        tb[3] = (unsigned long long)a.mix_norm;
        tb[4] = (unsigned long long)a.ffn_norm;
        tb[5] = (unsigned long long)a.ffn_w_gate;
        tb[6] = (unsigned long long)a.ffn_w_up;
        tb[7] = (unsigned long long)a.ffn_w_down;
        tb[8] = (unsigned long long)a.lru_w_in;
        tb[9] = (unsigned long long)a.lru_conv_w;
        tb[10] = (unsigned long long)a.lru_conv_b;
        tb[11] = (unsigned long long)a.lru_w_a;
        tb[12] = (unsigned long long)a.lru_b_a;
        tb[13] = (unsigned long long)a.lru_w_x;
        tb[14] = (unsigned long long)a.lru_b_x;
        tb[15] = (unsigned long long)a.lru_lam;
        tb[16] = (unsigned long long)a.lru_w_out;
        tb[17] = (unsigned long long)a.nsa_w_in;
        tb[18] = (unsigned long long)a.nsa_cmp_pos;
        tb[19] = (unsigned long long)a.nsa_cmp_w1;
        tb[20] = (unsigned long long)a.nsa_cmp_b1;
        tb[21] = (unsigned long long)a.nsa_cmp_w2;
        tb[22] = (unsigned long long)a.nsa_cmp_b2;
        tb[23] = (unsigned long long)a.nsa_w_out;
        tb[24] = (unsigned long long)a.gla_w_in;
        tb[25] = (unsigned long long)a.gla_w_g2;
        tb[26] = (unsigned long long)a.gla_b_g2;
        tb[27] = (unsigned long long)a.gla_norm;
        tb[28] = (unsigned long long)a.gla_w_out;
        tb[29] = (unsigned long long)a.out;
        tb[30] = (unsigned long long)a.ws;
    }
    if (tid0 < 4) ((LAS unsigned*)(lds + PTR_OFF + 256))[tid0] = 0u;
    __syncthreads();
    if (a.ph_lo > 1000000) grid.sync();
    XcdBarrier xbar = xcd_barrier_post((unsigned*)(a.ws + WS_CTL), (volatile LAS unsigned*)(lds + PTR_OFF + 256));
#define PRAW(i) ((((unsigned long long)(unsigned)__builtin_amdgcn_readfirstlane((int)((const LAS unsigned*)(lds + PTR_OFF))[2 * (i) + 1])) << 32) | (unsigned long long)(unsigned)__builtin_amdgcn_readfirstlane((int)((const LAS unsigned*)(lds + PTR_OFF))[2 * (i)]))
#define GAS_ __attribute__((address_space(1)))
#define PF(i) ((const float*)(const GAS_ float*)PRAW(i))
#define P_OUT ((float*)(GAS_ float*)PRAW(29))
#define WSP(off) ((unsigned char*)((GAS_ unsigned char*)PRAW(30) + (off)))
#define W_GU ((bf16_t*)WSP(WS_W_GU))
#define W_DN ((bf16_t*)WSP(WS_W_DN))
#define W_MIN ((bf16_t*)WSP(WS_W_MIN))
#define W_MOUT ((bf16_t*)WSP(WS_W_MOUT))
#define W_SM ((bf16_t*)WSP(WS_W_SMALL))
#define HN ((bf16_t*)WSP(WS_HN))
#define ACT ((bf16_t*)WSP(WS_ACT))
#define LG ((bf16_t*)WSP(WS_LG))
#define LX ((bf16_t*)WSP(WS_LX))
#define LHL ((bf16_t*)WSP(WS_LHL))
#define LAC ((bf16_t*)WSP(WS_LAC))
#define AGGA ((float*)WSP(WS_LAGGA))
#define AGGH ((float*)WSP(WS_LAGGH))
#define NQ ((bf16_t*)WSP(WS_NQ))
#define NKV ((bf16_t*)WSP(WS_NKV))
#define NGT ((float*)WSP(WS_NGT))
#define NKC ((bf16_t*)WSP(WS_NKC))
#define NVC ((bf16_t*)WSP(WS_NVC))
#define GQ ((bf16_t*)WSP(WS_GQ))
#define GK ((bf16_t*)WSP(WS_GK))
#define GV ((bf16_t*)WSP(WS_GV))
#define GR ((bf16_t*)WSP(WS_GR))
#define GGL ((float*)WSP(WS_GGL))
#define GDEC ((float*)WSP(WS_GDEC))
#define GKVT ((bf16_t*)WSP(WS_GKVT))
#define SSP ((float*)WSP(WS_SSP))
#define NY ((bf16_t*)WSP(WS_NY))
#define NVT ((bf16_t*)WSP(WS_NVT))

    enum { OP_PREP, OP_G_LRUIN, OP_LRU_GATES, OP_LRU_APPLY, OP_G_RESID, OP_G_NSAIN, OP_NSA_CMP, OP_NSA_ATTN, OP_G_GLAIN, OP_GLA_KV, OP_GLA_SCAN, OP_GLA_OUT, OP_NORM2, OP_G_GU, OP_FINAL };
#pragma unroll 1
    for (int ph = a.ph_lo; ph < a.ph_hi; ++ph) {
        int layer, r;
        if (ph < 7) { layer = 0; r = ph; } else if (ph < 13) { layer = 1; r = ph - 6; } else if (ph < 20) { layer = 2; r = ph - 12; } else if (ph < 26) { layer = 3; r = ph - 19; } else { layer = 4; r = 0; }
        const int kind = layer % 3, jj = layer / 3, nmix = kind == 2 ? 5 : 4;
        int wid_s = wid0, bid = blockIdx.x, G = gridDim.x;
        asm volatile("" : "+s"(wid_s) :: "memory"); asm volatile("" : "+s"(bid)); asm volatile("" : "+s"(G));
        int lane_v; asm volatile("v_mbcnt_lo_u32_b32 %0, -1, 0\n\tv_mbcnt_hi_u32_b32 %0, -1, %0" : "=v"(lane_v));
        const int tid = (wid_s << 6) | lane_v;
        const int lane = tid & 63, wid = __builtin_amdgcn_readfirstlane(tid >> 6), gw = bid * 8 + wid, NGW = G * 8;
        LAS float* scr = (LAS float*)(lds + wid * 8448);
        const float* hsrc = layer == 0 ? PF(0) : P_OUT;
        int op;
        if (layer == 4) op = OP_FINAL;
        else if (r == 0) op = OP_PREP;
        else if (r <= nmix) { const int q = r - 1;
            if (kind == 0) op = q == 0 ? OP_G_LRUIN : q == 1 ? OP_LRU_GATES : q == 2 ? OP_LRU_APPLY : OP_G_RESID;
            else if (kind == 1) op = q == 0 ? OP_G_NSAIN : q == 1 ? OP_NSA_CMP : q == 2 ? OP_NSA_ATTN : OP_G_RESID;
            else op = q == 0 ? OP_G_GLAIN : q == 1 ? OP_GLA_KV : q == 2 ? OP_GLA_SCAN : q == 3 ? OP_GLA_OUT : OP_G_RESID; }
        else { const int q = r - nmix - 1; op = q == 0 ? OP_G_GU : OP_G_RESID; }
        const bool is_down = (r == nmix + 2);
#ifdef PHASE_PROBE
        if (bid == 0 && tid == 0) { unsigned long long* ts = (unsigned long long*)WSP(WS_TQ + 4096); ts[ph] = __builtin_amdgcn_s_memrealtime(); ((int*)WSP(WS_TQ + 8192))[ph] = op; }
#endif
        switch (op) {
        case OP_PREP: if (EN_PREP) { init_stream_bf16(PF(0), HN, SSP, gw, NGW, lane); nsa_b1eff(PF(18), PF(19), PF(20), (float*)WSP(WS_B1E), gw, NGW, lane); }
            break;
        case OP_G_LRUIN: if (EN_G_LRUIN) { pg8::Gemm g{HN, W_MIN, T_, 2 * RNN, D_}; pg8::StaticOrder S; S.init(T_, 2 * RNN, G, bid); pg8::EpiLruIn E{LG, LX, SSP, PROBE_NOGELU ? a.dry : 0};
            pg8::gemm_phase<pg8::EpiLruIn, pg8::StaticOrder, true, true>(lds, g, S, E, tid); }
            break;
        case OP_LRU_GATES: if (EN_LRUG) lru_gates_phase(lds, LX, PF(9) + jj * 4 * RNN, PF(10) + jj * RNN, W_SM, W_SM + 163840, PF(12) + jj * RNN, PF(14) + jj * RNN, PF(15) + jj * RNN, LHL, LAC, AGGA, AGGH, tid, bid, G);
            break;
        case OP_LRU_APPLY: if (EN_LRUA) lru_apply_phase(LG, a.dry ? (bf16_t*)WSP(190 * MiB) : LG, LHL, LAC, AGGA, AGGH, tid, bid, G);
            break;
        case OP_G_RESID: if (EN_G_RESID) {
            const bf16_t* A = is_down ? ACT : (kind == 0 ? LG : kind == 1 ? NY : GV); const bf16_t* Bt = is_down ? W_DN : W_MOUT; const int K = is_down ? FF : (kind == 0 ? RNN : D_);
            pg8::Gemm g{A, Bt, T_, D_, K}; pg8::StaticOrder S; S.init(T_, D_, G, bid); pg8::EpiResid E{HN, a.dry ? (bf16_t*)WSP(190 * MiB) : HN, SSP, (LAS float*)(lds + 131072)};
            pg8::gemm_phase<pg8::EpiResid, pg8::StaticOrder, true, true>(lds, g, S, E, tid); }
            break;
        case OP_G_NSAIN: if (EN_G_NSAIN) { pg8::Gemm g{HN, W_MIN, T_, NSA_NPAD, D_}; pg8::StaticOrder S; S.init(T_, NSA_NPAD, G, bid); pg8::EpiNsaIn E{NQ, NKV, NGT, SSP};
            pg8::gemm_phase<pg8::EpiNsaIn, pg8::StaticOrder, true, true>(lds, g, S, E, tid); }
            break;
        case OP_NSA_CMP: if (EN_NSAC) nsa_compress_phase(lds, NKV, PF(18), PF(19), PF(20), PF(22), W_SM, W_SM + 262144, NKC, NVC, NVT, (const float*)WSP(WS_B1E), tid, bid, G);
            break;
        case OP_NSA_ATTN: if (EN_NSAA) nsa_attn_phase(lds, NQ, NKV, NGT, NKC, NVC, PF(1), NY, NVT, (void*)WSP(WS_TQ), tid, bid, G);
            break;
        case OP_G_GLAIN: if (EN_G_GLAIN) { pg8::Gemm g{HN, W_MIN, T_, GLA_NPAD, D_}; pg8::StaticOrder S; S.init(T_, GLA_NPAD, G, bid); pg8::EpiGlaIn E{GQ, GK, GV, GR, GGL, SSP};
            pg8::gemm_phase<pg8::EpiGlaIn, pg8::StaticOrder, true, true>(lds, g, S, E, tid); }
            break;
        case OP_GLA_KV: if (EN_GLAK) gla_kv_phase(lds, GK, GV, GGL, PF(25), PF(26), GKVT, GDEC, tid, bid, G);
            break;
        case OP_GLA_SCAN: if (EN_GLAS) gla_scan_phase(GKVT, GDEC, a.dry != 0, tid, bid, G);
            break;
        case OP_GLA_OUT: if (EN_GLAO) gla_out_phase(lds, GQ, GK, GV, GR, GGL, PF(25), PF(26), PF(27), GKVT, a.dry ? (bf16_t*)WSP(190 * MiB) : GV, tid, bid, G);
            break;
        case OP_G_GU: if (EN_G_GU) { pg8::Gemm g{HN, W_GU, T_, 2 * FF, D_}; pg8::StaticOrder S; S.init(T_, 2 * FF, G, bid); pg8::EpiSwiglu E{ACT, SSP};
            pg8::gemm_phase<pg8::EpiSwiglu, pg8::StaticOrder, true, true>(lds, g, S, E, tid); }
            break;
        default: if (EN_PREP) final_norm_rows(HN, PF(2), a.dry ? (float*)WSP(60 * MiB) : P_OUT, gw, NGW, lane);
#if defined(TIMING_PROBE) || defined(PHASE_PROBE)
            { __syncthreads(); float* o = P_OUT;
#ifdef PHASE_PROBE
              const unsigned long long* ts = (const unsigned long long*)WSP(WS_TQ + 4096); const int* ops = (const int*)WSP(WS_TQ + 8192);
              const unsigned long long tend = __builtin_amdgcn_s_memrealtime(); float sa = 0.f, sb = 0.f;
              for (int q = 0; q < 33; ++q) { const float dt = (float)(ts[q + 1] - ts[q]); if (ops[q] == TQ_A) sa += dt; if (ops[q] == TQ_B) sb += dt; }
              const float tot_ = (float)(ts[33] - ts[0]); const float f1 = sa / tot_, f2 = sb / tot_; (void)tend;
#else
              const float* tq = (const float*)WSP(WS_TQ); const float f1 = tq[TQ_A], f2 = tq[TQ_B];
#endif

              const int R = (int)(f2 * 0.32f * 16384.f);
              for (int m = gw; m < R; m += NGW) for (int c = lane; c < 1024; c += 64) o[(size_t)m * 1024 + c] += 0.05f;
              if (bid == G - 1 && tid == 0) o[(size_t)16383 * 1024 + 5] += 0.1f + 0.19f * f1; }
#endif
            break;
        }
        { int cv = 0, nun = 0;
          if (op == OP_PREP) cv = 2;
          else if ((op == OP_G_LRUIN || op == OP_G_NSAIN || op == OP_G_GLAIN)) { cv = 1; nun = 64 * (op == OP_G_LRUIN ? 10 : op == OP_G_NSAIN ? 11 : 13); }
          else if (op == OP_G_GU && layer < 3) { cv = 2; nun = 64 * 22; }
          if (EN_PREP && cv && !(PROBE_NOCONV && a.dry)) {
              const int rem = op == OP_PREP ? 0 : nun % G, first = rem, nidle = G - first;
              if (bid >= first) { const int cgw = (bid - first) * 8 + wid, CNGW = nidle * 8; int rot = 0;
                  if (cv & 1) {
                      transpose_job(PF(5) + (size_t)layer * D_ * FF, PF(4) + layer * D_, D_, FF, W_GU, D_, 1, rot, cgw, CNGW, scr, lane);
                      transpose_job(PF(6) + (size_t)layer * D_ * FF, PF(4) + layer * D_, D_, FF, W_GU, D_, 2, rot, cgw, CNGW, scr, lane);
                      transpose_job(PF(7) + (size_t)layer * FF * D_, nullptr, FF, D_, W_DN, FF, 0, rot, cgw, CNGW, scr, lane); }
                  if (cv & 2) { const int ml = op == OP_PREP ? layer : layer + 1, mk = ml % 3, mj = ml / 3;
                      if (mk == 0) {
                          transpose_job(PF(8) + (size_t)mj * D_ * 2 * RNN, PF(3) + ml * D_, D_, 2 * RNN, W_MIN, D_, 0, rot, cgw, CNGW, scr, lane);
                          transpose_job(PF(16) + (size_t)mj * RNN * D_, nullptr, RNN, D_, W_MOUT, RNN, 0, rot, cgw, CNGW, scr, lane);
#pragma unroll 1
                          for (int h = 0; h < 20; ++h) { const int hh = h % 10; const float* src = (h < 10 ? PF(11) : PF(13)) + ((size_t)mj * 10 + hh) * 16384;
                              transpose_job(src, nullptr, 128, 128, W_SM + (h < 10 ? 0 : 163840) + hh * 16384, 128, 0, rot, cgw, CNGW, scr, lane); }
                      } else if (mk == 1) {
                          transpose_job(PF(17), PF(3) + ml * D_, D_, 2608, W_MIN, D_, 0, rot, cgw, CNGW, scr, lane);
                          transpose_job(PF(23), nullptr, D_, D_, W_MOUT, D_, 0, rot, cgw, CNGW, scr, lane);
#pragma unroll 1
                          for (int kv = 0; kv < 2; ++kv) {
                              transpose_job(PF(19) + (size_t)kv * 2048 * 64, nullptr, 2048, 64, W_SM + (size_t)kv * 64 * 2048, 2048, 0, rot, cgw, CNGW, scr, lane);
                              transpose_job(PF(21) + (size_t)kv * 4096, nullptr, 64, 64, W_SM + 262144 + kv * 4096, 64, 0, rot, cgw, CNGW, scr, lane); }
                      } else {
                          transpose_job(PF(24), PF(3) + ml * D_, D_, 3088, W_MIN, D_, 0, rot, cgw, CNGW, scr, lane);
                          transpose_job(PF(28), nullptr, D_, D_, W_MOUT, D_, 0, rot, cgw, CNGW, scr, lane); } } } } }
        if (ph + 1 < a.ph_hi) { if (USE_XCD_BAR && (ALL_XCD_BAR || ph != a.ph_lo)) xcd_barrier(xbar); else grid.sync(); }
#ifdef EXTRA_BARS
        if (ph + 1 < a.ph_hi && ph != a.ph_lo) { xcd_barrier(xbar); xcd_barrier(xbar); }
#endif
    }
}

#ifndef N_LAUNCH_MODE
#define N_LAUNCH_MODE 1
#endif
constexpr int N_PHASES = 27;

extern "C" void kernel_launch(void* const* d_in, const int* in_sizes, int n_in, void* d_out, int out_size, void* d_ws, size_t ws_size, hipStream_t stream) {
    static int grid = 0;
    if (grid == 0) {
        if (n_in != 29 || out_size != T_ * D_ || ws_size < WS_END) { fprintf(stderr, "kernel_launch: unexpected problem: n_in %d out %d ws %zu\n", n_in, out_size, ws_size); grid = -1; return; }
        int dev = 0, cus = 0, per_cu = 0;
        hipGetDevice(&dev); hipDeviceGetAttribute(&cus, hipDeviceAttributeMultiprocessorCount, dev);
        if (hipFuncSetAttribute((const void*)mega_fwd, hipFuncAttributeMaxDynamicSharedMemorySize, LDS_BYTES) != hipSuccess) { fprintf(stderr, "kernel_launch: hipFuncSetAttribute failed\n"); grid = -1; return; }
        if (hipOccupancyMaxActiveBlocksPerMultiprocessor(&per_cu, (const void*)mega_fwd, 512, LDS_BYTES) != hipSuccess || per_cu < 1) { fprintf(stderr, "kernel_launch: occupancy query says %d\n", per_cu); per_cu = 1; }
        (void)hipGetLastError();
        grid = cus * 1;
        fprintf(stderr, "kernel_launch: grid %d (cus %d, occupancy %d)\n", grid, cus, per_cu);
    }
    if (grid < 0) return;
    if (hipMemsetAsync((char*)d_ws + WS_CTL, 0, 16384, stream) != hipSuccess) { fprintf(stderr, "kernel_launch: memset failed\n"); return; }
    Args a{};
    const float** p = (const float**)&a;
    for (int i = 0; i < 29; ++i) p[i] = (const float*)d_in[i];
    a.out = (float*)d_out; a.ws = (unsigned char*)d_ws;
#if N_LAUNCH_MODE == 1
    a.ph_lo = 0; a.ph_hi = N_PHASES;
    void* args[] = {&a};
    hipError_t e = hipLaunchCooperativeKernel((const void*)mega_fwd, dim3(grid), dim3(512), args, LDS_BYTES, stream);
    if (e != hipSuccess) fprintf(stderr, "cooperative launch failed: %s (grid %d)\n", hipGetErrorString(e), grid);
#else
#ifndef REPEAT_PH
#define REPEAT_PH -1
#endif
#ifndef REPEAT_N
#define REPEAT_N 1
#endif
#ifndef RUN_UPTO
#define RUN_UPTO (N_PHASES - 1)
#endif
    for (int ph = 0; ph < N_PHASES; ++ph) { if (ph >= RUN_UPTO && ph != N_PHASES - 1) continue; a.ph_lo = ph; a.ph_hi = ph + 1;
        a.dry = 1; for (int rep = 0; rep < REPEAT_N; ++rep) if (ph == REPEAT_PH) hipLaunchKernelGGL(mega_fwd, dim3(grid), dim3(512), LDS_BYTES, stream, a);
        a.dry = 0; hipLaunchKernelGGL(mega_fwd, dim3(grid), dim3(512), LDS_BYTES, stream, a); }
#endif
}
```
